# Optimizing an MI355X kernel written in HIP

```python
import numpy as np
import jax
import jax.numpy as jnp
from jax import lax

D_MODEL = 1024
BATCH = 8
SEQ = 4096
DEPTH = 1

N_MEM = 256
EPS = 1e-6
MLA_HEADS = 8
Q_LORA = 256
KV_LORA = 128
NOPE_DIM = 64
ROPE_DIM = 32
V_DIM = 64
ROPE_THETA = 10000.0
Q_BLOCK = 128
MLSTM_HEADS = 4
MLSTM_HEAD_DIM = 128
MLSTM_WIDTH = MLSTM_HEADS * MLSTM_HEAD_DIM
MLSTM_CHUNK = 128
MLSTM_CONV = 3
MIX_WIDTH = MLA_HEADS * V_DIM + MLSTM_WIDTH
IN_SPLITS = (Q_LORA, KV_LORA, ROPE_DIM, 2 * MLSTM_WIDTH, MLSTM_WIDTH, MLSTM_WIDTH, 4 * MLSTM_HEADS)
IN_WIDTH = sum(IN_SPLITS)
X_HEADS = 4
X_HEAD_DIM = D_MODEL // X_HEADS
D_FF = ((8 * D_MODEL + 767) // 768) * 256

kernel_name = 'hymba_mla_mlstm_memory_encoder_layer'


def rms_norm(x, g):
    xf = x.astype(jnp.float32)
    y = xf * lax.rsqrt(jnp.mean(xf * xf, axis=-1, keepdims=True) + EPS)
    return (y * g.astype(jnp.float32)).astype(x.dtype)


def rope_tables(positions):
    inv = ROPE_THETA ** (-jnp.arange(0, ROPE_DIM, 2, dtype=jnp.float32) / ROPE_DIM)
    ang = positions.astype(jnp.float32)[..., None] * inv
    return jnp.cos(ang), jnp.sin(ang)


def apply_rope(x, cos, sin):
    xf = x.astype(jnp.float32)
    x1, x2 = jnp.split(xf, 2, axis=-1)
    return jnp.concatenate([x1 * cos - x2 * sin, x2 * cos + x1 * sin], axis=-1).astype(x.dtype)


def mla_attention(z_cq, z_ckv, z_kr, q_norm, w_uq, kv_norm, w_ukv, cos, sin):
    B, S, _ = z_cq.shape
    q = (rms_norm(z_cq, q_norm) @ w_uq).reshape(B, S, MLA_HEADS, NOPE_DIM + ROPE_DIM)
    q_nope = q[..., :NOPE_DIM]
    q_rope = apply_rope(q[..., NOPE_DIM:], cos[:, :, None, :], sin[:, :, None, :])
    kv = (rms_norm(z_ckv, kv_norm) @ w_ukv).reshape(B, S, MLA_HEADS, NOPE_DIM + V_DIM)
    k_nope, v = kv[..., :NOPE_DIM], kv[..., NOPE_DIM:]
    k_rope = apply_rope(z_kr, cos, sin)
    scale = (NOPE_DIM + ROPE_DIM) ** -0.5
    nb = S // Q_BLOCK
    qn = q_nope.reshape(B, nb, Q_BLOCK, MLA_HEADS, NOPE_DIM).swapaxes(0, 1)
    qr = q_rope.reshape(B, nb, Q_BLOCK, MLA_HEADS, ROPE_DIM).swapaxes(0, 1)

    def block(args):
        qn_b, qr_b = args
        s = (jnp.einsum('bqhd,bkhd->bhqk', qn_b, k_nope)
             + jnp.einsum('bqhr,bkr->bhqk', qr_b, k_rope))
        p = jax.nn.softmax(s.astype(jnp.float32) * scale, axis=-1).astype(v.dtype)
        return jnp.einsum('bhqk,bkhd->bqhd', p, v)

    o = lax.map(block, (qn, qr))
    return o.swapaxes(0, 1).reshape(B, S, MLA_HEADS * V_DIM)


def centred_dwconv(u, w):
    K = w.shape[0]
    pad = (K - 1) // 2
    S = u.shape[1]
    up = jnp.pad(u, ((0, 0), (pad, pad), (0, 0)))
    out = up[:, 0:S] * w[0]
    for j in range(1, K):
        out = out + up[:, j:j + S] * w[j]
    return out


def mlstm_direction(q, k, v, i_pre, f_pre):
    B, H, S, Dh = q.shape
    L = MLSTM_CHUNK
    NC = S // L
    qc = q.reshape(B, H, NC, L, Dh)
    kc = k.reshape(B, H, NC, L, Dh)
    vc = v.reshape(B, H, NC, L, Dh)
    logf = jax.nn.log_sigmoid(f_pre).reshape(B, H, NC, L)
    logi = i_pre.reshape(B, H, NC, L)
    b = jnp.cumsum(logf, axis=-1)
    tri = jnp.tril(jnp.ones((L, L), dtype=bool))
    log_d = jnp.where(tri, b[..., :, None] - b[..., None, :] + logi[..., None, :], -jnp.inf)
    w_end = b[..., -1:] - b + logi
    m_loc = jnp.max(w_end, axis=-1)
    e_end = jnp.exp(w_end - m_loc[..., None])
    C_loc = jnp.einsum('bhcs,bhcsd,bhcse->bhcde', e_end, vc, kc)
    n_loc = jnp.einsum('bhcs,bhcse->bhce', e_end, kc)
    b_last = b[..., -1]

    def step(carry, inp):
        C, n, m = carry
        Cl, nl, ml, bl = inp
        m_new = jnp.maximum(bl + m, ml)
        a = jnp.exp(bl + m - m_new)
        c = jnp.exp(ml - m_new)
        C_new = a[..., None, None] * C + c[..., None, None] * Cl
        n_new = a[..., None] * n + c[..., None] * nl
        return (C_new, n_new, m_new), (C, n, m)

    init = (jnp.zeros((B, H, Dh, Dh), jnp.float32),
            jnp.zeros((B, H, Dh), jnp.float32),
            jnp.zeros((B, H), jnp.float32))
    xs = (jnp.moveaxis(C_loc, 2, 0), jnp.moveaxis(n_loc, 2, 0),
          jnp.moveaxis(m_loc, 2, 0), jnp.moveaxis(b_last, 2, 0))
    _, (C_prev, n_prev, m_prev) = lax.scan(step, init, xs)
    C_prev = jnp.moveaxis(C_prev, 0, 2)
    n_prev = jnp.moveaxis(n_prev, 0, 2)
    m_prev = jnp.moveaxis(m_prev, 0, 2)

    log_inter = b + m_prev[..., None]
    m_t = jnp.maximum(log_inter, jnp.max(log_d, axis=-1))
    p = jnp.exp(log_d - m_t[..., None])
    a = jnp.exp(log_inter - m_t)
    s = jnp.einsum('bhctd,bhcsd->bhcts', qc, kc) * p
    num = (jnp.einsum('bhcts,bhcsd->bhctd', s, vc)
           + a[..., None] * jnp.einsum('bhcde,bhcte->bhctd', C_prev, qc))
    den = jnp.sum(s, axis=-1) + a * jnp.einsum('bhce,bhcte->bhct', n_prev, qc)
    h = num / jnp.maximum(jnp.abs(den), jnp.exp(-m_t))[..., None]
    return h.reshape(B, H, S, Dh)


def mlstm_mixer(z_qk, z_v, z_o, z_g, conv_w, gate_bias, out_norm):
    B, S, _ = z_qk.shape
    qk = jax.nn.silu(centred_dwconv(z_qk, conv_w))

    def heads(t):
        return t.astype(jnp.float32).reshape(B, S, MLSTM_HEADS, MLSTM_HEAD_DIM).transpose(0, 2, 1, 3)

    q = heads(qk[..., :MLSTM_WIDTH])
    k = heads(qk[..., MLSTM_WIDTH:]) * (MLSTM_HEAD_DIM ** -0.5)
    v = heads(z_v)
    g = (z_g + gate_bias).astype(jnp.float32).transpose(0, 2, 1)
    i_f, f_f, i_b, f_b = jnp.split(g, 4, axis=1)
    h_fwd = mlstm_direction(q, k, v, i_f, f_f)

    def flip(t):
        return jnp.flip(t, axis=2)

    h_bwd = flip(mlstm_direction(flip(q), flip(k), flip(v), flip(i_b), flip(f_b)))
    h = (h_fwd + h_bwd).transpose(0, 2, 1, 3)
    h = rms_norm(h, out_norm.reshape(MLSTM_HEADS, MLSTM_HEAD_DIM))
    out = jax.nn.sigmoid(z_o.astype(jnp.float32)) * h.reshape(B, S, MLSTM_WIDTH)
    return out.astype(z_o.dtype)


def cross_attention(h, mem_n, w_xq, w_xkv, w_xo):
    B, S, _ = h.shape
    M = mem_n.shape[1]
    q = (h @ w_xq).reshape(B, S, X_HEADS, X_HEAD_DIM)
    kv = (mem_n @ w_xkv).reshape(B, M, 2, X_HEADS, X_HEAD_DIM)
    k, v = kv[:, :, 0], kv[:, :, 1]
    s = jnp.einsum('bqhd,bmhd->bhqm', q, k).astype(jnp.float32) * (X_HEAD_DIM ** -0.5)
    p = jax.nn.softmax(s, axis=-1).astype(v.dtype)
    o = jnp.einsum('bhqm,bmhd->bqhd', p, v).reshape(B, S, X_HEADS * X_HEAD_DIM)
    return o @ w_xo


def swiglu(h, w_gate_up, w_down):
    g, u = jnp.split(h @ w_gate_up, 2, axis=-1)
    return (jax.nn.silu(g) * u) @ w_down


def setup_inputs(seed: int = 0) -> dict:
    key = jax.random.key(seed)
    ks = jax.random.split(key, 26)
    f32 = jnp.float32

    def w(k, shape, fan_in):
        return jax.random.normal(k, shape, f32) * (fan_in ** -0.5)

    def gain(k, shape):
        return 1.0 + 0.02 * jax.random.normal(k, shape, f32)

    x = jax.random.normal(ks[0], (BATCH, SEQ, D_MODEL), f32)
    mem = jax.random.normal(ks[1], (BATCH, N_MEM, D_MODEL), f32)
    offsets = jax.random.randint(ks[2], (BATCH, 1), 0, 2048, dtype=jnp.int32)
    positions = (offsets + jnp.arange(SEQ, dtype=jnp.int32)[None, :]).astype(jnp.int32)
    i_bias_f = 0.1 * jax.random.normal(ks[3], (DEPTH, MLSTM_HEADS), f32)
    i_bias_b = 0.1 * jax.random.normal(ks[4], (DEPTH, MLSTM_HEADS), f32)
    f_base = jnp.linspace(3.0, 6.0, MLSTM_HEADS, dtype=f32)[None, :]
    f_bias_f = f_base + 0.01 * jax.random.normal(ks[5], (DEPTH, MLSTM_HEADS), f32)
    f_bias_b = f_base + 0.01 * jax.random.normal(ks[6], (DEPTH, MLSTM_HEADS), f32)
    mlstm_gate_bias = jnp.concatenate([i_bias_f, f_bias_f, i_bias_b, f_bias_b], axis=-1)
    return {
        'x': x,
        'mem': mem,
        'positions': positions,
        'attn_norm': gain(ks[7], (DEPTH, D_MODEL)),
        'w_in': w(ks[8], (DEPTH, D_MODEL, IN_WIDTH), D_MODEL),
        'q_norm': gain(ks[9], (DEPTH, Q_LORA)),
        'w_uq': w(ks[10], (DEPTH, Q_LORA, MLA_HEADS * (NOPE_DIM + ROPE_DIM)), Q_LORA),
        'kv_norm': gain(ks[11], (DEPTH, KV_LORA)),
        'w_ukv': w(ks[12], (DEPTH, KV_LORA, MLA_HEADS * (NOPE_DIM + V_DIM)), KV_LORA),
        'mlstm_conv': w(ks[13], (DEPTH, MLSTM_CONV, 2 * MLSTM_WIDTH), MLSTM_CONV),
        'mlstm_gate_bias': mlstm_gate_bias,
        'mlstm_norm': gain(ks[14], (DEPTH, MLSTM_WIDTH)),
        'w_out': w(ks[15], (DEPTH, MIX_WIDTH, D_MODEL), MIX_WIDTH),
        'xattn_norm': gain(ks[16], (DEPTH, D_MODEL)),
        'mem_norm': gain(ks[17], (DEPTH, D_MODEL)),
        'w_xq': w(ks[18], (DEPTH, D_MODEL, X_HEADS * X_HEAD_DIM), D_MODEL),
        'w_xkv': w(ks[19], (DEPTH, D_MODEL, 2 * X_HEADS * X_HEAD_DIM), D_MODEL),
        'w_xo': w(ks[20], (DEPTH, X_HEADS * X_HEAD_DIM, D_MODEL), X_HEADS * X_HEAD_DIM),
        'ffn_norm': gain(ks[21], (DEPTH, D_MODEL)),
        'w_gate_up': w(ks[22], (DEPTH, D_MODEL, 2 * D_FF), D_MODEL),
        'w_down': w(ks[23], (DEPTH, D_FF, D_MODEL), D_FF),
        'final_norm': gain(ks[24], (D_MODEL,)),
    }


def reference(x, mem, positions, attn_norm, w_in, q_norm, w_uq, kv_norm, w_ukv,
              mlstm_conv, mlstm_gate_bias, mlstm_norm, w_out, xattn_norm, mem_norm,
              w_xq, w_xkv, w_xo, ffn_norm, w_gate_up, w_down, final_norm):
    cos, sin = rope_tables(positions)
    split_idx = [int(c) for c in np.cumsum(IN_SPLITS)[:-1]]
    for l in range(DEPTH):
        h = rms_norm(x, attn_norm[l])
        z_cq, z_ckv, z_kr, z_qk, z_v, z_o, z_g = jnp.split(h @ w_in[l], split_idx, axis=-1)
        y_mla = mla_attention(z_cq, z_ckv, z_kr, q_norm[l], w_uq[l], kv_norm[l], w_ukv[l], cos, sin)
        y_mlstm = mlstm_mixer(z_qk, z_v, z_o, z_g, mlstm_conv[l], mlstm_gate_bias[l], mlstm_norm[l])
        x = x + jnp.concatenate([y_mla, y_mlstm], axis=-1) @ w_out[l]
        x = x + cross_attention(rms_norm(x, xattn_norm[l]), rms_norm(mem, mem_norm[l]),
                                w_xq[l], w_xkv[l], w_xo[l])
        x = x + swiglu(rms_norm(x, ffn_norm[l]), w_gate_up[l], w_down[l])
    return rms_norm(x, final_norm)
```

```cpp
#include <hip/hip_runtime.h>
#include <cstdio>
#include <cstdint>

constexpr int BATCH = 8, SEQ = 4096, DM = 1024, T = BATCH * SEQ;
constexpr int NMEM = 256, TM = BATCH * NMEM;
constexpr float EPS = 1e-6f;
constexpr int MLA_H = 8, QLORA = 256, KVLORA = 128, NOPE = 64, ROPE = 32, VD = 64, DQK = NOPE + ROPE;
constexpr int ML_H = 4, ML_D = 128, ML_W = 512;
constexpr int XH = 4, XD = 256;
constexpr int DFF = 2816;
constexpr int INW = 2480;
constexpr int LDZ = 2560, ZC_CQ = 0, ZC_CKV = 256, ZC_KR = 384, ZC_G = 416, ZC_QK = 512, ZC_V = 1536, ZC_O = 2048;
constexpr int NWAVES = 8, NTHR = 512;

constexpr size_t MiB = 1u << 20;
constexpr size_t WS_CTL = 0;
constexpr size_t WS_WIN = 1 * MiB;
constexpr size_t WS_WUQ = 6 * MiB;
constexpr size_t WS_WUKV = 7 * MiB;
constexpr size_t WS_WOUT = 8 * MiB;
constexpr size_t WS_WXQ = 10 * MiB;
constexpr size_t WS_WXKV = 12 * MiB;
constexpr size_t WS_WXO = 16 * MiB;
constexpr size_t WS_WGU = 18 * MiB;
constexpr size_t WS_WD = 30 * MiB;
constexpr size_t WS_COS = 36 * MiB;
constexpr size_t WS_SIN = 38 * MiB;
constexpr size_t WS_G = 40 * MiB;
constexpr size_t WS_KR = 42 * MiB;
constexpr size_t WS_SSQ = 44 * MiB;
constexpr size_t WS_MEMN = 46 * MiB;
constexpr size_t WS_KVM = 50 * MiB;
constexpr size_t WS_XB = 64 * MiB;
constexpr size_t WS_Z = 128 * MiB;
constexpr size_t WS_H = 128 * MiB;
constexpr size_t WS_QALL = 288 * MiB;
constexpr size_t WS_KV = 336 * MiB;
constexpr size_t WS_Y = 400 * MiB;
constexpr size_t WS_HQ = 304 * MiB;
constexpr size_t WS_OX = 368 * MiB;
constexpr size_t WS_END = 464 * MiB;

typedef unsigned short bf16_t;
typedef short bf16x8 __attribute__((ext_vector_type(8)));
typedef float f32x4 __attribute__((ext_vector_type(4)));
typedef unsigned u32x4 __attribute__((ext_vector_type(4)));
typedef unsigned u32x2 __attribute__((ext_vector_type(2)));
#define LAS __attribute__((address_space(3)))

__device__ __forceinline__ float bf2f(bf16_t h) { return __uint_as_float(((unsigned)h) << 16); }
__device__ __forceinline__ unsigned f2bf(float f) { unsigned u = __float_as_uint(f); return (u + 0x7fffu + ((u >> 16) & 1u)) >> 16; }
__device__ __forceinline__ unsigned pk2(float lo, float hi) { return f2bf(lo) | (f2bf(hi) << 16); }
__device__ __forceinline__ float wave_sum(float v) {
#pragma unroll
    for (int o = 1; o < 64; o <<= 1) v += __shfl_xor(v, o);
    return v;
}
__device__ __forceinline__ float wave_max(float v) {
#pragma unroll
    for (int o = 1; o < 64; o <<= 1) v = fmaxf(v, __shfl_xor(v, o));
    return v;
}

struct Params {
    const float* x; const float* mem; const int* pos;
    const float *attn_norm, *w_in, *q_norm, *w_uq, *kv_norm, *w_ukv, *conv, *gbias, *ml_norm, *w_out, *xattn_norm, *mem_norm, *w_xq, *w_xkv, *w_xo, *ffn_norm, *w_gu, *w_down, *final_norm;
    float* out; unsigned char* ws; unsigned char* ws2;
    int ph_lo, ph_hi;
};

struct Unit { int pm, pn; };
struct Gemm { const bf16_t* A; int lda; const bf16_t* Bt; int ldb; int M, N, K; };

template <class Epi>
__device__ __forceinline__ void gemm_naive(const Gemm g, const Epi& E) {
    const int tid = threadIdx.x, wid = tid >> 6, lane = tid & 63, wr = wid >> 2, wc = wid & 3, fr = lane & 15, fq = lane >> 4;
    const int nM = g.M / 256, nN = g.N / 256;
    for (int unit = blockIdx.x; unit < nM * nN; unit += gridDim.x) {
        Unit u; u.pm = unit / nN; u.pn = unit % nN;
        f32x4 acc[2][2][4][2];
#pragma unroll
        for (int a = 0; a < 2; ++a)
#pragma unroll
            for (int b = 0; b < 2; ++b)
#pragma unroll
                for (int m = 0; m < 4; ++m)
#pragma unroll
                    for (int n = 0; n < 2; ++n) acc[a][b][m][n] = (f32x4){0.f, 0.f, 0.f, 0.f};
        const bf16_t* Ab = g.A + (size_t)(u.pm * 256 + wr * 64 + fr) * g.lda + 8 * fq;
        const bf16_t* Bb = g.Bt + (size_t)(u.pn * 256 + wc * 32 + 8 * (fr >> 2) + (fr & 3)) * g.ldb + 8 * fq;
        for (int kk = 0; kk < g.K; kk += 32) {
            bf16x8 a[2][4], b[2][2];
#pragma unroll
            for (int ai = 0; ai < 2; ++ai)
#pragma unroll
                for (int m = 0; m < 4; ++m) a[ai][m] = *(const bf16x8*)(Ab + (size_t)(ai * 128 + m * 16) * g.lda + kk);
#pragma unroll
            for (int bj = 0; bj < 2; ++bj)
#pragma unroll
                for (int n = 0; n < 2; ++n) b[bj][n] = *(const bf16x8*)(Bb + (size_t)(bj * 128 + 4 * n) * g.ldb + kk);
#pragma unroll
            for (int ai = 0; ai < 2; ++ai)
#pragma unroll
                for (int bj = 0; bj < 2; ++bj)
#pragma unroll
                    for (int m = 0; m < 4; ++m)
#pragma unroll
                        for (int n = 0; n < 2; ++n) acc[ai][bj][m][n] = __builtin_amdgcn_mfma_f32_16x16x32_bf16(b[bj][n], a[ai][m], acc[ai][bj][m][n], 0, 0, 0);
        }
        E(acc, u, wr, wc, fr, fq);
    }
}

__device__ __forceinline__ u32x4 pack8(const f32x4 v0, const f32x4 v1) { u32x4 w; w.x = pk2(v0[0], v0[1]); w.y = pk2(v0[2], v0[3]); w.z = pk2(v1[0], v1[1]); w.w = pk2(v1[2], v1[3]); return w; }
__device__ __forceinline__ float sq8(const f32x4 a, const f32x4 b) { return (a[0] * a[0] + a[1] * a[1]) + (a[2] * a[2] + a[3] * a[3]) + (b[0] * b[0] + b[1] * b[1]) + (b[2] * b[2] + b[3] * b[3]); }

struct EpiZ {
    bf16_t* Z; float* ssq_q; float* ssq_kv; bf16_t* KR; float* G; const float* cosT; const float* sinT;
    __device__ __forceinline__ void operator()(const f32x4 (&acc)[2][2][4][2], const Unit& u, int wr, int wc, int fr, int fq) const {
#pragma unroll
        for (int ai = 0; ai < 2; ++ai)
#pragma unroll
            for (int m = 0; m < 4; ++m) {
                const int row = u.pm * 256 + ai * 128 + wr * 64 + m * 16 + fr;
                bf16_t* zp = Z + (size_t)row * LDZ + u.pn * 256 + wc * 32 + 8 * fq;
#pragma unroll
                for (int bj = 0; bj < 2; ++bj) *(u32x4*)(zp + bj * 128) = pack8(acc[ai][bj][m][0], acc[ai][bj][m][1]);
                if (u.pn == 0) {
                    float s = sq8(acc[ai][0][m][0], acc[ai][0][m][1]) + sq8(acc[ai][1][m][0], acc[ai][1][m][1]);
                    s += __shfl_xor(s, 16); s += __shfl_xor(s, 32);
                    if (fq == 0) atomicAdd(ssq_q + row, s);
                } else if (u.pn == 1) {
                    float s = sq8(acc[ai][0][m][0], acc[ai][0][m][1]);
                    s += __shfl_xor(s, 16); s += __shfl_xor(s, 32);
                    if (fq == 0) atomicAdd(ssq_kv + row, s);
                    if (wc == 0) {
                        const f32x4 o0 = acc[ai][1][m][0], o1 = acc[ai][1][m][1];
                        f32x4 p0, p1;
#pragma unroll
                        for (int j = 0; j < 4; ++j) { p0[j] = __shfl_xor(o0[j], 32); p1[j] = __shfl_xor(o1[j], 32); }
                        const int jj = 8 * (fq & 1);
                        const f32x4 c0 = *(const f32x4*)(cosT + (size_t)row * 16 + jj), c1 = *(const f32x4*)(cosT + (size_t)row * 16 + jj + 4);
                        const f32x4 s0 = *(const f32x4*)(sinT + (size_t)row * 16 + jj), s1 = *(const f32x4*)(sinT + (size_t)row * 16 + jj + 4);
                        f32x4 r0, r1;
                        if (fq < 2) { r0 = o0 * c0 - p0 * s0; r1 = o1 * c1 - p1 * s1; }
                        else        { r0 = o0 * c0 + p0 * s0; r1 = o1 * c1 + p1 * s1; }
                        *(u32x4*)(KR + (size_t)row * 32 + 8 * fq) = pack8(r0, r1);
                    } else if (wc == 1 && fq < 2) {
                        *(f32x4*)(G + (size_t)row * 16 + 8 * fq) = acc[ai][1][m][0];
                        *(f32x4*)(G + (size_t)row * 16 + 8 * fq + 4) = acc[ai][1][m][1];
                    }
                }
            }
    }
};
struct EpiScaleBf16 {
    bf16_t* O; int ldo; const float* ssq; float inv_n; float c;
    __device__ __forceinline__ void operator()(const f32x4 (&acc)[2][2][4][2], const Unit& u, int wr, int wc, int fr, int fq) const {
#pragma unroll
        for (int ai = 0; ai < 2; ++ai)
#pragma unroll
            for (int m = 0; m < 4; ++m) {
                const int row = u.pm * 256 + ai * 128 + wr * 64 + m * 16 + fr;
                const float sc = ssq ? c * rsqrtf(ssq[row] * inv_n + EPS) : c;
                bf16_t* op = O + (size_t)row * ldo + u.pn * 256 + wc * 32 + 8 * fq;
#pragma unroll
                for (int bj = 0; bj < 2; ++bj) *(u32x4*)(op + bj * 128) = pack8(acc[ai][bj][m][0] * sc, acc[ai][bj][m][1] * sc);
            }
    }
};
struct EpiResid {
    const float* res; float* out; bf16_t* XB; float* ssq;
    __device__ __forceinline__ void operator()(const f32x4 (&acc)[2][2][4][2], const Unit& u, int wr, int wc, int fr, int fq) const {
#pragma unroll
        for (int ai = 0; ai < 2; ++ai)
#pragma unroll
            for (int m = 0; m < 4; ++m) {
                const int row = u.pm * 256 + ai * 128 + wr * 64 + m * 16 + fr;
                const size_t off = (size_t)row * DM + u.pn * 256 + wc * 32 + 8 * fq;
                float s = 0.f;
#pragma unroll
                for (int bj = 0; bj < 2; ++bj) {
                    const f32x4 v0 = *(const f32x4*)(res + off + bj * 128) + acc[ai][bj][m][0];
                    const f32x4 v1 = *(const f32x4*)(res + off + bj * 128 + 4) + acc[ai][bj][m][1];
                    *(f32x4*)(out + off + bj * 128) = v0; *(f32x4*)(out + off + bj * 128 + 4) = v1;
                    if (XB) *(u32x4*)(XB + off + bj * 128) = pack8(v0, v1);
                    s += sq8(v0, v1);
                }
                s += __shfl_xor(s, 16); s += __shfl_xor(s, 32);
                if (fq == 0) atomicAdd(ssq + row, s);
            }
    }
};
struct EpiSwiglu {
    bf16_t* H; const float* ssq;
    __device__ __forceinline__ void operator()(const f32x4 (&acc)[2][2][4][2], const Unit& u, int wr, int wc, int fr, int fq) const {
#pragma unroll
        for (int ai = 0; ai < 2; ++ai)
#pragma unroll
            for (int m = 0; m < 4; ++m) {
                const int row = u.pm * 256 + ai * 128 + wr * 64 + m * 16 + fr;
                const float sc = rsqrtf(ssq[row] * (1.0f / DM) + EPS);
                f32x4 h[2];
#pragma unroll
                for (int n = 0; n < 2; ++n)
#pragma unroll
                    for (int j = 0; j < 4; ++j) { const float gg = acc[ai][0][m][n][j] * sc, uu = acc[ai][1][m][n][j] * sc; h[n][j] = gg * uu / (1.0f + __expf(-gg)); }
                *(u32x4*)(H + (size_t)row * DFF + u.pn * 128 + wc * 32 + 8 * fq) = pack8(h[0], h[1]);
            }
    }
};

struct MapIdent { __device__ __forceinline__ int operator()(int n) const { return n; } };
struct MapWin { __device__ __forceinline__ int operator()(int n) const {
    if (n < 416) return n; if (n < 1440) return ZC_QK + (n - 416); if (n < 1952) return ZC_V + (n - 1440); if (n < 2464) return ZC_O + (n - 1952); return ZC_G + (n - 2464); } };
struct MapGU { __device__ __forceinline__ int operator()(int n) const { const int up = n >= DFF, j = up ? n - DFF : n; return (j >> 7) * 256 + up * 128 + (j & 127); } };

template <class Map>
__device__ __forceinline__ void transpose_w(const float* W, int K, int N, const float* gain, bf16_t* WT, int ldt, Map map, LAS float* scr, int gw, int ngw, int lane) {
    const int nblk = (N + 31) / 32, nitems = (K / 64) * nblk;
    for (int it = gw; it < nitems; it += ngw) {
        const int kb = it / nblk, nb = it % nblk, k0 = 64 * kb, n0 = 32 * nb;
        for (int i = 0; i < 32; ++i) { const int kk = 2 * i + (lane >> 5), nn = n0 + (lane & 31);
            float v = 0.f; if (nn < N) { v = W[(size_t)(k0 + kk) * N + nn]; if (gain) v *= gain[k0 + kk]; }
            scr[kk * 33 + (lane & 31)] = v; }
        asm volatile("s_waitcnt lgkmcnt(0)" ::: "memory");
        const int c = lane & 7;
#pragma unroll
        for (int j = 0; j < 4; ++j) { const int n = (lane >> 3) + 8 * j, nn = n0 + n;
            if (nn < N) { const LAS float* s = scr + (8 * c) * 33 + n;
                u32x4 o; o.x = pk2(s[0 * 33], s[1 * 33]); o.y = pk2(s[2 * 33], s[3 * 33]); o.z = pk2(s[4 * 33], s[5 * 33]); o.w = pk2(s[6 * 33], s[7 * 33]);
                *(u32x4*)(WT + (size_t)map(nn) * ldt + k0 + 8 * c) = o; } }
        asm volatile("s_waitcnt lgkmcnt(0)" ::: "memory");
    }
}
__device__ __forceinline__ void rms_row_bf16(const float* xrow, const float* gain, bf16_t* orow, int lane) {
    const f32x4* xr = (const f32x4*)xrow + lane; const f32x4* gr = (const f32x4*)gain + lane;
    f32x4 v[4]; float s = 0.f;
#pragma unroll
    for (int j = 0; j < 4; ++j) { v[j] = xr[64 * j]; s += (v[j][0] * v[j][0] + v[j][1] * v[j][1]) + (v[j][2] * v[j][2] + v[j][3] * v[j][3]); }
    const float r = rsqrtf(wave_sum(s) * (1.0f / DM) + EPS);
    u32x2* o8 = (u32x2*)orow + lane;
#pragma unroll
    for (int j = 0; j < 4; ++j) { const f32x4 gg = gr[64 * j]; u32x2 w; w.x = pk2(v[j][0] * r * gg[0], v[j][1] * r * gg[1]); w.y = pk2(v[j][2] * r * gg[2], v[j][3] * r * gg[3]); o8[64 * j] = w; }
}

__device__ __forceinline__ void phase0(const Params& p, LAS unsigned char* lds) {
    const int tid = threadIdx.x, wid = tid >> 6, lane = tid & 63;
    const int gw = blockIdx.x * NWAVES + wid, ngw = gridDim.x * NWAVES;
    const int gt = blockIdx.x * NTHR + tid, ngt = gridDim.x * NTHR;
    LAS float* scr = (LAS float*)(lds + wid * 16384);
    unsigned char* ws = p.ws;
    transpose_w(p.w_in, DM, INW, nullptr, (bf16_t*)(ws + WS_WIN), DM, MapWin(), scr, gw, ngw, lane);
    transpose_w(p.w_uq, QLORA, MLA_H * DQK, p.q_norm, (bf16_t*)(ws + WS_WUQ), QLORA, MapIdent(), scr, gw, ngw, lane);
    transpose_w(p.w_ukv, KVLORA, MLA_H * (NOPE + VD), p.kv_norm, (bf16_t*)(ws + WS_WUKV), 256, MapIdent(), scr, gw, ngw, lane);
    transpose_w(p.w_out, DM, DM, nullptr, (bf16_t*)(ws + WS_WOUT), DM, MapIdent(), scr, gw, ngw, lane);
    transpose_w(p.w_xq, DM, DM, p.xattn_norm, (bf16_t*)(ws + WS_WXQ), DM, MapIdent(), scr, gw, ngw, lane);
    transpose_w(p.w_xkv, DM, 2 * DM, nullptr, (bf16_t*)(ws + WS_WXKV), DM, MapIdent(), scr, gw, ngw, lane);
    transpose_w(p.w_xo, DM, DM, nullptr, (bf16_t*)(ws + WS_WXO), DM, MapIdent(), scr, gw, ngw, lane);
    transpose_w(p.w_gu, DM, 2 * DFF, p.ffn_norm, (bf16_t*)(ws + WS_WGU), DM, MapGU(), scr, gw, ngw, lane);
    transpose_w(p.w_down, DFF, DM, nullptr, (bf16_t*)(ws + WS_WD), DFF, MapIdent(), scr, gw, ngw, lane);
    { bf16_t* wz = (bf16_t*)(ws + WS_WIN) + (size_t)432 * DM; for (int i = gt; i < 80 * DM / 8; i += ngt) ((u32x4*)wz)[i] = (u32x4){0u, 0u, 0u, 0u};
      bf16_t* wk = (bf16_t*)(ws + WS_WUKV); for (int i = gt; i < 1024 * 16; i += ngt) { const int r = i >> 4, c = i & 15; *(u32x4*)(wk + (size_t)r * 256 + 128 + 8 * c) = (u32x4){0u, 0u, 0u, 0u}; } }
    { float* ssq = (float*)(ws + WS_SSQ); for (int i = gt; i < 5 * T; i += ngt) ssq[i] = 0.f; }
    { float* ct = (float*)(ws + WS_COS); float* st = (float*)(ws + WS_SIN);
      for (int i = gt; i < T * 16; i += ngt) { const int row = i >> 4, j = i & 15; const float inv = (float)pow(10000.0, -(double)(2 * j) / 32.0); const float ang = (float)p.pos[row] * inv; ct[i] = cosf(ang); st[i] = sinf(ang); } }
    for (int r = gw; r < T; r += ngw) rms_row_bf16(p.x + (size_t)r * DM, p.attn_norm, (bf16_t*)(ws + WS_XB) + (size_t)r * DM, lane);
    for (int r = gw; r < TM; r += ngw) rms_row_bf16(p.mem + (size_t)r * DM, p.mem_norm, (bf16_t*)(ws + WS_MEMN) + (size_t)r * DM, lane);
}

__device__ __forceinline__ void phase_conv(const Params& p) {
    const bf16_t* Z = (const bf16_t*)(p.ws + WS_Z); bf16_t* Q = (bf16_t*)p.ws2;
    const int gt = blockIdx.x * NTHR + threadIdx.x, ngt = gridDim.x * NTHR;
    for (int i = gt; i < T * 128; i += ngt) {
        const int row = i >> 7, c0 = (i & 127) * 8, t = row & (SEQ - 1);
        const bf16x8 zc = *(const bf16x8*)(Z + (size_t)row * LDZ + ZC_QK + c0);
        bf16x8 zp = (bf16x8){0, 0, 0, 0, 0, 0, 0, 0}, zn = zp;
        if (t > 0) zp = *(const bf16x8*)(Z + (size_t)(row - 1) * LDZ + ZC_QK + c0);
        if (t < SEQ - 1) zn = *(const bf16x8*)(Z + (size_t)(row + 1) * LDZ + ZC_QK + c0);
        const float sc = c0 >= 512 ? 0.08838834764831845f : 1.0f;
        float o[8];
#pragma unroll
        for (int j = 0; j < 8; ++j) { const float a = p.conv[c0 + j] * bf2f((bf16_t)zp[j]) + p.conv[1024 + c0 + j] * bf2f((bf16_t)zc[j]) + p.conv[2048 + c0 + j] * bf2f((bf16_t)zn[j]);
            o[j] = a / (1.0f + __expf(-a)) * sc; }
        u32x4 w; w.x = pk2(o[0], o[1]); w.y = pk2(o[2], o[3]); w.z = pk2(o[4], o[5]); w.w = pk2(o[6], o[7]);
        *(u32x4*)(Q + (size_t)row * 1024 + c0) = w;
    }
}

__device__ __forceinline__ void mlstm_naive(const Params& p) {
    const bf16_t* Z = (const bf16_t*)(p.ws + WS_Z); const bf16_t* QKC = (const bf16_t*)p.ws2; const float* G = (const float*)(p.ws + WS_G);
    float* HF = p.out; float* HB = p.out + (size_t)T * ML_W;
    const int tid = threadIdx.x, d = tid >> 2, eq = tid & 3;
    for (int unit = blockIdx.x; unit < BATCH * ML_H * 2; unit += gridDim.x) {
        const int dir = unit & 1, h = (unit >> 1) & 3, b = unit >> 3;
        float C[32], n[32]; float m = 0.f;
#pragma unroll
        for (int j = 0; j < 32; ++j) { C[j] = 0.f; n[j] = 0.f; }
        const float bi = p.gbias[dir * 8 + h], bff = p.gbias[dir * 8 + 4 + h];
        float* Hout = dir ? HB : HF;
        for (int s = 0; s < SEQ; ++s) {
            const int t = dir ? SEQ - 1 - s : s; const size_t row = (size_t)b * SEQ + t;
            const float ip = G[row * 16 + dir * 8 + h] + bi, fp = G[row * 16 + dir * 8 + 4 + h] + bff;
            const float logf = fminf(fp, 0.f) - log1pf(__expf(-fabsf(fp)));
            const float mn = fmaxf(logf + m, ip), fe = __expf(logf + m - mn), ie = __expf(ip - mn);
            m = mn;
            const float vv = bf2f(Z[row * LDZ + ZC_V + h * 128 + d]) * ie;
            float pn = 0.f, pd = 0.f;
#pragma unroll
            for (int c = 0; c < 4; ++c) {
                const bf16x8 q8 = *(const bf16x8*)(QKC + row * 1024 + h * 128 + eq * 32 + c * 8);
                const bf16x8 k8 = *(const bf16x8*)(QKC + row * 1024 + 512 + h * 128 + eq * 32 + c * 8);
#pragma unroll
                for (int j = 0; j < 8; ++j) { const float qq = bf2f((bf16_t)q8[j]), kk = bf2f((bf16_t)k8[j]);
                    C[c * 8 + j] = fe * C[c * 8 + j] + vv * kk; n[c * 8 + j] = fe * n[c * 8 + j] + ie * kk;
                    pn += C[c * 8 + j] * qq; pd += n[c * 8 + j] * qq; }
            }
            pn += __shfl_xor(pn, 1); pn += __shfl_xor(pn, 2); pd += __shfl_xor(pd, 1); pd += __shfl_xor(pd, 2);
            if (eq == 0) Hout[row * ML_W + h * 128 + d] = pn / fmaxf(fabsf(pd), __expf(-mn));
        }
    }
}
__device__ __forceinline__ void phase_mlfin(const Params& p) {
    const bf16_t* Z = (const bf16_t*)(p.ws + WS_Z); bf16_t* Y = (bf16_t*)(p.ws + WS_Y);
    const float* HF = p.out; const float* HB = p.out + (size_t)T * ML_W;
    const int wid = threadIdx.x >> 6, lane = threadIdx.x & 63;
    for (int row = blockIdx.x * NWAVES + wid; row < T; row += gridDim.x * NWAVES) {
        const size_t o = (size_t)row * ML_W + lane * 8;
        const f32x4 a0 = *(const f32x4*)(HF + o) + *(const f32x4*)(HB + o), a1 = *(const f32x4*)(HF + o + 4) + *(const f32x4*)(HB + o + 4);
        float s = sq8(a0, a1);
        s += __shfl_xor(s, 1); s += __shfl_xor(s, 2); s += __shfl_xor(s, 4); s += __shfl_xor(s, 8);
        const float r = rsqrtf(s * (1.0f / ML_D) + EPS);
        const bf16x8 zo = *(const bf16x8*)(Z + (size_t)row * LDZ + ZC_O + lane * 8);
        const f32x4 g0 = *(const f32x4*)(p.ml_norm + lane * 8), g1 = *(const f32x4*)(p.ml_norm + lane * 8 + 4);
        float ov[8];
#pragma unroll
        for (int j = 0; j < 8; ++j) { const float hv = (j < 4 ? a0[j] : a1[j - 4]) * r * (j < 4 ? g0[j] : g1[j - 4]); const float z = bf2f((bf16_t)zo[j]); ov[j] = hv / (1.0f + __expf(-z)); }
        u32x4 w; w.x = pk2(ov[0], ov[1]); w.y = pk2(ov[2], ov[3]); w.z = pk2(ov[4], ov[5]); w.w = pk2(ov[6], ov[7]);
        *(u32x4*)(Y + (size_t)row * DM + 512 + lane * 8) = w;
    }
}

__device__ __forceinline__ void mla_attn_naive(const Params& p, LAS unsigned char* lds) {
    const bf16_t* QALL = (const bf16_t*)(p.ws + WS_QALL); const bf16_t* KV = (const bf16_t*)(p.ws + WS_KV); const bf16_t* KR = (const bf16_t*)(p.ws + WS_KR);
    const float* cosT = (const float*)(p.ws + WS_COS); const float* sinT = (const float*)(p.ws + WS_SIN); bf16_t* Y = (bf16_t*)(p.ws + WS_Y);
    const int wid = threadIdx.x >> 6, lane = threadIdx.x & 63;
    LAS float* sc = (LAS float*)(lds + wid * 16384);
    LAS float* qs = (LAS float*)(lds + 131072 + wid * 512);
    const float scale = 0.10206207261596575f;
    for (int item = blockIdx.x * NWAVES + wid; item < T * MLA_H; item += gridDim.x * NWAVES) {
        const int h = item & 7, row = item >> 3, b = row / SEQ;
        for (int dd = lane; dd < DQK; dd += 64) {
            float v = bf2f(QALL[(size_t)row * 768 + h * DQK + dd]);
            if (dd >= NOPE) { const int j = (dd - NOPE) & 15; const float c = cosT[(size_t)row * 16 + j], s = sinT[(size_t)row * 16 + j];
                const float other = bf2f(QALL[(size_t)row * 768 + h * DQK + (dd < NOPE + 16 ? dd + 16 : dd - 16)]);
                v = dd < NOPE + 16 ? v * c - other * s : v * c + other * s; }
            qs[dd] = v * scale;
        }
        asm volatile("s_waitcnt lgkmcnt(0)" ::: "memory");
        float mx = -1e30f;
        for (int k0 = 0; k0 < SEQ; k0 += 64) {
            const size_t kr = (size_t)b * SEQ + k0 + lane; float s = 0.f;
#pragma unroll
            for (int c = 0; c < 8; ++c) { const bf16x8 k8 = *(const bf16x8*)(KV + kr * 1024 + h * 128 + c * 8);
#pragma unroll
                for (int j = 0; j < 8; ++j) s += qs[c * 8 + j] * bf2f((bf16_t)k8[j]); }
#pragma unroll
            for (int c = 0; c < 4; ++c) { const bf16x8 k8 = *(const bf16x8*)(KR + kr * 32 + c * 8);
#pragma unroll
                for (int j = 0; j < 8; ++j) s += qs[NOPE + c * 8 + j] * bf2f((bf16_t)k8[j]); }
            sc[k0 + lane] = s; mx = fmaxf(mx, s);
        }
        mx = wave_max(mx);
        float l = 0.f;
        for (int k0 = 0; k0 < SEQ; k0 += 64) { const float e = __expf(sc[k0 + lane] - mx); sc[k0 + lane] = e; l += e; }
        l = wave_sum(l);
        asm volatile("s_waitcnt lgkmcnt(0)" ::: "memory");
        float o = 0.f;
        for (int k = 0; k < SEQ; ++k) o += sc[k] * bf2f(KV[((size_t)b * SEQ + k) * 1024 + h * 128 + 64 + lane]);
        Y[(size_t)row * DM + h * VD + lane] = (bf16_t)f2bf(o / l);
        asm volatile("s_waitcnt lgkmcnt(0)" ::: "memory");
    }
}
__device__ __forceinline__ void x_attn_naive(const Params& p, LAS unsigned char* lds) {
    const bf16_t* HQ = (const bf16_t*)(p.ws + WS_HQ); const bf16_t* KVM = (const bf16_t*)(p.ws + WS_KVM); bf16_t* OX = (bf16_t*)(p.ws + WS_OX);
    const int wid = threadIdx.x >> 6, lane = threadIdx.x & 63;
    LAS float* sc = (LAS float*)(lds + wid * 16384);
    LAS float* qs = (LAS float*)(lds + 131072 + wid * 1024);
    for (int item = blockIdx.x * NWAVES + wid; item < T * XH; item += gridDim.x * NWAVES) {
        const int h = item & 3, row = item >> 2, b = row / SEQ;
        for (int dd = lane; dd < XD; dd += 64) qs[dd] = bf2f(HQ[(size_t)row * DM + h * XD + dd]) * 0.0625f;
        asm volatile("s_waitcnt lgkmcnt(0)" ::: "memory");
        float mx = -1e30f;
        for (int k0 = 0; k0 < NMEM; k0 += 64) {
            const size_t kr = (size_t)b * NMEM + k0 + lane; float s = 0.f;
            for (int c = 0; c < 32; ++c) { const bf16x8 k8 = *(const bf16x8*)(KVM + kr * 2048 + h * XD + c * 8);
#pragma unroll
                for (int j = 0; j < 8; ++j) s += qs[c * 8 + j] * bf2f((bf16_t)k8[j]); }
            sc[k0 + lane] = s; mx = fmaxf(mx, s);
        }
        mx = wave_max(mx);
        float l = 0.f;
        for (int k0 = 0; k0 < NMEM; k0 += 64) { const float e = __expf(sc[k0 + lane] - mx); sc[k0 + lane] = e; l += e; }
        l = wave_sum(l);
        asm volatile("s_waitcnt lgkmcnt(0)" ::: "memory");
        float o[4] = {0.f, 0.f, 0.f, 0.f};
        for (int k = 0; k < NMEM; ++k) { const u32x2 v4 = *(const u32x2*)(KVM + ((size_t)b * NMEM + k) * 2048 + 1024 + h * XD + 4 * lane); const float pk = sc[k];
            o[0] += pk * __uint_as_float(v4.x << 16); o[1] += pk * __uint_as_float(v4.x & 0xffff0000u); o[2] += pk * __uint_as_float(v4.y << 16); o[3] += pk * __uint_as_float(v4.y & 0xffff0000u); }
        const float rl = 1.0f / l; u32x2 w; w.x = pk2(o[0] * rl, o[1] * rl); w.y = pk2(o[2] * rl, o[3] * rl);
        *(u32x2*)(OX + (size_t)row * DM + h * XD + 4 * lane) = w;
        asm volatile("s_waitcnt lgkmcnt(0)" ::: "memory");
    }
}
__device__ __forceinline__ void phase_final(const Params& p) {
    const float* ssq = (const float*)(p.ws + WS_SSQ) + 4 * (size_t)T;
    const int wid = threadIdx.x >> 6, lane = threadIdx.x & 63;
    for (int row = blockIdx.x * NWAVES + wid; row < T; row += gridDim.x * NWAVES) {
        const float r = rsqrtf(ssq[row] * (1.0f / DM) + EPS);
        f32x4* o = (f32x4*)(p.out + (size_t)row * DM) + lane; const f32x4* g = (const f32x4*)p.final_norm + lane;
#pragma unroll
        for (int j = 0; j < 4; ++j) o[64 * j] = o[64 * j] * r * g[64 * j];
    }
}

constexpr int LDS_BYTES = 147456;
constexpr int NPHASE = 12;

__global__ void __launch_bounds__(NTHR, 2) mega(Params p) {
    extern __shared__ __attribute__((aligned(16))) unsigned char lds_raw[];
    LAS unsigned char* lds = (LAS unsigned char*)lds_raw;
    unsigned char* ws = p.ws;
    float* ssq = (float*)(ws + WS_SSQ);
    const int lo = p.ph_lo, hi = p.ph_hi;
#define IN(k) (lo <= (k) && (k) < hi)
    if (IN(0)) phase0(p, lds);
    if (IN(1)) {
        Gemm g{(const bf16_t*)(ws + WS_XB), DM, (const bf16_t*)(ws + WS_WIN), DM, T, LDZ, DM};
        EpiZ E{(bf16_t*)(ws + WS_Z), ssq, ssq + T, (bf16_t*)(ws + WS_KR), (float*)(ws + WS_G), (const float*)(ws + WS_COS), (const float*)(ws + WS_SIN)};
        gemm_naive(g, E);
    }
    if (IN(2)) {
        { Gemm g{(const bf16_t*)(ws + WS_Z) + ZC_CQ, LDZ, (const bf16_t*)(ws + WS_WUQ), QLORA, T, MLA_H * DQK, QLORA};
          EpiScaleBf16 E{(bf16_t*)(ws + WS_QALL), MLA_H * DQK, ssq, 1.0f / QLORA, 1.0f}; gemm_naive(g, E); }
        { Gemm g{(const bf16_t*)(ws + WS_Z) + ZC_CKV, LDZ, (const bf16_t*)(ws + WS_WUKV), 256, T, 1024, 256};
          EpiScaleBf16 E{(bf16_t*)(ws + WS_KV), 1024, ssq + T, 1.0f / KVLORA, 1.0f}; gemm_naive(g, E); }
        { Gemm g{(const bf16_t*)(ws + WS_MEMN), DM, (const bf16_t*)(ws + WS_WXKV), DM, TM, 2 * DM, DM};
          EpiScaleBf16 E{(bf16_t*)(ws + WS_KVM), 2 * DM, nullptr, 0.f, 1.0f}; gemm_naive(g, E); }
        phase_conv(p);
    }
    if (IN(3)) { mlstm_naive(p); mla_attn_naive(p, lds); }
    if (IN(4)) phase_mlfin(p);
    if (IN(5)) {
        Gemm g{(const bf16_t*)(ws + WS_Y), DM, (const bf16_t*)(ws + WS_WOUT), DM, T, DM, DM};
        EpiResid E{p.x, p.out, (bf16_t*)(ws + WS_XB), ssq + 2 * T}; gemm_naive(g, E);
    }
    if (IN(6)) {
        Gemm g{(const bf16_t*)(ws + WS_XB), DM, (const bf16_t*)(ws + WS_WXQ), DM, T, DM, DM};
        EpiScaleBf16 E{(bf16_t*)(ws + WS_HQ), DM, ssq + 2 * T, 1.0f / DM, 1.0f}; gemm_naive(g, E);
    }
    if (IN(7)) x_attn_naive(p, lds);
    if (IN(8)) {
        Gemm g{(const bf16_t*)(ws + WS_OX), DM, (const bf16_t*)(ws + WS_WXO), DM, T, DM, DM};
        EpiResid E{p.out, p.out, (bf16_t*)(ws + WS_XB), ssq + 3 * T}; gemm_naive(g, E);
    }
    if (IN(9)) {
        Gemm g{(const bf16_t*)(ws + WS_XB), DM, (const bf16_t*)(ws + WS_WGU), DM, T, 2 * DFF, DM};
        EpiSwiglu E{(bf16_t*)(ws + WS_H), ssq + 3 * T}; gemm_naive(g, E);
    }
    if (IN(10)) {
        Gemm g{(const bf16_t*)(ws + WS_H), DFF, (const bf16_t*)(ws + WS_WD), DFF, T, DM, DFF};
        EpiResid E{p.out, p.out, nullptr, ssq + 4 * T}; gemm_naive(g, E);
    }
    if (IN(11)) phase_final(p);
#undef IN
}

extern "C" void kernel_launch(void* const* d_in, const int* in_sizes, int n_in, void* d_out, int out_size, void* d_ws, size_t ws_size, hipStream_t stream) {
    static int grid = 0;
    if (grid == 0) {
        if (n_in != 22 || in_sizes[0] != T * DM || out_size != T * DM) { fprintf(stderr, "kernel_launch: unexpected shapes (n_in %d, in0 %d, out %d)\n", n_in, n_in > 0 ? in_sizes[0] : -1, out_size); grid = -1; return; }
        if (ws_size < WS_END) { fprintf(stderr, "kernel_launch: workspace too small: %zu\n", ws_size); grid = -1; return; }
        int dev = 0, cus = 0, per_cu = 0;
        hipGetDevice(&dev); hipDeviceGetAttribute(&cus, hipDeviceAttributeMultiprocessorCount, dev);
        if (hipFuncSetAttribute((const void*)mega, hipFuncAttributeMaxDynamicSharedMemorySize, LDS_BYTES) != hipSuccess) { fprintf(stderr, "kernel_launch: hipFuncSetAttribute failed\n"); grid = -1; return; }
        if (hipOccupancyMaxActiveBlocksPerMultiprocessor(&per_cu, (const void*)mega, NTHR, LDS_BYTES) != hipSuccess || per_cu < 1) { fprintf(stderr, "kernel_launch: occupancy query says %d\n", per_cu); per_cu = 1; }
        (void)hipGetLastError();
        grid = cus * 1;
        fprintf(stderr, "kernel_launch: grid %d (cus %d, per_cu %d), ws %zu MiB\n", grid, cus, per_cu, ws_size >> 20);
    }
    if (grid < 0) return;
    Params p{};
    p.x = (const float*)d_in[0]; p.mem = (const float*)d_in[1]; p.pos = (const int*)d_in[2];
    p.attn_norm = (const float*)d_in[3]; p.w_in = (const float*)d_in[4]; p.q_norm = (const float*)d_in[5]; p.w_uq = (const float*)d_in[6];
    p.kv_norm = (const float*)d_in[7]; p.w_ukv = (const float*)d_in[8]; p.conv = (const float*)d_in[9]; p.gbias = (const float*)d_in[10];
    p.ml_norm = (const float*)d_in[11]; p.w_out = (const float*)d_in[12]; p.xattn_norm = (const float*)d_in[13]; p.mem_norm = (const float*)d_in[14];
    p.w_xq = (const float*)d_in[15]; p.w_xkv = (const float*)d_in[16]; p.w_xo = (const float*)d_in[17]; p.ffn_norm = (const float*)d_in[18];
    p.w_gu = (const float*)d_in[19]; p.w_down = (const float*)d_in[20]; p.final_norm = (const float*)d_in[21];
    p.out = (float*)d_out; p.ws = (unsigned char*)d_ws;
    p.ws2 = (unsigned char*)d_ws + WS_XB;
    for (int ph = 0; ph < NPHASE; ++ph) {
        p.ph_lo = ph; p.ph_hi = ph + 1;
        hipLaunchKernelGGL(mega, dim3(grid), dim3(NTHR), LDS_BYTES, stream, p);
    }
    const hipError_t le = hipPeekAtLastError();
    if (le != hipSuccess) fprintf(stderr, "kernel_launch: launch failed: %s\n", hipGetErrorName(le));
}
```

```cpp
#include <hip/hip_runtime.h>
#include <cstdio>
#include <cstdint>

constexpr int BATCH = 8, SEQ = 4096, DM = 1024, T = BATCH * SEQ;
constexpr int NMEM = 256, TM = BATCH * NMEM;
constexpr float EPS = 1e-6f;
constexpr int MLA_H = 8, QLORA = 256, KVLORA = 128, NOPE = 64, ROPE = 32, VD = 64, DQK = NOPE + ROPE;
constexpr int ML_H = 4, ML_D = 128, ML_W = 512;
constexpr int XH = 4, XD = 256;
constexpr int DFF = 2816;
constexpr int INW = 2480;
constexpr int LDZ = 2560, ZC_CQ = 0, ZC_CKV = 256, ZC_KR = 384, ZC_G = 416, ZC_QK = 512, ZC_V = 1536, ZC_O = 2048;
constexpr int NWAVES = 8, NTHR = 512;

constexpr size_t MiB = 1u << 20;
constexpr size_t WS_CTL = 0;
constexpr size_t WS_WIN = 1 * MiB;
constexpr size_t WS_WUQ = 6 * MiB;
constexpr size_t WS_WUKV = 7 * MiB;
constexpr size_t WS_WOUT = 8 * MiB;
constexpr size_t WS_WXQ = 10 * MiB;
constexpr size_t WS_WXKV = 12 * MiB;
constexpr size_t WS_WXO = 16 * MiB;
constexpr size_t WS_WGU = 18 * MiB;
constexpr size_t WS_WD = 30 * MiB;
constexpr size_t WS_COS = 36 * MiB;
constexpr size_t WS_SIN = 38 * MiB;
constexpr size_t WS_G = 40 * MiB;
constexpr size_t WS_KR = 42 * MiB;
constexpr size_t WS_SSQ = 44 * MiB;
constexpr size_t WS_MEMN = 46 * MiB;
constexpr size_t WS_KVM = 50 * MiB;
constexpr size_t WS_XB = 64 * MiB;
constexpr size_t WS_Z = 128 * MiB;
constexpr size_t WS_H = 128 * MiB;
constexpr size_t WS_QALL = 288 * MiB;
constexpr size_t WS_KV = 336 * MiB;
constexpr size_t WS_Y = 400 * MiB;
constexpr size_t WS_HQ = 304 * MiB;
constexpr size_t WS_OX = 368 * MiB;
constexpr size_t WS_END = 464 * MiB;

typedef unsigned short bf16_t;
typedef short bf16x8 __attribute__((ext_vector_type(8)));
typedef float f32x4 __attribute__((ext_vector_type(4)));
typedef unsigned u32x4 __attribute__((ext_vector_type(4)));
typedef unsigned u32x2 __attribute__((ext_vector_type(2)));
#define LAS __attribute__((address_space(3)))

__device__ __forceinline__ float bf2f(bf16_t h) { return __uint_as_float(((unsigned)h) << 16); }
__device__ __forceinline__ unsigned f2bf(float f) { unsigned u = __float_as_uint(f); return (u + 0x7fffu + ((u >> 16) & 1u)) >> 16; }
__device__ __forceinline__ unsigned pk2(float lo, float hi) { return f2bf(lo) | (f2bf(hi) << 16); }
__device__ __forceinline__ float wave_sum(float v) {
#pragma unroll
    for (int o = 1; o < 64; o <<= 1) v += __shfl_xor(v, o);
    return v;
}
__device__ __forceinline__ float wave_max(float v) {
#pragma unroll
    for (int o = 1; o < 64; o <<= 1) v = fmaxf(v, __shfl_xor(v, o));
    return v;
}

struct Params {
    const float* x; const float* mem; const int* pos;
    const float *attn_norm, *w_in, *q_norm, *w_uq, *kv_norm, *w_ukv, *conv, *gbias, *ml_norm, *w_out, *xattn_norm, *mem_norm, *w_xq, *w_xkv, *w_xo, *ffn_norm, *w_gu, *w_down, *final_norm;
    float* out; unsigned char* ws; unsigned char* ws2;
    int ph_lo, ph_hi;
};

struct Unit { int pm, pn; };
struct Gemm { const bf16_t* A; int lda; const bf16_t* Bt; int ldb; int M, N, K; };

template <class Epi>
__device__ __forceinline__ void gemm_naive(const Gemm g, const Epi& E) {
    const int tid = threadIdx.x, wid = tid >> 6, lane = tid & 63, wr = wid >> 2, wc = wid & 3, fr = lane & 15, fq = lane >> 4;
    const int nM = g.M / 256, nN = g.N / 256;
    for (int unit = blockIdx.x; unit < nM * nN; unit += gridDim.x) {
        Unit u; u.pm = unit / nN; u.pn = unit % nN;
        f32x4 acc[2][2][4][2];
#pragma unroll
        for (int a = 0; a < 2; ++a)
#pragma unroll
            for (int b = 0; b < 2; ++b)
#pragma unroll
                for (int m = 0; m < 4; ++m)
#pragma unroll
                    for (int n = 0; n < 2; ++n) acc[a][b][m][n] = (f32x4){0.f, 0.f, 0.f, 0.f};
        const bf16_t* Ab = g.A + (size_t)(u.pm * 256 + wr * 64 + fr) * g.lda + 8 * fq;
        const bf16_t* Bb = g.Bt + (size_t)(u.pn * 256 + wc * 32 + 8 * (fr >> 2) + (fr & 3)) * g.ldb + 8 * fq;
        for (int kk = 0; kk < g.K; kk += 32) {
            bf16x8 a[2][4], b[2][2];
#pragma unroll
            for (int ai = 0; ai < 2; ++ai)
#pragma unroll
                for (int m = 0; m < 4; ++m) a[ai][m] = *(const bf16x8*)(Ab + (size_t)(ai * 128 + m * 16) * g.lda + kk);
#pragma unroll
            for (int bj = 0; bj < 2; ++bj)
#pragma unroll
                for (int n = 0; n < 2; ++n) b[bj][n] = *(const bf16x8*)(Bb + (size_t)(bj * 128 + 4 * n) * g.ldb + kk);
#pragma unroll
            for (int ai = 0; ai < 2; ++ai)
#pragma unroll
                for (int bj = 0; bj < 2; ++bj)
#pragma unroll
                    for (int m = 0; m < 4; ++m)
#pragma unroll
                        for (int n = 0; n < 2; ++n) acc[ai][bj][m][n] = __builtin_amdgcn_mfma_f32_16x16x32_bf16(b[bj][n], a[ai][m], acc[ai][bj][m][n], 0, 0, 0);
        }
        E(acc, u, wr, wc, fr, fq);
    }
}

__device__ __forceinline__ u32x4 pack8(const f32x4 v0, const f32x4 v1) { u32x4 w; w.x = pk2(v0[0], v0[1]); w.y = pk2(v0[2], v0[3]); w.z = pk2(v1[0], v1[1]); w.w = pk2(v1[2], v1[3]); return w; }
__device__ __forceinline__ float sq8(const f32x4 a, const f32x4 b) { return (a[0] * a[0] + a[1] * a[1]) + (a[2] * a[2] + a[3] * a[3]) + (b[0] * b[0] + b[1] * b[1]) + (b[2] * b[2] + b[3] * b[3]); }

struct EpiZ {
    bf16_t* Z; float* ssq_q; float* ssq_kv; bf16_t* KR; float* G; const float* cosT; const float* sinT;
    __device__ __forceinline__ void operator()(const f32x4 (&acc)[2][2][4][2], const Unit& u, int wr, int wc, int fr, int fq) const {
#pragma unroll
        for (int ai = 0; ai < 2; ++ai)
#pragma unroll
            for (int m = 0; m < 4; ++m) {
                const int row = u.pm * 256 + ai * 128 + wr * 64 + m * 16 + fr;
                bf16_t* zp = Z + (size_t)row * LDZ + u.pn * 256 + wc * 32 + 8 * fq;
#pragma unroll
                for (int bj = 0; bj < 2; ++bj) *(u32x4*)(zp + bj * 128) = pack8(acc[ai][bj][m][0], acc[ai][bj][m][1]);
                if (u.pn == 0) {
                    float s = sq8(acc[ai][0][m][0], acc[ai][0][m][1]) + sq8(acc[ai][1][m][0], acc[ai][1][m][1]);
                    s += __shfl_xor(s, 16); s += __shfl_xor(s, 32);
                    if (fq == 0) atomicAdd(ssq_q + row, s);
                } else if (u.pn == 1) {
                    float s = sq8(acc[ai][0][m][0], acc[ai][0][m][1]);
                    s += __shfl_xor(s, 16); s += __shfl_xor(s, 32);
                    if (fq == 0) atomicAdd(ssq_kv + row, s);
                    if (wc == 0) {
                        const f32x4 o0 = acc[ai][1][m][0], o1 = acc[ai][1][m][1];
                        f32x4 p0, p1;
#pragma unroll
                        for (int j = 0; j < 4; ++j) { p0[j] = __shfl_xor(o0[j], 32); p1[j] = __shfl_xor(o1[j], 32); }
                        const int jj = 8 * (fq & 1);
                        const f32x4 c0 = *(const f32x4*)(cosT + (size_t)row * 16 + jj), c1 = *(const f32x4*)(cosT + (size_t)row * 16 + jj + 4);
                        const f32x4 s0 = *(const f32x4*)(sinT + (size_t)row * 16 + jj), s1 = *(const f32x4*)(sinT + (size_t)row * 16 + jj + 4);
                        f32x4 r0, r1;
                        if (fq < 2) { r0 = o0 * c0 - p0 * s0; r1 = o1 * c1 - p1 * s1; }
                        else        { r0 = o0 * c0 + p0 * s0; r1 = o1 * c1 + p1 * s1; }
                        *(u32x4*)(KR + (size_t)row * 32 + 8 * fq) = pack8(r0, r1);
                    } else if (wc == 1 && fq < 2) {
                        *(f32x4*)(G + (size_t)row * 16 + 8 * fq) = acc[ai][1][m][0];
                        *(f32x4*)(G + (size_t)row * 16 + 8 * fq + 4) = acc[ai][1][m][1];
                    }
                }
            }
    }
};
struct EpiScaleBf16 {
    bf16_t* O; int ldo; const float* ssq; float inv_n; float c;
    __device__ __forceinline__ void operator()(const f32x4 (&acc)[2][2][4][2], const Unit& u, int wr, int wc, int fr, int fq) const {
#pragma unroll
        for (int ai = 0; ai < 2; ++ai)
#pragma unroll
            for (int m = 0; m < 4; ++m) {
                const int row = u.pm * 256 + ai * 128 + wr * 64 + m * 16 + fr;
                const float sc = ssq ? c * rsqrtf(ssq[row] * inv_n + EPS) : c;
                bf16_t* op = O + (size_t)row * ldo + u.pn * 256 + wc * 32 + 8 * fq;
#pragma unroll
                for (int bj = 0; bj < 2; ++bj) *(u32x4*)(op + bj * 128) = pack8(acc[ai][bj][m][0] * sc, acc[ai][bj][m][1] * sc);
            }
    }
};
struct EpiResid {
    const float* res; float* out; bf16_t* XB; float* ssq;
    __device__ __forceinline__ void operator()(const f32x4 (&acc)[2][2][4][2], const Unit& u, int wr, int wc, int fr, int fq) const {
#pragma unroll
        for (int ai = 0; ai < 2; ++ai)
#pragma unroll
            for (int m = 0; m < 4; ++m) {
                const int row = u.pm * 256 + ai * 128 + wr * 64 + m * 16 + fr;
                const size_t off = (size_t)row * DM + u.pn * 256 + wc * 32 + 8 * fq;
                float s = 0.f;
#pragma unroll
                for (int bj = 0; bj < 2; ++bj) {
                    const f32x4 v0 = *(const f32x4*)(res + off + bj * 128) + acc[ai][bj][m][0];
                    const f32x4 v1 = *(const f32x4*)(res + off + bj * 128 + 4) + acc[ai][bj][m][1];
                    *(f32x4*)(out + off + bj * 128) = v0; *(f32x4*)(out + off + bj * 128 + 4) = v1;
                    if (XB) *(u32x4*)(XB + off + bj * 128) = pack8(v0, v1);
                    s += sq8(v0, v1);
                }
                s += __shfl_xor(s, 16); s += __shfl_xor(s, 32);
                if (fq == 0) atomicAdd(ssq + row, s);
            }
    }
};
struct EpiSwiglu {
    bf16_t* H; const float* ssq;
    __device__ __forceinline__ void operator()(const f32x4 (&acc)[2][2][4][2], const Unit& u, int wr, int wc, int fr, int fq) const {
#pragma unroll
        for (int ai = 0; ai < 2; ++ai)
#pragma unroll
            for (int m = 0; m < 4; ++m) {
                const int row = u.pm * 256 + ai * 128 + wr * 64 + m * 16 + fr;
                const float sc = rsqrtf(ssq[row] * (1.0f / DM) + EPS);
                f32x4 h[2];
#pragma unroll
                for (int n = 0; n < 2; ++n)
#pragma unroll
                    for (int j = 0; j < 4; ++j) { const float gg = acc[ai][0][m][n][j] * sc, uu = acc[ai][1][m][n][j] * sc; h[n][j] = gg * uu / (1.0f + __expf(-gg)); }
                *(u32x4*)(H + (size_t)row * DFF + u.pn * 128 + wc * 32 + 8 * fq) = pack8(h[0], h[1]);
            }
    }
};

struct MapIdent { __device__ __forceinline__ int operator()(int n) const { return n; } };
struct MapWin { __device__ __forceinline__ int operator()(int n) const {
    if (n < 416) return n; if (n < 1440) return ZC_QK + (n - 416); if (n < 1952) return ZC_V + (n - 1440); if (n < 2464) return ZC_O + (n - 1952); return ZC_G + (n - 2464); } };
struct MapGU { __device__ __forceinline__ int operator()(int n) const { const int up = n >= DFF, j = up ? n - DFF : n; return (j >> 7) * 256 + up * 128 + (j & 127); } };

template <class Map>
__device__ __forceinline__ void transpose_w(const float* W, int K, int N, const float* gain, bf16_t* WT, int ldt, Map map, LAS float* scr, int gw, int ngw, int lane) {
    const int nblk = (N + 31) / 32, nitems = (K / 64) * nblk;
    for (int it = gw; it < nitems; it += ngw) {
        const int kb = it / nblk, nb = it % nblk, k0 = 64 * kb, n0 = 32 * nb;
        for (int i = 0; i < 32; ++i) { const int kk = 2 * i + (lane >> 5), nn = n0 + (lane & 31);
            float v = 0.f; if (nn < N) { v = W[(size_t)(k0 + kk) * N + nn]; if (gain) v *= gain[k0 + kk]; }
            scr[kk * 33 + (lane & 31)] = v; }
        asm volatile("s_waitcnt lgkmcnt(0)" ::: "memory");
        const int c = lane & 7;
#pragma unroll
        for (int j = 0; j < 4; ++j) { const int n = (lane >> 3) + 8 * j, nn = n0 + n;
            if (nn < N) { const LAS float* s = scr + (8 * c) * 33 + n;
                u32x4 o; o.x = pk2(s[0 * 33], s[1 * 33]); o.y = pk2(s[2 * 33], s[3 * 33]); o.z = pk2(s[4 * 33], s[5 * 33]); o.w = pk2(s[6 * 33], s[7 * 33]);
                *(u32x4*)(WT + (size_t)map(nn) * ldt + k0 + 8 * c) = o; } }
        asm volatile("s_waitcnt lgkmcnt(0)" ::: "memory");
    }
}
__device__ __forceinline__ void rms_row_bf16(const float* xrow, const float* gain, bf16_t* orow, int lane) {
    const f32x4* xr = (const f32x4*)xrow + lane; const f32x4* gr = (const f32x4*)gain + lane;
    f32x4 v[4]; float s = 0.f;
#pragma unroll
    for (int j = 0; j < 4; ++j) { v[j] = xr[64 * j]; s += (v[j][0] * v[j][0] + v[j][1] * v[j][1]) + (v[j][2] * v[j][2] + v[j][3] * v[j][3]); }
    const float r = rsqrtf(wave_sum(s) * (1.0f / DM) + EPS);
    u32x2* o8 = (u32x2*)orow + lane;
#pragma unroll
    for (int j = 0; j < 4; ++j) { const f32x4 gg = gr[64 * j]; u32x2 w; w.x = pk2(v[j][0] * r * gg[0], v[j][1] * r * gg[1]); w.y = pk2(v[j][2] * r * gg[2], v[j][3] * r * gg[3]); o8[64 * j] = w; }
}

__device__ __forceinline__ void phase0(const Params& p, LAS unsigned char* lds) {
    const int tid = threadIdx.x, wid = tid >> 6, lane = tid & 63;
    const int gw = blockIdx.x * NWAVES + wid, ngw = gridDim.x * NWAVES;
    const int gt = blockIdx.x * NTHR + tid, ngt = gridDim.x * NTHR;
    LAS float* scr = (LAS float*)(lds + wid * 16384);
    unsigned char* ws = p.ws;
    transpose_w(p.w_in, DM, INW, nullptr, (bf16_t*)(ws + WS_WIN), DM, MapWin(), scr, gw, ngw, lane);
    transpose_w(p.w_uq, QLORA, MLA_H * DQK, p.q_norm, (bf16_t*)(ws + WS_WUQ), QLORA, MapIdent(), scr, gw, ngw, lane);
    transpose_w(p.w_ukv, KVLORA, MLA_H * (NOPE + VD), p.kv_norm, (bf16_t*)(ws + WS_WUKV), 256, MapIdent(), scr, gw, ngw, lane);
    transpose_w(p.w_out, DM, DM, nullptr, (bf16_t*)(ws + WS_WOUT), DM, MapIdent(), scr, gw, ngw, lane);
    transpose_w(p.w_xq, DM, DM, p.xattn_norm, (bf16_t*)(ws + WS_WXQ), DM, MapIdent(), scr, gw, ngw, lane);
    transpose_w(p.w_xkv, DM, 2 * DM, nullptr, (bf16_t*)(ws + WS_WXKV), DM, MapIdent(), scr, gw, ngw, lane);
    transpose_w(p.w_xo, DM, DM, nullptr, (bf16_t*)(ws + WS_WXO), DM, MapIdent(), scr, gw, ngw, lane);
    transpose_w(p.w_gu, DM, 2 * DFF, p.ffn_norm, (bf16_t*)(ws + WS_WGU), DM, MapGU(), scr, gw, ngw, lane);
    transpose_w(p.w_down, DFF, DM, nullptr, (bf16_t*)(ws + WS_WD), DFF, MapIdent(), scr, gw, ngw, lane);
    { bf16_t* wz = (bf16_t*)(ws + WS_WIN) + (size_t)432 * DM; for (int i = gt; i < 80 * DM / 8; i += ngt) ((u32x4*)wz)[i] = (u32x4){0u, 0u, 0u, 0u};
      bf16_t* wk = (bf16_t*)(ws + WS_WUKV); for (int i = gt; i < 1024 * 16; i += ngt) { const int r = i >> 4, c = i & 15; *(u32x4*)(wk + (size_t)r * 256 + 128 + 8 * c) = (u32x4){0u, 0u, 0u, 0u}; } }
    { float* ssq = (float*)(ws + WS_SSQ); for (int i = gt; i < 5 * T; i += ngt) ssq[i] = 0.f; }
    { float* ct = (float*)(ws + WS_COS); float* st = (float*)(ws + WS_SIN);
      for (int i = gt; i < T * 16; i += ngt) { const int row = i >> 4, j = i & 15; const float inv = (float)pow(10000.0, -(double)(2 * j) / 32.0); const float ang = (float)p.pos[row] * inv; ct[i] = cosf(ang); st[i] = sinf(ang); } }
    for (int r = gw; r < T; r += ngw) rms_row_bf16(p.x + (size_t)r * DM, p.attn_norm, (bf16_t*)(ws + WS_XB) + (size_t)r * DM, lane);
    for (int r = gw; r < TM; r += ngw) rms_row_bf16(p.mem + (size_t)r * DM, p.mem_norm, (bf16_t*)(ws + WS_MEMN) + (size_t)r * DM, lane);
}

__device__ __forceinline__ void phase_conv(const Params& p) {
    const bf16_t* Z = (const bf16_t*)(p.ws + WS_Z); bf16_t* Q = (bf16_t*)p.ws2;
    const int gt = blockIdx.x * NTHR + threadIdx.x, ngt = gridDim.x * NTHR;
    for (int i = gt; i < T * 128; i += ngt) {
        const int row = i >> 7, c0 = (i & 127) * 8, t = row & (SEQ - 1);
        const bf16x8 zc = *(const bf16x8*)(Z + (size_t)row * LDZ + ZC_QK + c0);
        bf16x8 zp = (bf16x8){0, 0, 0, 0, 0, 0, 0, 0}, zn = zp;
        if (t > 0) zp = *(const bf16x8*)(Z + (size_t)(row - 1) * LDZ + ZC_QK + c0);
        if (t < SEQ - 1) zn = *(const bf16x8*)(Z + (size_t)(row + 1) * LDZ + ZC_QK + c0);
        const float sc = c0 >= 512 ? 0.08838834764831845f : 1.0f;
        float o[8];
#pragma unroll
        for (int j = 0; j < 8; ++j) { const float a = p.conv[c0 + j] * bf2f((bf16_t)zp[j]) + p.conv[1024 + c0 + j] * bf2f((bf16_t)zc[j]) + p.conv[2048 + c0 + j] * bf2f((bf16_t)zn[j]);
            o[j] = a / (1.0f + __expf(-a)) * sc; }
        u32x4 w; w.x = pk2(o[0], o[1]); w.y = pk2(o[2], o[3]); w.z = pk2(o[4], o[5]); w.w = pk2(o[6], o[7]);
        *(u32x4*)(Q + (size_t)row * 1024 + c0) = w;
    }
}

__device__ __forceinline__ void mlstm_naive(const Params& p) {
    const bf16_t* Z = (const bf16_t*)(p.ws + WS_Z); const bf16_t* QKC = (const bf16_t*)p.ws2; const float* G = (const float*)(p.ws + WS_G);
    float* HF = p.out; float* HB = p.out + (size_t)T * ML_W;
    const int tid = threadIdx.x, d = tid >> 2, eq = tid & 3;
    for (int unit = blockIdx.x; unit < BATCH * ML_H * 2; unit += gridDim.x) {
        const int dir = unit & 1, h = (unit >> 1) & 3, b = unit >> 3;
        float C[32], n[32]; float m = 0.f;
#pragma unroll
        for (int j = 0; j < 32; ++j) { C[j] = 0.f; n[j] = 0.f; }
        const float bi = p.gbias[dir * 8 + h], bff = p.gbias[dir * 8 + 4 + h];
        float* Hout = dir ? HB : HF;
        for (int s = 0; s < SEQ; ++s) {
            const int t = dir ? SEQ - 1 - s : s; const size_t row = (size_t)b * SEQ + t;
            const float ip = G[row * 16 + dir * 8 + h] + bi, fp = G[row * 16 + dir * 8 + 4 + h] + bff;
            const float logf = fminf(fp, 0.f) - log1pf(__expf(-fabsf(fp)));
            const float mn = fmaxf(logf + m, ip), fe = __expf(logf + m - mn), ie = __expf(ip - mn);
            m = mn;
            const float vv = bf2f(Z[row * LDZ + ZC_V + h * 128 + d]) * ie;
            float pn = 0.f, pd = 0.f;
#pragma unroll
            for (int c = 0; c < 4; ++c) {
                const bf16x8 q8 = *(const bf16x8*)(QKC + row * 1024 + h * 128 + eq * 32 + c * 8);
                const bf16x8 k8 = *(const bf16x8*)(QKC + row * 1024 + 512 + h * 128 + eq * 32 + c * 8);
#pragma unroll
                for (int j = 0; j < 8; ++j) { const float qq = bf2f((bf16_t)q8[j]), kk = bf2f((bf16_t)k8[j]);
                    C[c * 8 + j] = fe * C[c * 8 + j] + vv * kk; n[c * 8 + j] = fe * n[c * 8 + j] + ie * kk;
                    pn += C[c * 8 + j] * qq; pd += n[c * 8 + j] * qq; }
            }
            pn += __shfl_xor(pn, 1); pn += __shfl_xor(pn, 2); pd += __shfl_xor(pd, 1); pd += __shfl_xor(pd, 2);
            if (eq == 0) Hout[row * ML_W + h * 128 + d] = pn / fmaxf(fabsf(pd), __expf(-mn));
        }
    }
}
__device__ __forceinline__ void phase_mlfin(const Params& p) {
    const bf16_t* Z = (const bf16_t*)(p.ws + WS_Z); bf16_t* Y = (bf16_t*)(p.ws + WS_Y);
    const float* HF = p.out; const float* HB = p.out + (size_t)T * ML_W;
    const int wid = threadIdx.x >> 6, lane = threadIdx.x & 63;
    for (int row = blockIdx.x * NWAVES + wid; row < T; row += gridDim.x * NWAVES) {
        const size_t o = (size_t)row * ML_W + lane * 8;
        const f32x4 a0 = *(const f32x4*)(HF + o) + *(const f32x4*)(HB + o), a1 = *(const f32x4*)(HF + o + 4) + *(const f32x4*)(HB + o + 4);
        float s = sq8(a0, a1);
        s += __shfl_xor(s, 1); s += __shfl_xor(s, 2); s += __shfl_xor(s, 4); s += __shfl_xor(s, 8);
        const float r = rsqrtf(s * (1.0f / ML_D) + EPS);
        const bf16x8 zo = *(const bf16x8*)(Z + (size_t)row * LDZ + ZC_O + lane * 8);
        const f32x4 g0 = *(const f32x4*)(p.ml_norm + lane * 8), g1 = *(const f32x4*)(p.ml_norm + lane * 8 + 4);
        float ov[8];
#pragma unroll
        for (int j = 0; j < 8; ++j) { const float hv = (j < 4 ? a0[j] : a1[j - 4]) * r * (j < 4 ? g0[j] : g1[j - 4]); const float z = bf2f((bf16_t)zo[j]); ov[j] = hv / (1.0f + __expf(-z)); }
        u32x4 w; w.x = pk2(ov[0], ov[1]); w.y = pk2(ov[2], ov[3]); w.z = pk2(ov[4], ov[5]); w.w = pk2(ov[6], ov[7]);
        *(u32x4*)(Y + (size_t)row * DM + 512 + lane * 8) = w;
    }
}

__device__ __forceinline__ void mla_attn_naive(const Params& p, LAS unsigned char* lds) {
    const bf16_t* QALL = (const bf16_t*)(p.ws + WS_QALL); const bf16_t* KV = (const bf16_t*)(p.ws + WS_KV); const bf16_t* KR = (const bf16_t*)(p.ws + WS_KR);
    const float* cosT = (const float*)(p.ws + WS_COS); const float* sinT = (const float*)(p.ws + WS_SIN); bf16_t* Y = (bf16_t*)(p.ws + WS_Y);
    const int wid = threadIdx.x >> 6, lane = threadIdx.x & 63;
    LAS float* sc = (LAS float*)(lds + wid * 16384);
    LAS float* qs = (LAS float*)(lds + 131072 + wid * 512);
    const float scale = 0.10206207261596575f;
    for (int item = blockIdx.x * NWAVES + wid; item < T * MLA_H; item += gridDim.x * NWAVES) {
        const int h = item & 7, row = item >> 3, b = row / SEQ;
        for (int dd = lane; dd < DQK; dd += 64) {
            float v = bf2f(QALL[(size_t)row * 768 + h * DQK + dd]);
            if (dd >= NOPE) { const int j = (dd - NOPE) & 15; const float c = cosT[(size_t)row * 16 + j], s = sinT[(size_t)row * 16 + j];
                const float other = bf2f(QALL[(size_t)row * 768 + h * DQK + (dd < NOPE + 16 ? dd + 16 : dd - 16)]);
                v = dd < NOPE + 16 ? v * c - other * s : v * c + other * s; }
            qs[dd] = v * scale;
        }
        asm volatile("s_waitcnt lgkmcnt(0)" ::: "memory");
        float mx = -1e30f;
        for (int k0 = 0; k0 < SEQ; k0 += 64) {
            const size_t kr = (size_t)b * SEQ + k0 + lane; float s = 0.f;
#pragma unroll
            for (int c = 0; c < 8; ++c) { const bf16x8 k8 = *(const bf16x8*)(KV + kr * 1024 + h * 128 + c * 8);
#pragma unroll
                for (int j = 0; j < 8; ++j) s += qs[c * 8 + j] * bf2f((bf16_t)k8[j]); }
#pragma unroll
            for (int c = 0; c < 4; ++c) { const bf16x8 k8 = *(const bf16x8*)(KR + kr * 32 + c * 8);
#pragma unroll
                for (int j = 0; j < 8; ++j) s += qs[NOPE + c * 8 + j] * bf2f((bf16_t)k8[j]); }
            sc[k0 + lane] = s; mx = fmaxf(mx, s);
        }
        mx = wave_max(mx);
        float l = 0.f;
        for (int k0 = 0; k0 < SEQ; k0 += 64) { const float e = __expf(sc[k0 + lane] - mx); sc[k0 + lane] = e; l += e; }
        l = wave_sum(l);
        asm volatile("s_waitcnt lgkmcnt(0)" ::: "memory");
        float o = 0.f;
        for (int k = 0; k < SEQ; ++k) o += sc[k] * bf2f(KV[((size_t)b * SEQ + k) * 1024 + h * 128 + 64 + lane]);
        Y[(size_t)row * DM + h * VD + lane] = (bf16_t)f2bf(o / l);
        asm volatile("s_waitcnt lgkmcnt(0)" ::: "memory");
    }
}
__device__ __forceinline__ void x_attn_naive(const Params& p, LAS unsigned char* lds) {
    const bf16_t* HQ = (const bf16_t*)(p.ws + WS_HQ); const bf16_t* KVM = (const bf16_t*)(p.ws + WS_KVM); bf16_t* OX = (bf16_t*)(p.ws + WS_OX);
    const int wid = threadIdx.x >> 6, lane = threadIdx.x & 63;
    LAS float* sc = (LAS float*)(lds + wid * 16384);
    LAS float* qs = (LAS float*)(lds + 131072 + wid * 1024);
    for (int item = blockIdx.x * NWAVES + wid; item < T * XH; item += gridDim.x * NWAVES) {
        const int h = item & 3, row = item >> 2, b = row / SEQ;
        for (int dd = lane; dd < XD; dd += 64) qs[dd] = bf2f(HQ[(size_t)row * DM + h * XD + dd]) * 0.0625f;
        asm volatile("s_waitcnt lgkmcnt(0)" ::: "memory");
        float mx = -1e30f;
        for (int k0 = 0; k0 < NMEM; k0 += 64) {
            const size_t kr = (size_t)b * NMEM + k0 + lane; float s = 0.f;
            for (int c = 0; c < 32; ++c) { const bf16x8 k8 = *(const bf16x8*)(KVM + kr * 2048 + h * XD + c * 8);
#pragma unroll
                for (int j = 0; j < 8; ++j) s += qs[c * 8 + j] * bf2f((bf16_t)k8[j]); }
            sc[k0 + lane] = s; mx = fmaxf(mx, s);
        }
        mx = wave_max(mx);
        float l = 0.f;
        for (int k0 = 0; k0 < NMEM; k0 += 64) { const float e = __expf(sc[k0 + lane] - mx); sc[k0 + lane] = e; l += e; }
        l = wave_sum(l);
        asm volatile("s_waitcnt lgkmcnt(0)" ::: "memory");
        float o[4] = {0.f, 0.f, 0.f, 0.f};
        for (int k = 0; k < NMEM; ++k) { const u32x2 v4 = *(const u32x2*)(KVM + ((size_t)b * NMEM + k) * 2048 + 1024 + h * XD + 4 * lane); const float pk = sc[k];
            o[0] += pk * __uint_as_float(v4.x << 16); o[1] += pk * __uint_as_float(v4.x & 0xffff0000u); o[2] += pk * __uint_as_float(v4.y << 16); o[3] += pk * __uint_as_float(v4.y & 0xffff0000u); }
        const float rl = 1.0f / l; u32x2 w; w.x = pk2(o[0] * rl, o[1] * rl); w.y = pk2(o[2] * rl, o[3] * rl);
        *(u32x2*)(OX + (size_t)row * DM + h * XD + 4 * lane) = w;
        asm volatile("s_waitcnt lgkmcnt(0)" ::: "memory");
    }
}
__device__ __forceinline__ void phase_final(const Params& p) {
    const float* ssq = (const float*)(p.ws + WS_SSQ) + 4 * (size_t)T;
    const int wid = threadIdx.x >> 6, lane = threadIdx.x & 63;
    for (int row = blockIdx.x * NWAVES + wid; row < T; row += gridDim.x * NWAVES) {
        const float r = rsqrtf(ssq[row] * (1.0f / DM) + EPS);
        f32x4* o = (f32x4*)(p.out + (size_t)row * DM) + lane; const f32x4* g = (const f32x4*)p.final_norm + lane;
#pragma unroll
        for (int j = 0; j < 4; ++j) o[64 * j] = o[64 * j] * r * g[64 * j];
    }
}


#define XB_TMO      128
#define XB_XCNT(j)  (256  + 64 * (j))
#define XB_XSUB(j)  (1280 + 64 * (j))
#define XB_XGEN(j)  (2304 + 64 * (j))
#define XB_TOP      3328
#define XB_TOPGEN   3392
#define XCD_BAR_WORDS 3456
#define XB_SPIN_CAP (1u << 20)
__device__ __forceinline__ unsigned xb_ld(unsigned* p)              { return __hip_atomic_load(p, __ATOMIC_RELAXED, __HIP_MEMORY_SCOPE_AGENT); }
__device__ __forceinline__ unsigned xb_add(unsigned* p, unsigned v) { return __hip_atomic_fetch_add(p, v, __ATOMIC_RELAXED, __HIP_MEMORY_SCOPE_AGENT); }
__device__ __forceinline__ unsigned xb_xcc_id() { return (unsigned)__builtin_amdgcn_s_getreg((3 << 11) | 20) & 0xFu; }
#define XB_SPIN(cond, bar) do { unsigned _sp = 0; while (cond) { __builtin_amdgcn_s_sleep(1); \
    if ((++_sp & 255u) == 0u) { if (xb_ld(&(bar)[XB_TMO])) break; if (_sp > XB_SPIN_CAP) { atomicAdd(&(bar)[XB_TMO], 1u); break; } } } } while (0)
struct XcdBarrier { unsigned* bar; unsigned x; volatile LAS unsigned* st; };
__device__ __forceinline__ XcdBarrier xcd_barrier_post(unsigned* bar, volatile LAS unsigned* st) {
    XcdBarrier b; b.bar = bar; b.x = xb_xcc_id(); b.st = st;
    if (threadIdx.x == 0) (void)xb_add(&bar[XB_XCNT(b.x)], 1u);
    return b;
}
__device__ __forceinline__ void xcd_barrier_complete(unsigned* bar, unsigned x, unsigned& nloc, unsigned& nx) {
    const unsigned G = gridDim.x * gridDim.y * gridDim.z;
    unsigned sum, cnt, mine, sp = 0u;
    for (;;) {
        sum = 0u; cnt = 0u; mine = 0u;
#pragma unroll
        for (unsigned j = 0; j < 16; ++j) { const unsigned c = xb_ld(&bar[XB_XCNT(j)]); sum += c; cnt += (c > 0u) ? 1u : 0u; mine = (j == x) ? c : mine; }
        if (sum == G) break;
        __builtin_amdgcn_s_sleep(1);
        if ((++sp & 255u) == 0u) { if (xb_ld(&bar[XB_TMO])) break; if (sp > XB_SPIN_CAP) { atomicAdd(&bar[XB_TMO], 1u); break; } }
    }
    nloc = mine > 0u ? mine : 1u; nx = cnt > 0u ? cnt : 1u;
}
__device__ __forceinline__ void xcd_barrier(const XcdBarrier& b) {
    asm volatile("s_waitcnt vmcnt(0)" ::: "memory");
    __syncthreads();
    if (threadIdx.x == 0) {
        unsigned* bar = b.bar;
        __builtin_amdgcn_s_waitcnt(0);
        unsigned nloc = b.st[0], nx = b.st[1];
        if (nloc == 0u) { xcd_barrier_complete(bar, b.x, nloc, nx); b.st[0] = nloc; b.st[1] = nx; }
        const unsigned old = xb_add(&bar[XB_XSUB(b.x)], 1u);
        const unsigned gen = old / nloc;
        if (old + 1u == (gen + 1u) * nloc) {
            __builtin_amdgcn_fence(__ATOMIC_RELEASE, "agent");
            asm volatile("s_waitcnt vmcnt(0)" ::: "memory");
            const unsigned og = xb_add(&bar[XB_TOP], 1u);
            const unsigned tg = og / nx;
            if (og + 1u == (tg + 1u) * nx) xb_add(&bar[XB_TOPGEN], 1u);
            else XB_SPIN(xb_ld(&bar[XB_TOPGEN]) == tg, bar);
            __builtin_amdgcn_fence(__ATOMIC_ACQUIRE, "agent");
            xb_add(&bar[XB_XGEN(b.x)], 1u);
            asm volatile("s_waitcnt vmcnt(0)" ::: "memory");
        } else {
            XB_SPIN(xb_ld(&bar[XB_XGEN(b.x)]) == gen, bar);
            __builtin_amdgcn_fence(__ATOMIC_ACQUIRE, "agent");
            asm volatile("s_waitcnt vmcnt(0)" ::: "memory");
        }
    }
    __syncthreads();
}

constexpr int LDS_BYTES = 147456;
constexpr int NPHASE = 12;
#ifndef MK_N_LAUNCHES
#define MK_N_LAUNCHES 1
#endif

__global__ void __launch_bounds__(NTHR, 2) mega(Params p) {
    extern __shared__ __attribute__((aligned(16))) unsigned char lds_raw[];
    LAS unsigned char* lds = (LAS unsigned char*)lds_raw;
    unsigned char* ws = p.ws;
    float* ssq = (float*)(ws + WS_SSQ);
    const int lo = p.ph_lo, hi = p.ph_hi;
    volatile LAS unsigned* misc = (volatile LAS unsigned*)(lds + LDS_BYTES - 64);
    if (threadIdx.x < 16) misc[threadIdx.x] = 0u;
    __syncthreads();
    XcdBarrier bar; bar.bar = (unsigned*)(ws + WS_CTL) + 4096; bar.x = 0; bar.st = nullptr;
    if (hi - lo > 1) bar = xcd_barrier_post((unsigned*)(ws + WS_CTL) + 4096, misc);
#define IN(k) (lo <= (k) && (k) < hi)
#define SEAM(k) do { if (IN(k) && IN((k) + 1)) xcd_barrier(bar); } while (0)
    if (IN(0)) phase0(p, lds);
    SEAM(0);
    if (IN(1)) {
        Gemm g{(const bf16_t*)(ws + WS_XB), DM, (const bf16_t*)(ws + WS_WIN), DM, T, LDZ, DM};
        EpiZ E{(bf16_t*)(ws + WS_Z), ssq, ssq + T, (bf16_t*)(ws + WS_KR), (float*)(ws + WS_G), (const float*)(ws + WS_COS), (const float*)(ws + WS_SIN)};
        gemm_naive(g, E);
    }
    SEAM(1);
    if (IN(2)) {
        { Gemm g{(const bf16_t*)(ws + WS_Z) + ZC_CQ, LDZ, (const bf16_t*)(ws + WS_WUQ), QLORA, T, MLA_H * DQK, QLORA};
          EpiScaleBf16 E{(bf16_t*)(ws + WS_QALL), MLA_H * DQK, ssq, 1.0f / QLORA, 1.0f}; gemm_naive(g, E); }
        { Gemm g{(const bf16_t*)(ws + WS_Z) + ZC_CKV, LDZ, (const bf16_t*)(ws + WS_WUKV), 256, T, 1024, 256};
          EpiScaleBf16 E{(bf16_t*)(ws + WS_KV), 1024, ssq + T, 1.0f / KVLORA, 1.0f}; gemm_naive(g, E); }
        { Gemm g{(const bf16_t*)(ws + WS_MEMN), DM, (const bf16_t*)(ws + WS_WXKV), DM, TM, 2 * DM, DM};
          EpiScaleBf16 E{(bf16_t*)(ws + WS_KVM), 2 * DM, nullptr, 0.f, 1.0f}; gemm_naive(g, E); }
        phase_conv(p);
    }
    SEAM(2);
    if (IN(3)) { mlstm_naive(p); mla_attn_naive(p, lds); }
    SEAM(3);
    if (IN(4)) phase_mlfin(p);
    SEAM(4);
    if (IN(5)) {
        Gemm g{(const bf16_t*)(ws + WS_Y), DM, (const bf16_t*)(ws + WS_WOUT), DM, T, DM, DM};
        EpiResid E{p.x, p.out, (bf16_t*)(ws + WS_XB), ssq + 2 * T}; gemm_naive(g, E);
    }
    SEAM(5);
    if (IN(6)) {
        Gemm g{(const bf16_t*)(ws + WS_XB), DM, (const bf16_t*)(ws + WS_WXQ), DM, T, DM, DM};
        EpiScaleBf16 E{(bf16_t*)(ws + WS_HQ), DM, ssq + 2 * T, 1.0f / DM, 1.0f}; gemm_naive(g, E);
    }
    SEAM(6);
    if (IN(7)) x_attn_naive(p, lds);
    SEAM(7);
    if (IN(8)) {
        Gemm g{(const bf16_t*)(ws + WS_OX), DM, (const bf16_t*)(ws + WS_WXO), DM, T, DM, DM};
        EpiResid E{p.out, p.out, (bf16_t*)(ws + WS_XB), ssq + 3 * T}; gemm_naive(g, E);
    }
    SEAM(8);
    if (IN(9)) {
        Gemm g{(const bf16_t*)(ws + WS_XB), DM, (const bf16_t*)(ws + WS_WGU), DM, T, 2 * DFF, DM};
        EpiSwiglu E{(bf16_t*)(ws + WS_H), ssq + 3 * T}; gemm_naive(g, E);
    }
    SEAM(9);
    if (IN(10)) {
        Gemm g{(const bf16_t*)(ws + WS_H), DFF, (const bf16_t*)(ws + WS_WD), DFF, T, DM, DFF};
        EpiResid E{p.out, p.out, nullptr, ssq + 4 * T}; gemm_naive(g, E);
    }
    SEAM(10);
    if (IN(11)) phase_final(p);
#undef IN
#undef SEAM
}

extern "C" void kernel_launch(void* const* d_in, const int* in_sizes, int n_in, void* d_out, int out_size, void* d_ws, size_t ws_size, hipStream_t stream) {
    static int grid = 0;
    if (grid == 0) {
        if (n_in != 22 || in_sizes[0] != T * DM || out_size != T * DM) { fprintf(stderr, "kernel_launch: unexpected shapes (n_in %d, in0 %d, out %d)\n", n_in, n_in > 0 ? in_sizes[0] : -1, out_size); grid = -1; return; }
        if (ws_size < WS_END) { fprintf(stderr, "kernel_launch: workspace too small: %zu\n", ws_size); grid = -1; return; }
        int dev = 0, cus = 0, per_cu = 0;
        (void)hipGetDevice(&dev); (void)hipDeviceGetAttribute(&cus, hipDeviceAttributeMultiprocessorCount, dev);
        if (hipFuncSetAttribute((const void*)mega, hipFuncAttributeMaxDynamicSharedMemorySize, LDS_BYTES) != hipSuccess) { fprintf(stderr, "kernel_launch: hipFuncSetAttribute failed\n"); grid = -1; return; }
        if (hipOccupancyMaxActiveBlocksPerMultiprocessor(&per_cu, (const void*)mega, NTHR, LDS_BYTES) != hipSuccess || per_cu < 1) { fprintf(stderr, "kernel_launch: occupancy query says %d\n", per_cu); per_cu = 1; }
        (void)hipGetLastError();
        grid = cus * (per_cu < 1 ? per_cu : 1);
        fprintf(stderr, "kernel_launch: grid %d (cus %d, per_cu %d), ws %zu MiB\n", grid, cus, per_cu, ws_size >> 20);
    }
    if (grid < 0) return;
    Params p{};
    p.x = (const float*)d_in[0]; p.mem = (const float*)d_in[1]; p.pos = (const int*)d_in[2];
    p.attn_norm = (const float*)d_in[3]; p.w_in = (const float*)d_in[4]; p.q_norm = (const float*)d_in[5]; p.w_uq = (const float*)d_in[6];
    p.kv_norm = (const float*)d_in[7]; p.w_ukv = (const float*)d_in[8]; p.conv = (const float*)d_in[9]; p.gbias = (const float*)d_in[10];
    p.ml_norm = (const float*)d_in[11]; p.w_out = (const float*)d_in[12]; p.xattn_norm = (const float*)d_in[13]; p.mem_norm = (const float*)d_in[14];
    p.w_xq = (const float*)d_in[15]; p.w_xkv = (const float*)d_in[16]; p.w_xo = (const float*)d_in[17]; p.ffn_norm = (const float*)d_in[18];
    p.w_gu = (const float*)d_in[19]; p.w_down = (const float*)d_in[20]; p.final_norm = (const float*)d_in[21];
    p.out = (float*)d_out; p.ws = (unsigned char*)d_ws;
    p.ws2 = (unsigned char*)d_ws + WS_XB;
    if (hipMemsetAsync((char*)d_ws + WS_CTL, 0, 65536, stream) != hipSuccess) { fprintf(stderr, "kernel_launch: memset failed\n"); return; }
#if MK_N_LAUNCHES == 1
    p.ph_lo = 0; p.ph_hi = NPHASE;
    { void* args[] = {&p};
      const hipError_t e = hipLaunchCooperativeKernel((const void*)mega, dim3(grid), dim3(NTHR), args, LDS_BYTES, stream);
      if (e != hipSuccess) fprintf(stderr, "kernel_launch: cooperative launch failed: %s (grid %d)\n", hipGetErrorString(e), grid); }
#else
    for (int ph = 0; ph < NPHASE; ++ph) {
        p.ph_lo = ph; p.ph_hi = ph + 1;
        hipLaunchKernelGGL(mega, dim3(grid), dim3(NTHR), LDS_BYTES, stream, p);
    }
#endif
    const hipError_t le = hipPeekAtLastError();
    if (le != hipSuccess) fprintf(stderr, "kernel_launch: launch failed: %s\n", hipGetErrorName(le));
}
```

```cpp
#include <hip/hip_runtime.h>
#include <cstdio>
#include <cstdint>

constexpr int BATCH = 8, SEQ = 4096, DM = 1024, T = BATCH * SEQ;
constexpr int NMEM = 256, TM = BATCH * NMEM;
constexpr float EPS = 1e-6f;
constexpr int MLA_H = 8, QLORA = 256, KVLORA = 128, NOPE = 64, ROPE = 32, VD = 64, DQK = NOPE + ROPE;
constexpr int ML_H = 4, ML_D = 128, ML_W = 512;
constexpr int XH = 4, XD = 256;
constexpr int DFF = 2816;
constexpr int INW = 2480;
constexpr int LDZ = 2560, ZC_CQ = 0, ZC_CKV = 256, ZC_KR = 384, ZC_G = 416, ZC_QK = 512, ZC_V = 1536, ZC_O = 2048;
constexpr int NWAVES = 8, NTHR = 512;

constexpr size_t MiB = 1u << 20;
constexpr size_t WS_CTL = 0;
constexpr size_t WS_WIN = 1 * MiB;
constexpr size_t WS_WUQ = 6 * MiB;
constexpr size_t WS_WUKV = 7 * MiB;
constexpr size_t WS_WOUT = 8 * MiB;
constexpr size_t WS_WXQ = 10 * MiB;
constexpr size_t WS_WXKV = 12 * MiB;
constexpr size_t WS_WXO = 16 * MiB;
constexpr size_t WS_WGU = 18 * MiB;
constexpr size_t WS_WD = 30 * MiB;
constexpr size_t WS_COS = 36 * MiB;
constexpr size_t WS_SIN = 38 * MiB;
constexpr size_t WS_G = 40 * MiB;
constexpr size_t WS_KR = 42 * MiB;
constexpr size_t WS_SSQ = 44 * MiB;
constexpr size_t WS_MEMN = 46 * MiB;
constexpr size_t WS_KVM = 50 * MiB;
constexpr size_t WS_XB = 64 * MiB;
constexpr size_t WS_Z = 128 * MiB;
constexpr size_t WS_H = 128 * MiB;
constexpr size_t WS_QALL = 288 * MiB;
constexpr size_t WS_KV = 336 * MiB;
constexpr size_t WS_Y = 400 * MiB;
constexpr size_t WS_HQ = 304 * MiB;
constexpr size_t WS_OX = 368 * MiB;
constexpr size_t WS_END = 464 * MiB;

typedef unsigned short bf16_t;
typedef short bf16x8 __attribute__((ext_vector_type(8)));
typedef float f32x4 __attribute__((ext_vector_type(4)));
typedef unsigned u32x4 __attribute__((ext_vector_type(4)));
typedef unsigned u32x2 __attribute__((ext_vector_type(2)));
#define LAS __attribute__((address_space(3)))

__device__ __forceinline__ float bf2f(bf16_t h) { return __uint_as_float(((unsigned)h) << 16); }
__device__ __forceinline__ unsigned f2bf(float f) { unsigned u = __float_as_uint(f); return (u + 0x7fffu + ((u >> 16) & 1u)) >> 16; }
__device__ __forceinline__ unsigned pk2(float lo, float hi) { return f2bf(lo) | (f2bf(hi) << 16); }
__device__ __forceinline__ float wave_sum(float v) {
#pragma unroll
    for (int o = 1; o < 64; o <<= 1) v += __shfl_xor(v, o);
    return v;
}
__device__ __forceinline__ float wave_max(float v) {
#pragma unroll
    for (int o = 1; o < 64; o <<= 1) v = fmaxf(v, __shfl_xor(v, o));
    return v;
}

struct Params {
    const float* x; const float* mem; const int* pos;
    const float *attn_norm, *w_in, *q_norm, *w_uq, *kv_norm, *w_ukv, *conv, *gbias, *ml_norm, *w_out, *xattn_norm, *mem_norm, *w_xq, *w_xkv, *w_xo, *ffn_norm, *w_gu, *w_down, *final_norm;
    float* out; unsigned char* ws; unsigned char* ws2;
    int ph_lo, ph_hi;
};

struct Unit { int pm, pn; };
struct Gemm { const bf16_t* A; int lda; const bf16_t* Bt; int ldb; int M, N, K; };

template <class Epi>
__device__ __forceinline__ void gemm_naive(const Gemm g, const Epi& E) {
    const int tid = threadIdx.x, wid = tid >> 6, lane = tid & 63, wr = wid >> 2, wc = wid & 3, fr = lane & 15, fq = lane >> 4;
    const int nM = g.M / 256, nN = g.N / 256;
    for (int unit = blockIdx.x; unit < nM * nN; unit += gridDim.x) {
        Unit u; u.pm = unit / nN; u.pn = unit % nN;
        f32x4 acc[2][2][4][2];
#pragma unroll
        for (int a = 0; a < 2; ++a)
#pragma unroll
            for (int b = 0; b < 2; ++b)
#pragma unroll
                for (int m = 0; m < 4; ++m)
#pragma unroll
                    for (int n = 0; n < 2; ++n) acc[a][b][m][n] = (f32x4){0.f, 0.f, 0.f, 0.f};
        const bf16_t* Ab = g.A + (size_t)(u.pm * 256 + wr * 64 + fr) * g.lda + 8 * fq;
        const bf16_t* Bb = g.Bt + (size_t)(u.pn * 256 + wc * 32 + 8 * (fr >> 2) + (fr & 3)) * g.ldb + 8 * fq;
        for (int kk = 0; kk < g.K; kk += 32) {
            bf16x8 a[2][4], b[2][2];
#pragma unroll
            for (int ai = 0; ai < 2; ++ai)
#pragma unroll
                for (int m = 0; m < 4; ++m) a[ai][m] = *(const bf16x8*)(Ab + (size_t)(ai * 128 + m * 16) * g.lda + kk);
#pragma unroll
            for (int bj = 0; bj < 2; ++bj)
#pragma unroll
                for (int n = 0; n < 2; ++n) b[bj][n] = *(const bf16x8*)(Bb + (size_t)(bj * 128 + 4 * n) * g.ldb + kk);
#pragma unroll
            for (int ai = 0; ai < 2; ++ai)
#pragma unroll
                for (int bj = 0; bj < 2; ++bj)
#pragma unroll
                    for (int m = 0; m < 4; ++m)
#pragma unroll
                        for (int n = 0; n < 2; ++n) acc[ai][bj][m][n] = __builtin_amdgcn_mfma_f32_16x16x32_bf16(b[bj][n], a[ai][m], acc[ai][bj][m][n], 0, 0, 0);
        }
        E(acc, u, wr, wc, fr, fq);
    }
}


#define PG8_LAS __attribute__((address_space(3)))
constexpr int BM = 256, BK = 64, HALF = 128, HTB = HALF * BK * 2  , STAGE_BYTES = 8 * HTB, NXCD = 8, WGM = 8;

__host__ __device__ __forceinline__ int lds_byte(int r, int c) { const int st = (r >> 4) * 2 + (c >> 5), rr = r & 15, cc = c & 31, ob = rr * 64 + cc * 2; return st * 1024 + (ob ^ (((ob >> 9) & 1) << 5)); }
__host__ __device__ __forceinline__ void stage_rc(int b, int& R, int& C) { const int st = b / 1024, sb = b % 1024, swz = sb ^ (((sb >> 9) & 1) << 5); R = (st >> 1) * 16 + swz / 64; C = (st & 1) * 32 + (swz % 64) / 2; }
__host__ __device__ __forceinline__ int perm32(int rho) { const int n = rho >> 4, i = rho & 15; return 8 * (i >> 2) + 4 * n + (i & 3); }


struct StaticOrder {
    int nM, nN, nwg, G, c;
    __host__ __device__ void init(int M, int N, int G_, int c_) { nM = M / BM; nN = N / BM; nwg = nM * nN; G = G_; c = c_; }
    __host__ __device__ bool next(int i, Unit& u) const {
        const long L = (long)i * G + c; if (L >= nwg) return false;
        int wgid = (int)L; { const int q = nwg / NXCD, r = nwg % NXCD, xcd = wgid % NXCD, off = wgid / NXCD; wgid = (xcd < r ? xcd * (q + 1) : r * (q + 1) + (xcd - r) * q) + off; }
        const int nig = WGM * nN, gid = wgid / nig, fm = gid * WGM, gsz = (nM - fm) < WGM ? (nM - fm) : WGM;
        u.pm = fm + ((wgid % nig) % gsz); u.pn = (wgid % nig) / gsz; return true;
    }
    __device__ __forceinline__ void a_ready(const Unit&) const {}
    __device__ __forceinline__ void done(const Unit&) const {}
};

template <class Epi, class Sched, bool ALIGN_EPI = false, bool SP2 = false>
__device__ __forceinline__ void gemm_phase(PG8_LAS unsigned char* lds, const Gemm g, const Sched& S, const Epi& E) {
    const int tid = threadIdx.x, wid = __builtin_amdgcn_readfirstlane(tid >> 6), lane = tid & 63, wr = wid >> 2, wc = wid & 3, fr = lane & 15, fq = lane >> 4;
    const int K = g.K, nt = K / BK, lda = g.lda, ldb = g.ldb;
    unsigned voffA[2], voffB[2];
#pragma unroll
    for (int i = 0; i < 2; ++i) { int R, C; stage_rc(tid * 16 + i * 8192, R, C); const int Rb = Epi::PERM ? ((R & ~31) + perm32(R & 31)) : R;
        voffA[i] = (unsigned)(R * lda + C) * 2u; voffB[i] = (unsigned)(Rb * ldb + C) * 2u; }
    const size_t kstep = (size_t)(BK * 2);
    const size_t hstepA = (size_t)HALF * lda * 2, hstepB = (size_t)HALF * ldb * 2;
    const size_t tstepA = 2 * hstepA, tstepB = 2 * hstepB;
    const unsigned ldsw = (unsigned)wid * 1024u;
    const int aoff = lds_byte(wr * 64 + fr, fq * 8), boff = lds_byte(wc * 32 + fr, fq * 8);
#define PG8_SA(b, h) (((b) * 2 + (h)) * HTB)
#define PG8_SB(b, h) ((4 + (b) * 2 + (h)) * HTB)
#define PG8_STAGE(bufoff, gbase, voff) do { _Pragma("unroll") for (int _i = 0; _i < 2; ++_i) \
        __builtin_amdgcn_global_load_lds((const unsigned*)((const char*)(gbase) + (voff)[_i]), (PG8_LAS unsigned*)(lds + (bufoff) + ldsw + _i * 8192), 16, 0, 0); } while (0)
#define PG8_LDA(dst, b, h) do { _Pragma("unroll") for (int m = 0; m < 4; ++m) _Pragma("unroll") for (int k = 0; k < 2; ++k) dst[m][k] = *(const PG8_LAS bf16x8*)(lds + PG8_SA(b, h) + aoff + m * 2048 + k * 1024); } while (0)
#define PG8_LDB(dst, b, h) do { _Pragma("unroll") for (int n = 0; n < 2; ++n) _Pragma("unroll") for (int k = 0; k < 2; ++k) dst[n][k] = *(const PG8_LAS bf16x8*)(lds + PG8_SB(b, h) + boff + n * 2048 + k * 1024); } while (0)
#define PG8_MMA(ai, bj, At, Bt) do { __builtin_amdgcn_s_setprio(1); _Pragma("unroll") for (int m = 0; m < 4; ++m) _Pragma("unroll") for (int n = 0; n < 2; ++n) _Pragma("unroll") for (int k = 0; k < 2; ++k) \
        acc[ai][bj][m][n] = __builtin_amdgcn_mfma_f32_16x16x32_bf16(Bt[n][k], At[m][k], acc[ai][bj][m][n], 0, 0, 0); __builtin_amdgcn_s_setprio(0); } while (0)
#define PG8_WAIT_V(n) asm volatile("s_waitcnt vmcnt(" #n ")" ::: "memory")
#define PG8_WAIT_L(n) asm volatile("s_waitcnt lgkmcnt(" #n ")" ::: "memory")
#define PG8_BAR __builtin_amdgcn_s_barrier()
#define PG8_SCHED __builtin_amdgcn_sched_barrier(0)
    Unit cur, nxt; int ui = 0;
    if (!S.next(0, cur)) return;
    f32x4 acc[2][2][4][2];
#pragma unroll
    for (int a = 0; a < 2; ++a)
#pragma unroll
        for (int b = 0; b < 2; ++b)
#pragma unroll
            for (int m = 0; m < 4; ++m)
#pragma unroll
                for (int n = 0; n < 2; ++n) acc[a][b][m][n] = (f32x4){0.f, 0.f, 0.f, 0.f};
    bf16x8 At[4][2], B0[2][2], B1[2][2];
    const char* cA = (const char*)g.A + (size_t)cur.pm * tstepA; const char* cB = (const char*)g.Bt + (size_t)cur.pn * tstepB;
    S.a_ready(cur);
    if constexpr (SP2) {
        PG8_STAGE(PG8_SB(0, 0), cB, voffB); PG8_STAGE(PG8_SB(0, 1), cB + hstepB, voffB); PG8_STAGE(PG8_SA(0, 0), cA, voffA); PG8_STAGE(PG8_SA(0, 1), cA + hstepA, voffA);
        if (wr == 1) PG8_BAR;
        PG8_WAIT_V(2); PG8_BAR;
        PG8_STAGE(PG8_SB(1, 0), cB + kstep, voffB); PG8_STAGE(PG8_SA(1, 0), cA + kstep, voffA); PG8_STAGE(PG8_SB(1, 1), cB + hstepB + kstep, voffB);
        PG8_WAIT_V(6); PG8_BAR;
    } else {
        PG8_STAGE(PG8_SB(0, 0), cB, voffB); PG8_STAGE(PG8_SA(0, 0), cA, voffA); PG8_STAGE(PG8_SB(0, 1), cB + hstepB, voffB); PG8_STAGE(PG8_SA(0, 1), cA + hstepA, voffA);
        if (wr == 1) PG8_BAR;
        PG8_WAIT_V(4); PG8_BAR;
        PG8_STAGE(PG8_SB(1, 0), cB + kstep, voffB); PG8_STAGE(PG8_SA(1, 0), cA + kstep, voffA); PG8_STAGE(PG8_SB(1, 1), cB + hstepB + kstep, voffB);
        PG8_WAIT_V(6); PG8_BAR;
    }
    for (;;) {
        const bool has_next = S.next(ui + 1, nxt);
        const char* nA = has_next ? (const char*)g.A + (size_t)nxt.pm * tstepA : cA; const char* nB = has_next ? (const char*)g.Bt + (size_t)nxt.pn * tstepB : cB;
        for (int t = 0; t < nt; t += 2) {
            const bool last = (t == nt - 2);
            const char* a1 = cA + (size_t)(t + 1) * kstep;
            const char* a2 = last ? nA : cA + (size_t)(t + 2) * kstep; const char* b2 = last ? nB : cB + (size_t)(t + 2) * kstep;
            const char* a3 = a2 + kstep; const char* b3 = b2 + kstep;
            if (last && has_next) S.a_ready(nxt);
            if constexpr (SP2) {
            PG8_LDB(B0, 0, 0); PG8_LDB(B1, 0, 1); PG8_SCHED; PG8_LDA(At, 0, 0); PG8_STAGE(PG8_SA(1, 1), a1 + hstepA, voffA);
            PG8_WAIT_V(8); PG8_WAIT_L(0); PG8_BAR; PG8_MMA(0, 0, At, B0); PG8_MMA(0, 1, At, B1); PG8_BAR; PG8_SCHED;
            PG8_LDA(At, 0, 1); PG8_STAGE(PG8_SB(0, 0), b2, voffB); PG8_STAGE(PG8_SB(0, 1), b2 + hstepB, voffB); PG8_STAGE(PG8_SA(0, 0), a2, voffA);
            PG8_WAIT_V(8); PG8_WAIT_L(0); PG8_BAR; PG8_MMA(1, 0, At, B0); PG8_MMA(1, 1, At, B1); PG8_BAR; PG8_SCHED;
            PG8_LDB(B0, 1, 0); PG8_LDB(B1, 1, 1); PG8_SCHED; PG8_LDA(At, 1, 0); PG8_STAGE(PG8_SA(0, 1), a2 + hstepA, voffA);
            PG8_WAIT_V(8); PG8_WAIT_L(0); PG8_BAR; PG8_MMA(0, 0, At, B0); PG8_MMA(0, 1, At, B1); PG8_BAR; PG8_SCHED;
            PG8_LDA(At, 1, 1); PG8_STAGE(PG8_SB(1, 0), b3, voffB); PG8_STAGE(PG8_SB(1, 1), b3 + hstepB, voffB); PG8_STAGE(PG8_SA(1, 0), a3, voffA);
            PG8_WAIT_V(8); PG8_WAIT_L(0); PG8_BAR; PG8_MMA(1, 0, At, B0); PG8_MMA(1, 1, At, B1); PG8_BAR; PG8_SCHED;
            } else {
            PG8_LDB(B0, 0, 0); PG8_SCHED; PG8_LDA(At, 0, 0); PG8_STAGE(PG8_SA(1, 1), a1 + hstepA, voffA);
            PG8_WAIT_L(8); PG8_BAR; PG8_WAIT_L(0); PG8_MMA(0, 0, At, B0); PG8_BAR; PG8_SCHED;
            PG8_LDB(B1, 0, 1); PG8_STAGE(PG8_SB(0, 0), b2, voffB);
            PG8_BAR; PG8_WAIT_L(0); PG8_MMA(0, 1, At, B1); PG8_BAR;
            PG8_LDA(At, 0, 1); PG8_STAGE(PG8_SA(0, 0), a2, voffA);
            PG8_BAR; PG8_WAIT_L(0); PG8_MMA(1, 0, At, B0); PG8_BAR; PG8_SCHED;
            PG8_STAGE(PG8_SB(0, 1), b2 + hstepB, voffB);
            PG8_WAIT_V(6); PG8_BAR; PG8_MMA(1, 1, At, B1); PG8_BAR;
            PG8_LDB(B0, 1, 0); PG8_SCHED; PG8_LDA(At, 1, 0); PG8_STAGE(PG8_SA(0, 1), a2 + hstepA, voffA);
            PG8_WAIT_L(8); PG8_BAR; PG8_WAIT_L(0); PG8_MMA(0, 0, At, B0); PG8_BAR; PG8_SCHED;
            PG8_LDB(B1, 1, 1); PG8_STAGE(PG8_SB(1, 0), b3, voffB);
            PG8_BAR; PG8_WAIT_L(0); PG8_MMA(0, 1, At, B1); PG8_BAR;
            PG8_LDA(At, 1, 1); PG8_STAGE(PG8_SA(1, 0), a3, voffA);
            PG8_BAR; PG8_WAIT_L(0); PG8_MMA(1, 0, At, B0); PG8_BAR; PG8_SCHED;
            PG8_STAGE(PG8_SB(1, 1), b3 + hstepB, voffB);
            PG8_WAIT_V(6); PG8_BAR; PG8_MMA(1, 1, At, B1); PG8_BAR;
            }
        }
        if constexpr (ALIGN_EPI) { if (wr == 0) PG8_BAR; }
        if constexpr (!Epi::AFTER_DRAIN) { E(acc, cur, wr, wc, fr, fq); S.done(cur); }
        if (!has_next) break;
#pragma unroll
        for (int a = 0; a < 2; ++a)
#pragma unroll
            for (int b = 0; b < 2; ++b)
#pragma unroll
                for (int m = 0; m < 4; ++m)
#pragma unroll
                    for (int n = 0; n < 2; ++n) acc[a][b][m][n] = (f32x4){0.f, 0.f, 0.f, 0.f};
        cur = nxt; cA = nA; cB = nB; ++ui;
        if constexpr (ALIGN_EPI) { if (wr == 1) PG8_BAR; }
    }
    PG8_WAIT_V(0);
    if constexpr (!ALIGN_EPI) { if (wr == 0) PG8_BAR; }
    PG8_BAR;
    if constexpr (Epi::AFTER_DRAIN) { E.fused(acc, cur, wr, wc, fr, fq, lds, wid, lane); S.done(cur); }
#undef PG8_SA
#undef PG8_SB
#undef PG8_STAGE
#undef PG8_LDA
#undef PG8_LDB
#undef PG8_MMA
#undef PG8_WAIT_V
#undef PG8_WAIT_L
#undef PG8_BAR
#undef PG8_SCHED
}

__device__ __forceinline__ u32x4 pack8(const f32x4 v0, const f32x4 v1) { u32x4 w; w.x = pk2(v0[0], v0[1]); w.y = pk2(v0[2], v0[3]); w.z = pk2(v1[0], v1[1]); w.w = pk2(v1[2], v1[3]); return w; }
__device__ __forceinline__ float sq8(const f32x4 a, const f32x4 b) { return (a[0] * a[0] + a[1] * a[1]) + (a[2] * a[2] + a[3] * a[3]) + (b[0] * b[0] + b[1] * b[1]) + (b[2] * b[2] + b[3] * b[3]); }

struct EpiZ {
    static constexpr bool PERM = true, AFTER_DRAIN = false;
    bf16_t* Z; float* ssq_q; float* ssq_kv; bf16_t* KR; float* G; const float* cosT; const float* sinT;
    __device__ __forceinline__ void operator()(const f32x4 (&acc)[2][2][4][2], const Unit& u, int wr, int wc, int fr, int fq) const {
#pragma unroll
        for (int ai = 0; ai < 2; ++ai)
#pragma unroll
            for (int m = 0; m < 4; ++m) {
                const int row = u.pm * 256 + ai * 128 + wr * 64 + m * 16 + fr;
                bf16_t* zp = Z + (size_t)row * LDZ + u.pn * 256 + wc * 32 + 8 * fq;
#pragma unroll
                for (int bj = 0; bj < 2; ++bj) *(u32x4*)(zp + bj * 128) = pack8(acc[ai][bj][m][0], acc[ai][bj][m][1]);
                if (u.pn == 0) {
                    float s = sq8(acc[ai][0][m][0], acc[ai][0][m][1]) + sq8(acc[ai][1][m][0], acc[ai][1][m][1]);
                    s += __shfl_xor(s, 16); s += __shfl_xor(s, 32);
                    if (fq == 0) atomicAdd(ssq_q + row, s);
                } else if (u.pn == 1) {
                    float s = sq8(acc[ai][0][m][0], acc[ai][0][m][1]);
                    s += __shfl_xor(s, 16); s += __shfl_xor(s, 32);
                    if (fq == 0) atomicAdd(ssq_kv + row, s);
                    if (wc == 0) {
                        const f32x4 o0 = acc[ai][1][m][0], o1 = acc[ai][1][m][1];
                        f32x4 p0, p1;
#pragma unroll
                        for (int j = 0; j < 4; ++j) { p0[j] = __shfl_xor(o0[j], 32); p1[j] = __shfl_xor(o1[j], 32); }
                        const int jj = 8 * (fq & 1);
                        const f32x4 c0 = *(const f32x4*)(cosT + (size_t)row * 16 + jj), c1 = *(const f32x4*)(cosT + (size_t)row * 16 + jj + 4);
                        const f32x4 s0 = *(const f32x4*)(sinT + (size_t)row * 16 + jj), s1 = *(const f32x4*)(sinT + (size_t)row * 16 + jj + 4);
                        f32x4 r0, r1;
                        if (fq < 2) { r0 = o0 * c0 - p0 * s0; r1 = o1 * c1 - p1 * s1; }
                        else        { r0 = o0 * c0 + p0 * s0; r1 = o1 * c1 + p1 * s1; }
                        *(u32x4*)(KR + (size_t)row * 32 + 8 * fq) = pack8(r0, r1);
                    } else if (wc == 1 && fq < 2) {
                        *(f32x4*)(G + (size_t)row * 16 + 8 * fq) = acc[ai][1][m][0];
                        *(f32x4*)(G + (size_t)row * 16 + 8 * fq + 4) = acc[ai][1][m][1];
                    }
                }
            }
    }
};
struct EpiScaleBf16 {
    static constexpr bool PERM = true, AFTER_DRAIN = false;
    bf16_t* O; int ldo; const float* ssq; float inv_n; float c;
    __device__ __forceinline__ void operator()(const f32x4 (&acc)[2][2][4][2], const Unit& u, int wr, int wc, int fr, int fq) const {
#pragma unroll
        for (int ai = 0; ai < 2; ++ai)
#pragma unroll
            for (int m = 0; m < 4; ++m) {
                const int row = u.pm * 256 + ai * 128 + wr * 64 + m * 16 + fr;
                const float sc = ssq ? c * rsqrtf(ssq[row] * inv_n + EPS) : c;
                bf16_t* op = O + (size_t)row * ldo + u.pn * 256 + wc * 32 + 8 * fq;
#pragma unroll
                for (int bj = 0; bj < 2; ++bj) *(u32x4*)(op + bj * 128) = pack8(acc[ai][bj][m][0] * sc, acc[ai][bj][m][1] * sc);
            }
    }
};
struct EpiResid {
    static constexpr bool PERM = true, AFTER_DRAIN = false;
    const float* res; float* out; bf16_t* XB; float* ssq;
    __device__ __forceinline__ void operator()(const f32x4 (&acc)[2][2][4][2], const Unit& u, int wr, int wc, int fr, int fq) const {
#pragma unroll
        for (int ai = 0; ai < 2; ++ai)
#pragma unroll
            for (int m = 0; m < 4; ++m) {
                const int row = u.pm * 256 + ai * 128 + wr * 64 + m * 16 + fr;
                const size_t off = (size_t)row * DM + u.pn * 256 + wc * 32 + 8 * fq;
                float s = 0.f;
#pragma unroll
                for (int bj = 0; bj < 2; ++bj) {
                    const f32x4 v0 = *(const f32x4*)(res + off + bj * 128) + acc[ai][bj][m][0];
                    const f32x4 v1 = *(const f32x4*)(res + off + bj * 128 + 4) + acc[ai][bj][m][1];
                    *(f32x4*)(out + off + bj * 128) = v0; *(f32x4*)(out + off + bj * 128 + 4) = v1;
                    if (XB) *(u32x4*)(XB + off + bj * 128) = pack8(v0, v1);
                    s += sq8(v0, v1);
                }
                s += __shfl_xor(s, 16); s += __shfl_xor(s, 32);
                if (fq == 0) atomicAdd(ssq + row, s);
            }
    }
};
struct EpiSwiglu {
    static constexpr bool PERM = true, AFTER_DRAIN = false;
    bf16_t* H; const float* ssq;
    __device__ __forceinline__ void operator()(const f32x4 (&acc)[2][2][4][2], const Unit& u, int wr, int wc, int fr, int fq) const {
#pragma unroll
        for (int ai = 0; ai < 2; ++ai)
#pragma unroll
            for (int m = 0; m < 4; ++m) {
                const int row = u.pm * 256 + ai * 128 + wr * 64 + m * 16 + fr;
                const float sc = rsqrtf(ssq[row] * (1.0f / DM) + EPS);
                f32x4 h[2];
#pragma unroll
                for (int n = 0; n < 2; ++n)
#pragma unroll
                    for (int j = 0; j < 4; ++j) { const float gg = acc[ai][0][m][n][j] * sc, uu = acc[ai][1][m][n][j] * sc; h[n][j] = gg * uu / (1.0f + __expf(-gg)); }
                *(u32x4*)(H + (size_t)row * DFF + u.pn * 128 + wc * 32 + 8 * fq) = pack8(h[0], h[1]);
            }
    }
};

#ifndef FAST_GEMM
#define FAST_GEMM 1
#endif
template <class Epi>
__device__ __forceinline__ void run_gemm(LAS unsigned char* lds, const Gemm g, const Epi& E, int c) {
#if FAST_GEMM
    StaticOrder S; S.init(g.M, g.N, (int)gridDim.x, c);
    gemm_phase<Epi, StaticOrder, true, true>(lds, g, S, E);
#else
    gemm_naive(g, E);
#endif
}

struct MapIdent { __device__ __forceinline__ int operator()(int n) const { return n; } };
struct MapWin { __device__ __forceinline__ int operator()(int n) const {
    if (n < 416) return n; if (n < 1440) return ZC_QK + (n - 416); if (n < 1952) return ZC_V + (n - 1440); if (n < 2464) return ZC_O + (n - 1952); return ZC_G + (n - 2464); } };
struct MapGU { __device__ __forceinline__ int operator()(int n) const { const int up = n >= DFF, j = up ? n - DFF : n; return (j >> 7) * 256 + up * 128 + (j & 127); } };

template <class Map>
__device__ __forceinline__ void transpose_w(const float* W, int K, int N, const float* gain, bf16_t* WT, int ldt, Map map, LAS float* scr, int gw, int ngw, int lane) {
    const int nblk = (N + 31) / 32, nitems = (K / 64) * nblk;
    for (int it = gw; it < nitems; it += ngw) {
        const int kb = it / nblk, nb = it % nblk, k0 = 64 * kb, n0 = 32 * nb;
        for (int i = 0; i < 32; ++i) { const int kk = 2 * i + (lane >> 5), nn = n0 + (lane & 31);
            float v = 0.f; if (nn < N) { v = W[(size_t)(k0 + kk) * N + nn]; if (gain) v *= gain[k0 + kk]; }
            scr[kk * 33 + (lane & 31)] = v; }
        asm volatile("s_waitcnt lgkmcnt(0)" ::: "memory");
        const int c = lane & 7;
#pragma unroll
        for (int j = 0; j < 4; ++j) { const int n = (lane >> 3) + 8 * j, nn = n0 + n;
            if (nn < N) { const LAS float* s = scr + (8 * c) * 33 + n;
                u32x4 o; o.x = pk2(s[0 * 33], s[1 * 33]); o.y = pk2(s[2 * 33], s[3 * 33]); o.z = pk2(s[4 * 33], s[5 * 33]); o.w = pk2(s[6 * 33], s[7 * 33]);
                *(u32x4*)(WT + (size_t)map(nn) * ldt + k0 + 8 * c) = o; } }
        asm volatile("s_waitcnt lgkmcnt(0)" ::: "memory");
    }
}
__device__ __forceinline__ void rms_row_bf16(const float* xrow, const float* gain, bf16_t* orow, int lane) {
    const f32x4* xr = (const f32x4*)xrow + lane; const f32x4* gr = (const f32x4*)gain + lane;
    f32x4 v[4]; float s = 0.f;
#pragma unroll
    for (int j = 0; j < 4; ++j) { v[j] = xr[64 * j]; s += (v[j][0] * v[j][0] + v[j][1] * v[j][1]) + (v[j][2] * v[j][2] + v[j][3] * v[j][3]); }
    const float r = rsqrtf(wave_sum(s) * (1.0f / DM) + EPS);
    u32x2* o8 = (u32x2*)orow + lane;
#pragma unroll
    for (int j = 0; j < 4; ++j) { const f32x4 gg = gr[64 * j]; u32x2 w; w.x = pk2(v[j][0] * r * gg[0], v[j][1] * r * gg[1]); w.y = pk2(v[j][2] * r * gg[2], v[j][3] * r * gg[3]); o8[64 * j] = w; }
}

__device__ __forceinline__ void phase0(const Params& p, LAS unsigned char* lds) {
    const int tid = threadIdx.x, wid = tid >> 6, lane = tid & 63;
    const int gw = blockIdx.x * NWAVES + wid, ngw = gridDim.x * NWAVES;
    const int gt = blockIdx.x * NTHR + tid, ngt = gridDim.x * NTHR;
    LAS float* scr = (LAS float*)(lds + wid * 16384);
    unsigned char* ws = p.ws;
    transpose_w(p.w_in, DM, INW, nullptr, (bf16_t*)(ws + WS_WIN), DM, MapWin(), scr, gw, ngw, lane);
    transpose_w(p.w_uq, QLORA, MLA_H * DQK, p.q_norm, (bf16_t*)(ws + WS_WUQ), QLORA, MapIdent(), scr, gw, ngw, lane);
    transpose_w(p.w_ukv, KVLORA, MLA_H * (NOPE + VD), p.kv_norm, (bf16_t*)(ws + WS_WUKV), 256, MapIdent(), scr, gw, ngw, lane);
    transpose_w(p.w_out, DM, DM, nullptr, (bf16_t*)(ws + WS_WOUT), DM, MapIdent(), scr, gw, ngw, lane);
    transpose_w(p.w_xq, DM, DM, p.xattn_norm, (bf16_t*)(ws + WS_WXQ), DM, MapIdent(), scr, gw, ngw, lane);
    transpose_w(p.w_xkv, DM, 2 * DM, nullptr, (bf16_t*)(ws + WS_WXKV), DM, MapIdent(), scr, gw, ngw, lane);
    transpose_w(p.w_xo, DM, DM, nullptr, (bf16_t*)(ws + WS_WXO), DM, MapIdent(), scr, gw, ngw, lane);
    transpose_w(p.w_gu, DM, 2 * DFF, p.ffn_norm, (bf16_t*)(ws + WS_WGU), DM, MapGU(), scr, gw, ngw, lane);
    transpose_w(p.w_down, DFF, DM, nullptr, (bf16_t*)(ws + WS_WD), DFF, MapIdent(), scr, gw, ngw, lane);
    { bf16_t* wz = (bf16_t*)(ws + WS_WIN) + (size_t)432 * DM; for (int i = gt; i < 80 * DM / 8; i += ngt) ((u32x4*)wz)[i] = (u32x4){0u, 0u, 0u, 0u};
      bf16_t* wk = (bf16_t*)(ws + WS_WUKV); for (int i = gt; i < 1024 * 16; i += ngt) { const int r = i >> 4, c = i & 15; *(u32x4*)(wk + (size_t)r * 256 + 128 + 8 * c) = (u32x4){0u, 0u, 0u, 0u}; } }
    { float* ssq = (float*)(ws + WS_SSQ); for (int i = gt; i < 5 * T; i += ngt) ssq[i] = 0.f; }
    { float* ct = (float*)(ws + WS_COS); float* st = (float*)(ws + WS_SIN);
      for (int i = gt; i < T * 16; i += ngt) { const int row = i >> 4, j = i & 15; const float inv = (float)pow(10000.0, -(double)(2 * j) / 32.0); const float ang = (float)p.pos[row] * inv; ct[i] = cosf(ang); st[i] = sinf(ang); } }
    for (int r = gw; r < T; r += ngw) rms_row_bf16(p.x + (size_t)r * DM, p.attn_norm, (bf16_t*)(ws + WS_XB) + (size_t)r * DM, lane);
    for (int r = gw; r < TM; r += ngw) rms_row_bf16(p.mem + (size_t)r * DM, p.mem_norm, (bf16_t*)(ws + WS_MEMN) + (size_t)r * DM, lane);
}

__device__ __forceinline__ void phase_conv(const Params& p) {
    const bf16_t* Z = (const bf16_t*)(p.ws + WS_Z); bf16_t* Q = (bf16_t*)p.ws2;
    const int gt = blockIdx.x * NTHR + threadIdx.x, ngt = gridDim.x * NTHR;
    for (int i = gt; i < T * 128; i += ngt) {
        const int row = i >> 7, c0 = (i & 127) * 8, t = row & (SEQ - 1);
        const bf16x8 zc = *(const bf16x8*)(Z + (size_t)row * LDZ + ZC_QK + c0);
        bf16x8 zp = (bf16x8){0, 0, 0, 0, 0, 0, 0, 0}, zn = zp;
        if (t > 0) zp = *(const bf16x8*)(Z + (size_t)(row - 1) * LDZ + ZC_QK + c0);
        if (t < SEQ - 1) zn = *(const bf16x8*)(Z + (size_t)(row + 1) * LDZ + ZC_QK + c0);
        const float sc = c0 >= 512 ? 0.08838834764831845f : 1.0f;
        float o[8];
#pragma unroll
        for (int j = 0; j < 8; ++j) { const float a = p.conv[c0 + j] * bf2f((bf16_t)zp[j]) + p.conv[1024 + c0 + j] * bf2f((bf16_t)zc[j]) + p.conv[2048 + c0 + j] * bf2f((bf16_t)zn[j]);
            o[j] = a / (1.0f + __expf(-a)) * sc; }
        u32x4 w; w.x = pk2(o[0], o[1]); w.y = pk2(o[2], o[3]); w.z = pk2(o[4], o[5]); w.w = pk2(o[6], o[7]);
        *(u32x4*)(Q + (size_t)row * 1024 + c0) = w;
    }
}

__device__ __forceinline__ void mlstm_naive(const Params& p) {
    const bf16_t* Z = (const bf16_t*)(p.ws + WS_Z); const bf16_t* QKC = (const bf16_t*)p.ws2; const float* G = (const float*)(p.ws + WS_G);
    float* HF = p.out; float* HB = p.out + (size_t)T * ML_W;
    const int tid = threadIdx.x, d = tid >> 2, eq = tid & 3;
    for (int unit = blockIdx.x; unit < BATCH * ML_H * 2; unit += gridDim.x) {
        const int dir = unit & 1, h = (unit >> 1) & 3, b = unit >> 3;
        float C[32], n[32]; float m = 0.f;
#pragma unroll
        for (int j = 0; j < 32; ++j) { C[j] = 0.f; n[j] = 0.f; }
        const float bi = p.gbias[dir * 8 + h], bff = p.gbias[dir * 8 + 4 + h];
        float* Hout = dir ? HB : HF;
        for (int s = 0; s < SEQ; ++s) {
            const int t = dir ? SEQ - 1 - s : s; const size_t row = (size_t)b * SEQ + t;
            const float ip = G[row * 16 + dir * 8 + h] + bi, fp = G[row * 16 + dir * 8 + 4 + h] + bff;
            const float logf = fminf(fp, 0.f) - log1pf(__expf(-fabsf(fp)));
            const float mn = fmaxf(logf + m, ip), fe = __expf(logf + m - mn), ie = __expf(ip - mn);
            m = mn;
            const float vv = bf2f(Z[row * LDZ + ZC_V + h * 128 + d]) * ie;
            float pn = 0.f, pd = 0.f;
#pragma unroll
            for (int c = 0; c < 4; ++c) {
                const bf16x8 q8 = *(const bf16x8*)(QKC + row * 1024 + h * 128 + eq * 32 + c * 8);
                const bf16x8 k8 = *(const bf16x8*)(QKC + row * 1024 + 512 + h * 128 + eq * 32 + c * 8);
#pragma unroll
                for (int j = 0; j < 8; ++j) { const float qq = bf2f((bf16_t)q8[j]), kk = bf2f((bf16_t)k8[j]);
                    C[c * 8 + j] = fe * C[c * 8 + j] + vv * kk; n[c * 8 + j] = fe * n[c * 8 + j] + ie * kk;
                    pn += C[c * 8 + j] * qq; pd += n[c * 8 + j] * qq; }
            }
            pn += __shfl_xor(pn, 1); pn += __shfl_xor(pn, 2); pd += __shfl_xor(pd, 1); pd += __shfl_xor(pd, 2);
            if (eq == 0) Hout[row * ML_W + h * 128 + d] = pn / fmaxf(fabsf(pd), __expf(-mn));
        }
    }
}
__device__ __forceinline__ void phase_mlfin(const Params& p) {
    const bf16_t* Z = (const bf16_t*)(p.ws + WS_Z); bf16_t* Y = (bf16_t*)(p.ws + WS_Y);
    const float* HF = p.out; const float* HB = p.out + (size_t)T * ML_W;
    const int wid = threadIdx.x >> 6, lane = threadIdx.x & 63;
    for (int row = blockIdx.x * NWAVES + wid; row < T; row += gridDim.x * NWAVES) {
        const size_t o = (size_t)row * ML_W + lane * 8;
        const f32x4 a0 = *(const f32x4*)(HF + o) + *(const f32x4*)(HB + o), a1 = *(const f32x4*)(HF + o + 4) + *(const f32x4*)(HB + o + 4);
        float s = sq8(a0, a1);
        s += __shfl_xor(s, 1); s += __shfl_xor(s, 2); s += __shfl_xor(s, 4); s += __shfl_xor(s, 8);
        const float r = rsqrtf(s * (1.0f / ML_D) + EPS);
        const bf16x8 zo = *(const bf16x8*)(Z + (size_t)row * LDZ + ZC_O + lane * 8);
        const f32x4 g0 = *(const f32x4*)(p.ml_norm + lane * 8), g1 = *(const f32x4*)(p.ml_norm + lane * 8 + 4);
        float ov[8];
#pragma unroll
        for (int j = 0; j < 8; ++j) { const float hv = (j < 4 ? a0[j] : a1[j - 4]) * r * (j < 4 ? g0[j] : g1[j - 4]); const float z = bf2f((bf16_t)zo[j]); ov[j] = hv / (1.0f + __expf(-z)); }
        u32x4 w; w.x = pk2(ov[0], ov[1]); w.y = pk2(ov[2], ov[3]); w.z = pk2(ov[4], ov[5]); w.w = pk2(ov[6], ov[7]);
        *(u32x4*)(Y + (size_t)row * DM + 512 + lane * 8) = w;
    }
}

__device__ __forceinline__ void mla_attn_naive(const Params& p, LAS unsigned char* lds) {
    const bf16_t* QALL = (const bf16_t*)(p.ws + WS_QALL); const bf16_t* KV = (const bf16_t*)(p.ws + WS_KV); const bf16_t* KR = (const bf16_t*)(p.ws + WS_KR);
    const float* cosT = (const float*)(p.ws + WS_COS); const float* sinT = (const float*)(p.ws + WS_SIN); bf16_t* Y = (bf16_t*)(p.ws + WS_Y);
    const int wid = threadIdx.x >> 6, lane = threadIdx.x & 63;
    LAS float* sc = (LAS float*)(lds + wid * 16384);
    LAS float* qs = (LAS float*)(lds + 131072 + wid * 512);
    const float scale = 0.10206207261596575f;
    for (int item = blockIdx.x * NWAVES + wid; item < T * MLA_H; item += gridDim.x * NWAVES) {
        const int h = item & 7, row = item >> 3, b = row / SEQ;
        for (int dd = lane; dd < DQK; dd += 64) {
            float v = bf2f(QALL[(size_t)row * 768 + h * DQK + dd]);
            if (dd >= NOPE) { const int j = (dd - NOPE) & 15; const float c = cosT[(size_t)row * 16 + j], s = sinT[(size_t)row * 16 + j];
                const float other = bf2f(QALL[(size_t)row * 768 + h * DQK + (dd < NOPE + 16 ? dd + 16 : dd - 16)]);
                v = dd < NOPE + 16 ? v * c - other * s : v * c + other * s; }
            qs[dd] = v * scale;
        }
        asm volatile("s_waitcnt lgkmcnt(0)" ::: "memory");
        float mx = -1e30f;
        for (int k0 = 0; k0 < SEQ; k0 += 64) {
            const size_t kr = (size_t)b * SEQ + k0 + lane; float s = 0.f;
#pragma unroll
            for (int c = 0; c < 8; ++c) { const bf16x8 k8 = *(const bf16x8*)(KV + kr * 1024 + h * 128 + c * 8);
#pragma unroll
                for (int j = 0; j < 8; ++j) s += qs[c * 8 + j] * bf2f((bf16_t)k8[j]); }
#pragma unroll
            for (int c = 0; c < 4; ++c) { const bf16x8 k8 = *(const bf16x8*)(KR + kr * 32 + c * 8);
#pragma unroll
                for (int j = 0; j < 8; ++j) s += qs[NOPE + c * 8 + j] * bf2f((bf16_t)k8[j]); }
            sc[k0 + lane] = s; mx = fmaxf(mx, s);
        }
        mx = wave_max(mx);
        float l = 0.f;
        for (int k0 = 0; k0 < SEQ; k0 += 64) { const float e = __expf(sc[k0 + lane] - mx); sc[k0 + lane] = e; l += e; }
        l = wave_sum(l);
        asm volatile("s_waitcnt lgkmcnt(0)" ::: "memory");
        float o = 0.f;
        for (int k = 0; k < SEQ; ++k) o += sc[k] * bf2f(KV[((size_t)b * SEQ + k) * 1024 + h * 128 + 64 + lane]);
        Y[(size_t)row * DM + h * VD + lane] = (bf16_t)f2bf(o / l);
        asm volatile("s_waitcnt lgkmcnt(0)" ::: "memory");
    }
}
__device__ __forceinline__ void x_attn_naive(const Params& p, LAS unsigned char* lds) {
    const bf16_t* HQ = (const bf16_t*)(p.ws + WS_HQ); const bf16_t* KVM = (const bf16_t*)(p.ws + WS_KVM); bf16_t* OX = (bf16_t*)(p.ws + WS_OX);
    const int wid = threadIdx.x >> 6, lane = threadIdx.x & 63;
    LAS float* sc = (LAS float*)(lds + wid * 16384);
    LAS float* qs = (LAS float*)(lds + 131072 + wid * 1024);
    for (int item = blockIdx.x * NWAVES + wid; item < T * XH; item += gridDim.x * NWAVES) {
        const int h = item & 3, row = item >> 2, b = row / SEQ;
        for (int dd = lane; dd < XD; dd += 64) qs[dd] = bf2f(HQ[(size_t)row * DM + h * XD + dd]) * 0.0625f;
        asm volatile("s_waitcnt lgkmcnt(0)" ::: "memory");
        float mx = -1e30f;
        for (int k0 = 0; k0 < NMEM; k0 += 64) {
            const size_t kr = (size_t)b * NMEM + k0 + lane; float s = 0.f;
            for (int c = 0; c < 32; ++c) { const bf16x8 k8 = *(const bf16x8*)(KVM + kr * 2048 + h * XD + c * 8);
#pragma unroll
                for (int j = 0; j < 8; ++j) s += qs[c * 8 + j] * bf2f((bf16_t)k8[j]); }
            sc[k0 + lane] = s; mx = fmaxf(mx, s);
        }
        mx = wave_max(mx);
        float l = 0.f;
        for (int k0 = 0; k0 < NMEM; k0 += 64) { const float e = __expf(sc[k0 + lane] - mx); sc[k0 + lane] = e; l += e; }
        l = wave_sum(l);
        asm volatile("s_waitcnt lgkmcnt(0)" ::: "memory");
        float o[4] = {0.f, 0.f, 0.f, 0.f};
        for (int k = 0; k < NMEM; ++k) { const u32x2 v4 = *(const u32x2*)(KVM + ((size_t)b * NMEM + k) * 2048 + 1024 + h * XD + 4 * lane); const float pk = sc[k];
            o[0] += pk * __uint_as_float(v4.x << 16); o[1] += pk * __uint_as_float(v4.x & 0xffff0000u); o[2] += pk * __uint_as_float(v4.y << 16); o[3] += pk * __uint_as_float(v4.y & 0xffff0000u); }
        const float rl = 1.0f / l; u32x2 w; w.x = pk2(o[0] * rl, o[1] * rl); w.y = pk2(o[2] * rl, o[3] * rl);
        *(u32x2*)(OX + (size_t)row * DM + h * XD + 4 * lane) = w;
        asm volatile("s_waitcnt lgkmcnt(0)" ::: "memory");
    }
}

namespace fa {
using f32x16 = __attribute__((ext_vector_type(16))) float;
using s16x4  = __attribute__((ext_vector_type(4))) short;
#define FA_SBAR() __builtin_amdgcn_sched_barrier(0)
constexpr float THRL = 11.0f;
__device__ __forceinline__ int crow(int r, int hi) { return (r & 3) + 8 * (r >> 2) + 4 * hi; }
__device__ __forceinline__ unsigned cvtpk(float lo, float hi) { unsigned r; asm volatile("v_cvt_pk_bf16_f32 %0, %1, %2" : "=v"(r) : "v"(lo), "v"(hi)); return r; }
__device__ __forceinline__ void partialSM(f32x16& p0, f32x16& p1, float& m_reg, float& mn, float& alpha) {
    float pmax = p0[0];
#pragma unroll
    for (int r = 1; r < 16; ++r) pmax = fmaxf(pmax, p0[r]);
#pragma unroll
    for (int r = 0; r < 16; ++r) pmax = fmaxf(pmax, p1[r]);
    { auto rr = __builtin_amdgcn_permlane32_swap(__float_as_uint(pmax), __float_as_uint(pmax), false, false);
      pmax = fmaxf(__uint_as_float(rr[0]), __uint_as_float(rr[1])); }
    if (__builtin_expect(__all(pmax - m_reg <= THRL), 1)) { mn = m_reg; alpha = 1.f; }
    else { mn = fmaxf(m_reg, pmax); alpha = __builtin_amdgcn_exp2f(m_reg - mn); m_reg = mn; }
#pragma unroll
    for (int r = 0; r < 16; ++r) { p0[r] -= mn; p1[r] -= mn; }
#pragma unroll
    for (int r = 0; r < 16; ++r) p0[r] = __builtin_amdgcn_exp2f(p0[r]);
}
__device__ __forceinline__ void finishSM(f32x16& p0, f32x16& p1, float alpha, float& l_reg, bf16x8& pa0, bf16x8& pa1, bf16x8& pa2, bf16x8& pa3) {
#pragma unroll
    for (int r = 0; r < 16; ++r) p1[r] = __builtin_amdgcn_exp2f(p1[r]);
    float ps = 0;
#pragma unroll
    for (int r = 0; r < 16; ++r) ps += p0[r];
#pragma unroll
    for (int r = 0; r < 16; ++r) ps += p1[r];
    { auto rr = __builtin_amdgcn_permlane32_swap(__float_as_uint(ps), __float_as_uint(ps), false, false);
      ps = __uint_as_float(rr[0]) + __uint_as_float(rr[1]); }
    l_reg = l_reg * alpha + ps;
#define FA_PK4(P, BASE, OUT) do { unsigned a0 = cvtpk(P[BASE + 0], P[BASE + 1]), a1 = cvtpk(P[BASE + 2], P[BASE + 3]);   \
    unsigned b0 = cvtpk(P[BASE + 4], P[BASE + 5]), b1 = cvtpk(P[BASE + 6], P[BASE + 7]);                              \
    auto r0 = __builtin_amdgcn_permlane32_swap(a0, b0, false, false); auto r1 = __builtin_amdgcn_permlane32_swap(a1, b1, false, false); \
    u32x4 w = {r0[0], r1[0], r0[1], r1[1]}; OUT = *reinterpret_cast<bf16x8*>(&w); } while (0)
    FA_PK4(p0, 0, pa0); FA_PK4(p0, 8, pa1); FA_PK4(p1, 0, pa2); FA_PK4(p1, 8, pa3);
#undef FA_PK4
}
template <int NDQ, int KP>
__device__ __forceinline__ void qkt(f32x16& p0, f32x16& p1, const LAS unsigned char* Ks, const bf16x8* qr, int r32, int hi) {
    p0 = f32x16{}; p1 = f32x16{};
#pragma unroll
    for (int d0 = 0; d0 < NDQ; ++d0) { const int cb = (d0 * 16 + hi * 8) * 2;
        const bf16x8 b0 = *(const LAS bf16x8*)(Ks + r32 * KP + cb);
        const bf16x8 b1 = *(const LAS bf16x8*)(Ks + (32 + r32) * KP + cb);
        p0 = __builtin_amdgcn_mfma_f32_32x32x16_bf16(b0, qr[d0], p0, 0, 0, 0);
        p1 = __builtin_amdgcn_mfma_f32_32x32x16_bf16(b1, qr[d0], p1, 0, 0, 0); }
}
template <int NDV> __device__ __forceinline__ int v_st(int k, int c) { const int kk = (k & ~0xC) | ((k & 4) << 1) | ((k & 8) >> 1); return ((kk >> 3) * NDV + (c >> 5)) * 512 + ((kk & 7) * 32 + (c & 31)) * 2; }
__device__ __forceinline__ int v_rd_base(int lane) { return ((lane & 3) << 3) | (((lane >> 2) & 3) << 6) | (((lane >> 4) & 1) << 5) | (((lane >> 5) & 1) << 8); }
template <int OFF> __device__ __forceinline__ s16x4 tr_read(int vb) { s16x4 r; asm volatile("ds_read_b64_tr_b16 %0, %1 offset:%2" : "=&v"(r) : "v"(vb), "i"(OFF) : "memory"); return r; }
template <int NDV, int D0> __device__ __forceinline__ void pv_one(f32x16& od, int vb, bf16x8 pa0, bf16x8 pa1, bf16x8 pa2, bf16x8 pa3) {
    constexpr int KS = 2 * NDV * 512, HF = NDV * 512, B0 = D0 * 512;
    const s16x4 l0 = tr_read<B0>(vb), h0 = tr_read<B0 + HF>(vb), l1 = tr_read<B0 + KS>(vb), h1 = tr_read<B0 + KS + HF>(vb);
    const s16x4 l2 = tr_read<B0 + 2 * KS>(vb), h2 = tr_read<B0 + 2 * KS + HF>(vb), l3 = tr_read<B0 + 3 * KS>(vb), h3 = tr_read<B0 + 3 * KS + HF>(vb);
    asm volatile("s_waitcnt lgkmcnt(0)" ::: "memory"); FA_SBAR();
#define FA_PK(L, H) (bf16x8){L[0], L[1], L[2], L[3], H[0], H[1], H[2], H[3]}
    od = __builtin_amdgcn_mfma_f32_32x32x16_bf16(pa0, FA_PK(l0, h0), od, 0, 0, 0);
    od = __builtin_amdgcn_mfma_f32_32x32x16_bf16(pa1, FA_PK(l1, h1), od, 0, 0, 0);
    od = __builtin_amdgcn_mfma_f32_32x32x16_bf16(pa2, FA_PK(l2, h2), od, 0, 0, 0);
    od = __builtin_amdgcn_mfma_f32_32x32x16_bf16(pa3, FA_PK(l3, h3), od, 0, 0, 0);
#undef FA_PK
}
__device__ __forceinline__ bf16x8 cvt8(const float* v) { u32x4 w = {cvtpk(v[0], v[1]), cvtpk(v[2], v[3]), cvtpk(v[4], v[5]), cvtpk(v[6], v[7])}; return *reinterpret_cast<bf16x8*>(&w); }

constexpr int MLA_KP = 208, MLA_SHM_K = 64 * MLA_KP, MLA_SHM_V = 64 * 64 * 2, MLA_WS = 2 * MLA_SHM_V + 2 * MLA_SHM_K;
__device__ __forceinline__ void mla_unit(int b, int h, int qb, const bf16_t* __restrict__ QALL, const bf16_t* __restrict__ KV, const bf16_t* __restrict__ KR,
                                         const float* __restrict__ cosT, const float* __restrict__ sinT, bf16_t* __restrict__ Y, LAS unsigned char* lds) {
    const int tid = threadIdx.x, wid = tid >> 6, lane = tid & 63, r32 = lane & 31, hi = lane >> 5;
    LAS unsigned char* V_lds = lds; LAS unsigned char* K_lds = lds + 2 * MLA_SHM_V;
    LAS float* wsf = (LAS float*)(lds + MLA_WS) + wid * 64; LAS float* li_l = wsf; LAS float* al_l = wsf + 32;
    float m_reg = -1e30f, l_reg = 0; f32x16 o[2] = {}; bf16x8 qr[6];
    const size_t rowb = (size_t)b * SEQ;
    {
        const size_t qrow = rowb + qb * 256 + wid * 32 + r32;
        const bf16_t* Qw = QALL + qrow * 768 + h * 96 + hi * 8;
        const float C = 0.10206207261596575f * 1.4426950408889634f;
        float x1[8], x2[8];
#pragma unroll
        for (int d0 = 0; d0 < 6; ++d0) { const bf16x8 raw = *(const bf16x8*)(Qw + d0 * 16); float v[8];
#pragma unroll
            for (int j = 0; j < 8; ++j) v[j] = bf2f((bf16_t)raw[j]);
            if (d0 < 4) {
#pragma unroll
                for (int j = 0; j < 8; ++j) v[j] *= C;
                qr[d0] = cvt8(v); }
            else if (d0 == 4) {
#pragma unroll
                for (int j = 0; j < 8; ++j) x1[j] = v[j]; }
            else {
#pragma unroll
                for (int j = 0; j < 8; ++j) x2[j] = v[j]; } }
        float o1[8], o2[8];
#pragma unroll
        for (int j = 0; j < 8; ++j) { const float c = cosT[qrow * 16 + hi * 8 + j], s = sinT[qrow * 16 + hi * 8 + j]; o1[j] = (x1[j] * c - x2[j] * s) * C; o2[j] = (x2[j] * c + x1[j] * s) * C; }
        qr[4] = cvt8(o1); qr[5] = cvt8(o2);
    }
    const int sr = tid >> 3, scn = tid & 7, rr = (tid & 255) >> 2, rc = tid & 3;
    const bf16_t* gkn = KV + (rowb + sr) * 1024 + h * 128 + scn * 8;
    const bf16_t* gv = gkn + 64;
    const bf16_t* gkr = KR + (rowb + rr) * 32 + rc * 8;
    const int okn = sr * MLA_KP + scn * 16, okr = rr * MLA_KP + 128 + rc * 16, ov = v_st<2>(sr, scn * 8);
    const int vb0 = (int)(unsigned)(uintptr_t)V_lds + v_rd_base(lane);
    struct { bf16x8 kn, kr, v; } st_[2];
#define FA_SLOAD(i, k0) do { st_[i].v = *(const bf16x8*)(gv + (size_t)(k0) * 1024); st_[i].kn = *(const bf16x8*)(gkn + (size_t)(k0) * 1024); st_[i].kr = *(const bf16x8*)(gkr + (size_t)(k0) * 32); } while (0)
#define FA_SWRITE(bb, i) do { *(LAS bf16x8*)(V_lds + (bb) * MLA_SHM_V + ov) = st_[i].v; *(LAS bf16x8*)(K_lds + (bb) * MLA_SHM_K + okn) = st_[i].kn; *(LAS bf16x8*)(K_lds + (bb) * MLA_SHM_K + okr) = st_[i].kr; } while (0)
#define FA_SWAIT() asm volatile("s_waitcnt vmcnt(3)" ::: "memory")
#define FA_RESC(a) do { if (__any((a) < 1.f)) { if (hi == 0) al_l[r32] = (a); asm volatile("s_waitcnt lgkmcnt(0)" ::: "memory"); \
    _Pragma("unroll") for (int d = 0; d < 2; ++d) _Pragma("unroll") for (int r = 0; r < 16; ++r) o[d][r] *= al_l[crow(r, hi)]; } } while (0)
#define FA_PV(vbx) do { pv_one<2, 0>(o[0], (vbx), pa0, pa1, pa2, pa3); pv_one<2, 1>(o[1], (vbx), pa0, pa1, pa2, pa3); } while (0)
    f32x16 pA0, pA1, pB0, pB1; float mnA, mnB, alA, alB; bf16x8 pa0, pa1, pa2, pa3; constexpr int NT = SEQ / 64;
    FA_SLOAD(0, 0); asm volatile("s_waitcnt vmcnt(0)" ::: "memory"); FA_SWRITE(0, 0); __syncthreads();
    qkt<6, MLA_KP>(pA0, pA1, K_lds, qr, r32, hi); partialSM(pA0, pA1, m_reg, mnA, alA);
    FA_SLOAD(1, 64); FA_SLOAD(0, 128);
    FA_SWAIT(); FA_SWRITE(1, 1); __syncthreads();
    for (int j = 1; j + 1 < NT; j += 2) {
        FA_SBAR(); qkt<6, MLA_KP>(pB0, pB1, K_lds + MLA_SHM_K, qr, r32, hi);
        finishSM(pA0, pA1, alA, l_reg, pa0, pa1, pa2, pa3); FA_SBAR();
        FA_SLOAD(1, (j + 2) * 64); FA_SBAR();
        FA_PV(vb0); partialSM(pB0, pB1, m_reg, mnB, alB);
        __syncthreads(); FA_SWAIT(); FA_SWRITE(0, 0);
        FA_RESC(alB); __syncthreads();
        FA_SBAR(); qkt<6, MLA_KP>(pA0, pA1, K_lds, qr, r32, hi);
        finishSM(pB0, pB1, alB, l_reg, pa0, pa1, pa2, pa3); FA_SBAR();
        if (j + 3 < NT) FA_SLOAD(0, (j + 3) * 64); FA_SBAR();
        FA_PV(vb0 + MLA_SHM_V); partialSM(pA0, pA1, m_reg, mnA, alA);
        __syncthreads(); FA_SWAIT(); FA_SWRITE(1, 1);
        FA_RESC(alA); __syncthreads();
    }
    FA_SBAR(); qkt<6, MLA_KP>(pB0, pB1, K_lds + MLA_SHM_K, qr, r32, hi);
    finishSM(pA0, pA1, alA, l_reg, pa0, pa1, pa2, pa3); FA_SBAR();
    FA_PV(vb0); partialSM(pB0, pB1, m_reg, mnB, alB);
    __syncthreads(); FA_RESC(alB);
    finishSM(pB0, pB1, alB, l_reg, pa0, pa1, pa2, pa3); FA_SBAR();
    FA_PV(vb0 + MLA_SHM_V);
    if (hi == 0) li_l[r32] = l_reg; asm volatile("s_waitcnt lgkmcnt(0)" ::: "memory");
    bf16_t* Yw = Y + (rowb + qb * 256 + wid * 32) * DM + h * 64 + r32;
#pragma unroll
    for (int r = 0; r < 16; ++r) { const int orow = crow(r, hi); const float rl = __builtin_amdgcn_rcpf(li_l[orow]);
        Yw[(size_t)orow * DM] = (bf16_t)f2bf(o[0][r] * rl); Yw[(size_t)orow * DM + 32] = (bf16_t)f2bf(o[1][r] * rl); }
    __syncthreads();
#undef FA_SLOAD
#undef FA_SWRITE
#undef FA_SWAIT
#undef FA_RESC
#undef FA_PV
}

constexpr int XA_KP = 528, XA_SHM_K = 64 * XA_KP, XA_SHM_V = 64 * 128 * 2;
__device__ __forceinline__ void xattn_unit(int b, int h, int vh, int qb, const bf16_t* __restrict__ HQ, const bf16_t* __restrict__ KVM, bf16_t* __restrict__ OX, LAS unsigned char* lds) {
    const int tid = threadIdx.x, wid = tid >> 6, lane = tid & 63, r32 = lane & 31, hi = lane >> 5;
    LAS unsigned char* K_lds = lds; LAS unsigned char* V_lds = lds + XA_SHM_K;
    LAS float* wsf = (LAS float*)(lds + XA_SHM_K + XA_SHM_V) + wid * 64; LAS float* li_l = wsf; LAS float* al_l = wsf + 32;
    float m_reg = -1e30f, l_reg = 0; f32x16 o[4] = {}; bf16x8 qr[16];
    const size_t qrow0 = (size_t)b * SEQ + qb * 256 + wid * 32;
    { const bf16_t* Qw = HQ + (qrow0 + r32) * DM + h * 256 + hi * 8; const float C = 0.0625f * 1.4426950408889634f;
#pragma unroll
      for (int d0 = 0; d0 < 16; ++d0) { const bf16x8 raw = *(const bf16x8*)(Qw + d0 * 16); float v[8];
#pragma unroll
          for (int j = 0; j < 8; ++j) v[j] = bf2f((bf16_t)raw[j]) * C;
          qr[d0] = cvt8(v); } }
    const int ksr = tid >> 5, ksc = tid & 31, vsr = tid >> 4, vsc = tid & 15;
    const bf16_t* gk = KVM + ((size_t)b * NMEM + ksr) * 2048 + h * 256 + ksc * 8;
    const bf16_t* gv = KVM + ((size_t)b * NMEM + vsr) * 2048 + 1024 + h * 256 + vh * 128 + vsc * 8;
    const int vb0 = (int)(unsigned)(uintptr_t)V_lds + v_rd_base(lane);
    bf16x8 sk[4], sv[2];
#define XA_SLOAD(k0) do { _Pragma("unroll") for (int i = 0; i < 4; ++i) sk[i] = *(const bf16x8*)(gk + (size_t)((k0) + 16 * i) * 2048); \
    _Pragma("unroll") for (int i = 0; i < 2; ++i) sv[i] = *(const bf16x8*)(gv + (size_t)((k0) + 32 * i) * 2048); } while (0)
#define XA_SWRITE() do { _Pragma("unroll") for (int i = 0; i < 4; ++i) *(LAS bf16x8*)(K_lds + (ksr + 16 * i) * XA_KP + ksc * 16) = sk[i]; \
    _Pragma("unroll") for (int i = 0; i < 2; ++i) *(LAS bf16x8*)(V_lds + v_st<4>(vsr + 32 * i, vsc * 8)) = sv[i]; } while (0)
    XA_SLOAD(0);
    for (int t = 0; t < NMEM / 64; ++t) {
        __syncthreads();
        XA_SWRITE(); __syncthreads();
        f32x16 p0, p1; float mn, al; bf16x8 pa0, pa1, pa2, pa3;
        qkt<16, XA_KP>(p0, p1, K_lds, qr, r32, hi);
        partialSM(p0, p1, m_reg, mn, al);
        if (__any(al < 1.f)) { if (hi == 0) al_l[r32] = al; asm volatile("s_waitcnt lgkmcnt(0)" ::: "memory");
#pragma unroll
            for (int d = 0; d < 4; ++d)
#pragma unroll
                for (int r = 0; r < 16; ++r) o[d][r] *= al_l[crow(r, hi)]; }
        finishSM(p0, p1, al, l_reg, pa0, pa1, pa2, pa3); FA_SBAR();
        if (t + 1 < NMEM / 64) XA_SLOAD((t + 1) * 64);
        FA_SBAR();
        pv_one<4, 0>(o[0], vb0, pa0, pa1, pa2, pa3); pv_one<4, 1>(o[1], vb0, pa0, pa1, pa2, pa3); pv_one<4, 2>(o[2], vb0, pa0, pa1, pa2, pa3); pv_one<4, 3>(o[3], vb0, pa0, pa1, pa2, pa3);
    }
    if (hi == 0) li_l[r32] = l_reg; asm volatile("s_waitcnt lgkmcnt(0)" ::: "memory");
    bf16_t* Ow = OX + qrow0 * DM + h * 256 + vh * 128 + r32;
#pragma unroll
    for (int r = 0; r < 16; ++r) { const int orow = crow(r, hi); const float rl = __builtin_amdgcn_rcpf(li_l[orow]);
#pragma unroll
        for (int d0 = 0; d0 < 4; ++d0) Ow[(size_t)orow * DM + d0 * 32] = (bf16_t)f2bf(o[d0][r] * rl); }
    __syncthreads();
#undef XA_SLOAD
#undef XA_SWRITE
}
}

__device__ __forceinline__ void mla_attn_fast(const Params& p, LAS unsigned char* lds) {
    const int G = gridDim.x, bx = blockIdx.x, vcu = (G % 8 == 0) ? (bx % 8) * (G / 8) + bx / 8 : bx;
    for (int u = vcu; u < BATCH * MLA_H * 16; u += G) {
        const int qb = u & 15, bh = u >> 4;
        fa::mla_unit(bh >> 3, bh & 7, qb, (const bf16_t*)(p.ws + WS_QALL), (const bf16_t*)(p.ws + WS_KV), (const bf16_t*)(p.ws + WS_KR),
                     (const float*)(p.ws + WS_COS), (const float*)(p.ws + WS_SIN), (bf16_t*)(p.ws + WS_Y), lds);
    }
}
__device__ __forceinline__ void x_attn_fast(const Params& p, LAS unsigned char* lds) {
    const int G = gridDim.x, bx = blockIdx.x, vcu = (G % 8 == 0) ? (bx % 8) * (G / 8) + bx / 8 : bx;
    for (int u = vcu; u < BATCH * XH * 2 * 16; u += G) {
        const int qb = u & 15, vh = (u >> 4) & 1, bh = u >> 5;
        fa::xattn_unit(bh >> 2, bh & 3, vh, qb, (const bf16_t*)(p.ws + WS_HQ), (const bf16_t*)(p.ws + WS_KVM), (bf16_t*)(p.ws + WS_OX), lds);
    }
}
__device__ __forceinline__ void phase_final(const Params& p) {
    const float* ssq = (const float*)(p.ws + WS_SSQ) + 4 * (size_t)T;
    const int wid = threadIdx.x >> 6, lane = threadIdx.x & 63;
    for (int row = blockIdx.x * NWAVES + wid; row < T; row += gridDim.x * NWAVES) {
        const float r = rsqrtf(ssq[row] * (1.0f / DM) + EPS);
        f32x4* o = (f32x4*)(p.out + (size_t)row * DM) + lane; const f32x4* g = (const f32x4*)p.final_norm + lane;
#pragma unroll
        for (int j = 0; j < 4; ++j) o[64 * j] = o[64 * j] * r * g[64 * j];
    }
}


#define XB_TMO      128
#define XB_XCNT(j)  (256  + 64 * (j))
#define XB_XSUB(j)  (1280 + 64 * (j))
#define XB_XGEN(j)  (2304 + 64 * (j))
#define XB_TOP      3328
#define XB_TOPGEN   3392
#define XCD_BAR_WORDS 3456
#define XB_SPIN_CAP (1u << 20)
__device__ __forceinline__ unsigned xb_ld(unsigned* p)              { return __hip_atomic_load(p, __ATOMIC_RELAXED, __HIP_MEMORY_SCOPE_AGENT); }
__device__ __forceinline__ unsigned xb_add(unsigned* p, unsigned v) { return __hip_atomic_fetch_add(p, v, __ATOMIC_RELAXED, __HIP_MEMORY_SCOPE_AGENT); }
__device__ __forceinline__ unsigned xb_xcc_id() { return (unsigned)__builtin_amdgcn_s_getreg((3 << 11) | 20) & 0xFu; }
#define XB_SPIN(cond, bar) do { unsigned _sp = 0; while (cond) { __builtin_amdgcn_s_sleep(1); \
    if ((++_sp & 255u) == 0u) { if (xb_ld(&(bar)[XB_TMO])) break; if (_sp > XB_SPIN_CAP) { atomicAdd(&(bar)[XB_TMO], 1u); break; } } } } while (0)
struct XcdBarrier { unsigned* bar; unsigned x; volatile LAS unsigned* st; };
__device__ __forceinline__ XcdBarrier xcd_barrier_post(unsigned* bar, volatile LAS unsigned* st) {
    XcdBarrier b; b.bar = bar; b.x = xb_xcc_id(); b.st = st;
    if (threadIdx.x == 0) (void)xb_add(&bar[XB_XCNT(b.x)], 1u);
    return b;
}
__device__ __forceinline__ void xcd_barrier_complete(unsigned* bar, unsigned x, unsigned& nloc, unsigned& nx) {
    const unsigned G = gridDim.x * gridDim.y * gridDim.z;
    unsigned sum, cnt, mine, sp = 0u;
    for (;;) {
        sum = 0u; cnt = 0u; mine = 0u;
#pragma unroll
        for (unsigned j = 0; j < 16; ++j) { const unsigned c = xb_ld(&bar[XB_XCNT(j)]); sum += c; cnt += (c > 0u) ? 1u : 0u; mine = (j == x) ? c : mine; }
        if (sum == G) break;
        __builtin_amdgcn_s_sleep(1);
        if ((++sp & 255u) == 0u) { if (xb_ld(&bar[XB_TMO])) break; if (sp > XB_SPIN_CAP) { atomicAdd(&bar[XB_TMO], 1u); break; } }
    }
    nloc = mine > 0u ? mine : 1u; nx = cnt > 0u ? cnt : 1u;
}
__device__ __forceinline__ void xcd_barrier(const XcdBarrier& b) {
    asm volatile("s_waitcnt vmcnt(0)" ::: "memory");
    __syncthreads();
    if (threadIdx.x == 0) {
        unsigned* bar = b.bar;
        __builtin_amdgcn_s_waitcnt(0);
        unsigned nloc = b.st[0], nx = b.st[1];
        if (nloc == 0u) { xcd_barrier_complete(bar, b.x, nloc, nx); b.st[0] = nloc; b.st[1] = nx; }
        const unsigned old = xb_add(&bar[XB_XSUB(b.x)], 1u);
        const unsigned gen = old / nloc;
        if (old + 1u == (gen + 1u) * nloc) {
            __builtin_amdgcn_fence(__ATOMIC_RELEASE, "agent");
            asm volatile("s_waitcnt vmcnt(0)" ::: "memory");
            const unsigned og = xb_add(&bar[XB_TOP], 1u);
            const unsigned tg = og / nx;
            if (og + 1u == (tg + 1u) * nx) xb_add(&bar[XB_TOPGEN], 1u);
            else XB_SPIN(xb_ld(&bar[XB_TOPGEN]) == tg, bar);
            __builtin_amdgcn_fence(__ATOMIC_ACQUIRE, "agent");
            xb_add(&bar[XB_XGEN(b.x)], 1u);
            asm volatile("s_waitcnt vmcnt(0)" ::: "memory");
        } else {
            XB_SPIN(xb_ld(&bar[XB_XGEN(b.x)]) == gen, bar);
            __builtin_amdgcn_fence(__ATOMIC_ACQUIRE, "agent");
            asm volatile("s_waitcnt vmcnt(0)" ::: "memory");
        }
    }
    __syncthreads();
}

constexpr int LDS_BYTES = 147456;
constexpr int NPHASE = 12;
#ifndef MK_N_LAUNCHES
#define MK_N_LAUNCHES 1
#endif

__global__ void __launch_bounds__(NTHR, 2) mega(Params p) {
    extern __shared__ __attribute__((aligned(16))) unsigned char lds_raw[];
    LAS unsigned char* lds = (LAS unsigned char*)lds_raw;
    unsigned char* ws = p.ws;
    float* ssq = (float*)(ws + WS_SSQ);
    const int lo = p.ph_lo, hi = p.ph_hi;
    volatile LAS unsigned* misc = (volatile LAS unsigned*)(lds + LDS_BYTES - 64);
    if (threadIdx.x < 16) misc[threadIdx.x] = 0u;
    __syncthreads();
    XcdBarrier bar; bar.bar = (unsigned*)(ws + WS_CTL) + 4096; bar.x = 0; bar.st = nullptr;
    if (hi - lo > 1) bar = xcd_barrier_post((unsigned*)(ws + WS_CTL) + 4096, misc);
#define IN(k) (lo <= (k) && (k) < hi)
#define SEAM(k) do { if (IN(k) && IN((k) + 1)) xcd_barrier(bar); } while (0)
    if (IN(0)) phase0(p, lds);
    SEAM(0);
    if (IN(1)) {
        Gemm g{(const bf16_t*)(ws + WS_XB), DM, (const bf16_t*)(ws + WS_WIN), DM, T, LDZ, DM};
        EpiZ E{(bf16_t*)(ws + WS_Z), ssq, ssq + T, (bf16_t*)(ws + WS_KR), (float*)(ws + WS_G), (const float*)(ws + WS_COS), (const float*)(ws + WS_SIN)};
        run_gemm(lds, g, E, (int)blockIdx.x);
    }
    SEAM(1);
    if (IN(2)) {
        { Gemm g{(const bf16_t*)(ws + WS_Z) + ZC_CQ, LDZ, (const bf16_t*)(ws + WS_WUQ), QLORA, T, MLA_H * DQK, QLORA};
          EpiScaleBf16 E{(bf16_t*)(ws + WS_QALL), MLA_H * DQK, ssq, 1.0f / QLORA, 1.0f}; run_gemm(lds, g, E, (int)blockIdx.x); }
        { Gemm g{(const bf16_t*)(ws + WS_Z) + ZC_CKV, LDZ, (const bf16_t*)(ws + WS_WUKV), 256, T, 1024, 256};
          EpiScaleBf16 E{(bf16_t*)(ws + WS_KV), 1024, ssq + T, 1.0f / KVLORA, 1.0f}; run_gemm(lds, g, E, (int)blockIdx.x); }
        { Gemm g{(const bf16_t*)(ws + WS_MEMN), DM, (const bf16_t*)(ws + WS_WXKV), DM, TM, 2 * DM, DM};
          EpiScaleBf16 E{(bf16_t*)(ws + WS_KVM), 2 * DM, nullptr, 0.f, 1.0f}; run_gemm(lds, g, E, (int)blockIdx.x); }
        phase_conv(p);
    }
    SEAM(2);
    if (IN(3)) { mlstm_naive(p); mla_attn_fast(p, lds); }
    SEAM(3);
    if (IN(4)) phase_mlfin(p);
    SEAM(4);
    if (IN(5)) {
        Gemm g{(const bf16_t*)(ws + WS_Y), DM, (const bf16_t*)(ws + WS_WOUT), DM, T, DM, DM};
        EpiResid E{p.x, p.out, (bf16_t*)(ws + WS_XB), ssq + 2 * T}; run_gemm(lds, g, E, (int)blockIdx.x);
    }
    SEAM(5);
    if (IN(6)) {
        Gemm g{(const bf16_t*)(ws + WS_XB), DM, (const bf16_t*)(ws + WS_WXQ), DM, T, DM, DM};
        EpiScaleBf16 E{(bf16_t*)(ws + WS_HQ), DM, ssq + 2 * T, 1.0f / DM, 1.0f}; run_gemm(lds, g, E, (int)blockIdx.x);
    }
    SEAM(6);
    if (IN(7)) x_attn_fast(p, lds);
    SEAM(7);
    if (IN(8)) {
        Gemm g{(const bf16_t*)(ws + WS_OX), DM, (const bf16_t*)(ws + WS_WXO), DM, T, DM, DM};
        EpiResid E{p.out, p.out, (bf16_t*)(ws + WS_XB), ssq + 3 * T}; run_gemm(lds, g, E, (int)blockIdx.x);
    }
    SEAM(8);
    if (IN(9)) {
        Gemm g{(const bf16_t*)(ws + WS_XB), DM, (const bf16_t*)(ws + WS_WGU), DM, T, 2 * DFF, DM};
        EpiSwiglu E{(bf16_t*)(ws + WS_H), ssq + 3 * T}; run_gemm(lds, g, E, (int)blockIdx.x);
    }
    SEAM(9);
    if (IN(10)) {
        Gemm g{(const bf16_t*)(ws + WS_H), DFF, (const bf16_t*)(ws + WS_WD), DFF, T, DM, DFF};
        EpiResid E{p.out, p.out, nullptr, ssq + 4 * T}; run_gemm(lds, g, E, (int)blockIdx.x);
    }
    SEAM(10);
    if (IN(11)) phase_final(p);
#undef IN
#undef SEAM
}

extern "C" void kernel_launch(void* const* d_in, const int* in_sizes, int n_in, void* d_out, int out_size, void* d_ws, size_t ws_size, hipStream_t stream) {
    static int grid = 0;
    if (grid == 0) {
        if (n_in != 22 || in_sizes[0] != T * DM || out_size != T * DM) { fprintf(stderr, "kernel_launch: unexpected shapes (n_in %d, in0 %d, out %d)\n", n_in, n_in > 0 ? in_sizes[0] : -1, out_size); grid = -1; return; }
        if (ws_size < WS_END) { fprintf(stderr, "kernel_launch: workspace too small: %zu\n", ws_size); grid = -1; return; }
        int dev = 0, cus = 0, per_cu = 0;
        (void)hipGetDevice(&dev); (void)hipDeviceGetAttribute(&cus, hipDeviceAttributeMultiprocessorCount, dev);
        if (hipFuncSetAttribute((const void*)mega, hipFuncAttributeMaxDynamicSharedMemorySize, LDS_BYTES) != hipSuccess) { fprintf(stderr, "kernel_launch: hipFuncSetAttribute failed\n"); grid = -1; return; }
        if (hipOccupancyMaxActiveBlocksPerMultiprocessor(&per_cu, (const void*)mega, NTHR, LDS_BYTES) != hipSuccess || per_cu < 1) { fprintf(stderr, "kernel_launch: occupancy query says %d\n", per_cu); per_cu = 1; }
        (void)hipGetLastError();
        grid = cus * (per_cu < 1 ? per_cu : 1);
        fprintf(stderr, "kernel_launch: grid %d (cus %d, per_cu %d), ws %zu MiB\n", grid, cus, per_cu, ws_size >> 20);
    }
    if (grid < 0) return;
    Params p{};
    p.x = (const float*)d_in[0]; p.mem = (const float*)d_in[1]; p.pos = (const int*)d_in[2];
    p.attn_norm = (const float*)d_in[3]; p.w_in = (const float*)d_in[4]; p.q_norm = (const float*)d_in[5]; p.w_uq = (const float*)d_in[6];
    p.kv_norm = (const float*)d_in[7]; p.w_ukv = (const float*)d_in[8]; p.conv = (const float*)d_in[9]; p.gbias = (const float*)d_in[10];
    p.ml_norm = (const float*)d_in[11]; p.w_out = (const float*)d_in[12]; p.xattn_norm = (const float*)d_in[13]; p.mem_norm = (const float*)d_in[14];
    p.w_xq = (const float*)d_in[15]; p.w_xkv = (const float*)d_in[16]; p.w_xo = (const float*)d_in[17]; p.ffn_norm = (const float*)d_in[18];
    p.w_gu = (const float*)d_in[19]; p.w_down = (const float*)d_in[20]; p.final_norm = (const float*)d_in[21];
    p.out = (float*)d_out; p.ws = (unsigned char*)d_ws;
    p.ws2 = (unsigned char*)d_ws + WS_XB;
    if (hipMemsetAsync((char*)d_ws + WS_CTL, 0, 65536, stream) != hipSuccess) { fprintf(stderr, "kernel_launch: memset failed\n"); return; }
#if MK_N_LAUNCHES == 1
    p.ph_lo = 0; p.ph_hi = NPHASE;
    { void* args[] = {&p};
      const hipError_t e = hipLaunchCooperativeKernel((const void*)mega, dim3(grid), dim3(NTHR), args, LDS_BYTES, stream);
      if (e != hipSuccess) fprintf(stderr, "kernel_launch: cooperative launch failed: %s (grid %d)\n", hipGetErrorString(e), grid); }
#else
    for (int ph = 0; ph < NPHASE; ++ph) {
        p.ph_lo = ph; p.ph_hi = ph + 1;
        hipLaunchKernelGGL(mega, dim3(grid), dim3(NTHR), LDS_BYTES, stream, p);
    }
#endif
    const hipError_t le = hipPeekAtLastError();
    if (le != hipSuccess) fprintf(stderr, "kernel_launch: launch failed: %s\n", hipGetErrorName(le));
}
```

```cpp
#include <hip/hip_runtime.h>
#include <cstdio>
#include <cstdint>

constexpr int BATCH = 8, SEQ = 4096, DM = 1024, T = BATCH * SEQ;
constexpr int NMEM = 256, TM = BATCH * NMEM;
constexpr float EPS = 1e-6f;
constexpr int MLA_H = 8, QLORA = 256, KVLORA = 128, NOPE = 64, ROPE = 32, VD = 64, DQK = NOPE + ROPE;
constexpr int ML_H = 4, ML_D = 128, ML_W = 512;
constexpr int XH = 4, XD = 256;
constexpr int DFF = 2816;
constexpr int INW = 2480;
constexpr int LDZ = 2560, ZC_CQ = 0, ZC_CKV = 256, ZC_KR = 384, ZC_G = 416, ZC_QK = 512, ZC_V = 1536, ZC_O = 2048;
constexpr int NWAVES = 8, NTHR = 512;

constexpr size_t MiB = 1u << 20;
constexpr size_t WS_CTL = 0;
constexpr size_t WS_WIN = 1 * MiB;
constexpr size_t WS_WUQ = 6 * MiB;
constexpr size_t WS_WUKV = 7 * MiB;
constexpr size_t WS_WOUT = 8 * MiB;
constexpr size_t WS_WXQ = 10 * MiB;
constexpr size_t WS_WXKV = 12 * MiB;
constexpr size_t WS_WXO = 16 * MiB;
constexpr size_t WS_WGU = 18 * MiB;
constexpr size_t WS_WD = 30 * MiB;
constexpr size_t WS_COS = 36 * MiB;
constexpr size_t WS_SIN = 38 * MiB;
constexpr size_t WS_G = 40 * MiB;
constexpr size_t WS_KR = 42 * MiB;
constexpr size_t WS_SSQ = 44 * MiB;
constexpr size_t WS_MEMN = 46 * MiB;
constexpr size_t WS_KVM = 50 * MiB;
constexpr size_t WS_XB = 64 * MiB;
constexpr size_t WS_Z = 128 * MiB;
constexpr size_t WS_H = 128 * MiB;
constexpr size_t WS_QALL = 288 * MiB;
constexpr size_t WS_KV = 336 * MiB;
constexpr size_t WS_Y = 400 * MiB;
constexpr size_t WS_HQ = 304 * MiB;
constexpr size_t WS_OX = 368 * MiB;
constexpr size_t WS_END = 464 * MiB;

typedef unsigned short bf16_t;
typedef short bf16x8 __attribute__((ext_vector_type(8)));
typedef float f32x4 __attribute__((ext_vector_type(4)));
typedef unsigned u32x4 __attribute__((ext_vector_type(4)));
typedef unsigned u32x2 __attribute__((ext_vector_type(2)));
#define LAS __attribute__((address_space(3)))

__device__ __forceinline__ float bf2f(bf16_t h) { return __uint_as_float(((unsigned)h) << 16); }
__device__ __forceinline__ unsigned f2bf(float f) { unsigned u = __float_as_uint(f); return (u + 0x7fffu + ((u >> 16) & 1u)) >> 16; }
__device__ __forceinline__ unsigned pk2(float lo, float hi) { return f2bf(lo) | (f2bf(hi) << 16); }
__device__ __forceinline__ float wave_sum(float v) {
#pragma unroll
    for (int o = 1; o < 64; o <<= 1) v += __shfl_xor(v, o);
    return v;
}
__device__ __forceinline__ float wave_max(float v) {
#pragma unroll
    for (int o = 1; o < 64; o <<= 1) v = fmaxf(v, __shfl_xor(v, o));
    return v;
}

struct Params {
    const float* x; const float* mem; const int* pos;
    const float *attn_norm, *w_in, *q_norm, *w_uq, *kv_norm, *w_ukv, *conv, *gbias, *ml_norm, *w_out, *xattn_norm, *mem_norm, *w_xq, *w_xkv, *w_xo, *ffn_norm, *w_gu, *w_down, *final_norm;
    float* out; unsigned char* ws; unsigned char* ws2;
    int ph_lo, ph_hi;
};

struct Unit { int pm, pn; };
struct Gemm { const bf16_t* A; int lda; const bf16_t* Bt; int ldb; int M, N, K; };

template <class Epi>
__device__ __forceinline__ void gemm_naive(const Gemm g, const Epi& E) {
    const int tid = threadIdx.x, wid = tid >> 6, lane = tid & 63, wr = wid >> 2, wc = wid & 3, fr = lane & 15, fq = lane >> 4;
    const int nM = g.M / 256, nN = g.N / 256;
    for (int unit = blockIdx.x; unit < nM * nN; unit += gridDim.x) {
        Unit u; u.pm = unit / nN; u.pn = unit % nN;
        f32x4 acc[2][2][4][2];
#pragma unroll
        for (int a = 0; a < 2; ++a)
#pragma unroll
            for (int b = 0; b < 2; ++b)
#pragma unroll
                for (int m = 0; m < 4; ++m)
#pragma unroll
                    for (int n = 0; n < 2; ++n) acc[a][b][m][n] = (f32x4){0.f, 0.f, 0.f, 0.f};
        const bf16_t* Ab = g.A + (size_t)(u.pm * 256 + wr * 64 + fr) * g.lda + 8 * fq;
        const bf16_t* Bb = g.Bt + (size_t)(u.pn * 256 + wc * 32 + 8 * (fr >> 2) + (fr & 3)) * g.ldb + 8 * fq;
        for (int kk = 0; kk < g.K; kk += 32) {
            bf16x8 a[2][4], b[2][2];
#pragma unroll
            for (int ai = 0; ai < 2; ++ai)
#pragma unroll
                for (int m = 0; m < 4; ++m) a[ai][m] = *(const bf16x8*)(Ab + (size_t)(ai * 128 + m * 16) * g.lda + kk);
#pragma unroll
            for (int bj = 0; bj < 2; ++bj)
#pragma unroll
                for (int n = 0; n < 2; ++n) b[bj][n] = *(const bf16x8*)(Bb + (size_t)(bj * 128 + 4 * n) * g.ldb + kk);
#pragma unroll
            for (int ai = 0; ai < 2; ++ai)
#pragma unroll
                for (int bj = 0; bj < 2; ++bj)
#pragma unroll
                    for (int m = 0; m < 4; ++m)
#pragma unroll
                        for (int n = 0; n < 2; ++n) acc[ai][bj][m][n] = __builtin_amdgcn_mfma_f32_16x16x32_bf16(b[bj][n], a[ai][m], acc[ai][bj][m][n], 0, 0, 0);
        }
        E(acc, u, wr, wc, fr, fq);
    }
}


#define PG8_LAS __attribute__((address_space(3)))
constexpr int BM = 256, BK = 64, HALF = 128, HTB = HALF * BK * 2  , STAGE_BYTES = 8 * HTB, NXCD = 8, WGM = 8;

__host__ __device__ __forceinline__ int lds_byte(int r, int c) { const int st = (r >> 4) * 2 + (c >> 5), rr = r & 15, cc = c & 31, ob = rr * 64 + cc * 2; return st * 1024 + (ob ^ (((ob >> 9) & 1) << 5)); }
__host__ __device__ __forceinline__ void stage_rc(int b, int& R, int& C) { const int st = b / 1024, sb = b % 1024, swz = sb ^ (((sb >> 9) & 1) << 5); R = (st >> 1) * 16 + swz / 64; C = (st & 1) * 32 + (swz % 64) / 2; }
__host__ __device__ __forceinline__ int perm32(int rho) { const int n = rho >> 4, i = rho & 15; return 8 * (i >> 2) + 4 * n + (i & 3); }


struct StaticOrder {
    int nM, nN, nwg, G, c;
    __host__ __device__ void init(int M, int N, int G_, int c_) { nM = M / BM; nN = N / BM; nwg = nM * nN; G = G_; c = c_; }
    __host__ __device__ bool next(int i, Unit& u) const {
        const long L = (long)i * G + c; if (L >= nwg) return false;
        int wgid = (int)L; { const int q = nwg / NXCD, r = nwg % NXCD, xcd = wgid % NXCD, off = wgid / NXCD; wgid = (xcd < r ? xcd * (q + 1) : r * (q + 1) + (xcd - r) * q) + off; }
        const int nig = WGM * nN, gid = wgid / nig, fm = gid * WGM, gsz = (nM - fm) < WGM ? (nM - fm) : WGM;
        u.pm = fm + ((wgid % nig) % gsz); u.pn = (wgid % nig) / gsz; return true;
    }
    __device__ __forceinline__ void a_ready(const Unit&) const {}
    __device__ __forceinline__ void done(const Unit&) const {}
};

template <class Epi, class Sched, bool ALIGN_EPI = false, bool SP2 = false>
__device__ __forceinline__ void gemm_phase(PG8_LAS unsigned char* lds, const Gemm g, const Sched& S, const Epi& E) {
    const int tid = threadIdx.x, wid = __builtin_amdgcn_readfirstlane(tid >> 6), lane = tid & 63, wr = wid >> 2, wc = wid & 3, fr = lane & 15, fq = lane >> 4;
    const int K = g.K, nt = K / BK, lda = g.lda, ldb = g.ldb;
    unsigned voffA[2], voffB[2];
#pragma unroll
    for (int i = 0; i < 2; ++i) { int R, C; stage_rc(tid * 16 + i * 8192, R, C); const int Rb = Epi::PERM ? ((R & ~31) + perm32(R & 31)) : R;
        voffA[i] = (unsigned)(R * lda + C) * 2u; voffB[i] = (unsigned)(Rb * ldb + C) * 2u; }
    const size_t kstep = (size_t)(BK * 2);
    const size_t hstepA = (size_t)HALF * lda * 2, hstepB = (size_t)HALF * ldb * 2;
    const size_t tstepA = 2 * hstepA, tstepB = 2 * hstepB;
    const unsigned ldsw = (unsigned)wid * 1024u;
    const int aoff = lds_byte(wr * 64 + fr, fq * 8), boff = lds_byte(wc * 32 + fr, fq * 8);
#define PG8_SA(b, h) (((b) * 2 + (h)) * HTB)
#define PG8_SB(b, h) ((4 + (b) * 2 + (h)) * HTB)
#define PG8_STAGE(bufoff, gbase, voff) do { _Pragma("unroll") for (int _i = 0; _i < 2; ++_i) \
        __builtin_amdgcn_global_load_lds((const unsigned*)((const char*)(gbase) + (voff)[_i]), (PG8_LAS unsigned*)(lds + (bufoff) + ldsw + _i * 8192), 16, 0, 0); } while (0)
#define PG8_LDA(dst, b, h) do { _Pragma("unroll") for (int m = 0; m < 4; ++m) _Pragma("unroll") for (int k = 0; k < 2; ++k) dst[m][k] = *(const PG8_LAS bf16x8*)(lds + PG8_SA(b, h) + aoff + m * 2048 + k * 1024); } while (0)
#define PG8_LDB(dst, b, h) do { _Pragma("unroll") for (int n = 0; n < 2; ++n) _Pragma("unroll") for (int k = 0; k < 2; ++k) dst[n][k] = *(const PG8_LAS bf16x8*)(lds + PG8_SB(b, h) + boff + n * 2048 + k * 1024); } while (0)
#define PG8_MMA(ai, bj, At, Bt) do { __builtin_amdgcn_s_setprio(1); _Pragma("unroll") for (int m = 0; m < 4; ++m) _Pragma("unroll") for (int n = 0; n < 2; ++n) _Pragma("unroll") for (int k = 0; k < 2; ++k) \
        acc[ai][bj][m][n] = __builtin_amdgcn_mfma_f32_16x16x32_bf16(Bt[n][k], At[m][k], acc[ai][bj][m][n], 0, 0, 0); __builtin_amdgcn_s_setprio(0); } while (0)
#define PG8_WAIT_V(n) asm volatile("s_waitcnt vmcnt(" #n ")" ::: "memory")
#define PG8_WAIT_L(n) asm volatile("s_waitcnt lgkmcnt(" #n ")" ::: "memory")
#define PG8_BAR __builtin_amdgcn_s_barrier()
#define PG8_SCHED __builtin_amdgcn_sched_barrier(0)
    Unit cur, nxt; int ui = 0;
    if (!S.next(0, cur)) return;
    f32x4 acc[2][2][4][2];
#pragma unroll
    for (int a = 0; a < 2; ++a)
#pragma unroll
        for (int b = 0; b < 2; ++b)
#pragma unroll
            for (int m = 0; m < 4; ++m)
#pragma unroll
                for (int n = 0; n < 2; ++n) acc[a][b][m][n] = (f32x4){0.f, 0.f, 0.f, 0.f};
    bf16x8 At[4][2], B0[2][2], B1[2][2];
    const char* cA = (const char*)g.A + (size_t)cur.pm * tstepA; const char* cB = (const char*)g.Bt + (size_t)cur.pn * tstepB;
    S.a_ready(cur);
    if constexpr (SP2) {
        PG8_STAGE(PG8_SB(0, 0), cB, voffB); PG8_STAGE(PG8_SB(0, 1), cB + hstepB, voffB); PG8_STAGE(PG8_SA(0, 0), cA, voffA); PG8_STAGE(PG8_SA(0, 1), cA + hstepA, voffA);
        if (wr == 1) PG8_BAR;
        PG8_WAIT_V(2); PG8_BAR;
        PG8_STAGE(PG8_SB(1, 0), cB + kstep, voffB); PG8_STAGE(PG8_SA(1, 0), cA + kstep, voffA); PG8_STAGE(PG8_SB(1, 1), cB + hstepB + kstep, voffB);
        PG8_WAIT_V(6); PG8_BAR;
    } else {
        PG8_STAGE(PG8_SB(0, 0), cB, voffB); PG8_STAGE(PG8_SA(0, 0), cA, voffA); PG8_STAGE(PG8_SB(0, 1), cB + hstepB, voffB); PG8_STAGE(PG8_SA(0, 1), cA + hstepA, voffA);
        if (wr == 1) PG8_BAR;
        PG8_WAIT_V(4); PG8_BAR;
        PG8_STAGE(PG8_SB(1, 0), cB + kstep, voffB); PG8_STAGE(PG8_SA(1, 0), cA + kstep, voffA); PG8_STAGE(PG8_SB(1, 1), cB + hstepB + kstep, voffB);
        PG8_WAIT_V(6); PG8_BAR;
    }
    for (;;) {
        const bool has_next = S.next(ui + 1, nxt);
        const char* nA = has_next ? (const char*)g.A + (size_t)nxt.pm * tstepA : cA; const char* nB = has_next ? (const char*)g.Bt + (size_t)nxt.pn * tstepB : cB;
        for (int t = 0; t < nt; t += 2) {
            const bool last = (t == nt - 2);
            const char* a1 = cA + (size_t)(t + 1) * kstep;
            const char* a2 = last ? nA : cA + (size_t)(t + 2) * kstep; const char* b2 = last ? nB : cB + (size_t)(t + 2) * kstep;
            const char* a3 = a2 + kstep; const char* b3 = b2 + kstep;
            if (last && has_next) S.a_ready(nxt);
            if constexpr (SP2) {
            PG8_LDB(B0, 0, 0); PG8_LDB(B1, 0, 1); PG8_SCHED; PG8_LDA(At, 0, 0); PG8_STAGE(PG8_SA(1, 1), a1 + hstepA, voffA);
            PG8_WAIT_V(8); PG8_WAIT_L(0); PG8_BAR; PG8_MMA(0, 0, At, B0); PG8_MMA(0, 1, At, B1); PG8_BAR; PG8_SCHED;
            PG8_LDA(At, 0, 1); PG8_STAGE(PG8_SB(0, 0), b2, voffB); PG8_STAGE(PG8_SB(0, 1), b2 + hstepB, voffB); PG8_STAGE(PG8_SA(0, 0), a2, voffA);
            PG8_WAIT_V(8); PG8_WAIT_L(0); PG8_BAR; PG8_MMA(1, 0, At, B0); PG8_MMA(1, 1, At, B1); PG8_BAR; PG8_SCHED;
            PG8_LDB(B0, 1, 0); PG8_LDB(B1, 1, 1); PG8_SCHED; PG8_LDA(At, 1, 0); PG8_STAGE(PG8_SA(0, 1), a2 + hstepA, voffA);
            PG8_WAIT_V(8); PG8_WAIT_L(0); PG8_BAR; PG8_MMA(0, 0, At, B0); PG8_MMA(0, 1, At, B1); PG8_BAR; PG8_SCHED;
            PG8_LDA(At, 1, 1); PG8_STAGE(PG8_SB(1, 0), b3, voffB); PG8_STAGE(PG8_SB(1, 1), b3 + hstepB, voffB); PG8_STAGE(PG8_SA(1, 0), a3, voffA);
            PG8_WAIT_V(8); PG8_WAIT_L(0); PG8_BAR; PG8_MMA(1, 0, At, B0); PG8_MMA(1, 1, At, B1); PG8_BAR; PG8_SCHED;
            } else {
            PG8_LDB(B0, 0, 0); PG8_SCHED; PG8_LDA(At, 0, 0); PG8_STAGE(PG8_SA(1, 1), a1 + hstepA, voffA);
            PG8_WAIT_L(8); PG8_BAR; PG8_WAIT_L(0); PG8_MMA(0, 0, At, B0); PG8_BAR; PG8_SCHED;
            PG8_LDB(B1, 0, 1); PG8_STAGE(PG8_SB(0, 0), b2, voffB);
            PG8_BAR; PG8_WAIT_L(0); PG8_MMA(0, 1, At, B1); PG8_BAR;
            PG8_LDA(At, 0, 1); PG8_STAGE(PG8_SA(0, 0), a2, voffA);
            PG8_BAR; PG8_WAIT_L(0); PG8_MMA(1, 0, At, B0); PG8_BAR; PG8_SCHED;
            PG8_STAGE(PG8_SB(0, 1), b2 + hstepB, voffB);
            PG8_WAIT_V(6); PG8_BAR; PG8_MMA(1, 1, At, B1); PG8_BAR;
            PG8_LDB(B0, 1, 0); PG8_SCHED; PG8_LDA(At, 1, 0); PG8_STAGE(PG8_SA(0, 1), a2 + hstepA, voffA);
            PG8_WAIT_L(8); PG8_BAR; PG8_WAIT_L(0); PG8_MMA(0, 0, At, B0); PG8_BAR; PG8_SCHED;
            PG8_LDB(B1, 1, 1); PG8_STAGE(PG8_SB(1, 0), b3, voffB);
            PG8_BAR; PG8_WAIT_L(0); PG8_MMA(0, 1, At, B1); PG8_BAR;
            PG8_LDA(At, 1, 1); PG8_STAGE(PG8_SA(1, 0), a3, voffA);
            PG8_BAR; PG8_WAIT_L(0); PG8_MMA(1, 0, At, B0); PG8_BAR; PG8_SCHED;
            PG8_STAGE(PG8_SB(1, 1), b3 + hstepB, voffB);
            PG8_WAIT_V(6); PG8_BAR; PG8_MMA(1, 1, At, B1); PG8_BAR;
            }
        }
        if constexpr (ALIGN_EPI) { if (wr == 0) PG8_BAR; }
        if constexpr (!Epi::AFTER_DRAIN) { E(acc, cur, wr, wc, fr, fq); S.done(cur); }
        if (!has_next) break;
#pragma unroll
        for (int a = 0; a < 2; ++a)
#pragma unroll
            for (int b = 0; b < 2; ++b)
#pragma unroll
                for (int m = 0; m < 4; ++m)
#pragma unroll
                    for (int n = 0; n < 2; ++n) acc[a][b][m][n] = (f32x4){0.f, 0.f, 0.f, 0.f};
        cur = nxt; cA = nA; cB = nB; ++ui;
        if constexpr (ALIGN_EPI) { if (wr == 1) PG8_BAR; }
    }
    PG8_WAIT_V(0);
    if constexpr (!ALIGN_EPI) { if (wr == 0) PG8_BAR; }
    PG8_BAR;
    if constexpr (Epi::AFTER_DRAIN) { E.fused(acc, cur, wr, wc, fr, fq, lds, wid, lane); S.done(cur); }
#undef PG8_SA
#undef PG8_SB
#undef PG8_STAGE
#undef PG8_LDA
#undef PG8_LDB
#undef PG8_MMA
#undef PG8_WAIT_V
#undef PG8_WAIT_L
#undef PG8_BAR
#undef PG8_SCHED
}

__device__ __forceinline__ u32x4 pack8(const f32x4 v0, const f32x4 v1) { u32x4 w; w.x = pk2(v0[0], v0[1]); w.y = pk2(v0[2], v0[3]); w.z = pk2(v1[0], v1[1]); w.w = pk2(v1[2], v1[3]); return w; }
__device__ __forceinline__ float sq8(const f32x4 a, const f32x4 b) { return (a[0] * a[0] + a[1] * a[1]) + (a[2] * a[2] + a[3] * a[3]) + (b[0] * b[0] + b[1] * b[1]) + (b[2] * b[2] + b[3] * b[3]); }

struct EpiZ {
    static constexpr bool PERM = true, AFTER_DRAIN = false;
    bf16_t* Z; float* ssq_q; float* ssq_kv; bf16_t* KR; float* G; const float* cosT; const float* sinT;
    __device__ __forceinline__ void operator()(const f32x4 (&acc)[2][2][4][2], const Unit& u, int wr, int wc, int fr, int fq) const {
#pragma unroll
        for (int ai = 0; ai < 2; ++ai)
#pragma unroll
            for (int m = 0; m < 4; ++m) {
                const int row = u.pm * 256 + ai * 128 + wr * 64 + m * 16 + fr;
                bf16_t* zp = Z + (size_t)row * LDZ + u.pn * 256 + wc * 32 + 8 * fq;
#pragma unroll
                for (int bj = 0; bj < 2; ++bj) *(u32x4*)(zp + bj * 128) = pack8(acc[ai][bj][m][0], acc[ai][bj][m][1]);
                if (u.pn == 0) {
                    float s = sq8(acc[ai][0][m][0], acc[ai][0][m][1]) + sq8(acc[ai][1][m][0], acc[ai][1][m][1]);
                    s += __shfl_xor(s, 16); s += __shfl_xor(s, 32);
                    if (fq == 0) atomicAdd(ssq_q + row, s);
                } else if (u.pn == 1) {
                    float s = sq8(acc[ai][0][m][0], acc[ai][0][m][1]);
                    s += __shfl_xor(s, 16); s += __shfl_xor(s, 32);
                    if (fq == 0) atomicAdd(ssq_kv + row, s);
                    if (wc == 0) {
                        const f32x4 o0 = acc[ai][1][m][0], o1 = acc[ai][1][m][1];
                        f32x4 p0, p1;
#pragma unroll
                        for (int j = 0; j < 4; ++j) { p0[j] = __shfl_xor(o0[j], 32); p1[j] = __shfl_xor(o1[j], 32); }
                        const int jj = 8 * (fq & 1);
                        const f32x4 c0 = *(const f32x4*)(cosT + (size_t)row * 16 + jj), c1 = *(const f32x4*)(cosT + (size_t)row * 16 + jj + 4);
                        const f32x4 s0 = *(const f32x4*)(sinT + (size_t)row * 16 + jj), s1 = *(const f32x4*)(sinT + (size_t)row * 16 + jj + 4);
                        f32x4 r0, r1;
                        if (fq < 2) { r0 = o0 * c0 - p0 * s0; r1 = o1 * c1 - p1 * s1; }
                        else        { r0 = o0 * c0 + p0 * s0; r1 = o1 * c1 + p1 * s1; }
                        *(u32x4*)(KR + (size_t)row * 32 + 8 * fq) = pack8(r0, r1);
                    } else if (wc == 1 && fq < 2) {
                        *(f32x4*)(G + (size_t)row * 16 + 8 * fq) = acc[ai][1][m][0];
                        *(f32x4*)(G + (size_t)row * 16 + 8 * fq + 4) = acc[ai][1][m][1];
                    }
                }
            }
    }
};
struct EpiScaleBf16 {
    static constexpr bool PERM = true, AFTER_DRAIN = false;
    bf16_t* O; int ldo; const float* ssq; float inv_n; float c;
    __device__ __forceinline__ void operator()(const f32x4 (&acc)[2][2][4][2], const Unit& u, int wr, int wc, int fr, int fq) const {
#pragma unroll
        for (int ai = 0; ai < 2; ++ai)
#pragma unroll
            for (int m = 0; m < 4; ++m) {
                const int row = u.pm * 256 + ai * 128 + wr * 64 + m * 16 + fr;
                const float sc = ssq ? c * rsqrtf(ssq[row] * inv_n + EPS) : c;
                bf16_t* op = O + (size_t)row * ldo + u.pn * 256 + wc * 32 + 8 * fq;
#pragma unroll
                for (int bj = 0; bj < 2; ++bj) *(u32x4*)(op + bj * 128) = pack8(acc[ai][bj][m][0] * sc, acc[ai][bj][m][1] * sc);
            }
    }
};
struct EpiResid {
    static constexpr bool PERM = true, AFTER_DRAIN = false;
    const float* res; float* out; bf16_t* XB; float* ssq;
    __device__ __forceinline__ void operator()(const f32x4 (&acc)[2][2][4][2], const Unit& u, int wr, int wc, int fr, int fq) const {
#pragma unroll
        for (int ai = 0; ai < 2; ++ai)
#pragma unroll
            for (int m = 0; m < 4; ++m) {
                const int row = u.pm * 256 + ai * 128 + wr * 64 + m * 16 + fr;
                const size_t off = (size_t)row * DM + u.pn * 256 + wc * 32 + 8 * fq;
                float s = 0.f;
#pragma unroll
                for (int bj = 0; bj < 2; ++bj) {
                    const f32x4 v0 = *(const f32x4*)(res + off + bj * 128) + acc[ai][bj][m][0];
                    const f32x4 v1 = *(const f32x4*)(res + off + bj * 128 + 4) + acc[ai][bj][m][1];
                    *(f32x4*)(out + off + bj * 128) = v0; *(f32x4*)(out + off + bj * 128 + 4) = v1;
                    if (XB) *(u32x4*)(XB + off + bj * 128) = pack8(v0, v1);
                    s += sq8(v0, v1);
                }
                s += __shfl_xor(s, 16); s += __shfl_xor(s, 32);
                if (fq == 0) atomicAdd(ssq + row, s);
            }
    }
};
struct EpiSwiglu {
    static constexpr bool PERM = true, AFTER_DRAIN = false;
    bf16_t* H; const float* ssq;
    __device__ __forceinline__ void operator()(const f32x4 (&acc)[2][2][4][2], const Unit& u, int wr, int wc, int fr, int fq) const {
#pragma unroll
        for (int ai = 0; ai < 2; ++ai)
#pragma unroll
            for (int m = 0; m < 4; ++m) {
                const int row = u.pm * 256 + ai * 128 + wr * 64 + m * 16 + fr;
                const float sc = rsqrtf(ssq[row] * (1.0f / DM) + EPS);
                f32x4 h[2];
#pragma unroll
                for (int n = 0; n < 2; ++n)
#pragma unroll
                    for (int j = 0; j < 4; ++j) { const float gg = acc[ai][0][m][n][j] * sc, uu = acc[ai][1][m][n][j] * sc; h[n][j] = gg * uu / (1.0f + __expf(-gg)); }
                *(u32x4*)(H + (size_t)row * DFF + u.pn * 128 + wc * 32 + 8 * fq) = pack8(h[0], h[1]);
            }
    }
};

#ifndef FAST_GEMM
#define FAST_GEMM 1
#endif
template <class Epi>
__device__ __forceinline__ void run_gemm(LAS unsigned char* lds, const Gemm g, const Epi& E, int c) {
#if FAST_GEMM
    StaticOrder S; S.init(g.M, g.N, (int)gridDim.x, c);
    gemm_phase<Epi, StaticOrder, true, true>(lds, g, S, E);
#else
    gemm_naive(g, E);
#endif
}

struct MapIdent { __device__ __forceinline__ int operator()(int n) const { return n; } };
struct MapWin { __device__ __forceinline__ int operator()(int n) const {
    if (n < 416) return n; if (n < 1440) return ZC_QK + (n - 416); if (n < 1952) return ZC_V + (n - 1440); if (n < 2464) return ZC_O + (n - 1952); return ZC_G + (n - 2464); } };
struct MapGU { __device__ __forceinline__ int operator()(int n) const { const int up = n >= DFF, j = up ? n - DFF : n; return (j >> 7) * 256 + up * 128 + (j & 127); } };

template <class Map>
__device__ __forceinline__ void transpose_w(const float* W, int K, int N, const float* gain, bf16_t* WT, int ldt, Map map, LAS float* scr, int gw, int ngw, int lane) {
    const int nblk = (N + 31) / 32, nitems = (K / 64) * nblk;
    for (int it = gw; it < nitems; it += ngw) {
        const int kb = it / nblk, nb = it % nblk, k0 = 64 * kb, n0 = 32 * nb;
        for (int i = 0; i < 32; ++i) { const int kk = 2 * i + (lane >> 5), nn = n0 + (lane & 31);
            float v = 0.f; if (nn < N) { v = W[(size_t)(k0 + kk) * N + nn]; if (gain) v *= gain[k0 + kk]; }
            scr[kk * 33 + (lane & 31)] = v; }
        asm volatile("s_waitcnt lgkmcnt(0)" ::: "memory");
        const int c = lane & 7;
#pragma unroll
        for (int j = 0; j < 4; ++j) { const int n = (lane >> 3) + 8 * j, nn = n0 + n;
            if (nn < N) { const LAS float* s = scr + (8 * c) * 33 + n;
                u32x4 o; o.x = pk2(s[0 * 33], s[1 * 33]); o.y = pk2(s[2 * 33], s[3 * 33]); o.z = pk2(s[4 * 33], s[5 * 33]); o.w = pk2(s[6 * 33], s[7 * 33]);
                *(u32x4*)(WT + (size_t)map(nn) * ldt + k0 + 8 * c) = o; } }
        asm volatile("s_waitcnt lgkmcnt(0)" ::: "memory");
    }
}
__device__ __forceinline__ void rms_row_bf16(const float* xrow, const float* gain, bf16_t* orow, int lane) {
    const f32x4* xr = (const f32x4*)xrow + lane; const f32x4* gr = (const f32x4*)gain + lane;
    f32x4 v[4]; float s = 0.f;
#pragma unroll
    for (int j = 0; j < 4; ++j) { v[j] = xr[64 * j]; s += (v[j][0] * v[j][0] + v[j][1] * v[j][1]) + (v[j][2] * v[j][2] + v[j][3] * v[j][3]); }
    const float r = rsqrtf(wave_sum(s) * (1.0f / DM) + EPS);
    u32x2* o8 = (u32x2*)orow + lane;
#pragma unroll
    for (int j = 0; j < 4; ++j) { const f32x4 gg = gr[64 * j]; u32x2 w; w.x = pk2(v[j][0] * r * gg[0], v[j][1] * r * gg[1]); w.y = pk2(v[j][2] * r * gg[2], v[j][3] * r * gg[3]); o8[64 * j] = w; }
}

__device__ __forceinline__ void phase0(const Params& p, LAS unsigned char* lds) {
    const int tid = threadIdx.x, wid = tid >> 6, lane = tid & 63;
    const int gw = blockIdx.x * NWAVES + wid, ngw = gridDim.x * NWAVES;
    const int gt = blockIdx.x * NTHR + tid, ngt = gridDim.x * NTHR;
    LAS float* scr = (LAS float*)(lds + wid * 16384);
    unsigned char* ws = p.ws;
    transpose_w(p.w_in, DM, INW, nullptr, (bf16_t*)(ws + WS_WIN), DM, MapWin(), scr, gw, ngw, lane);
    transpose_w(p.w_uq, QLORA, MLA_H * DQK, p.q_norm, (bf16_t*)(ws + WS_WUQ), QLORA, MapIdent(), scr, gw, ngw, lane);
    transpose_w(p.w_ukv, KVLORA, MLA_H * (NOPE + VD), p.kv_norm, (bf16_t*)(ws + WS_WUKV), 256, MapIdent(), scr, gw, ngw, lane);
    transpose_w(p.w_out, DM, DM, nullptr, (bf16_t*)(ws + WS_WOUT), DM, MapIdent(), scr, gw, ngw, lane);
    transpose_w(p.w_xq, DM, DM, p.xattn_norm, (bf16_t*)(ws + WS_WXQ), DM, MapIdent(), scr, gw, ngw, lane);
    transpose_w(p.w_xkv, DM, 2 * DM, nullptr, (bf16_t*)(ws + WS_WXKV), DM, MapIdent(), scr, gw, ngw, lane);
    transpose_w(p.w_xo, DM, DM, nullptr, (bf16_t*)(ws + WS_WXO), DM, MapIdent(), scr, gw, ngw, lane);
    transpose_w(p.w_gu, DM, 2 * DFF, p.ffn_norm, (bf16_t*)(ws + WS_WGU), DM, MapGU(), scr, gw, ngw, lane);
    transpose_w(p.w_down, DFF, DM, nullptr, (bf16_t*)(ws + WS_WD), DFF, MapIdent(), scr, gw, ngw, lane);
    { bf16_t* wz = (bf16_t*)(ws + WS_WIN) + (size_t)432 * DM; for (int i = gt; i < 80 * DM / 8; i += ngt) ((u32x4*)wz)[i] = (u32x4){0u, 0u, 0u, 0u};
      bf16_t* wk = (bf16_t*)(ws + WS_WUKV); for (int i = gt; i < 1024 * 16; i += ngt) { const int r = i >> 4, c = i & 15; *(u32x4*)(wk + (size_t)r * 256 + 128 + 8 * c) = (u32x4){0u, 0u, 0u, 0u}; } }
    { float* ssq = (float*)(ws + WS_SSQ); for (int i = gt; i < 5 * T; i += ngt) ssq[i] = 0.f; }
    { float* ct = (float*)(ws + WS_COS); float* st = (float*)(ws + WS_SIN);
      for (int i = gt; i < T * 16; i += ngt) { const int row = i >> 4, j = i & 15; const float inv = (float)pow(10000.0, -(double)(2 * j) / 32.0); const float ang = (float)p.pos[row] * inv; ct[i] = cosf(ang); st[i] = sinf(ang); } }
    for (int r = gw; r < T; r += ngw) rms_row_bf16(p.x + (size_t)r * DM, p.attn_norm, (bf16_t*)(ws + WS_XB) + (size_t)r * DM, lane);
    for (int r = gw; r < TM; r += ngw) rms_row_bf16(p.mem + (size_t)r * DM, p.mem_norm, (bf16_t*)(ws + WS_MEMN) + (size_t)r * DM, lane);
}

__device__ __forceinline__ void phase_conv(const Params& p) {
    const bf16_t* Z = (const bf16_t*)(p.ws + WS_Z); bf16_t* Q = (bf16_t*)p.ws2;
    const int gt = blockIdx.x * NTHR + threadIdx.x, ngt = gridDim.x * NTHR;
    for (int i = gt; i < T * 128; i += ngt) {
        const int row = i >> 7, c0 = (i & 127) * 8, t = row & (SEQ - 1);
        const bf16x8 zc = *(const bf16x8*)(Z + (size_t)row * LDZ + ZC_QK + c0);
        bf16x8 zp = (bf16x8){0, 0, 0, 0, 0, 0, 0, 0}, zn = zp;
        if (t > 0) zp = *(const bf16x8*)(Z + (size_t)(row - 1) * LDZ + ZC_QK + c0);
        if (t < SEQ - 1) zn = *(const bf16x8*)(Z + (size_t)(row + 1) * LDZ + ZC_QK + c0);
        const float sc = c0 >= 512 ? 0.08838834764831845f : 1.0f;
        float o[8];
#pragma unroll
        for (int j = 0; j < 8; ++j) { const float a = p.conv[c0 + j] * bf2f((bf16_t)zp[j]) + p.conv[1024 + c0 + j] * bf2f((bf16_t)zc[j]) + p.conv[2048 + c0 + j] * bf2f((bf16_t)zn[j]);
            o[j] = a / (1.0f + __expf(-a)) * sc; }
        u32x4 w; w.x = pk2(o[0], o[1]); w.y = pk2(o[2], o[3]); w.z = pk2(o[4], o[5]); w.w = pk2(o[6], o[7]);
        *(u32x4*)(Q + (size_t)row * 1024 + c0) = w;
    }
}

__device__ __forceinline__ void mlstm_naive(const Params& p) {
    const bf16_t* Z = (const bf16_t*)(p.ws + WS_Z); const bf16_t* QKC = (const bf16_t*)p.ws2; const float* G = (const float*)(p.ws + WS_G);
    float* HF = p.out; float* HB = p.out + (size_t)T * ML_W;
    const int tid = threadIdx.x, d = tid >> 2, eq = tid & 3;
    for (int unit = blockIdx.x; unit < BATCH * ML_H * 2; unit += gridDim.x) {
        const int dir = unit & 1, h = (unit >> 1) & 3, b = unit >> 3;
        float C[32], n[32]; float m = 0.f;
#pragma unroll
        for (int j = 0; j < 32; ++j) { C[j] = 0.f; n[j] = 0.f; }
        const float bi = p.gbias[dir * 8 + h], bff = p.gbias[dir * 8 + 4 + h];
        float* Hout = dir ? HB : HF;
        for (int s = 0; s < SEQ; ++s) {
            const int t = dir ? SEQ - 1 - s : s; const size_t row = (size_t)b * SEQ + t;
            const float ip = G[row * 16 + dir * 8 + h] + bi, fp = G[row * 16 + dir * 8 + 4 + h] + bff;
            const float logf = fminf(fp, 0.f) - log1pf(__expf(-fabsf(fp)));
            const float mn = fmaxf(logf + m, ip), fe = __expf(logf + m - mn), ie = __expf(ip - mn);
            m = mn;
            const float vv = bf2f(Z[row * LDZ + ZC_V + h * 128 + d]) * ie;
            float pn = 0.f, pd = 0.f;
#pragma unroll
            for (int c = 0; c < 4; ++c) {
                const bf16x8 q8 = *(const bf16x8*)(QKC + row * 1024 + h * 128 + eq * 32 + c * 8);
                const bf16x8 k8 = *(const bf16x8*)(QKC + row * 1024 + 512 + h * 128 + eq * 32 + c * 8);
#pragma unroll
                for (int j = 0; j < 8; ++j) { const float qq = bf2f((bf16_t)q8[j]), kk = bf2f((bf16_t)k8[j]);
                    C[c * 8 + j] = fe * C[c * 8 + j] + vv * kk; n[c * 8 + j] = fe * n[c * 8 + j] + ie * kk;
                    pn += C[c * 8 + j] * qq; pd += n[c * 8 + j] * qq; }
            }
            pn += __shfl_xor(pn, 1); pn += __shfl_xor(pn, 2); pd += __shfl_xor(pd, 1); pd += __shfl_xor(pd, 2);
            if (eq == 0) Hout[row * ML_W + h * 128 + d] = pn / fmaxf(fabsf(pd), __expf(-mn));
        }
    }
}
__device__ __forceinline__ void phase_mlfin(const Params& p) {
    const bf16_t* Z = (const bf16_t*)(p.ws + WS_Z); bf16_t* Y = (bf16_t*)(p.ws + WS_Y);
    const float* HF = p.out; const float* HB = p.out + (size_t)T * ML_W;
    const int wid = threadIdx.x >> 6, lane = threadIdx.x & 63;
    for (int row = blockIdx.x * NWAVES + wid; row < T; row += gridDim.x * NWAVES) {
        const size_t o = (size_t)row * ML_W + lane * 8;
        const f32x4 a0 = *(const f32x4*)(HF + o) + *(const f32x4*)(HB + o), a1 = *(const f32x4*)(HF + o + 4) + *(const f32x4*)(HB + o + 4);
        float s = sq8(a0, a1);
        s += __shfl_xor(s, 1); s += __shfl_xor(s, 2); s += __shfl_xor(s, 4); s += __shfl_xor(s, 8);
        const float r = rsqrtf(s * (1.0f / ML_D) + EPS);
        const bf16x8 zo = *(const bf16x8*)(Z + (size_t)row * LDZ + ZC_O + lane * 8);
        const f32x4 g0 = *(const f32x4*)(p.ml_norm + lane * 8), g1 = *(const f32x4*)(p.ml_norm + lane * 8 + 4);
        float ov[8];
#pragma unroll
        for (int j = 0; j < 8; ++j) { const float hv = (j < 4 ? a0[j] : a1[j - 4]) * r * (j < 4 ? g0[j] : g1[j - 4]); const float z = bf2f((bf16_t)zo[j]); ov[j] = hv / (1.0f + __expf(-z)); }
        u32x4 w; w.x = pk2(ov[0], ov[1]); w.y = pk2(ov[2], ov[3]); w.z = pk2(ov[4], ov[5]); w.w = pk2(ov[6], ov[7]);
        *(u32x4*)(Y + (size_t)row * DM + 512 + lane * 8) = w;
    }
}

__device__ __forceinline__ void mla_attn_naive(const Params& p, LAS unsigned char* lds) {
    const bf16_t* QALL = (const bf16_t*)(p.ws + WS_QALL); const bf16_t* KV = (const bf16_t*)(p.ws + WS_KV); const bf16_t* KR = (const bf16_t*)(p.ws + WS_KR);
    const float* cosT = (const float*)(p.ws + WS_COS); const float* sinT = (const float*)(p.ws + WS_SIN); bf16_t* Y = (bf16_t*)(p.ws + WS_Y);
    const int wid = threadIdx.x >> 6, lane = threadIdx.x & 63;
    LAS float* sc = (LAS float*)(lds + wid * 16384);
    LAS float* qs = (LAS float*)(lds + 131072 + wid * 512);
    const float scale = 0.10206207261596575f;
    for (int item = blockIdx.x * NWAVES + wid; item < T * MLA_H; item += gridDim.x * NWAVES) {
        const int h = item & 7, row = item >> 3, b = row / SEQ;
        for (int dd = lane; dd < DQK; dd += 64) {
            float v = bf2f(QALL[(size_t)row * 768 + h * DQK + dd]);
            if (dd >= NOPE) { const int j = (dd - NOPE) & 15; const float c = cosT[(size_t)row * 16 + j], s = sinT[(size_t)row * 16 + j];
                const float other = bf2f(QALL[(size_t)row * 768 + h * DQK + (dd < NOPE + 16 ? dd + 16 : dd - 16)]);
                v = dd < NOPE + 16 ? v * c - other * s : v * c + other * s; }
            qs[dd] = v * scale;
        }
        asm volatile("s_waitcnt lgkmcnt(0)" ::: "memory");
        float mx = -1e30f;
        for (int k0 = 0; k0 < SEQ; k0 += 64) {
            const size_t kr = (size_t)b * SEQ + k0 + lane; float s = 0.f;
#pragma unroll
            for (int c = 0; c < 8; ++c) { const bf16x8 k8 = *(const bf16x8*)(KV + kr * 1024 + h * 128 + c * 8);
#pragma unroll
                for (int j = 0; j < 8; ++j) s += qs[c * 8 + j] * bf2f((bf16_t)k8[j]); }
#pragma unroll
            for (int c = 0; c < 4; ++c) { const bf16x8 k8 = *(const bf16x8*)(KR + kr * 32 + c * 8);
#pragma unroll
                for (int j = 0; j < 8; ++j) s += qs[NOPE + c * 8 + j] * bf2f((bf16_t)k8[j]); }
            sc[k0 + lane] = s; mx = fmaxf(mx, s);
        }
        mx = wave_max(mx);
        float l = 0.f;
        for (int k0 = 0; k0 < SEQ; k0 += 64) { const float e = __expf(sc[k0 + lane] - mx); sc[k0 + lane] = e; l += e; }
        l = wave_sum(l);
        asm volatile("s_waitcnt lgkmcnt(0)" ::: "memory");
        float o = 0.f;
        for (int k = 0; k < SEQ; ++k) o += sc[k] * bf2f(KV[((size_t)b * SEQ + k) * 1024 + h * 128 + 64 + lane]);
        Y[(size_t)row * DM + h * VD + lane] = (bf16_t)f2bf(o / l);
        asm volatile("s_waitcnt lgkmcnt(0)" ::: "memory");
    }
}
__device__ __forceinline__ void x_attn_naive(const Params& p, LAS unsigned char* lds) {
    const bf16_t* HQ = (const bf16_t*)(p.ws + WS_HQ); const bf16_t* KVM = (const bf16_t*)(p.ws + WS_KVM); bf16_t* OX = (bf16_t*)(p.ws + WS_OX);
    const int wid = threadIdx.x >> 6, lane = threadIdx.x & 63;
    LAS float* sc = (LAS float*)(lds + wid * 16384);
    LAS float* qs = (LAS float*)(lds + 131072 + wid * 1024);
    for (int item = blockIdx.x * NWAVES + wid; item < T * XH; item += gridDim.x * NWAVES) {
        const int h = item & 3, row = item >> 2, b = row / SEQ;
        for (int dd = lane; dd < XD; dd += 64) qs[dd] = bf2f(HQ[(size_t)row * DM + h * XD + dd]) * 0.0625f;
        asm volatile("s_waitcnt lgkmcnt(0)" ::: "memory");
        float mx = -1e30f;
        for (int k0 = 0; k0 < NMEM; k0 += 64) {
            const size_t kr = (size_t)b * NMEM + k0 + lane; float s = 0.f;
            for (int c = 0; c < 32; ++c) { const bf16x8 k8 = *(const bf16x8*)(KVM + kr * 2048 + h * XD + c * 8);
#pragma unroll
                for (int j = 0; j < 8; ++j) s += qs[c * 8 + j] * bf2f((bf16_t)k8[j]); }
            sc[k0 + lane] = s; mx = fmaxf(mx, s);
        }
        mx = wave_max(mx);
        float l = 0.f;
        for (int k0 = 0; k0 < NMEM; k0 += 64) { const float e = __expf(sc[k0 + lane] - mx); sc[k0 + lane] = e; l += e; }
        l = wave_sum(l);
        asm volatile("s_waitcnt lgkmcnt(0)" ::: "memory");
        float o[4] = {0.f, 0.f, 0.f, 0.f};
        for (int k = 0; k < NMEM; ++k) { const u32x2 v4 = *(const u32x2*)(KVM + ((size_t)b * NMEM + k) * 2048 + 1024 + h * XD + 4 * lane); const float pk = sc[k];
            o[0] += pk * __uint_as_float(v4.x << 16); o[1] += pk * __uint_as_float(v4.x & 0xffff0000u); o[2] += pk * __uint_as_float(v4.y << 16); o[3] += pk * __uint_as_float(v4.y & 0xffff0000u); }
        const float rl = 1.0f / l; u32x2 w; w.x = pk2(o[0] * rl, o[1] * rl); w.y = pk2(o[2] * rl, o[3] * rl);
        *(u32x2*)(OX + (size_t)row * DM + h * XD + 4 * lane) = w;
        asm volatile("s_waitcnt lgkmcnt(0)" ::: "memory");
    }
}

namespace fa {
using f32x16 = __attribute__((ext_vector_type(16))) float;
using s16x4  = __attribute__((ext_vector_type(4))) short;
#define FA_SBAR() __builtin_amdgcn_sched_barrier(0)
constexpr float THRL = 11.0f;
__device__ __forceinline__ int crow(int r, int hi) { return (r & 3) + 8 * (r >> 2) + 4 * hi; }
__device__ __forceinline__ unsigned cvtpk(float lo, float hi) { unsigned r; asm volatile("v_cvt_pk_bf16_f32 %0, %1, %2" : "=v"(r) : "v"(lo), "v"(hi)); return r; }
__device__ __forceinline__ void partialSM(f32x16& p0, f32x16& p1, float& m_reg, float& mn, float& alpha) {
    float pmax = p0[0];
#pragma unroll
    for (int r = 1; r < 16; ++r) pmax = fmaxf(pmax, p0[r]);
#pragma unroll
    for (int r = 0; r < 16; ++r) pmax = fmaxf(pmax, p1[r]);
    { auto rr = __builtin_amdgcn_permlane32_swap(__float_as_uint(pmax), __float_as_uint(pmax), false, false);
      pmax = fmaxf(__uint_as_float(rr[0]), __uint_as_float(rr[1])); }
    if (__builtin_expect(__all(pmax - m_reg <= THRL), 1)) { mn = m_reg; alpha = 1.f; }
    else { mn = fmaxf(m_reg, pmax); alpha = __builtin_amdgcn_exp2f(m_reg - mn); m_reg = mn; }
#pragma unroll
    for (int r = 0; r < 16; ++r) { p0[r] -= mn; p1[r] -= mn; }
#pragma unroll
    for (int r = 0; r < 16; ++r) p0[r] = __builtin_amdgcn_exp2f(p0[r]);
}
__device__ __forceinline__ void finishSM(f32x16& p0, f32x16& p1, float alpha, float& l_reg, bf16x8& pa0, bf16x8& pa1, bf16x8& pa2, bf16x8& pa3) {
#pragma unroll
    for (int r = 0; r < 16; ++r) p1[r] = __builtin_amdgcn_exp2f(p1[r]);
    float ps = 0;
#pragma unroll
    for (int r = 0; r < 16; ++r) ps += p0[r];
#pragma unroll
    for (int r = 0; r < 16; ++r) ps += p1[r];
    { auto rr = __builtin_amdgcn_permlane32_swap(__float_as_uint(ps), __float_as_uint(ps), false, false);
      ps = __uint_as_float(rr[0]) + __uint_as_float(rr[1]); }
    l_reg = l_reg * alpha + ps;
#define FA_PK4(P, BASE, OUT) do { unsigned a0 = cvtpk(P[BASE + 0], P[BASE + 1]), a1 = cvtpk(P[BASE + 2], P[BASE + 3]);   \
    unsigned b0 = cvtpk(P[BASE + 4], P[BASE + 5]), b1 = cvtpk(P[BASE + 6], P[BASE + 7]);                              \
    auto r0 = __builtin_amdgcn_permlane32_swap(a0, b0, false, false); auto r1 = __builtin_amdgcn_permlane32_swap(a1, b1, false, false); \
    u32x4 w = {r0[0], r1[0], r0[1], r1[1]}; OUT = *reinterpret_cast<bf16x8*>(&w); } while (0)
    FA_PK4(p0, 0, pa0); FA_PK4(p0, 8, pa1); FA_PK4(p1, 0, pa2); FA_PK4(p1, 8, pa3);
#undef FA_PK4
}
template <int NDQ, int KP>
__device__ __forceinline__ void qkt(f32x16& p0, f32x16& p1, const LAS unsigned char* Ks, const bf16x8* qr, int r32, int hi) {
    p0 = f32x16{}; p1 = f32x16{};
#pragma unroll
    for (int d0 = 0; d0 < NDQ; ++d0) { const int cb = (d0 * 16 + hi * 8) * 2;
        const bf16x8 b0 = *(const LAS bf16x8*)(Ks + r32 * KP + cb);
        const bf16x8 b1 = *(const LAS bf16x8*)(Ks + (32 + r32) * KP + cb);
        p0 = __builtin_amdgcn_mfma_f32_32x32x16_bf16(b0, qr[d0], p0, 0, 0, 0);
        p1 = __builtin_amdgcn_mfma_f32_32x32x16_bf16(b1, qr[d0], p1, 0, 0, 0); }
}
template <int NDV> __device__ __forceinline__ int v_st(int k, int c) { const int kk = (k & ~0xC) | ((k & 4) << 1) | ((k & 8) >> 1); return ((kk >> 3) * NDV + (c >> 5)) * 512 + ((kk & 7) * 32 + (c & 31)) * 2; }
__device__ __forceinline__ int v_rd_base(int lane) { return ((lane & 3) << 3) | (((lane >> 2) & 3) << 6) | (((lane >> 4) & 1) << 5) | (((lane >> 5) & 1) << 8); }
template <int OFF> __device__ __forceinline__ s16x4 tr_read(int vb) { s16x4 r; asm volatile("ds_read_b64_tr_b16 %0, %1 offset:%2" : "=&v"(r) : "v"(vb), "i"(OFF) : "memory"); return r; }
template <int NDV, int D0> __device__ __forceinline__ void pv_one(f32x16& od, int vb, bf16x8 pa0, bf16x8 pa1, bf16x8 pa2, bf16x8 pa3) {
    constexpr int KS = 2 * NDV * 512, HF = NDV * 512, B0 = D0 * 512;
    const s16x4 l0 = tr_read<B0>(vb), h0 = tr_read<B0 + HF>(vb), l1 = tr_read<B0 + KS>(vb), h1 = tr_read<B0 + KS + HF>(vb);
    const s16x4 l2 = tr_read<B0 + 2 * KS>(vb), h2 = tr_read<B0 + 2 * KS + HF>(vb), l3 = tr_read<B0 + 3 * KS>(vb), h3 = tr_read<B0 + 3 * KS + HF>(vb);
    asm volatile("s_waitcnt lgkmcnt(0)" ::: "memory"); FA_SBAR();
#define FA_PK(L, H) (bf16x8){L[0], L[1], L[2], L[3], H[0], H[1], H[2], H[3]}
    od = __builtin_amdgcn_mfma_f32_32x32x16_bf16(pa0, FA_PK(l0, h0), od, 0, 0, 0);
    od = __builtin_amdgcn_mfma_f32_32x32x16_bf16(pa1, FA_PK(l1, h1), od, 0, 0, 0);
    od = __builtin_amdgcn_mfma_f32_32x32x16_bf16(pa2, FA_PK(l2, h2), od, 0, 0, 0);
    od = __builtin_amdgcn_mfma_f32_32x32x16_bf16(pa3, FA_PK(l3, h3), od, 0, 0, 0);
#undef FA_PK
}
__device__ __forceinline__ bf16x8 cvt8(const float* v) { u32x4 w = {cvtpk(v[0], v[1]), cvtpk(v[2], v[3]), cvtpk(v[4], v[5]), cvtpk(v[6], v[7])}; return *reinterpret_cast<bf16x8*>(&w); }

constexpr int MLA_KP = 208, MLA_SHM_K = 64 * MLA_KP, MLA_SHM_V = 64 * 64 * 2, MLA_WS = 2 * MLA_SHM_V + 2 * MLA_SHM_K;
__device__ __forceinline__ void mla_unit(int b, int h, int qb, const bf16_t* __restrict__ QALL, const bf16_t* __restrict__ KV, const bf16_t* __restrict__ KR,
                                         const float* __restrict__ cosT, const float* __restrict__ sinT, bf16_t* __restrict__ Y, LAS unsigned char* lds) {
    const int tid = threadIdx.x, wid = tid >> 6, lane = tid & 63, r32 = lane & 31, hi = lane >> 5;
    LAS unsigned char* V_lds = lds; LAS unsigned char* K_lds = lds + 2 * MLA_SHM_V;
    LAS float* wsf = (LAS float*)(lds + MLA_WS) + wid * 64; LAS float* li_l = wsf; LAS float* al_l = wsf + 32;
    float m_reg = -1e30f, l_reg = 0; f32x16 o[2] = {}; bf16x8 qr[6];
    const size_t rowb = (size_t)b * SEQ;
    {
        const size_t qrow = rowb + qb * 256 + wid * 32 + r32;
        const bf16_t* Qw = QALL + qrow * 768 + h * 96 + hi * 8;
        const float C = 0.10206207261596575f * 1.4426950408889634f;
        float x1[8], x2[8];
#pragma unroll
        for (int d0 = 0; d0 < 6; ++d0) { const bf16x8 raw = *(const bf16x8*)(Qw + d0 * 16); float v[8];
#pragma unroll
            for (int j = 0; j < 8; ++j) v[j] = bf2f((bf16_t)raw[j]);
            if (d0 < 4) {
#pragma unroll
                for (int j = 0; j < 8; ++j) v[j] *= C;
                qr[d0] = cvt8(v); }
            else if (d0 == 4) {
#pragma unroll
                for (int j = 0; j < 8; ++j) x1[j] = v[j]; }
            else {
#pragma unroll
                for (int j = 0; j < 8; ++j) x2[j] = v[j]; } }
        float o1[8], o2[8];
#pragma unroll
        for (int j = 0; j < 8; ++j) { const float c = cosT[qrow * 16 + hi * 8 + j], s = sinT[qrow * 16 + hi * 8 + j]; o1[j] = (x1[j] * c - x2[j] * s) * C; o2[j] = (x2[j] * c + x1[j] * s) * C; }
        qr[4] = cvt8(o1); qr[5] = cvt8(o2);
    }
    const int sr = tid >> 3, scn = tid & 7, rr = (tid & 255) >> 2, rc = tid & 3;
    const bf16_t* gkn = KV + (rowb + sr) * 1024 + h * 128 + scn * 8;
    const bf16_t* gv = gkn + 64;
    const bf16_t* gkr = KR + (rowb + rr) * 32 + rc * 8;
    const int okn = sr * MLA_KP + scn * 16, okr = rr * MLA_KP + 128 + rc * 16, ov = v_st<2>(sr, scn * 8);
    const int vb0 = (int)(unsigned)(uintptr_t)V_lds + v_rd_base(lane);
    struct { bf16x8 kn, kr, v; } st_[2];
#define FA_SLOAD(i, k0) do { st_[i].v = *(const bf16x8*)(gv + (size_t)(k0) * 1024); st_[i].kn = *(const bf16x8*)(gkn + (size_t)(k0) * 1024); st_[i].kr = *(const bf16x8*)(gkr + (size_t)(k0) * 32); } while (0)
#define FA_SWRITE(bb, i) do { *(LAS bf16x8*)(V_lds + (bb) * MLA_SHM_V + ov) = st_[i].v; *(LAS bf16x8*)(K_lds + (bb) * MLA_SHM_K + okn) = st_[i].kn; *(LAS bf16x8*)(K_lds + (bb) * MLA_SHM_K + okr) = st_[i].kr; } while (0)
#define FA_SWAIT() asm volatile("s_waitcnt vmcnt(3)" ::: "memory")
#define FA_RESC(a) do { if (__any((a) < 1.f)) { if (hi == 0) al_l[r32] = (a); asm volatile("s_waitcnt lgkmcnt(0)" ::: "memory"); \
    _Pragma("unroll") for (int d = 0; d < 2; ++d) _Pragma("unroll") for (int r = 0; r < 16; ++r) o[d][r] *= al_l[crow(r, hi)]; } } while (0)
#define FA_PV(vbx) do { pv_one<2, 0>(o[0], (vbx), pa0, pa1, pa2, pa3); pv_one<2, 1>(o[1], (vbx), pa0, pa1, pa2, pa3); } while (0)
    f32x16 pA0, pA1, pB0, pB1; float mnA, mnB, alA, alB; bf16x8 pa0, pa1, pa2, pa3; constexpr int NT = SEQ / 64;
    FA_SLOAD(0, 0); asm volatile("s_waitcnt vmcnt(0)" ::: "memory"); FA_SWRITE(0, 0); __syncthreads();
    qkt<6, MLA_KP>(pA0, pA1, K_lds, qr, r32, hi); partialSM(pA0, pA1, m_reg, mnA, alA);
    FA_SLOAD(1, 64); FA_SLOAD(0, 128);
    FA_SWAIT(); FA_SWRITE(1, 1); __syncthreads();
    for (int j = 1; j + 1 < NT; j += 2) {
        FA_SBAR(); qkt<6, MLA_KP>(pB0, pB1, K_lds + MLA_SHM_K, qr, r32, hi);
        finishSM(pA0, pA1, alA, l_reg, pa0, pa1, pa2, pa3); FA_SBAR();
        FA_SLOAD(1, (j + 2) * 64); FA_SBAR();
        FA_PV(vb0); partialSM(pB0, pB1, m_reg, mnB, alB);
        __syncthreads(); FA_SWAIT(); FA_SWRITE(0, 0);
        FA_RESC(alB); __syncthreads();
        FA_SBAR(); qkt<6, MLA_KP>(pA0, pA1, K_lds, qr, r32, hi);
        finishSM(pB0, pB1, alB, l_reg, pa0, pa1, pa2, pa3); FA_SBAR();
        if (j + 3 < NT) FA_SLOAD(0, (j + 3) * 64); FA_SBAR();
        FA_PV(vb0 + MLA_SHM_V); partialSM(pA0, pA1, m_reg, mnA, alA);
        __syncthreads(); FA_SWAIT(); FA_SWRITE(1, 1);
        FA_RESC(alA); __syncthreads();
    }
    FA_SBAR(); qkt<6, MLA_KP>(pB0, pB1, K_lds + MLA_SHM_K, qr, r32, hi);
    finishSM(pA0, pA1, alA, l_reg, pa0, pa1, pa2, pa3); FA_SBAR();
    FA_PV(vb0); partialSM(pB0, pB1, m_reg, mnB, alB);
    __syncthreads(); FA_RESC(alB);
    finishSM(pB0, pB1, alB, l_reg, pa0, pa1, pa2, pa3); FA_SBAR();
    FA_PV(vb0 + MLA_SHM_V);
    if (hi == 0) li_l[r32] = l_reg; asm volatile("s_waitcnt lgkmcnt(0)" ::: "memory");
    bf16_t* Yw = Y + (rowb + qb * 256 + wid * 32) * DM + h * 64 + r32;
#pragma unroll
    for (int r = 0; r < 16; ++r) { const int orow = crow(r, hi); const float rl = __builtin_amdgcn_rcpf(li_l[orow]);
        Yw[(size_t)orow * DM] = (bf16_t)f2bf(o[0][r] * rl); Yw[(size_t)orow * DM + 32] = (bf16_t)f2bf(o[1][r] * rl); }
    __syncthreads();
#undef FA_SLOAD
#undef FA_SWRITE
#undef FA_SWAIT
#undef FA_RESC
#undef FA_PV
}

constexpr int XA_KP = 528, XA_SHM_K = 64 * XA_KP, XA_SHM_V = 64 * 128 * 2;
__device__ __forceinline__ void xattn_unit(int b, int h, int vh, int qb, const bf16_t* __restrict__ HQ, const bf16_t* __restrict__ KVM, bf16_t* __restrict__ OX, LAS unsigned char* lds) {
    const int tid = threadIdx.x, wid = tid >> 6, lane = tid & 63, r32 = lane & 31, hi = lane >> 5;
    LAS unsigned char* K_lds = lds; LAS unsigned char* V_lds = lds + XA_SHM_K;
    LAS float* wsf = (LAS float*)(lds + XA_SHM_K + XA_SHM_V) + wid * 64; LAS float* li_l = wsf; LAS float* al_l = wsf + 32;
    float m_reg = -1e30f, l_reg = 0; f32x16 o[4] = {}; bf16x8 qr[16];
    const size_t qrow0 = (size_t)b * SEQ + qb * 256 + wid * 32;
    { const bf16_t* Qw = HQ + (qrow0 + r32) * DM + h * 256 + hi * 8; const float C = 0.0625f * 1.4426950408889634f;
#pragma unroll
      for (int d0 = 0; d0 < 16; ++d0) { const bf16x8 raw = *(const bf16x8*)(Qw + d0 * 16); float v[8];
#pragma unroll
          for (int j = 0; j < 8; ++j) v[j] = bf2f((bf16_t)raw[j]) * C;
          qr[d0] = cvt8(v); } }
    const int ksr = tid >> 5, ksc = tid & 31, vsr = tid >> 4, vsc = tid & 15;
    const bf16_t* gk = KVM + ((size_t)b * NMEM + ksr) * 2048 + h * 256 + ksc * 8;
    const bf16_t* gv = KVM + ((size_t)b * NMEM + vsr) * 2048 + 1024 + h * 256 + vh * 128 + vsc * 8;
    const int vb0 = (int)(unsigned)(uintptr_t)V_lds + v_rd_base(lane);
    bf16x8 sk[4], sv[2];
#define XA_SLOAD(k0) do { _Pragma("unroll") for (int i = 0; i < 4; ++i) sk[i] = *(const bf16x8*)(gk + (size_t)((k0) + 16 * i) * 2048); \
    _Pragma("unroll") for (int i = 0; i < 2; ++i) sv[i] = *(const bf16x8*)(gv + (size_t)((k0) + 32 * i) * 2048); } while (0)
#define XA_SWRITE() do { _Pragma("unroll") for (int i = 0; i < 4; ++i) *(LAS bf16x8*)(K_lds + (ksr + 16 * i) * XA_KP + ksc * 16) = sk[i]; \
    _Pragma("unroll") for (int i = 0; i < 2; ++i) *(LAS bf16x8*)(V_lds + v_st<4>(vsr + 32 * i, vsc * 8)) = sv[i]; } while (0)
    XA_SLOAD(0);
    for (int t = 0; t < NMEM / 64; ++t) {
        __syncthreads();
        XA_SWRITE(); __syncthreads();
        f32x16 p0, p1; float mn, al; bf16x8 pa0, pa1, pa2, pa3;
        qkt<16, XA_KP>(p0, p1, K_lds, qr, r32, hi);
        partialSM(p0, p1, m_reg, mn, al);
        if (__any(al < 1.f)) { if (hi == 0) al_l[r32] = al; asm volatile("s_waitcnt lgkmcnt(0)" ::: "memory");
#pragma unroll
            for (int d = 0; d < 4; ++d)
#pragma unroll
                for (int r = 0; r < 16; ++r) o[d][r] *= al_l[crow(r, hi)]; }
        finishSM(p0, p1, al, l_reg, pa0, pa1, pa2, pa3); FA_SBAR();
        if (t + 1 < NMEM / 64) XA_SLOAD((t + 1) * 64);
        FA_SBAR();
        pv_one<4, 0>(o[0], vb0, pa0, pa1, pa2, pa3); pv_one<4, 1>(o[1], vb0, pa0, pa1, pa2, pa3); pv_one<4, 2>(o[2], vb0, pa0, pa1, pa2, pa3); pv_one<4, 3>(o[3], vb0, pa0, pa1, pa2, pa3);
    }
    if (hi == 0) li_l[r32] = l_reg; asm volatile("s_waitcnt lgkmcnt(0)" ::: "memory");
    bf16_t* Ow = OX + qrow0 * DM + h * 256 + vh * 128 + r32;
#pragma unroll
    for (int r = 0; r < 16; ++r) { const int orow = crow(r, hi); const float rl = __builtin_amdgcn_rcpf(li_l[orow]);
#pragma unroll
        for (int d0 = 0; d0 < 4; ++d0) Ow[(size_t)orow * DM + d0 * 32] = (bf16_t)f2bf(o[d0][r] * rl); }
    __syncthreads();
#undef XA_SLOAD
#undef XA_SWRITE
}
}


namespace ml {
using fa::f32x16; using fa::s16x4; using fa::crow; using fa::cvtpk; using fa::tr_read; using fa::v_rd_base;
constexpr int RP = 272;
constexpr int L_Q = 0, L_K = 128 * RP, L_KW = 2 * 128 * RP, L_V = L_KW + 32768, L_C = L_V + 8192, L_ARR = L_C + 32 * RP;
constexpr int A_GI = 0, A_GF = 128, A_U2 = 256, A_MM2 = 384, A_A = 512, A_NEGM2 = 640, A_EW = 768, A_N = 896, A_NLP = 1024  , A_RD = 1536  , A_SC = 1664  ;
constexpr float LOG2E = 1.4426950408889634f;
#define ML_PK(L, H) (bf16x8){L[0], L[1], L[2], L[3], H[0], H[1], H[2], H[3]}
__device__ __forceinline__ float psum32(float v) { auto rr = __builtin_amdgcn_permlane32_swap(__float_as_uint(v), __float_as_uint(v), false, false); return __uint_as_float(rr[0]) + __uint_as_float(rr[1]); }

__device__ __forceinline__ void unit(int b, int h, int dir, int dq, const bf16_t* __restrict__ QKC, const bf16_t* __restrict__ Z, const float* __restrict__ G, const float* __restrict__ gbias,
                                     float* __restrict__ Hout, LAS unsigned char* lds) {
    const int tid0 = threadIdx.x, wid = __builtin_amdgcn_readfirstlane(tid0 >> 6);
    int tid = tid0;
    LAS float* arr = (LAS float*)(lds + L_ARR);
    const float bias_i = gbias[dir * 8 + h], bias_f = gbias[dir * 8 + 4 + h];
    for (int i = tid; i < 32 * RP / 4; i += NTHR) ((LAS unsigned*)(lds + L_C))[i] = 0u;
    if (tid < 128) arr[A_N + tid] = 0.f;
    f32x16 Cacc = {};
    float m_prev = 0.f;
#define ML_MAPS() const int lane = tid & 63, r32 = lane & 31, hi = lane >> 5, qr_r = tid >> 4, qr_c = tid & 15, v_r = tid >> 2, v_c = tid & 3; (void)lane; (void)r32; (void)hi
    const size_t seqb = (size_t)b * SEQ;
    bf16x8 sq[4], sk[4], sv; float sgi = 0.f, sgf = 0.f;
#define ML_LOAD(c) do { const size_t row0 = seqb + (dir ? SEQ - 128 * ((c) + 1) : 128 * (c)); \
    _Pragma("unroll") for (int i = 0; i < 4; ++i) { const bf16_t* pq = QKC + (row0 + qr_r + 32 * i) * 1024 + h * 128 + qr_c * 8; sq[i] = *(const bf16x8*)pq; sk[i] = *(const bf16x8*)(pq + 512); } \
    sv = *(const bf16x8*)(Z + (row0 + v_r) * LDZ + ZC_V + h * 128 + dq * 32 + v_c * 8); \
    if (tid < 128) { sgi = G[(row0 + tid) * 16 + dir * 8 + h]; sgf = G[(row0 + tid) * 16 + dir * 8 + 4 + h]; } } while (0)
#define ML_STORE() do { _Pragma("unroll") for (int i = 0; i < 4; ++i) { *(LAS bf16x8*)(lds + L_Q + (qr_r + 32 * i) * RP + qr_c * 16) = sq[i]; *(LAS bf16x8*)(lds + L_K + (qr_r + 32 * i) * RP + qr_c * 16) = sk[i]; } \
    *(LAS bf16x8*)(lds + L_V + fa::v_st<1>(v_r, v_c * 8)) = sv; \
    if (tid < 128) { arr[A_GI + tid] = sgi + bias_i; arr[A_GF + tid] = sgf + bias_f; } } while (0)
    { ML_MAPS(); ML_LOAD(0); }
#pragma unroll 1
    for (int c = 0; c < SEQ / 128; ++c) {
        asm volatile("" : "+v"(tid));
        ML_MAPS();
        const size_t row0 = seqb + (dir ? SEQ - 128 * (c + 1) : 128 * c);
        ML_STORE();
        __syncthreads();
        if (c + 1 < SEQ / 128) ML_LOAD(c + 1);
        if (wid == 0) {
            const int i0 = dir ? 127 - 2 * lane : 2 * lane, i1 = dir ? 126 - 2 * lane : 2 * lane + 1;
            const float f0 = arr[A_GF + i0], f1 = arr[A_GF + i1];
            const float lf0 = fminf(f0, 0.f) - log1pf(__expf(-fabsf(f0))), lf1 = fminf(f1, 0.f) - log1pf(__expf(-fabsf(f1)));
            float P = lf0 + lf1;
#pragma unroll
            for (int o = 1; o < 64; o <<= 1) { const float t_ = __shfl_up(P, o); if (lane >= o) P += t_; }
            const float b1 = P, b0 = P - lf1;
            const float u0 = arr[A_GI + i0] - b0, u1 = arr[A_GI + i1] - b1;
            float Pm = fmaxf(u0, u1);
#pragma unroll
            for (int o = 1; o < 64; o <<= 1) { const float t_ = __shfl_up(Pm, o); if (lane >= o) Pm = fmaxf(Pm, t_); }
            float E = __shfl_up(Pm, 1); if (lane == 0) E = -3.0e38f;
            const float M0 = fmaxf(E, u0), M1 = Pm;
            const float mm0 = fmaxf(m_prev, M0), mm1 = fmaxf(m_prev, M1);
            const float blast = __shfl(P, 63), Mall = __shfl(Pm, 63);
            const float mmL = fmaxf(m_prev, Mall);
            arr[A_U2 + i0] = u0 * LOG2E; arr[A_U2 + i1] = u1 * LOG2E;
            arr[A_MM2 + i0] = mm0 * LOG2E; arr[A_MM2 + i1] = mm1 * LOG2E;
            arr[A_A + i0] = __expf(m_prev - mm0); arr[A_A + i1] = __expf(m_prev - mm1);
            arr[A_NEGM2 + i0] = -(b0 + mm0) * LOG2E; arr[A_NEGM2 + i1] = -(b1 + mm1) * LOG2E;
            arr[A_EW + i0] = __expf(u0 - mmL); arr[A_EW + i1] = __expf(u1 - mmL);
            if (lane == 0) arr[A_SC] = __expf(m_prev - mmL);
            m_prev = blast + mmL;
        }
        __syncthreads();
        if (wid < 4) {
            const int tb = wid;
            bf16x8 qr[8];
#pragma unroll
            for (int ks = 0; ks < 8; ++ks) qr[ks] = *(const LAS bf16x8*)(lds + L_Q + (tb * 32 + r32) * RP + (ks * 16 + hi * 8) * 2);
            f32x16 inter = {}, intra = {};
#pragma unroll
            for (int ks = 0; ks < 8; ++ks) { const bf16x8 cf = *(const LAS bf16x8*)(lds + L_C + r32 * RP + (ks * 16 + hi * 8) * 2);
                inter = __builtin_amdgcn_mfma_f32_32x32x16_bf16(qr[ks], cf, inter, 0, 0, 0); }
            float nq = 0.f;
#pragma unroll
            for (int cc = 0; cc < 8; ++cc) { const bf16x8 q8 = *(const LAS bf16x8*)(lds + L_Q + (tb * 32 + r32) * RP + (hi * 64 + cc * 8) * 2);
                const f32x4 n0 = *(const LAS f32x4*)(arr + A_N + hi * 64 + cc * 8), n1 = *(const LAS f32x4*)(arr + A_N + hi * 64 + cc * 8 + 4);
#pragma unroll
                for (int j = 0; j < 4; ++j) nq += bf2f((bf16_t)q8[j]) * n0[j] + bf2f((bf16_t)q8[4 + j]) * n1[j]; }
            nq = psum32(nq);
            const float mm2t = arr[A_MM2 + tb * 32 + r32];
            float dsum = 0.f;
            const int vbase = (int)(unsigned)(uintptr_t)(lds + L_V) + v_rd_base(lane);
#pragma unroll 1
            for (int sb = 0; sb < 4; ++sb) {
                if (dir ? (sb < tb) : (sb > tb)) continue;
                f32x16 p = {};
#pragma unroll
                for (int ks = 0; ks < 8; ++ks) { const bf16x8 kf = *(const LAS bf16x8*)(lds + L_K + (sb * 32 + r32) * RP + (ks * 16 + hi * 8) * 2);
                    p = __builtin_amdgcn_mfma_f32_32x32x16_bf16(kf, qr[ks], p, 0, 0, 0); }
                const bool diag = (sb == tb);
#pragma unroll
                for (int r = 0; r < 16; ++r) { const int sl = crow(r, hi);
                    float w = __builtin_amdgcn_exp2f(arr[A_U2 + sb * 32 + sl] - mm2t);
                    if (diag && (dir ? (sl < r32) : (sl > r32))) w = 0.f;
                    p[r] *= w; dsum += p[r]; }
                bf16x8 pa0, pa1;
#define ML_PK4(P, BASE, OUT) do { unsigned a0 = cvtpk(P[BASE + 0], P[BASE + 1]), a1 = cvtpk(P[BASE + 2], P[BASE + 3]);   \
    unsigned b0_ = cvtpk(P[BASE + 4], P[BASE + 5]), b1_ = cvtpk(P[BASE + 6], P[BASE + 7]);                              \
    auto r0 = __builtin_amdgcn_permlane32_swap(a0, b0_, false, false); auto r1 = __builtin_amdgcn_permlane32_swap(a1, b1_, false, false); \
    u32x4 w_ = {r0[0], r1[0], r0[1], r1[1]}; OUT = *reinterpret_cast<bf16x8*>(&w_); } while (0)
                ML_PK4(p, 0, pa0); ML_PK4(p, 8, pa1);
                const int vb = vbase + sb * 2048;
                const s16x4 l0 = tr_read<0>(vb), h0 = tr_read<512>(vb), l1 = tr_read<1024>(vb), h1 = tr_read<1536>(vb);
                asm volatile("s_waitcnt lgkmcnt(0)" ::: "memory"); __builtin_amdgcn_sched_barrier(0);
                intra = __builtin_amdgcn_mfma_f32_32x32x16_bf16(pa0, ML_PK(l0, h0), intra, 0, 0, 0);
                intra = __builtin_amdgcn_mfma_f32_32x32x16_bf16(pa1, ML_PK(l1, h1), intra, 0, 0, 0);
            }
            dsum = psum32(dsum);
            const float at = arr[A_A + tb * 32 + r32];
            const float den = dsum + at * nq;
            const float rden = __builtin_amdgcn_rcpf(fmaxf(fabsf(den), __builtin_amdgcn_exp2f(arr[A_NEGM2 + tb * 32 + r32])));
            if (hi == 0) arr[A_RD + tb * 32 + r32] = rden;
            asm volatile("s_waitcnt lgkmcnt(0)" ::: "memory");
            float* Ho = Hout + (row0 + tb * 32) * ML_W + h * 128 + dq * 32 + r32;
#pragma unroll
            for (int r = 0; r < 16; ++r) { const int tl = crow(r, hi);
                Ho[(size_t)tl * ML_W] = (intra[r] + arr[A_A + tb * 32 + tl] * inter[r]) * arr[A_RD + tb * 32 + tl]; }
        } else {
            const int ht = tid - 256, ec = ht & 15, s0 = ht >> 4;
            float ns[8] = {0.f, 0.f, 0.f, 0.f, 0.f, 0.f, 0.f, 0.f};
#pragma unroll
            for (int i = 0; i < 8; ++i) { const int sidx = s0 + 16 * i; const bf16x8 k8 = *(const LAS bf16x8*)(lds + L_K + sidx * RP + ec * 16); const float ew = arr[A_EW + sidx];
                float kv[8];
#pragma unroll
                for (int j = 0; j < 8; ++j) { kv[j] = bf2f((bf16_t)k8[j]) * ew; ns[j] += kv[j]; }
                *(LAS bf16x8*)(lds + L_KW + fa::v_st<4>(sidx, ec * 8)) = fa::cvt8(kv); }
#pragma unroll
            for (int j = 0; j < 8; ++j) { ns[j] += __shfl_xor(ns[j], 16); ns[j] += __shfl_xor(ns[j], 32); }
            if (lane < 16) {
#pragma unroll
                for (int j = 0; j < 8; ++j) arr[A_NLP + (wid - 4) * 128 + ec * 8 + j] = ns[j]; }
        }
        __syncthreads();
        if (wid >= 4) {
            const int et = wid - 4; const float fC = arr[A_SC];
#pragma unroll
            for (int r = 0; r < 16; ++r) Cacc[r] *= fC;
            const int vb = (int)(unsigned)(uintptr_t)(lds + L_V) + v_rd_base(lane), kb = (int)(unsigned)(uintptr_t)(lds + L_KW) + v_rd_base(lane) + et * 512;
#define ML_CUP(ks) do { const s16x4 al = tr_read<(ks) * 1024>(vb), ah = tr_read<(ks) * 1024 + 512>(vb), bl = tr_read<(ks) * 4096>(kb), bh = tr_read<(ks) * 4096 + 2048>(kb); \
    asm volatile("s_waitcnt lgkmcnt(0)" ::: "memory"); __builtin_amdgcn_sched_barrier(0); \
    Cacc = __builtin_amdgcn_mfma_f32_32x32x16_bf16(ML_PK(al, ah), ML_PK(bl, bh), Cacc, 0, 0, 0); } while (0)
            ML_CUP(0); ML_CUP(1); ML_CUP(2); ML_CUP(3); ML_CUP(4); ML_CUP(5); ML_CUP(6); ML_CUP(7);
#undef ML_CUP
#pragma unroll
            for (int r = 0; r < 16; ++r) *(LAS bf16_t*)(lds + L_C + crow(r, hi) * RP + (et * 32 + r32) * 2) = (bf16_t)f2bf(Cacc[r]);
            const int ht = tid - 256;
            if (ht < 128) arr[A_N + ht] = fC * arr[A_N + ht] + (arr[A_NLP + ht] + arr[A_NLP + 128 + ht]) + (arr[A_NLP + 256 + ht] + arr[A_NLP + 384 + ht]);
        }
        __syncthreads();
    }
#undef ML_LOAD
#undef ML_STORE
#undef ML_MAPS
#undef ML_PK4
}
#undef ML_PK
}

__device__ __forceinline__ void mlstm_fast(const Params& p, LAS unsigned char* lds) {
    const int G = gridDim.x, bx = blockIdx.x, vcu = (G % 8 == 0) ? (bx % 8) * (G / 8) + bx / 8 : bx;
    for (int u = vcu; u < BATCH * ML_H * 2 * 4; u += G) {
        const int dq = u & 3, dir = (u >> 2) & 1, h = (u >> 3) & 3, b = u >> 5;
        ml::unit(b, h, dir, dq, (const bf16_t*)p.ws2, (const bf16_t*)(p.ws + WS_Z), (const float*)(p.ws + WS_G), p.gbias, dir ? p.out + (size_t)T * ML_W : p.out, lds);
    }
}
__device__ __forceinline__ void mla_attn_fast(const Params& p, LAS unsigned char* lds) {
    const int G = gridDim.x, bx = blockIdx.x, vcu = (G % 8 == 0) ? (bx % 8) * (G / 8) + bx / 8 : bx;
    for (int u = vcu; u < BATCH * MLA_H * 16; u += G) {
        const int qb = u & 15, bh = u >> 4;
        fa::mla_unit(bh >> 3, bh & 7, qb, (const bf16_t*)(p.ws + WS_QALL), (const bf16_t*)(p.ws + WS_KV), (const bf16_t*)(p.ws + WS_KR),
                     (const float*)(p.ws + WS_COS), (const float*)(p.ws + WS_SIN), (bf16_t*)(p.ws + WS_Y), lds);
    }
}
__device__ __forceinline__ void x_attn_fast(const Params& p, LAS unsigned char* lds) {
    const int G = gridDim.x, bx = blockIdx.x, vcu = (G % 8 == 0) ? (bx % 8) * (G / 8) + bx / 8 : bx;
    for (int u = vcu; u < BATCH * XH * 2 * 16; u += G) {
        const int qb = u & 15, vh = (u >> 4) & 1, bh = u >> 5;
        fa::xattn_unit(bh >> 2, bh & 3, vh, qb, (const bf16_t*)(p.ws + WS_HQ), (const bf16_t*)(p.ws + WS_KVM), (bf16_t*)(p.ws + WS_OX), lds);
    }
}
__device__ __forceinline__ void phase_final(const Params& p) {
    const float* ssq = (const float*)(p.ws + WS_SSQ) + 4 * (size_t)T;
    const int wid = threadIdx.x >> 6, lane = threadIdx.x & 63;
    for (int row = blockIdx.x * NWAVES + wid; row < T; row += gridDim.x * NWAVES) {
        const float r = rsqrtf(ssq[row] * (1.0f / DM) + EPS);
        f32x4* o = (f32x4*)(p.out + (size_t)row * DM) + lane; const f32x4* g = (const f32x4*)p.final_norm + lane;
#pragma unroll
        for (int j = 0; j < 4; ++j) o[64 * j] = o[64 * j] * r * g[64 * j];
    }
}


#define XB_TMO      128
#define XB_XCNT(j)  (256  + 64 * (j))
#define XB_XSUB(j)  (1280 + 64 * (j))
#define XB_XGEN(j)  (2304 + 64 * (j))
#define XB_TOP      3328
#define XB_TOPGEN   3392
#define XCD_BAR_WORDS 3456
#define XB_SPIN_CAP (1u << 20)
__device__ __forceinline__ unsigned xb_ld(unsigned* p)              { return __hip_atomic_load(p, __ATOMIC_RELAXED, __HIP_MEMORY_SCOPE_AGENT); }
__device__ __forceinline__ unsigned xb_add(unsigned* p, unsigned v) { return __hip_atomic_fetch_add(p, v, __ATOMIC_RELAXED, __HIP_MEMORY_SCOPE_AGENT); }
__device__ __forceinline__ unsigned xb_xcc_id() { return (unsigned)__builtin_amdgcn_s_getreg((3 << 11) | 20) & 0xFu; }
#define XB_SPIN(cond, bar) do { unsigned _sp = 0; while (cond) { __builtin_amdgcn_s_sleep(1); \
    if ((++_sp & 255u) == 0u) { if (xb_ld(&(bar)[XB_TMO])) break; if (_sp > XB_SPIN_CAP) { atomicAdd(&(bar)[XB_TMO], 1u); break; } } } } while (0)
struct XcdBarrier { unsigned* bar; unsigned x; volatile LAS unsigned* st; };
__device__ __forceinline__ XcdBarrier xcd_barrier_post(unsigned* bar, volatile LAS unsigned* st) {
    XcdBarrier b; b.bar = bar; b.x = xb_xcc_id(); b.st = st;
    if (threadIdx.x == 0) (void)xb_add(&bar[XB_XCNT(b.x)], 1u);
    return b;
}
__device__ __forceinline__ void xcd_barrier_complete(unsigned* bar, unsigned x, unsigned& nloc, unsigned& nx) {
    const unsigned G = gridDim.x * gridDim.y * gridDim.z;
    unsigned sum, cnt, mine, sp = 0u;
    for (;;) {
        sum = 0u; cnt = 0u; mine = 0u;
#pragma unroll
        for (unsigned j = 0; j < 16; ++j) { const unsigned c = xb_ld(&bar[XB_XCNT(j)]); sum += c; cnt += (c > 0u) ? 1u : 0u; mine = (j == x) ? c : mine; }
        if (sum == G) break;
        __builtin_amdgcn_s_sleep(1);
        if ((++sp & 255u) == 0u) { if (xb_ld(&bar[XB_TMO])) break; if (sp > XB_SPIN_CAP) { atomicAdd(&bar[XB_TMO], 1u); break; } }
    }
    nloc = mine > 0u ? mine : 1u; nx = cnt > 0u ? cnt : 1u;
}
__device__ __forceinline__ void xcd_barrier(const XcdBarrier& b) {
    asm volatile("s_waitcnt vmcnt(0)" ::: "memory");
    __syncthreads();
    if (threadIdx.x == 0) {
        unsigned* bar = b.bar;
        __builtin_amdgcn_s_waitcnt(0);
        unsigned nloc = b.st[0], nx = b.st[1];
        if (nloc == 0u) { xcd_barrier_complete(bar, b.x, nloc, nx); b.st[0] = nloc; b.st[1] = nx; }
        const unsigned old = xb_add(&bar[XB_XSUB(b.x)], 1u);
        const unsigned gen = old / nloc;
        if (old + 1u == (gen + 1u) * nloc) {
            __builtin_amdgcn_fence(__ATOMIC_RELEASE, "agent");
            asm volatile("s_waitcnt vmcnt(0)" ::: "memory");
            const unsigned og = xb_add(&bar[XB_TOP], 1u);
            const unsigned tg = og / nx;
            if (og + 1u == (tg + 1u) * nx) xb_add(&bar[XB_TOPGEN], 1u);
            else XB_SPIN(xb_ld(&bar[XB_TOPGEN]) == tg, bar);
            __builtin_amdgcn_fence(__ATOMIC_ACQUIRE, "agent");
            xb_add(&bar[XB_XGEN(b.x)], 1u);
            asm volatile("s_waitcnt vmcnt(0)" ::: "memory");
        } else {
            XB_SPIN(xb_ld(&bar[XB_XGEN(b.x)]) == gen, bar);
            __builtin_amdgcn_fence(__ATOMIC_ACQUIRE, "agent");
            asm volatile("s_waitcnt vmcnt(0)" ::: "memory");
        }
    }
    __syncthreads();
}

constexpr int LDS_BYTES = 147456;
constexpr int NPHASE = 12;
#ifndef MK_N_LAUNCHES
#define MK_N_LAUNCHES 1
#endif

__global__ void __launch_bounds__(NTHR, 2) mega(Params p) {
    extern __shared__ __attribute__((aligned(16))) unsigned char lds_raw[];
    LAS unsigned char* lds = (LAS unsigned char*)lds_raw;
    unsigned char* ws = p.ws;
    float* ssq = (float*)(ws + WS_SSQ);
    const int lo = p.ph_lo, hi = p.ph_hi;
    volatile LAS unsigned* misc = (volatile LAS unsigned*)(lds + LDS_BYTES - 64);
    if (threadIdx.x < 16) misc[threadIdx.x] = 0u;
    __syncthreads();
    XcdBarrier bar; bar.bar = (unsigned*)(ws + WS_CTL) + 4096; bar.x = 0; bar.st = nullptr;
    if (hi - lo > 1) bar = xcd_barrier_post((unsigned*)(ws + WS_CTL) + 4096, misc);
#define IN(k) (lo <= (k) && (k) < hi)
#define SEAM(k) do { if (IN(k) && IN((k) + 1)) xcd_barrier(bar); } while (0)
    if (IN(0)) phase0(p, lds);
    SEAM(0);
    if (IN(1)) {
        Gemm g{(const bf16_t*)(ws + WS_XB), DM, (const bf16_t*)(ws + WS_WIN), DM, T, LDZ, DM};
        EpiZ E{(bf16_t*)(ws + WS_Z), ssq, ssq + T, (bf16_t*)(ws + WS_KR), (float*)(ws + WS_G), (const float*)(ws + WS_COS), (const float*)(ws + WS_SIN)};
        run_gemm(lds, g, E, (int)blockIdx.x);
    }
    SEAM(1);
    if (IN(2)) {
        { Gemm g{(const bf16_t*)(ws + WS_Z) + ZC_CQ, LDZ, (const bf16_t*)(ws + WS_WUQ), QLORA, T, MLA_H * DQK, QLORA};
          EpiScaleBf16 E{(bf16_t*)(ws + WS_QALL), MLA_H * DQK, ssq, 1.0f / QLORA, 1.0f}; run_gemm(lds, g, E, (int)blockIdx.x); }
        { Gemm g{(const bf16_t*)(ws + WS_Z) + ZC_CKV, LDZ, (const bf16_t*)(ws + WS_WUKV), 256, T, 1024, 256};
          EpiScaleBf16 E{(bf16_t*)(ws + WS_KV), 1024, ssq + T, 1.0f / KVLORA, 1.0f}; run_gemm(lds, g, E, (int)blockIdx.x); }
        { Gemm g{(const bf16_t*)(ws + WS_MEMN), DM, (const bf16_t*)(ws + WS_WXKV), DM, TM, 2 * DM, DM};
          EpiScaleBf16 E{(bf16_t*)(ws + WS_KVM), 2 * DM, nullptr, 0.f, 1.0f}; run_gemm(lds, g, E, (int)blockIdx.x); }
        phase_conv(p);
    }
    SEAM(2);
    if (IN(3)) { mlstm_fast(p, lds); mla_attn_fast(p, lds); }
    SEAM(3);
    if (IN(4)) phase_mlfin(p);
    SEAM(4);
    if (IN(5)) {
        Gemm g{(const bf16_t*)(ws + WS_Y), DM, (const bf16_t*)(ws + WS_WOUT), DM, T, DM, DM};
        EpiResid E{p.x, p.out, (bf16_t*)(ws + WS_XB), ssq + 2 * T}; run_gemm(lds, g, E, (int)blockIdx.x);
    }
    SEAM(5);
    if (IN(6)) {
        Gemm g{(const bf16_t*)(ws + WS_XB), DM, (const bf16_t*)(ws + WS_WXQ), DM, T, DM, DM};
        EpiScaleBf16 E{(bf16_t*)(ws + WS_HQ), DM, ssq + 2 * T, 1.0f / DM, 1.0f}; run_gemm(lds, g, E, (int)blockIdx.x);
    }
    SEAM(6);
    if (IN(7)) x_attn_fast(p, lds);
    SEAM(7);
    if (IN(8)) {
        Gemm g{(const bf16_t*)(ws + WS_OX), DM, (const bf16_t*)(ws + WS_WXO), DM, T, DM, DM};
        EpiResid E{p.out, p.out, (bf16_t*)(ws + WS_XB), ssq + 3 * T}; run_gemm(lds, g, E, (int)blockIdx.x);
    }
    SEAM(8);
    if (IN(9)) {
        Gemm g{(const bf16_t*)(ws + WS_XB), DM, (const bf16_t*)(ws + WS_WGU), DM, T, 2 * DFF, DM};
        EpiSwiglu E{(bf16_t*)(ws + WS_H), ssq + 3 * T}; run_gemm(lds, g, E, (int)blockIdx.x);
    }
    SEAM(9);
    if (IN(10)) {
        Gemm g{(const bf16_t*)(ws + WS_H), DFF, (const bf16_t*)(ws + WS_WD), DFF, T, DM, DFF};
        EpiResid E{p.out, p.out, nullptr, ssq + 4 * T}; run_gemm(lds, g, E, (int)blockIdx.x);
    }
    SEAM(10);
    if (IN(11)) phase_final(p);
#undef IN
#undef SEAM
}

extern "C" void kernel_launch(void* const* d_in, const int* in_sizes, int n_in, void* d_out, int out_size, void* d_ws, size_t ws_size, hipStream_t stream) {
    static int grid = 0;
    if (grid == 0) {
        if (n_in != 22 || in_sizes[0] != T * DM || out_size != T * DM) { fprintf(stderr, "kernel_launch: unexpected shapes (n_in %d, in0 %d, out %d)\n", n_in, n_in > 0 ? in_sizes[0] : -1, out_size); grid = -1; return; }
        if (ws_size < WS_END) { fprintf(stderr, "kernel_launch: workspace too small: %zu\n", ws_size); grid = -1; return; }
        int dev = 0, cus = 0, per_cu = 0;
        (void)hipGetDevice(&dev); (void)hipDeviceGetAttribute(&cus, hipDeviceAttributeMultiprocessorCount, dev);
        if (hipFuncSetAttribute((const void*)mega, hipFuncAttributeMaxDynamicSharedMemorySize, LDS_BYTES) != hipSuccess) { fprintf(stderr, "kernel_launch: hipFuncSetAttribute failed\n"); grid = -1; return; }
        if (hipOccupancyMaxActiveBlocksPerMultiprocessor(&per_cu, (const void*)mega, NTHR, LDS_BYTES) != hipSuccess || per_cu < 1) { fprintf(stderr, "kernel_launch: occupancy query says %d\n", per_cu); per_cu = 1; }
        (void)hipGetLastError();
        grid = cus * (per_cu < 1 ? per_cu : 1);
        fprintf(stderr, "kernel_launch: grid %d (cus %d, per_cu %d), ws %zu MiB\n", grid, cus, per_cu, ws_size >> 20);
    }
    if (grid < 0) return;
    Params p{};
    p.x = (const float*)d_in[0]; p.mem = (const float*)d_in[1]; p.pos = (const int*)d_in[2];
    p.attn_norm = (const float*)d_in[3]; p.w_in = (const float*)d_in[4]; p.q_norm = (const float*)d_in[5]; p.w_uq = (const float*)d_in[6];
    p.kv_norm = (const float*)d_in[7]; p.w_ukv = (const float*)d_in[8]; p.conv = (const float*)d_in[9]; p.gbias = (const float*)d_in[10];
    p.ml_norm = (const float*)d_in[11]; p.w_out = (const float*)d_in[12]; p.xattn_norm = (const float*)d_in[13]; p.mem_norm = (const float*)d_in[14];
    p.w_xq = (const float*)d_in[15]; p.w_xkv = (const float*)d_in[16]; p.w_xo = (const float*)d_in[17]; p.ffn_norm = (const float*)d_in[18];
    p.w_gu = (const float*)d_in[19]; p.w_down = (const float*)d_in[20]; p.final_norm = (const float*)d_in[21];
    p.out = (float*)d_out; p.ws = (unsigned char*)d_ws;
    p.ws2 = (unsigned char*)d_ws + WS_XB;
    if (hipMemsetAsync((char*)d_ws + WS_CTL, 0, 65536, stream) != hipSuccess) { fprintf(stderr, "kernel_launch: memset failed\n"); return; }
#if MK_N_LAUNCHES == 1
    p.ph_lo = 0; p.ph_hi = NPHASE;
    { void* args[] = {&p};
      const hipError_t e = hipLaunchCooperativeKernel((const void*)mega, dim3(grid), dim3(NTHR), args, LDS_BYTES, stream);
      if (e != hipSuccess) fprintf(stderr, "kernel_launch: cooperative launch failed: %s (grid %d)\n", hipGetErrorString(e), grid); }
#else
    for (int ph = 0; ph < NPHASE; ++ph) {
        p.ph_lo = ph; p.ph_hi = ph + 1;
        hipLaunchKernelGGL(mega, dim3(grid), dim3(NTHR), LDS_BYTES, stream, p);
    }
#endif
    const hipError_t le = hipPeekAtLastError();
    if (le != hipSuccess) fprintf(stderr, "kernel_launch: launch failed: %s\n", hipGetErrorName(le));
}
```

```cpp
#include <hip/hip_runtime.h>
#include <cstdio>
#include <cstdint>

#ifndef PROBE_A
#define PROBE_A (-1)
#define PROBE_A_SCALE 1.0e-7f
#define PROBE_B (-1)
#define PROBE_B_SCALE 1.0e-4f
#endif
constexpr int BATCH = 8, SEQ = 4096, DM = 1024, T = BATCH * SEQ;
constexpr int NMEM = 256, TM = BATCH * NMEM;
constexpr float EPS = 1e-6f;
constexpr int MLA_H = 8, QLORA = 256, KVLORA = 128, NOPE = 64, ROPE = 32, VD = 64, DQK = NOPE + ROPE;
constexpr int ML_H = 4, ML_D = 128, ML_W = 512;
constexpr int XH = 4, XD = 256;
constexpr int DFF = 2816;
constexpr int INW = 2480;
constexpr int LDZ = 2560, ZC_CQ = 0, ZC_CKV = 256, ZC_KR = 384, ZC_G = 416, ZC_QK = 512, ZC_V = 1536, ZC_O = 2048;
constexpr int NWAVES = 8, NTHR = 512;

constexpr size_t MiB = 1u << 20;
constexpr size_t WS_CTL = 0;
constexpr size_t WS_WIN = 1 * MiB;
constexpr size_t WS_WUQ = 6 * MiB;
constexpr size_t WS_WUKV = 7 * MiB;
constexpr size_t WS_WOUT = 8 * MiB;
constexpr size_t WS_WXQ = 10 * MiB;
constexpr size_t WS_WXKV = 12 * MiB;
constexpr size_t WS_WXO = 16 * MiB;
constexpr size_t WS_WGU = 18 * MiB;
constexpr size_t WS_WD = 30 * MiB;
constexpr size_t WS_COS = 36 * MiB;
constexpr size_t WS_SIN = 38 * MiB;
constexpr size_t WS_G = 40 * MiB;
constexpr size_t WS_KR = 42 * MiB;
constexpr size_t WS_SSQ = 44 * MiB;
constexpr size_t WS_SMALL = 45 * MiB;
constexpr int SM_CONV = 0, SM_GBIAS = 3072, SM_MLN = 3136, SM_FIN = 3648, SM_END = 4672;
constexpr size_t WS_MEMN = 46 * MiB;
constexpr size_t WS_KVM = 50 * MiB;
constexpr size_t WS_XB = 64 * MiB;
constexpr size_t WS_Z = 128 * MiB;
constexpr size_t WS_H = 128 * MiB;
constexpr size_t WS_QALL = 288 * MiB;
constexpr size_t WS_KV = 336 * MiB;
constexpr size_t WS_Y = 400 * MiB;
constexpr size_t WS_HQ = 304 * MiB;
constexpr size_t WS_OX = 368 * MiB;
constexpr size_t WS_GT = 464 * MiB;
constexpr size_t WS_END = 476 * MiB;

typedef unsigned short bf16_t;
typedef short bf16x8 __attribute__((ext_vector_type(8)));
typedef float f32x4 __attribute__((ext_vector_type(4)));
typedef unsigned u32x4 __attribute__((ext_vector_type(4)));
typedef unsigned u32x2 __attribute__((ext_vector_type(2)));
#define LAS __attribute__((address_space(3)))

__device__ __forceinline__ float bf2f(bf16_t h) { return __uint_as_float(((unsigned)h) << 16); }
__device__ __forceinline__ unsigned f2bf(float f) { unsigned u = __float_as_uint(f); return (u + 0x7fffu + ((u >> 16) & 1u)) >> 16; }
__device__ __forceinline__ unsigned pk2(float lo, float hi) { return f2bf(lo) | (f2bf(hi) << 16); }
__device__ __forceinline__ float wave_sum(float v) {
#pragma unroll
    for (int o = 1; o < 64; o <<= 1) v += __shfl_xor(v, o);
    return v;
}
__device__ __forceinline__ float wave_max(float v) {
#pragma unroll
    for (int o = 1; o < 64; o <<= 1) v = fmaxf(v, __shfl_xor(v, o));
    return v;
}

struct Params {
    const float* x; const float* mem; const int* pos;
    const float *attn_norm, *w_in, *q_norm, *w_uq, *kv_norm, *w_ukv, *conv, *gbias, *ml_norm, *w_out, *xattn_norm, *mem_norm, *w_xq, *w_xkv, *w_xo, *ffn_norm, *w_gu, *w_down, *final_norm;
    float* out; unsigned char* ws;
    int ph_lo, ph_hi;
};

struct Unit { int pm, pn; };
struct Gemm { const bf16_t* A; int lda; const bf16_t* Bt; int ldb; int M, N, K; };

template <class Epi>
__device__ __forceinline__ void gemm_naive(const Gemm g, const Epi& E) {
    const int tid = threadIdx.x, wid = tid >> 6, lane = tid & 63, wr = wid >> 2, wc = wid & 3, fr = lane & 15, fq = lane >> 4;
    const int nM = g.M / 256, nN = g.N / 256;
    for (int unit = blockIdx.x; unit < nM * nN; unit += gridDim.x) {
        Unit u; u.pm = unit / nN; u.pn = unit % nN;
        f32x4 acc[2][2][4][2];
#pragma unroll
        for (int a = 0; a < 2; ++a)
#pragma unroll
            for (int b = 0; b < 2; ++b)
#pragma unroll
                for (int m = 0; m < 4; ++m)
#pragma unroll
                    for (int n = 0; n < 2; ++n) acc[a][b][m][n] = (f32x4){0.f, 0.f, 0.f, 0.f};
        const bf16_t* Ab = g.A + (size_t)(u.pm * 256 + wr * 64 + fr) * g.lda + 8 * fq;
        const bf16_t* Bb = g.Bt + (size_t)(u.pn * 256 + wc * 32 + 8 * (fr >> 2) + (fr & 3)) * g.ldb + 8 * fq;
        for (int kk = 0; kk < g.K; kk += 32) {
            bf16x8 a[2][4], b[2][2];
#pragma unroll
            for (int ai = 0; ai < 2; ++ai)
#pragma unroll
                for (int m = 0; m < 4; ++m) a[ai][m] = *(const bf16x8*)(Ab + (size_t)(ai * 128 + m * 16) * g.lda + kk);
#pragma unroll
            for (int bj = 0; bj < 2; ++bj)
#pragma unroll
                for (int n = 0; n < 2; ++n) b[bj][n] = *(const bf16x8*)(Bb + (size_t)(bj * 128 + 4 * n) * g.ldb + kk);
#pragma unroll
            for (int ai = 0; ai < 2; ++ai)
#pragma unroll
                for (int bj = 0; bj < 2; ++bj)
#pragma unroll
                    for (int m = 0; m < 4; ++m)
#pragma unroll
                        for (int n = 0; n < 2; ++n) acc[ai][bj][m][n] = __builtin_amdgcn_mfma_f32_16x16x32_bf16(b[bj][n], a[ai][m], acc[ai][bj][m][n], 0, 0, 0);
        }
        E(acc, u, wr, wc, fr, fq);
    }
}


#define PG8_LAS __attribute__((address_space(3)))
constexpr int BM = 256, BK = 64, HALF = 128, HTB = HALF * BK * 2  , STAGE_BYTES = 8 * HTB, NXCD = 8, WGM = 8;

__host__ __device__ __forceinline__ int lds_byte(int r, int c) { const int st = (r >> 4) * 2 + (c >> 5), rr = r & 15, cc = c & 31, ob = rr * 64 + cc * 2; return st * 1024 + (ob ^ (((ob >> 9) & 1) << 5)); }
__host__ __device__ __forceinline__ void stage_rc(int b, int& R, int& C) { const int st = b / 1024, sb = b % 1024, swz = sb ^ (((sb >> 9) & 1) << 5); R = (st >> 1) * 16 + swz / 64; C = (st & 1) * 32 + (swz % 64) / 2; }
__host__ __device__ __forceinline__ int perm32(int rho) { const int n = rho >> 4, i = rho & 15; return 8 * (i >> 2) + 4 * n + (i & 3); }


struct StaticOrder {
    int nM, nN, nwg, G, c;
    __host__ __device__ void init(int M, int N, int G_, int c_) { nM = M / BM; nN = N / BM; nwg = nM * nN; G = G_; c = c_; }
    __host__ __device__ bool next(int i, Unit& u) const {
        const long L = (long)i * G + c; if (L >= nwg) return false;
        int wgid = (int)L; { const int q = nwg / NXCD, r = nwg % NXCD, xcd = wgid % NXCD, off = wgid / NXCD; wgid = (xcd < r ? xcd * (q + 1) : r * (q + 1) + (xcd - r) * q) + off; }
        const int nig = WGM * nN, gid = wgid / nig, fm = gid * WGM, gsz = (nM - fm) < WGM ? (nM - fm) : WGM;
        u.pm = fm + ((wgid % nig) % gsz); u.pn = (wgid % nig) / gsz; return true;
    }
    __device__ __forceinline__ void a_ready(const Unit&) const {}
    __device__ __forceinline__ void done(const Unit&) const {}
};

template <class Epi, class Sched, bool ALIGN_EPI = false, bool SP2 = false>
__device__ __forceinline__ void gemm_phase(PG8_LAS unsigned char* lds, const Gemm g, const Sched& S, const Epi& E) {
    const int tid = threadIdx.x, wid = __builtin_amdgcn_readfirstlane(tid >> 6), lane = tid & 63, wr = wid >> 2, wc = wid & 3, fr = lane & 15, fq = lane >> 4;
    const int K = g.K, nt = K / BK, lda = g.lda, ldb = g.ldb;
    unsigned voffA[2], voffB[2];
#pragma unroll
    for (int i = 0; i < 2; ++i) { int R, C; stage_rc(tid * 16 + i * 8192, R, C); const int Rb = Epi::PERM ? ((R & ~31) + perm32(R & 31)) : R;
        voffA[i] = (unsigned)(R * lda + C) * 2u; voffB[i] = (unsigned)(Rb * ldb + C) * 2u; }
    const size_t kstep = (size_t)(BK * 2);
    const size_t hstepA = (size_t)HALF * lda * 2, hstepB = (size_t)HALF * ldb * 2;
    const size_t tstepA = 2 * hstepA, tstepB = 2 * hstepB;
    const unsigned ldsw = (unsigned)wid * 1024u;
    const int aoff = lds_byte(wr * 64 + fr, fq * 8), boff = lds_byte(wc * 32 + fr, fq * 8);
#define PG8_SA(b, h) (((b) * 2 + (h)) * HTB)
#define PG8_SB(b, h) ((4 + (b) * 2 + (h)) * HTB)
#define PG8_STAGE(bufoff, gbase, voff) do { _Pragma("unroll") for (int _i = 0; _i < 2; ++_i) \
        __builtin_amdgcn_global_load_lds((const unsigned*)((const char*)(gbase) + (voff)[_i]), (PG8_LAS unsigned*)(lds + (bufoff) + ldsw + _i * 8192), 16, 0, 0); } while (0)
#define PG8_LDA(dst, b, h) do { _Pragma("unroll") for (int m = 0; m < 4; ++m) _Pragma("unroll") for (int k = 0; k < 2; ++k) dst[m][k] = *(const PG8_LAS bf16x8*)(lds + PG8_SA(b, h) + aoff + m * 2048 + k * 1024); } while (0)
#define PG8_LDB(dst, b, h) do { _Pragma("unroll") for (int n = 0; n < 2; ++n) _Pragma("unroll") for (int k = 0; k < 2; ++k) dst[n][k] = *(const PG8_LAS bf16x8*)(lds + PG8_SB(b, h) + boff + n * 2048 + k * 1024); } while (0)
#define PG8_MMA(ai, bj, At, Bt) do { __builtin_amdgcn_s_setprio(1); _Pragma("unroll") for (int m = 0; m < 4; ++m) _Pragma("unroll") for (int n = 0; n < 2; ++n) _Pragma("unroll") for (int k = 0; k < 2; ++k) \
        acc[ai][bj][m][n] = __builtin_amdgcn_mfma_f32_16x16x32_bf16(Bt[n][k], At[m][k], acc[ai][bj][m][n], 0, 0, 0); __builtin_amdgcn_s_setprio(0); } while (0)
#define PG8_WAIT_V(n) asm volatile("s_waitcnt vmcnt(" #n ")" ::: "memory")
#define PG8_WAIT_L(n) asm volatile("s_waitcnt lgkmcnt(" #n ")" ::: "memory")
#define PG8_BAR __builtin_amdgcn_s_barrier()
#define PG8_SCHED __builtin_amdgcn_sched_barrier(0)
    Unit cur, nxt; int ui = 0;
    if (!S.next(0, cur)) return;
    f32x4 acc[2][2][4][2];
#pragma unroll
    for (int a = 0; a < 2; ++a)
#pragma unroll
        for (int b = 0; b < 2; ++b)
#pragma unroll
            for (int m = 0; m < 4; ++m)
#pragma unroll
                for (int n = 0; n < 2; ++n) acc[a][b][m][n] = (f32x4){0.f, 0.f, 0.f, 0.f};
    bf16x8 At[4][2], B0[2][2], B1[2][2];
    const char* cA = (const char*)g.A + (size_t)cur.pm * tstepA; const char* cB = (const char*)g.Bt + (size_t)cur.pn * tstepB;
    S.a_ready(cur);
    if constexpr (SP2) {
        PG8_STAGE(PG8_SB(0, 0), cB, voffB); PG8_STAGE(PG8_SB(0, 1), cB + hstepB, voffB); PG8_STAGE(PG8_SA(0, 0), cA, voffA); PG8_STAGE(PG8_SA(0, 1), cA + hstepA, voffA);
        if (wr == 1) PG8_BAR;
        PG8_WAIT_V(2); PG8_BAR;
        PG8_STAGE(PG8_SB(1, 0), cB + kstep, voffB); PG8_STAGE(PG8_SA(1, 0), cA + kstep, voffA); PG8_STAGE(PG8_SB(1, 1), cB + hstepB + kstep, voffB);
        PG8_WAIT_V(6); PG8_BAR;
    } else {
        PG8_STAGE(PG8_SB(0, 0), cB, voffB); PG8_STAGE(PG8_SA(0, 0), cA, voffA); PG8_STAGE(PG8_SB(0, 1), cB + hstepB, voffB); PG8_STAGE(PG8_SA(0, 1), cA + hstepA, voffA);
        if (wr == 1) PG8_BAR;
        PG8_WAIT_V(4); PG8_BAR;
        PG8_STAGE(PG8_SB(1, 0), cB + kstep, voffB); PG8_STAGE(PG8_SA(1, 0), cA + kstep, voffA); PG8_STAGE(PG8_SB(1, 1), cB + hstepB + kstep, voffB);
        PG8_WAIT_V(6); PG8_BAR;
    }
    for (;;) {
        const bool has_next = S.next(ui + 1, nxt);
        const char* nA = has_next ? (const char*)g.A + (size_t)nxt.pm * tstepA : cA; const char* nB = has_next ? (const char*)g.Bt + (size_t)nxt.pn * tstepB : cB;
        for (int t = 0; t < nt; t += 2) {
            const bool last = (t == nt - 2);
            const char* a1 = cA + (size_t)(t + 1) * kstep;
            const char* a2 = last ? nA : cA + (size_t)(t + 2) * kstep; const char* b2 = last ? nB : cB + (size_t)(t + 2) * kstep;
            const char* a3 = a2 + kstep; const char* b3 = b2 + kstep;
            if (last && has_next) S.a_ready(nxt);
            if constexpr (SP2) {
            PG8_LDB(B0, 0, 0); PG8_LDB(B1, 0, 1); PG8_SCHED; PG8_LDA(At, 0, 0); PG8_STAGE(PG8_SA(1, 1), a1 + hstepA, voffA);
            PG8_WAIT_V(8); PG8_WAIT_L(0); PG8_BAR; PG8_MMA(0, 0, At, B0); PG8_MMA(0, 1, At, B1); PG8_BAR; PG8_SCHED;
            PG8_LDA(At, 0, 1); PG8_STAGE(PG8_SB(0, 0), b2, voffB); PG8_STAGE(PG8_SB(0, 1), b2 + hstepB, voffB); PG8_STAGE(PG8_SA(0, 0), a2, voffA);
            PG8_WAIT_V(8); PG8_WAIT_L(0); PG8_BAR; PG8_MMA(1, 0, At, B0); PG8_MMA(1, 1, At, B1); PG8_BAR; PG8_SCHED;
            PG8_LDB(B0, 1, 0); PG8_LDB(B1, 1, 1); PG8_SCHED; PG8_LDA(At, 1, 0); PG8_STAGE(PG8_SA(0, 1), a2 + hstepA, voffA);
            PG8_WAIT_V(8); PG8_WAIT_L(0); PG8_BAR; PG8_MMA(0, 0, At, B0); PG8_MMA(0, 1, At, B1); PG8_BAR; PG8_SCHED;
            PG8_LDA(At, 1, 1); PG8_STAGE(PG8_SB(1, 0), b3, voffB); PG8_STAGE(PG8_SB(1, 1), b3 + hstepB, voffB); PG8_STAGE(PG8_SA(1, 0), a3, voffA);
            PG8_WAIT_V(8); PG8_WAIT_L(0); PG8_BAR; PG8_MMA(1, 0, At, B0); PG8_MMA(1, 1, At, B1); PG8_BAR; PG8_SCHED;
            } else {
            PG8_LDB(B0, 0, 0); PG8_SCHED; PG8_LDA(At, 0, 0); PG8_STAGE(PG8_SA(1, 1), a1 + hstepA, voffA);
            PG8_WAIT_L(8); PG8_BAR; PG8_WAIT_L(0); PG8_MMA(0, 0, At, B0); PG8_BAR; PG8_SCHED;
            PG8_LDB(B1, 0, 1); PG8_STAGE(PG8_SB(0, 0), b2, voffB);
            PG8_BAR; PG8_WAIT_L(0); PG8_MMA(0, 1, At, B1); PG8_BAR;
            PG8_LDA(At, 0, 1); PG8_STAGE(PG8_SA(0, 0), a2, voffA);
            PG8_BAR; PG8_WAIT_L(0); PG8_MMA(1, 0, At, B0); PG8_BAR; PG8_SCHED;
            PG8_STAGE(PG8_SB(0, 1), b2 + hstepB, voffB);
            PG8_WAIT_V(6); PG8_BAR; PG8_MMA(1, 1, At, B1); PG8_BAR;
            PG8_LDB(B0, 1, 0); PG8_SCHED; PG8_LDA(At, 1, 0); PG8_STAGE(PG8_SA(0, 1), a2 + hstepA, voffA);
            PG8_WAIT_L(8); PG8_BAR; PG8_WAIT_L(0); PG8_MMA(0, 0, At, B0); PG8_BAR; PG8_SCHED;
            PG8_LDB(B1, 1, 1); PG8_STAGE(PG8_SB(1, 0), b3, voffB);
            PG8_BAR; PG8_WAIT_L(0); PG8_MMA(0, 1, At, B1); PG8_BAR;
            PG8_LDA(At, 1, 1); PG8_STAGE(PG8_SA(1, 0), a3, voffA);
            PG8_BAR; PG8_WAIT_L(0); PG8_MMA(1, 0, At, B0); PG8_BAR; PG8_SCHED;
            PG8_STAGE(PG8_SB(1, 1), b3 + hstepB, voffB);
            PG8_WAIT_V(6); PG8_BAR; PG8_MMA(1, 1, At, B1); PG8_BAR;
            }
        }
        if constexpr (ALIGN_EPI) { if (wr == 0) PG8_BAR; }
        if constexpr (!Epi::AFTER_DRAIN) { E(acc, cur, wr, wc, fr, fq); S.done(cur); }
        if (!has_next) break;
#pragma unroll
        for (int a = 0; a < 2; ++a)
#pragma unroll
            for (int b = 0; b < 2; ++b)
#pragma unroll
                for (int m = 0; m < 4; ++m)
#pragma unroll
                    for (int n = 0; n < 2; ++n) acc[a][b][m][n] = (f32x4){0.f, 0.f, 0.f, 0.f};
        cur = nxt; cA = nA; cB = nB; ++ui;
        if constexpr (ALIGN_EPI) { if (wr == 1) PG8_BAR; }
    }
    PG8_WAIT_V(0);
    if constexpr (!ALIGN_EPI) { if (wr == 0) PG8_BAR; }
    PG8_BAR;
    if constexpr (Epi::AFTER_DRAIN) { E.fused(acc, cur, wr, wc, fr, fq, lds, wid, lane); S.done(cur); }
#undef PG8_SA
#undef PG8_SB
#undef PG8_STAGE
#undef PG8_LDA
#undef PG8_LDB
#undef PG8_MMA
#undef PG8_WAIT_V
#undef PG8_WAIT_L
#undef PG8_BAR
#undef PG8_SCHED
}

__device__ __forceinline__ u32x4 pack8(const f32x4 v0, const f32x4 v1) { u32x4 w; w.x = pk2(v0[0], v0[1]); w.y = pk2(v0[2], v0[3]); w.z = pk2(v1[0], v1[1]); w.w = pk2(v1[2], v1[3]); return w; }
__device__ __forceinline__ float sq8(const f32x4 a, const f32x4 b) { return (a[0] * a[0] + a[1] * a[1]) + (a[2] * a[2] + a[3] * a[3]) + (b[0] * b[0] + b[1] * b[1]) + (b[2] * b[2] + b[3] * b[3]); }

struct EpiZ {
    static constexpr bool PERM = true, AFTER_DRAIN = false;
    bf16_t* Z; float* ssq_q; float* ssq_kv; bf16_t* KR; float* G; const float* cosT; const float* sinT;
    __device__ __forceinline__ void operator()(const f32x4 (&acc)[2][2][4][2], const Unit& u, int wr, int wc, int fr, int fq) const {
#pragma unroll
        for (int ai = 0; ai < 2; ++ai) {
            f32x4 cs[4][4];
            if (u.pn == 1 && wc == 0) {
#pragma unroll
                for (int m = 0; m < 4; ++m) { const size_t ro = (size_t)(u.pm * 256 + ai * 128 + wr * 64 + m * 16 + fr) * 16 + 8 * (fq & 1);
                    cs[m][0] = *(const f32x4*)(cosT + ro); cs[m][1] = *(const f32x4*)(cosT + ro + 4); cs[m][2] = *(const f32x4*)(sinT + ro); cs[m][3] = *(const f32x4*)(sinT + ro + 4); } }
#pragma unroll
            for (int m = 0; m < 4; ++m) {
                const int row = u.pm * 256 + ai * 128 + wr * 64 + m * 16 + fr;
                bf16_t* zp = Z + (size_t)row * LDZ + u.pn * 256 + wc * 32 + 8 * fq;
#pragma unroll
                for (int bj = 0; bj < 2; ++bj) *(u32x4*)(zp + bj * 128) = pack8(acc[ai][bj][m][0], acc[ai][bj][m][1]);
                if (u.pn == 0) {
                    float s = sq8(acc[ai][0][m][0], acc[ai][0][m][1]) + sq8(acc[ai][1][m][0], acc[ai][1][m][1]);
                    s += __shfl_xor(s, 16); s += __shfl_xor(s, 32);
                    if (fq == 0) atomicAdd(ssq_q + row, s);
                } else if (u.pn == 1) {
                    float s = sq8(acc[ai][0][m][0], acc[ai][0][m][1]);
                    s += __shfl_xor(s, 16); s += __shfl_xor(s, 32);
                    if (fq == 0) atomicAdd(ssq_kv + row, s);
                    if (wc == 0) {
                        const f32x4 o0 = acc[ai][1][m][0], o1 = acc[ai][1][m][1];
                        f32x4 p0, p1;
#pragma unroll
                        for (int j = 0; j < 4; ++j) { p0[j] = __shfl_xor(o0[j], 32); p1[j] = __shfl_xor(o1[j], 32); }
                        const f32x4 c0 = cs[m][0], c1 = cs[m][1], s0 = cs[m][2], s1 = cs[m][3];
                        f32x4 r0, r1;
                        if (fq < 2) { r0 = o0 * c0 - p0 * s0; r1 = o1 * c1 - p1 * s1; }
                        else        { r0 = o0 * c0 + p0 * s0; r1 = o1 * c1 + p1 * s1; }
                        *(u32x4*)(KR + (size_t)row * 32 + 8 * fq) = pack8(r0, r1);
                    } else if (wc == 1 && fq < 2) {
                        *(f32x4*)(G + (size_t)row * 16 + 8 * fq) = acc[ai][1][m][0];
                        *(f32x4*)(G + (size_t)row * 16 + 8 * fq + 4) = acc[ai][1][m][1];
                    }
                }
            }
        }
    }
};
struct EpiScaleBf16 {
    static constexpr bool PERM = true, AFTER_DRAIN = false;
    bf16_t* O; int ldo; const float* ssq; float inv_n; float c;
    __device__ __forceinline__ void operator()(const f32x4 (&acc)[2][2][4][2], const Unit& u, int wr, int wc, int fr, int fq) const {
        float sc[2][4];
#pragma unroll
        for (int ai = 0; ai < 2; ++ai)
#pragma unroll
            for (int m = 0; m < 4; ++m) sc[ai][m] = ssq ? ssq[u.pm * 256 + ai * 128 + wr * 64 + m * 16 + fr] : 0.f;
#pragma unroll
        for (int ai = 0; ai < 2; ++ai)
#pragma unroll
            for (int m = 0; m < 4; ++m) {
                const int row = u.pm * 256 + ai * 128 + wr * 64 + m * 16 + fr;
                const float sv = ssq ? c * rsqrtf(sc[ai][m] * inv_n + EPS) : c;
                bf16_t* op = O + (size_t)row * ldo + u.pn * 256 + wc * 32 + 8 * fq;
#pragma unroll
                for (int bj = 0; bj < 2; ++bj) *(u32x4*)(op + bj * 128) = pack8(acc[ai][bj][m][0] * sv, acc[ai][bj][m][1] * sv);
            }
    }
};
struct EpiResid {
    static constexpr bool PERM = true, AFTER_DRAIN = false;
    const float* resf; const bf16_t* resb; bf16_t* XB; float* ssq;
    __device__ __forceinline__ void operator()(const f32x4 (&acc)[2][2][4][2], const Unit& u, int wr, int wc, int fr, int fq) const {
#pragma unroll
        for (int ai = 0; ai < 2; ++ai) {
            f32x4 r0[4][2], r1[4][2];
            if (resf) {
#pragma unroll
                for (int m = 0; m < 4; ++m)
#pragma unroll
                    for (int bj = 0; bj < 2; ++bj) { const size_t off = (size_t)(u.pm * 256 + ai * 128 + wr * 64 + m * 16 + fr) * DM + u.pn * 256 + wc * 32 + 8 * fq + bj * 128;
                        r0[m][bj] = *(const f32x4*)(resf + off); r1[m][bj] = *(const f32x4*)(resf + off + 4); }
            } else {
                u32x4 rb[4][2];
#pragma unroll
                for (int m = 0; m < 4; ++m)
#pragma unroll
                    for (int bj = 0; bj < 2; ++bj) rb[m][bj] = *(const u32x4*)(resb + (size_t)(u.pm * 256 + ai * 128 + wr * 64 + m * 16 + fr) * DM + u.pn * 256 + wc * 32 + 8 * fq + bj * 128);
#pragma unroll
                for (int m = 0; m < 4; ++m)
#pragma unroll
                    for (int bj = 0; bj < 2; ++bj) { const u32x4 q = rb[m][bj];
                        r0[m][bj] = (f32x4){__uint_as_float(q.x << 16), __uint_as_float(q.x & 0xffff0000u), __uint_as_float(q.y << 16), __uint_as_float(q.y & 0xffff0000u)};
                        r1[m][bj] = (f32x4){__uint_as_float(q.z << 16), __uint_as_float(q.z & 0xffff0000u), __uint_as_float(q.w << 16), __uint_as_float(q.w & 0xffff0000u)}; }
            }
#pragma unroll
            for (int m = 0; m < 4; ++m) {
                const int row = u.pm * 256 + ai * 128 + wr * 64 + m * 16 + fr;
                const size_t off = (size_t)row * DM + u.pn * 256 + wc * 32 + 8 * fq;
                float sq = 0.f;
#pragma unroll
                for (int bj = 0; bj < 2; ++bj) {
                    const f32x4 v0 = r0[m][bj] + acc[ai][bj][m][0], v1 = r1[m][bj] + acc[ai][bj][m][1];
                    *(u32x4*)(XB + off + bj * 128) = pack8(v0, v1);
                    sq += sq8(v0, v1);
                }
                sq += __shfl_xor(sq, 16); sq += __shfl_xor(sq, 32);
                if (fq == 0) atomicAdd(ssq + row, sq);
            }
        }
    }
};
struct EpiSwiglu {
    static constexpr bool PERM = true, AFTER_DRAIN = false;
    bf16_t* H; const float* ssq;
    __device__ __forceinline__ void operator()(const f32x4 (&acc)[2][2][4][2], const Unit& u, int wr, int wc, int fr, int fq) const {
        float scv[2][4];
#pragma unroll
        for (int ai = 0; ai < 2; ++ai)
#pragma unroll
            for (int m = 0; m < 4; ++m) scv[ai][m] = ssq[u.pm * 256 + ai * 128 + wr * 64 + m * 16 + fr];
#pragma unroll
        for (int ai = 0; ai < 2; ++ai)
#pragma unroll
            for (int m = 0; m < 4; ++m) {
                const int row = u.pm * 256 + ai * 128 + wr * 64 + m * 16 + fr;
                const float sc = rsqrtf(scv[ai][m] * (1.0f / DM) + EPS);
                f32x4 h[2];
#pragma unroll
                for (int n = 0; n < 2; ++n)
#pragma unroll
                    for (int j = 0; j < 4; ++j) { const float gg = acc[ai][0][m][n][j] * sc, uu = acc[ai][1][m][n][j] * sc;
                        h[n][j] = gg * uu * __builtin_amdgcn_rcpf(1.0f + __builtin_amdgcn_exp2f(-1.4426950408889634f * gg)); }
                *(u32x4*)(H + (size_t)row * DFF + u.pn * 128 + wc * 32 + 8 * fq) = pack8(h[0], h[1]);
            }
    }
};

#ifndef FAST_GEMM
#define FAST_GEMM 1
#endif
template <class Epi>
__device__ __forceinline__ void run_gemm(LAS unsigned char* lds, const Gemm g, const Epi& E, int c) {
#if FAST_GEMM
    StaticOrder S; S.init(g.M, g.N, (int)gridDim.x, c);
    gemm_phase<Epi, StaticOrder, true, true>(lds, g, S, E);
#else
    gemm_naive(g, E);
#endif
}

struct MapIdent { __device__ __forceinline__ int operator()(int n) const { return n; } };
struct MapWin { __device__ __forceinline__ int operator()(int n) const {
    if (n < 416) return n; if (n < 1440) return ZC_QK + (n - 416); if (n < 1952) return ZC_V + (n - 1440); if (n < 2464) return ZC_O + (n - 1952); return ZC_G + (n - 2464); } };
struct MapGU { __device__ __forceinline__ int operator()(int n) const { const int up = n >= DFF, j = up ? n - DFF : n; return (j >> 7) * 256 + up * 128 + (j & 127); } };

template <class Map>
__device__ __forceinline__ void transpose_w(const float* W, int K, int N, const float* gain, bf16_t* WT, int ldt, Map map, LAS float* scr, int gw, int ngw, int lane) {
    const int nblk = (N + 31) / 32, nitems = (K / 64) * nblk;
    for (int it = gw; it < nitems; it += ngw) {
        const int kb = it / nblk, nb = it % nblk, k0 = 64 * kb, n0 = 32 * nb;
        { const int nn = n0 + (lane & 31); const bool ok = nn < N; const float* wp = W + (size_t)(k0 + (lane >> 5)) * N + (ok ? nn : 0);
          float v[32];
#pragma unroll
          for (int i = 0; i < 32; ++i) v[i] = wp[(size_t)(2 * i) * N];
          if (gain) {
#pragma unroll
              for (int i = 0; i < 32; ++i) v[i] *= gain[k0 + 2 * i + (lane >> 5)]; }
#pragma unroll
          for (int i = 0; i < 32; ++i) scr[(2 * i + (lane >> 5)) * 33 + (lane & 31)] = ok ? v[i] : 0.f; }
        asm volatile("s_waitcnt lgkmcnt(0)" ::: "memory");
        const int c = lane & 7;
#pragma unroll
        for (int j = 0; j < 4; ++j) { const int n = (lane >> 3) + 8 * j, nn = n0 + n;
            if (nn < N) { const LAS float* s = scr + (8 * c) * 33 + n;
                u32x4 o; o.x = pk2(s[0 * 33], s[1 * 33]); o.y = pk2(s[2 * 33], s[3 * 33]); o.z = pk2(s[4 * 33], s[5 * 33]); o.w = pk2(s[6 * 33], s[7 * 33]);
                *(u32x4*)(WT + (size_t)map(nn) * ldt + k0 + 8 * c) = o; } }
        asm volatile("s_waitcnt lgkmcnt(0)" ::: "memory");
    }
}
__device__ __forceinline__ void rms_row_bf16(const float* xrow, const float* gain, bf16_t* orow, int lane) {
    const f32x4* xr = (const f32x4*)xrow + lane; const f32x4* gr = (const f32x4*)gain + lane;
    f32x4 v[4]; float s = 0.f;
#pragma unroll
    for (int j = 0; j < 4; ++j) { v[j] = xr[64 * j]; s += (v[j][0] * v[j][0] + v[j][1] * v[j][1]) + (v[j][2] * v[j][2] + v[j][3] * v[j][3]); }
    const float r = rsqrtf(wave_sum(s) * (1.0f / DM) + EPS);
    u32x2* o8 = (u32x2*)orow + lane;
#pragma unroll
    for (int j = 0; j < 4; ++j) { const f32x4 gg = gr[64 * j]; u32x2 w; w.x = pk2(v[j][0] * r * gg[0], v[j][1] * r * gg[1]); w.y = pk2(v[j][2] * r * gg[2], v[j][3] * r * gg[3]); o8[64 * j] = w; }
}

__device__ __forceinline__ void phase0(const Params& p, LAS unsigned char* lds) {
    const int tid = threadIdx.x, wid = tid >> 6, lane = tid & 63;
    const int gw = blockIdx.x * NWAVES + wid, ngw = gridDim.x * NWAVES;
    const int gt = blockIdx.x * NTHR + tid, ngt = gridDim.x * NTHR;
    LAS float* scr = (LAS float*)(lds + wid * 16384);
    unsigned char* ws = p.ws;
    transpose_w(p.w_in, DM, INW, nullptr, (bf16_t*)(ws + WS_WIN), DM, MapWin(), scr, gw, ngw, lane);
    transpose_w(p.w_uq, QLORA, MLA_H * DQK, p.q_norm, (bf16_t*)(ws + WS_WUQ), QLORA, MapIdent(), scr, gw, ngw, lane);
    transpose_w(p.w_ukv, KVLORA, MLA_H * (NOPE + VD), p.kv_norm, (bf16_t*)(ws + WS_WUKV), 256, MapIdent(), scr, gw, ngw, lane);
    transpose_w(p.w_out, DM, DM, nullptr, (bf16_t*)(ws + WS_WOUT), DM, MapIdent(), scr, gw, ngw, lane);
    transpose_w(p.w_xq, DM, DM, p.xattn_norm, (bf16_t*)(ws + WS_WXQ), DM, MapIdent(), scr, gw, ngw, lane);
    transpose_w(p.w_xkv, DM, 2 * DM, nullptr, (bf16_t*)(ws + WS_WXKV), DM, MapIdent(), scr, gw, ngw, lane);
    transpose_w(p.w_xo, DM, DM, nullptr, (bf16_t*)(ws + WS_WXO), DM, MapIdent(), scr, gw, ngw, lane);
    transpose_w(p.w_gu, DM, 2 * DFF, p.ffn_norm, (bf16_t*)(ws + WS_WGU), DM, MapGU(), scr, gw, ngw, lane);
    transpose_w(p.w_down, DFF, DM, nullptr, (bf16_t*)(ws + WS_WD), DFF, MapIdent(), scr, gw, ngw, lane);
    { bf16_t* wz = (bf16_t*)(ws + WS_WIN) + (size_t)432 * DM; for (int i = gt; i < 80 * DM / 8; i += ngt) ((u32x4*)wz)[i] = (u32x4){0u, 0u, 0u, 0u};
      bf16_t* wk = (bf16_t*)(ws + WS_WUKV); for (int i = gt; i < 1024 * 16; i += ngt) { const int r = i >> 4, c = i & 15; *(u32x4*)(wk + (size_t)r * 256 + 128 + 8 * c) = (u32x4){0u, 0u, 0u, 0u}; } }
    { float* sm = (float*)(ws + WS_SMALL);
      for (int i = gt; i < SM_END; i += ngt) { float v = 0.f;
          if (i < SM_GBIAS) v = p.conv[i]; else if (i < SM_GBIAS + 16) v = p.gbias[i - SM_GBIAS]; else if (i >= SM_MLN && i < SM_MLN + 512) v = p.ml_norm[i - SM_MLN]; else if (i >= SM_FIN) v = p.final_norm[i - SM_FIN];
          sm[i] = v; } }
    { float* ssq = (float*)(ws + WS_SSQ); for (int i = gt; i < 5 * T; i += ngt) ssq[i] = 0.f; }
    { float* ct = (float*)(ws + WS_COS); float* st = (float*)(ws + WS_SIN);
      for (int i = gt; i < T * 16; i += ngt) { const int row = i >> 4, j = i & 15;
          float inv = 1.0f;
          switch (j) { case 1: inv = 0.5623413251903491f; break; case 2: inv = 0.31622776601683794f; break; case 3: inv = 0.1778279410038923f; break; case 4: inv = 0.1f; break;
                       case 5: inv = 0.05623413251903491f; break; case 6: inv = 0.03162277660168379f; break; case 7: inv = 0.01778279410038923f; break; case 8: inv = 0.01f; break;
                       case 9: inv = 0.005623413251903491f; break; case 10: inv = 0.003162277660168379f; break; case 11: inv = 0.001778279410038923f; break; case 12: inv = 0.001f; break;
                       case 13: inv = 0.0005623413251903491f; break; case 14: inv = 0.00031622776601683794f; break; case 15: inv = 0.0001778279410038923f; break; default: break; }
          const float ang = (float)p.pos[row] * inv; float sn, cs; sincosf(ang, &sn, &cs); ct[i] = cs; st[i] = sn; } }
    for (int r4 = gw * 4; r4 < T; r4 += ngw * 4) {
        f32x4 v[4][4]; float sq[4];
#pragma unroll
        for (int q = 0; q < 4; ++q) { const f32x4* xr = (const f32x4*)(p.x + (size_t)(r4 + q) * DM) + lane;
#pragma unroll
            for (int j = 0; j < 4; ++j) v[q][j] = xr[64 * j]; }
#pragma unroll
        for (int q = 0; q < 4; ++q) { float s_ = 0.f;
#pragma unroll
            for (int j = 0; j < 4; ++j) s_ += (v[q][j][0] * v[q][j][0] + v[q][j][1] * v[q][j][1]) + (v[q][j][2] * v[q][j][2] + v[q][j][3] * v[q][j][3]);
            sq[q] = s_; }
#pragma unroll
        for (int o = 1; o < 64; o <<= 1) {
#pragma unroll
            for (int q = 0; q < 4; ++q) sq[q] += __shfl_xor(sq[q], o); }
        const f32x4* gr = (const f32x4*)p.attn_norm + lane;
#pragma unroll
        for (int q = 0; q < 4; ++q) { const float r_ = rsqrtf(sq[q] * (1.0f / DM) + EPS); u32x2* o8 = (u32x2*)((bf16_t*)(ws + WS_XB) + (size_t)(r4 + q) * DM) + lane;
#pragma unroll
            for (int j = 0; j < 4; ++j) { const f32x4 gg = gr[64 * j]; u32x2 w; w.x = pk2(v[q][j][0] * r_ * gg[0], v[q][j][1] * r_ * gg[1]); w.y = pk2(v[q][j][2] * r_ * gg[2], v[q][j][3] * r_ * gg[3]); o8[64 * j] = w; } }
    }
    for (int r = gw; r < TM; r += ngw) rms_row_bf16(p.mem + (size_t)r * DM, p.mem_norm, (bf16_t*)(ws + WS_MEMN) + (size_t)r * DM, lane);
}

__device__ __forceinline__ void phase_conv(const Params& p) {
    const bf16_t* Z = (const bf16_t*)(p.ws + WS_Z); bf16_t* Q = (bf16_t*)(p.ws + WS_XB); const float* conv = (const float*)(p.ws + WS_SMALL) + SM_CONV;
    const int gt = blockIdx.x * NTHR + threadIdx.x, ngt = gridDim.x * NTHR;
    for (int i = gt; i < T * 128; i += ngt) {
        const int row = i >> 7, c0 = (i & 127) * 8, t = row & (SEQ - 1);
        const bf16x8 zc = *(const bf16x8*)(Z + (size_t)row * LDZ + ZC_QK + c0);
        bf16x8 zp = (bf16x8){0, 0, 0, 0, 0, 0, 0, 0}, zn = zp;
        if (t > 0) zp = *(const bf16x8*)(Z + (size_t)(row - 1) * LDZ + ZC_QK + c0);
        if (t < SEQ - 1) zn = *(const bf16x8*)(Z + (size_t)(row + 1) * LDZ + ZC_QK + c0);
        const float sc = c0 >= 512 ? 0.08838834764831845f : 1.0f;
        float o[8];
#pragma unroll
        for (int j = 0; j < 8; ++j) { const float a = conv[c0 + j] * bf2f((bf16_t)zp[j]) + conv[1024 + c0 + j] * bf2f((bf16_t)zc[j]) + conv[2048 + c0 + j] * bf2f((bf16_t)zn[j]);
            o[j] = a / (1.0f + __expf(-a)) * sc; }
        u32x4 w; w.x = pk2(o[0], o[1]); w.y = pk2(o[2], o[3]); w.z = pk2(o[4], o[5]); w.w = pk2(o[6], o[7]);
        *(u32x4*)(Q + (size_t)row * 1024 + c0) = w;
    }
}

__device__ __forceinline__ void mlstm_naive(const Params& p) {
    const bf16_t* Z = (const bf16_t*)(p.ws + WS_Z); const bf16_t* QKC = (const bf16_t*)(p.ws + WS_XB); const float* G = (const float*)(p.ws + WS_G); const float* gbias = (const float*)(p.ws + WS_SMALL) + SM_GBIAS;
    float* HF = p.out; float* HB = p.out + (size_t)T * ML_W;
    const int tid = threadIdx.x, d = tid >> 2, eq = tid & 3;
    for (int unit = blockIdx.x; unit < BATCH * ML_H * 2; unit += gridDim.x) {
        const int dir = unit & 1, h = (unit >> 1) & 3, b = unit >> 3;
        float C[32], n[32]; float m = 0.f;
#pragma unroll
        for (int j = 0; j < 32; ++j) { C[j] = 0.f; n[j] = 0.f; }
        const float bi = gbias[dir * 8 + h], bff = gbias[dir * 8 + 4 + h];
        float* Hout = dir ? HB : HF;
        for (int s = 0; s < SEQ; ++s) {
            const int t = dir ? SEQ - 1 - s : s; const size_t row = (size_t)b * SEQ + t;
            const float ip = G[row * 16 + dir * 8 + h] + bi, fp = G[row * 16 + dir * 8 + 4 + h] + bff;
            const float logf = fminf(fp, 0.f) - log1pf(__expf(-fabsf(fp)));
            const float mn = fmaxf(logf + m, ip), fe = __expf(logf + m - mn), ie = __expf(ip - mn);
            m = mn;
            const float vv = bf2f(Z[row * LDZ + ZC_V + h * 128 + d]) * ie;
            float pn = 0.f, pd = 0.f;
#pragma unroll
            for (int c = 0; c < 4; ++c) {
                const bf16x8 q8 = *(const bf16x8*)(QKC + row * 1024 + h * 128 + eq * 32 + c * 8);
                const bf16x8 k8 = *(const bf16x8*)(QKC + row * 1024 + 512 + h * 128 + eq * 32 + c * 8);
#pragma unroll
                for (int j = 0; j < 8; ++j) { const float qq = bf2f((bf16_t)q8[j]), kk = bf2f((bf16_t)k8[j]);
                    C[c * 8 + j] = fe * C[c * 8 + j] + vv * kk; n[c * 8 + j] = fe * n[c * 8 + j] + ie * kk;
                    pn += C[c * 8 + j] * qq; pd += n[c * 8 + j] * qq; }
            }
            pn += __shfl_xor(pn, 1); pn += __shfl_xor(pn, 2); pd += __shfl_xor(pd, 1); pd += __shfl_xor(pd, 2);
            if (eq == 0) Hout[row * ML_W + h * 128 + d] = pn / fmaxf(fabsf(pd), __expf(-mn));
        }
    }
}
__device__ __forceinline__ void phase_mlfin(const Params& p) {
    const bf16_t* Z = (const bf16_t*)(p.ws + WS_Z); bf16_t* Y = (bf16_t*)(p.ws + WS_Y);
    const float* HF = p.out; const float* HB = p.out + (size_t)T * ML_W;
    const int wid = threadIdx.x >> 6, lane = threadIdx.x & 63;
    for (int row = blockIdx.x * NWAVES + wid; row < T; row += gridDim.x * NWAVES) {
        const size_t o = (size_t)row * ML_W + lane * 8;
        const f32x4 a0 = *(const f32x4*)(HF + o) + *(const f32x4*)(HB + o), a1 = *(const f32x4*)(HF + o + 4) + *(const f32x4*)(HB + o + 4);
        float s = sq8(a0, a1);
        s += __shfl_xor(s, 1); s += __shfl_xor(s, 2); s += __shfl_xor(s, 4); s += __shfl_xor(s, 8);
        const float r = rsqrtf(s * (1.0f / ML_D) + EPS);
        const bf16x8 zo = *(const bf16x8*)(Z + (size_t)row * LDZ + ZC_O + lane * 8);
        const float* mln = (const float*)(p.ws + WS_SMALL) + SM_MLN; const f32x4 g0 = *(const f32x4*)(mln + lane * 8), g1 = *(const f32x4*)(mln + lane * 8 + 4);
        float ov[8];
#pragma unroll
        for (int j = 0; j < 8; ++j) { const float hv = (j < 4 ? a0[j] : a1[j - 4]) * r * (j < 4 ? g0[j] : g1[j - 4]); const float z = bf2f((bf16_t)zo[j]); ov[j] = hv / (1.0f + __expf(-z)); }
        u32x4 w; w.x = pk2(ov[0], ov[1]); w.y = pk2(ov[2], ov[3]); w.z = pk2(ov[4], ov[5]); w.w = pk2(ov[6], ov[7]);
        *(u32x4*)(Y + (size_t)row * DM + 512 + lane * 8) = w;
    }
}

__device__ __forceinline__ void mla_attn_naive(const Params& p, LAS unsigned char* lds) {
    const bf16_t* QALL = (const bf16_t*)(p.ws + WS_QALL); const bf16_t* KV = (const bf16_t*)(p.ws + WS_KV); const bf16_t* KR = (const bf16_t*)(p.ws + WS_KR);
    const float* cosT = (const float*)(p.ws + WS_COS); const float* sinT = (const float*)(p.ws + WS_SIN); bf16_t* Y = (bf16_t*)(p.ws + WS_Y);
    const int wid = threadIdx.x >> 6, lane = threadIdx.x & 63;
    LAS float* sc = (LAS float*)(lds + wid * 16384);
    LAS float* qs = (LAS float*)(lds + 131072 + wid * 512);
    const float scale = 0.10206207261596575f;
    for (int item = blockIdx.x * NWAVES + wid; item < T * MLA_H; item += gridDim.x * NWAVES) {
        const int h = item & 7, row = item >> 3, b = row / SEQ;
        for (int dd = lane; dd < DQK; dd += 64) {
            float v = bf2f(QALL[(size_t)row * 768 + h * DQK + dd]);
            if (dd >= NOPE) { const int j = (dd - NOPE) & 15; const float c = cosT[(size_t)row * 16 + j], s = sinT[(size_t)row * 16 + j];
                const float other = bf2f(QALL[(size_t)row * 768 + h * DQK + (dd < NOPE + 16 ? dd + 16 : dd - 16)]);
                v = dd < NOPE + 16 ? v * c - other * s : v * c + other * s; }
            qs[dd] = v * scale;
        }
        asm volatile("s_waitcnt lgkmcnt(0)" ::: "memory");
        float mx = -1e30f;
        for (int k0 = 0; k0 < SEQ; k0 += 64) {
            const size_t kr = (size_t)b * SEQ + k0 + lane; float s = 0.f;
#pragma unroll
            for (int c = 0; c < 8; ++c) { const bf16x8 k8 = *(const bf16x8*)(KV + kr * 1024 + h * 128 + c * 8);
#pragma unroll
                for (int j = 0; j < 8; ++j) s += qs[c * 8 + j] * bf2f((bf16_t)k8[j]); }
#pragma unroll
            for (int c = 0; c < 4; ++c) { const bf16x8 k8 = *(const bf16x8*)(KR + kr * 32 + c * 8);
#pragma unroll
                for (int j = 0; j < 8; ++j) s += qs[NOPE + c * 8 + j] * bf2f((bf16_t)k8[j]); }
            sc[k0 + lane] = s; mx = fmaxf(mx, s);
        }
        mx = wave_max(mx);
        float l = 0.f;
        for (int k0 = 0; k0 < SEQ; k0 += 64) { const float e = __expf(sc[k0 + lane] - mx); sc[k0 + lane] = e; l += e; }
        l = wave_sum(l);
        asm volatile("s_waitcnt lgkmcnt(0)" ::: "memory");
        float o = 0.f;
        for (int k = 0; k < SEQ; ++k) o += sc[k] * bf2f(KV[((size_t)b * SEQ + k) * 1024 + h * 128 + 64 + lane]);
        Y[(size_t)row * DM + h * VD + lane] = (bf16_t)f2bf(o / l);
        asm volatile("s_waitcnt lgkmcnt(0)" ::: "memory");
    }
}
__device__ __forceinline__ void x_attn_naive(const Params& p, LAS unsigned char* lds) {
    const bf16_t* HQ = (const bf16_t*)(p.ws + WS_HQ); const bf16_t* KVM = (const bf16_t*)(p.ws + WS_KVM); bf16_t* OX = (bf16_t*)(p.ws + WS_OX);
    const int wid = threadIdx.x >> 6, lane = threadIdx.x & 63;
    LAS float* sc = (LAS float*)(lds + wid * 16384);
    LAS float* qs = (LAS float*)(lds + 131072 + wid * 1024);
    for (int item = blockIdx.x * NWAVES + wid; item < T * XH; item += gridDim.x * NWAVES) {
        const int h = item & 3, row = item >> 2, b = row / SEQ;
        for (int dd = lane; dd < XD; dd += 64) qs[dd] = bf2f(HQ[(size_t)row * DM + h * XD + dd]) * 0.0625f;
        asm volatile("s_waitcnt lgkmcnt(0)" ::: "memory");
        float mx = -1e30f;
        for (int k0 = 0; k0 < NMEM; k0 += 64) {
            const size_t kr = (size_t)b * NMEM + k0 + lane; float s = 0.f;
            for (int c = 0; c < 32; ++c) { const bf16x8 k8 = *(const bf16x8*)(KVM + kr * 2048 + h * XD + c * 8);
#pragma unroll
                for (int j = 0; j < 8; ++j) s += qs[c * 8 + j] * bf2f((bf16_t)k8[j]); }
            sc[k0 + lane] = s; mx = fmaxf(mx, s);
        }
        mx = wave_max(mx);
        float l = 0.f;
        for (int k0 = 0; k0 < NMEM; k0 += 64) { const float e = __expf(sc[k0 + lane] - mx); sc[k0 + lane] = e; l += e; }
        l = wave_sum(l);
        asm volatile("s_waitcnt lgkmcnt(0)" ::: "memory");
        float o[4] = {0.f, 0.f, 0.f, 0.f};
        for (int k = 0; k < NMEM; ++k) { const u32x2 v4 = *(const u32x2*)(KVM + ((size_t)b * NMEM + k) * 2048 + 1024 + h * XD + 4 * lane); const float pk = sc[k];
            o[0] += pk * __uint_as_float(v4.x << 16); o[1] += pk * __uint_as_float(v4.x & 0xffff0000u); o[2] += pk * __uint_as_float(v4.y << 16); o[3] += pk * __uint_as_float(v4.y & 0xffff0000u); }
        const float rl = 1.0f / l; u32x2 w; w.x = pk2(o[0] * rl, o[1] * rl); w.y = pk2(o[2] * rl, o[3] * rl);
        *(u32x2*)(OX + (size_t)row * DM + h * XD + 4 * lane) = w;
        asm volatile("s_waitcnt lgkmcnt(0)" ::: "memory");
    }
}

namespace fa {
using f32x16 = __attribute__((ext_vector_type(16))) float;
using s16x4  = __attribute__((ext_vector_type(4))) short;
typedef float f32x2_t __attribute__((ext_vector_type(2))); typedef __bf16 bf16x2_t __attribute__((ext_vector_type(2)));
#define FA_SBAR() __builtin_amdgcn_sched_barrier(0)
constexpr float THRL = 11.0f;
__device__ __forceinline__ int crow(int r, int hi) { return (r & 3) + 8 * (r >> 2) + 4 * hi; }
__device__ __forceinline__ unsigned cvtpk(float lo, float hi) { unsigned r; asm volatile("v_cvt_pk_bf16_f32 %0, %1, %2" : "=v"(r) : "v"(lo), "v"(hi)); return r; }
__device__ __forceinline__ unsigned cvtpk_s(float lo, float hi) { f32x2_t v = {lo, hi}; bf16x2_t b = __builtin_convertvector(v, bf16x2_t); return __builtin_bit_cast(unsigned, b); }
#define FA_MX3(a, b, c) __builtin_fmaxf(__builtin_fmaxf((a), (b)), (c))
__device__ __forceinline__ float rowmax32(const f32x16& p0, const f32x16& p1) {
    float a = FA_MX3(p0[0], p0[1], p1[0]), b = FA_MX3(p0[2], p0[3], p1[1]); a = FA_MX3(a, p1[2], p1[3]);
#pragma unroll
    for (int r = 4; r < 16; r += 4) { a = FA_MX3(a, p0[r], p0[r + 1]); b = FA_MX3(b, p0[r + 2], p0[r + 3]); a = FA_MX3(a, p1[r], p1[r + 1]); b = FA_MX3(b, p1[r + 2], p1[r + 3]); }
    float rm = __builtin_fmaxf(a, b);
    auto rr = __builtin_amdgcn_permlane32_swap(__float_as_uint(rm), __float_as_uint(rm), false, false);
    return __builtin_fmaxf(__uint_as_float(rr[0]), __uint_as_float(rr[1]));
}
template <bool FIRST>
__device__ __forceinline__ void smA(f32x16& p0, f32x16& p1, float& mref, f32x16& negm, LAS float* fl, int r32, int hi, bool& resc, float& fself) {
    const float rm = rowmax32(p0, p1);
    resc = false; fself = 1.f;
    if (FIRST || __builtin_expect(__any(rm > THRL), 0)) {
        const float dl = FIRST ? rm : __builtin_fmaxf(rm, 0.f);
        mref += dl;
#pragma unroll
        for (int r = 0; r < 16; ++r) { p0[r] -= dl; p1[r] -= dl; }
#pragma unroll
        for (int r = 0; r < 16; ++r) negm[r] = -mref;
        if (!FIRST) { fself = __builtin_amdgcn_exp2f(-dl); if (hi == 0) fl[r32] = fself; resc = true; }
    }
#pragma unroll
    for (int r = 0; r < 16; ++r) p0[r] = __builtin_amdgcn_exp2f(p0[r]);
}
__device__ __forceinline__ void smB(const f32x16& p0, f32x16& p1, bf16x8& pa0, bf16x8& pa1, bf16x8& pa2, bf16x8& pa3) {
#pragma unroll
    for (int r = 0; r < 16; ++r) p1[r] = __builtin_amdgcn_exp2f(p1[r]);
#define FA_PKD(P, B, OUT) do { u32x4 w_ = {cvtpk_s(P[B], P[B + 1]), cvtpk_s(P[B + 2], P[B + 3]), cvtpk_s(P[B + 4], P[B + 5]), cvtpk_s(P[B + 6], P[B + 7])}; OUT = __builtin_bit_cast(bf16x8, w_); } while (0)
    FA_PKD(p0, 0, pa0); FA_PKD(p0, 8, pa1); FA_PKD(p1, 0, pa2); FA_PKD(p1, 8, pa3);
#undef FA_PKD
}
template <int NDQ, int KP>
__device__ __forceinline__ void qkt(f32x16& p0, f32x16& p1, const LAS unsigned char* Ks, const bf16x8* qr, const f32x16& negm, int r32, int hi) {
#pragma unroll
    for (int d0 = 0; d0 < NDQ; ++d0) { const int cb = (d0 * 16 + hi * 8) * 2;
        const bf16x8 b0 = *(const LAS bf16x8*)(Ks + r32 * KP + cb);
        const bf16x8 b1 = *(const LAS bf16x8*)(Ks + (32 + r32) * KP + cb);
        if (d0 == 0) { p0 = __builtin_amdgcn_mfma_f32_32x32x16_bf16(b0, qr[0], negm, 0, 0, 0); p1 = __builtin_amdgcn_mfma_f32_32x32x16_bf16(b1, qr[0], negm, 0, 0, 0); }
        else { p0 = __builtin_amdgcn_mfma_f32_32x32x16_bf16(b0, qr[d0], p0, 0, 0, 0); p1 = __builtin_amdgcn_mfma_f32_32x32x16_bf16(b1, qr[d0], p1, 0, 0, 0); } }
}
template <int NDV> __device__ __forceinline__ int v_st(int k, int c) { const int kk = (k & ~0xC) | ((k & 4) << 1) | ((k & 8) >> 1); return ((kk >> 3) * NDV + (c >> 5)) * 512 + ((kk & 7) * 32 + (c & 31)) * 2; }
template <int NDV> __device__ __forceinline__ int v_stp(int k, int c) { return ((k >> 3) * NDV + (c >> 5)) * 512 + ((k & 7) * 32 + (c & 31)) * 2; }
__device__ __forceinline__ int v_rd_base(int lane) { return ((lane & 3) << 3) | (((lane >> 2) & 3) << 6) | (((lane >> 4) & 1) << 5) | (((lane >> 5) & 1) << 8); }
template <int OFF> __device__ __forceinline__ s16x4 tr_read(int vb) { s16x4 r; asm volatile("ds_read_b64_tr_b16 %0, %1 offset:%2" : "=&v"(r) : "v"(vb), "i"(OFF) : "memory"); return r; }
template <int NDV, int D0> __device__ __forceinline__ void pv_one(f32x16& od, int vb, bf16x8 pa0, bf16x8 pa1, bf16x8 pa2, bf16x8 pa3) {
    constexpr int KS = 2 * NDV * 512, HF = NDV * 512, B0 = D0 * 512;
    const s16x4 l0 = tr_read<B0>(vb), h0 = tr_read<B0 + HF>(vb), l1 = tr_read<B0 + KS>(vb), h1 = tr_read<B0 + KS + HF>(vb);
    const s16x4 l2 = tr_read<B0 + 2 * KS>(vb), h2 = tr_read<B0 + 2 * KS + HF>(vb), l3 = tr_read<B0 + 3 * KS>(vb), h3 = tr_read<B0 + 3 * KS + HF>(vb);
    asm volatile("s_waitcnt lgkmcnt(0)" ::: "memory"); FA_SBAR();
#define FA_PK(L, H) (bf16x8){L[0], L[1], L[2], L[3], H[0], H[1], H[2], H[3]}
    od = __builtin_amdgcn_mfma_f32_32x32x16_bf16(pa0, FA_PK(l0, h0), od, 0, 0, 0);
    od = __builtin_amdgcn_mfma_f32_32x32x16_bf16(pa1, FA_PK(l1, h1), od, 0, 0, 0);
    od = __builtin_amdgcn_mfma_f32_32x32x16_bf16(pa2, FA_PK(l2, h2), od, 0, 0, 0);
    od = __builtin_amdgcn_mfma_f32_32x32x16_bf16(pa3, FA_PK(l3, h3), od, 0, 0, 0);
#undef FA_PK
}
__device__ __forceinline__ void pl_ones(f32x16& lacc, bf16x8 pa0, bf16x8 pa1, bf16x8 pa2, bf16x8 pa3) {
    const bf16x8 one = (bf16x8){0x3F80, 0x3F80, 0x3F80, 0x3F80, 0x3F80, 0x3F80, 0x3F80, 0x3F80};
    lacc = __builtin_amdgcn_mfma_f32_32x32x16_bf16(pa0, one, lacc, 0, 0, 0); lacc = __builtin_amdgcn_mfma_f32_32x32x16_bf16(pa1, one, lacc, 0, 0, 0);
    lacc = __builtin_amdgcn_mfma_f32_32x32x16_bf16(pa2, one, lacc, 0, 0, 0); lacc = __builtin_amdgcn_mfma_f32_32x32x16_bf16(pa3, one, lacc, 0, 0, 0);
}
__device__ __forceinline__ bf16x8 cvt8(const float* v) { u32x4 w = {cvtpk(v[0], v[1]), cvtpk(v[2], v[3]), cvtpk(v[4], v[5]), cvtpk(v[6], v[7])}; return *reinterpret_cast<bf16x8*>(&w); }

constexpr int MLA_KP = 208, MLA_SHM_K = 64 * MLA_KP, MLA_SHM_V = 64 * 64 * 2, MLA_WS = 2 * MLA_SHM_V + 2 * MLA_SHM_K;
__device__ __forceinline__ void mla_unit(int b, int h, int qb, const bf16_t* __restrict__ QALL, const bf16_t* __restrict__ KV, const bf16_t* __restrict__ KR,
                                         const float* __restrict__ cosT, const float* __restrict__ sinT, bf16_t* __restrict__ Y, LAS unsigned char* lds) {
    const int tid = threadIdx.x, wid = tid >> 6, lane = tid & 63, r32 = lane & 31, hi = lane >> 5;
    LAS unsigned char* V_lds = lds; LAS unsigned char* K_lds = lds + 2 * MLA_SHM_V;
    LAS float* fl = (LAS float*)(lds + MLA_WS) + wid * 32;
    float mref = 0.f; f32x16 o[2] = {}; f32x16 lacc = {}; f32x16 negm = {}; bf16x8 qr[6];
    const size_t rowb = (size_t)b * SEQ;
    {
        const size_t qrow = rowb + qb * 256 + wid * 32 + r32;
        const bf16_t* Qw = QALL + qrow * 768 + h * 96 + hi * 8;
        const float C = 0.10206207261596575f * 1.4426950408889634f;
        float x1[8], x2[8];
#pragma unroll
        for (int d0 = 0; d0 < 6; ++d0) { const bf16x8 raw = *(const bf16x8*)(Qw + d0 * 16); float v[8];
#pragma unroll
            for (int j = 0; j < 8; ++j) v[j] = bf2f((bf16_t)raw[j]);
            if (d0 < 4) {
#pragma unroll
                for (int j = 0; j < 8; ++j) v[j] *= C;
                qr[d0] = cvt8(v); }
            else if (d0 == 4) {
#pragma unroll
                for (int j = 0; j < 8; ++j) x1[j] = v[j]; }
            else {
#pragma unroll
                for (int j = 0; j < 8; ++j) x2[j] = v[j]; } }
        float o1[8], o2[8];
#pragma unroll
        for (int j = 0; j < 8; ++j) { const float c = cosT[qrow * 16 + hi * 8 + j], s = sinT[qrow * 16 + hi * 8 + j]; o1[j] = (x1[j] * c - x2[j] * s) * C; o2[j] = (x2[j] * c + x1[j] * s) * C; }
        qr[4] = cvt8(o1); qr[5] = cvt8(o2);
    }
    const int sr = tid >> 3, scn = tid & 7, rr = (tid & 255) >> 2, rc = tid & 3;
    const bf16_t* gkn = KV + (rowb + sr) * 1024 + h * 128 + scn * 8;
    const bf16_t* gv = gkn + 64;
    const bf16_t* gkr = KR + (rowb + rr) * 32 + rc * 8;
    const int okn = sr * MLA_KP + scn * 16, okr = rr * MLA_KP + 128 + rc * 16, ov = v_stp<2>(sr, scn * 8);
    const int vb0 = (int)(unsigned)(uintptr_t)V_lds + v_rd_base(lane);
    struct { bf16x8 kn, kr, v; } st_[2];
#define FA_SLOAD(i, k0) do { st_[i].v = *(const bf16x8*)(gv + (size_t)(k0) * 1024); st_[i].kn = *(const bf16x8*)(gkn + (size_t)(k0) * 1024); st_[i].kr = *(const bf16x8*)(gkr + (size_t)(k0) * 32); } while (0)
#define FA_SWRITE(bb, i) do { *(LAS bf16x8*)(V_lds + (bb) * MLA_SHM_V + ov) = st_[i].v; *(LAS bf16x8*)(K_lds + (bb) * MLA_SHM_K + okn) = st_[i].kn; *(LAS bf16x8*)(K_lds + (bb) * MLA_SHM_K + okr) = st_[i].kr; } while (0)
#define FA_SWAIT() asm volatile("s_waitcnt vmcnt(3)" ::: "memory")
#define FA_RESC(f) do { if (f) { asm volatile("s_waitcnt lgkmcnt(0)" ::: "memory"); \
    _Pragma("unroll") for (int r = 0; r < 16; ++r) { const float f_ = fl[crow(r, hi)]; o[0][r] *= f_; o[1][r] *= f_; lacc[r] *= f_; } } } while (0)
#define FA_PV(vbx) do { pv_one<2, 0>(o[0], (vbx), pa0, pa1, pa2, pa3); pv_one<2, 1>(o[1], (vbx), pa0, pa1, pa2, pa3); pl_ones(lacc, pa0, pa1, pa2, pa3); } while (0)
    f32x16 pA0, pA1, pB0, pB1; bool rsA, rsB; float fdum; bf16x8 pa0, pa1, pa2, pa3; constexpr int NT = SEQ / 64;
    FA_SLOAD(0, 0); asm volatile("s_waitcnt vmcnt(0)" ::: "memory"); FA_SWRITE(0, 0); __syncthreads();
    qkt<6, MLA_KP>(pA0, pA1, K_lds, qr, negm, r32, hi); smA<true>(pA0, pA1, mref, negm, fl, r32, hi, rsA, fdum);
    FA_SLOAD(1, 64); FA_SLOAD(0, 128);
    FA_SWAIT(); FA_SWRITE(1, 1); __syncthreads();
    for (int j = 1; j + 1 < NT; j += 2) {
        FA_SBAR(); qkt<6, MLA_KP>(pB0, pB1, K_lds + MLA_SHM_K, qr, negm, r32, hi);
        smB(pA0, pA1, pa0, pa1, pa2, pa3); FA_SBAR();
        FA_SLOAD(1, (j + 2) * 64); FA_SBAR();
        FA_PV(vb0); smA<false>(pB0, pB1, mref, negm, fl, r32, hi, rsB, fdum);
        __syncthreads(); FA_SWAIT(); FA_SWRITE(0, 0);
        FA_RESC(rsB); __syncthreads();
        FA_SBAR(); qkt<6, MLA_KP>(pA0, pA1, K_lds, qr, negm, r32, hi);
        smB(pB0, pB1, pa0, pa1, pa2, pa3); FA_SBAR();
        if (j + 3 < NT) FA_SLOAD(0, (j + 3) * 64); FA_SBAR();
        FA_PV(vb0 + MLA_SHM_V); smA<false>(pA0, pA1, mref, negm, fl, r32, hi, rsA, fdum);
        __syncthreads(); FA_SWAIT(); FA_SWRITE(1, 1);
        FA_RESC(rsA); __syncthreads();
    }
    FA_SBAR(); qkt<6, MLA_KP>(pB0, pB1, K_lds + MLA_SHM_K, qr, negm, r32, hi);
    smB(pA0, pA1, pa0, pa1, pa2, pa3); FA_SBAR();
    FA_PV(vb0); smA<false>(pB0, pB1, mref, negm, fl, r32, hi, rsB, fdum);
    __syncthreads(); FA_RESC(rsB);
    smB(pB0, pB1, pa0, pa1, pa2, pa3); FA_SBAR();
    FA_PV(vb0 + MLA_SHM_V);
    bf16_t* Yw = Y + (rowb + qb * 256 + wid * 32) * DM + h * 64 + r32;
#pragma unroll
    for (int r = 0; r < 16; ++r) { const int orow = crow(r, hi); const float rl = __builtin_amdgcn_rcpf(lacc[r]);
        Yw[(size_t)orow * DM] = (bf16_t)f2bf(o[0][r] * rl); Yw[(size_t)orow * DM + 32] = (bf16_t)f2bf(o[1][r] * rl); }
    __syncthreads();
#undef FA_SLOAD
#undef FA_SWRITE
#undef FA_SWAIT
#undef FA_RESC
#undef FA_PV
}

__device__ __forceinline__ void partialSM_o(f32x16& p0, f32x16& p1, float& m_reg, float& mn, float& alpha) {
    float pmax = p0[0];
#pragma unroll
    for (int r = 1; r < 16; ++r) pmax = fmaxf(pmax, p0[r]);
#pragma unroll
    for (int r = 0; r < 16; ++r) pmax = fmaxf(pmax, p1[r]);
    { auto rr = __builtin_amdgcn_permlane32_swap(__float_as_uint(pmax), __float_as_uint(pmax), false, false);
      pmax = fmaxf(__uint_as_float(rr[0]), __uint_as_float(rr[1])); }
    if (__builtin_expect(__all(pmax - m_reg <= THRL), 1)) { mn = m_reg; alpha = 1.f; }
    else { mn = fmaxf(m_reg, pmax); alpha = __builtin_amdgcn_exp2f(m_reg - mn); m_reg = mn; }
#pragma unroll
    for (int r = 0; r < 16; ++r) { p0[r] -= mn; p1[r] -= mn; }
#pragma unroll
    for (int r = 0; r < 16; ++r) p0[r] = __builtin_amdgcn_exp2f(p0[r]);
}
__device__ __forceinline__ void finishSM_o(f32x16& p0, f32x16& p1, float alpha, float& l_reg, bf16x8& pa0, bf16x8& pa1, bf16x8& pa2, bf16x8& pa3) {
#pragma unroll
    for (int r = 0; r < 16; ++r) p1[r] = __builtin_amdgcn_exp2f(p1[r]);
    float ps = 0;
#pragma unroll
    for (int r = 0; r < 16; ++r) ps += p0[r];
#pragma unroll
    for (int r = 0; r < 16; ++r) ps += p1[r];
    { auto rr = __builtin_amdgcn_permlane32_swap(__float_as_uint(ps), __float_as_uint(ps), false, false);
      ps = __uint_as_float(rr[0]) + __uint_as_float(rr[1]); }
    l_reg = l_reg * alpha + ps;
#define FA_PK4(P, BASE, OUT) do { unsigned a0 = cvtpk(P[BASE + 0], P[BASE + 1]), a1 = cvtpk(P[BASE + 2], P[BASE + 3]);   \
    unsigned b0 = cvtpk(P[BASE + 4], P[BASE + 5]), b1 = cvtpk(P[BASE + 6], P[BASE + 7]);                              \
    auto r0 = __builtin_amdgcn_permlane32_swap(a0, b0, false, false); auto r1 = __builtin_amdgcn_permlane32_swap(a1, b1, false, false); \
    u32x4 w = {r0[0], r1[0], r0[1], r1[1]}; OUT = *reinterpret_cast<bf16x8*>(&w); } while (0)
    FA_PK4(p0, 0, pa0); FA_PK4(p0, 8, pa1); FA_PK4(p1, 0, pa2); FA_PK4(p1, 8, pa3);
#undef FA_PK4
}
template <int NDQ, int KP>
__device__ __forceinline__ void qkt_o(f32x16& p0, f32x16& p1, const LAS unsigned char* Ks, const bf16x8* qr, int r32, int hi) {
    p0 = f32x16{}; p1 = f32x16{};
#pragma unroll
    for (int d0 = 0; d0 < NDQ; ++d0) { const int cb = (d0 * 16 + hi * 8) * 2;
        const bf16x8 b0 = *(const LAS bf16x8*)(Ks + r32 * KP + cb);
        const bf16x8 b1 = *(const LAS bf16x8*)(Ks + (32 + r32) * KP + cb);
        p0 = __builtin_amdgcn_mfma_f32_32x32x16_bf16(b0, qr[d0], p0, 0, 0, 0);
        p1 = __builtin_amdgcn_mfma_f32_32x32x16_bf16(b1, qr[d0], p1, 0, 0, 0); }
}
constexpr int XA_KP = 528, XA_SHM_K = 64 * XA_KP, XA_SHM_V = 64 * 128 * 2;
__device__ __forceinline__ void xattn_unit(int b, int h, int vh, int qb, const bf16_t* __restrict__ HQ, const bf16_t* __restrict__ KVM, bf16_t* __restrict__ OX, LAS unsigned char* lds) {
    const int tid = threadIdx.x, wid = tid >> 6, lane = tid & 63, r32 = lane & 31, hi = lane >> 5;
    LAS unsigned char* K_lds = lds; LAS unsigned char* V_lds = lds + XA_SHM_K;
    LAS float* wsf = (LAS float*)(lds + XA_SHM_K + XA_SHM_V) + wid * 64; LAS float* li_l = wsf; LAS float* al_l = wsf + 32;
    float m_reg = -1e30f, l_reg = 0; f32x16 o[4] = {}; bf16x8 qr[16];
    const size_t qrow0 = (size_t)b * SEQ + qb * 256 + wid * 32;
    { const bf16_t* Qw = HQ + (qrow0 + r32) * DM + h * 256 + hi * 8; const float C = 0.0625f * 1.4426950408889634f;
#pragma unroll
      for (int d0 = 0; d0 < 16; ++d0) { const bf16x8 raw = *(const bf16x8*)(Qw + d0 * 16); float v[8];
#pragma unroll
          for (int j = 0; j < 8; ++j) v[j] = bf2f((bf16_t)raw[j]) * C;
          qr[d0] = cvt8(v); } }
    const int ksr = tid >> 5, ksc = tid & 31, vsr = tid >> 4, vsc = tid & 15;
    const bf16_t* gk = KVM + ((size_t)b * NMEM + ksr) * 2048 + h * 256 + ksc * 8;
    const bf16_t* gv = KVM + ((size_t)b * NMEM + vsr) * 2048 + 1024 + h * 256 + vh * 128 + vsc * 8;
    const int vb0 = (int)(unsigned)(uintptr_t)V_lds + v_rd_base(lane);
    bf16x8 sk[4], sv[2];
#define XA_SLOAD(k0) do { _Pragma("unroll") for (int i = 0; i < 4; ++i) sk[i] = *(const bf16x8*)(gk + (size_t)((k0) + 16 * i) * 2048); \
    _Pragma("unroll") for (int i = 0; i < 2; ++i) sv[i] = *(const bf16x8*)(gv + (size_t)((k0) + 32 * i) * 2048); } while (0)
#define XA_SWRITE() do { _Pragma("unroll") for (int i = 0; i < 4; ++i) *(LAS bf16x8*)(K_lds + (ksr + 16 * i) * XA_KP + ksc * 16) = sk[i]; \
    _Pragma("unroll") for (int i = 0; i < 2; ++i) *(LAS bf16x8*)(V_lds + v_st<4>(vsr + 32 * i, vsc * 8)) = sv[i]; } while (0)
    XA_SLOAD(0);
    for (int t = 0; t < NMEM / 64; ++t) {
        __syncthreads();
        XA_SWRITE(); __syncthreads();
        f32x16 p0, p1; float mn, al; bf16x8 pa0, pa1, pa2, pa3;
        qkt_o<16, XA_KP>(p0, p1, K_lds, qr, r32, hi);
        partialSM_o(p0, p1, m_reg, mn, al);
        if (__any(al < 1.f)) { if (hi == 0) al_l[r32] = al; asm volatile("s_waitcnt lgkmcnt(0)" ::: "memory");
#pragma unroll
            for (int d = 0; d < 4; ++d)
#pragma unroll
                for (int r = 0; r < 16; ++r) o[d][r] *= al_l[crow(r, hi)]; }
        finishSM_o(p0, p1, al, l_reg, pa0, pa1, pa2, pa3); FA_SBAR();
        if (t + 1 < NMEM / 64) XA_SLOAD((t + 1) * 64);
        FA_SBAR();
        pv_one<4, 0>(o[0], vb0, pa0, pa1, pa2, pa3); pv_one<4, 1>(o[1], vb0, pa0, pa1, pa2, pa3); pv_one<4, 2>(o[2], vb0, pa0, pa1, pa2, pa3); pv_one<4, 3>(o[3], vb0, pa0, pa1, pa2, pa3);
    }
    if (hi == 0) li_l[r32] = l_reg; asm volatile("s_waitcnt lgkmcnt(0)" ::: "memory");
    bf16_t* Ow = OX + qrow0 * DM + h * 256 + vh * 128 + r32;
#pragma unroll
    for (int r = 0; r < 16; ++r) { const int orow = crow(r, hi); const float rl = __builtin_amdgcn_rcpf(li_l[orow]);
#pragma unroll
        for (int d0 = 0; d0 < 4; ++d0) Ow[(size_t)orow * DM + d0 * 32] = (bf16_t)f2bf(o[d0][r] * rl); }
    __syncthreads();
#undef XA_SLOAD
#undef XA_SWRITE
}
}

namespace ml {
using fa::f32x16; using fa::s16x4; using fa::crow; using fa::cvtpk_s; using fa::tr_read; using fa::v_rd_base;
constexpr int RP = 272;
constexpr int L_Q = 0, L_K = 128 * RP, L_KW = 2 * 128 * RP, L_V = L_KW + 32768, L_C = L_V + 8192, L_ARR = L_C + 32 * RP, L_PART = L_ARR + 10240, L_END = L_PART + 16384;
static_assert(L_END <= 147200, "mLSTM LDS map");
constexpr int A_U2 = 0, A_MM2 = 128, A_A = 256, A_NEGM2 = 384, A_EW = 512, A_N = 640, A_RD = 768, A_DS1 = 896, A_NQ = 1024, A_NLP = 1152  , A_BL = 2176  , A_MALL = 2208  , A_MP = 2240  , A_SC = 2280;
constexpr float LOG2E = 1.4426950408889634f;
constexpr size_t GT_UNIT = 32 * 3 * 128;
#define ML_PK(L, H) (bf16x8){L[0], L[1], L[2], L[3], H[0], H[1], H[2], H[3]}
__device__ __forceinline__ float psum32(float v) { auto rr = __builtin_amdgcn_permlane32_swap(__float_as_uint(v), __float_as_uint(v), false, false); return __uint_as_float(rr[0]) + __uint_as_float(rr[1]); }

__device__ __forceinline__ void unit(int b, int h, int dir, int dq, const bf16_t* __restrict__ QKC, const bf16_t* __restrict__ Z, const float* __restrict__ G, const float* __restrict__ gbias,
                                     float* __restrict__ Hout, float* __restrict__ GT, LAS unsigned char* lds) {
    const int tid0 = threadIdx.x, wid = __builtin_amdgcn_readfirstlane(tid0 >> 6);
    int tid = tid0;
    LAS float* arr = (LAS float*)(lds + L_ARR);
    const float bias_i = gbias[dir * 8 + h], bias_f = gbias[dir * 8 + 4 + h];
    const size_t seqb = (size_t)b * SEQ;
    for (int i = tid; i < 32 * RP / 4; i += NTHR) ((LAS unsigned*)(lds + L_C))[i] = 0u;
    if (tid < 128) arr[A_N + tid] = 0.f;
    {   const int lane = tid & 63;
        for (int cc = wid; cc < SEQ / 128; cc += NWAVES) {
            const size_t row0 = seqb + (dir ? SEQ - 128 * (cc + 1) : 128 * cc);
            const int i0 = dir ? 127 - 2 * lane : 2 * lane, i1 = dir ? 126 - 2 * lane : 2 * lane + 1;
            const float f0 = G[(row0 + i0) * 16 + dir * 8 + 4 + h] + bias_f, f1 = G[(row0 + i1) * 16 + dir * 8 + 4 + h] + bias_f;
            const float g0 = G[(row0 + i0) * 16 + dir * 8 + h] + bias_i, g1 = G[(row0 + i1) * 16 + dir * 8 + h] + bias_i;
            const float lf0 = fminf(f0, 0.f) - log1pf(__expf(-fabsf(f0))), lf1 = fminf(f1, 0.f) - log1pf(__expf(-fabsf(f1)));
            float P = lf0 + lf1;
#pragma unroll
            for (int o = 1; o < 64; o <<= 1) { const float t_ = __shfl_up(P, o); if (lane >= o) P += t_; }
            const float b1 = P, b0 = P - lf1;
            const float u0 = g0 - b0, u1 = g1 - b1;
            float Pm = fmaxf(u0, u1);
#pragma unroll
            for (int o = 1; o < 64; o <<= 1) { const float t_ = __shfl_up(Pm, o); if (lane >= o) Pm = fmaxf(Pm, t_); }
            float E = __shfl_up(Pm, 1); if (lane == 0) E = -3.0e38f;
            const float M0 = fmaxf(E, u0), M1 = Pm;
            float* gt = GT + (size_t)cc * 384;
            gt[i0] = u0; gt[i1] = u1; gt[128 + i0] = M0; gt[128 + i1] = M1; gt[256 + i0] = b0; gt[256 + i1] = b1;
            if (lane == 63) { arr[A_BL + cc] = P; arr[A_MALL + cc] = Pm; }
        }
    }
    asm volatile("s_waitcnt vmcnt(0)" ::: "memory");
    __syncthreads();
    if (tid == 0) { float m = 0.f; arr[A_MP] = 0.f;
        for (int cc = 0; cc < SEQ / 128; ++cc) { m = arr[A_BL + cc] + fmaxf(m, arr[A_MALL + cc]); arr[A_MP + cc + 1] = m; } }
    __syncthreads();
    f32x16 Cacc = {};
#define ML_MAPS() const int lane = tid & 63, r32 = lane & 31, hi = lane >> 5, qr_r = tid >> 4, qr_c = tid & 15, v_r = tid >> 2, v_c = tid & 3; (void)lane; (void)r32; (void)hi
    bf16x8 sq[4], sk[4], sv; float su = 0.f, sM = 0.f, sb_ = 0.f;
#define ML_LOAD(c) do { const size_t row0_ = seqb + (dir ? SEQ - 128 * ((c) + 1) : 128 * (c)); \
    _Pragma("unroll") for (int i = 0; i < 4; ++i) { const bf16_t* pq = QKC + (row0_ + qr_r + 32 * i) * 1024 + h * 128 + qr_c * 8; sq[i] = *(const bf16x8*)pq; sk[i] = *(const bf16x8*)(pq + 512); } \
    sv = *(const bf16x8*)(Z + (row0_ + v_r) * LDZ + ZC_V + h * 128 + dq * 32 + v_c * 8); \
    if (tid < 128) { const float* gt = GT + (size_t)(c) * 384 + tid; su = gt[0]; sM = gt[128]; sb_ = gt[256]; } } while (0)
#define ML_STORE(c) do { _Pragma("unroll") for (int i = 0; i < 4; ++i) { *(LAS bf16x8*)(lds + L_Q + (qr_r + 32 * i) * RP + qr_c * 16) = sq[i]; *(LAS bf16x8*)(lds + L_K + (qr_r + 32 * i) * RP + qr_c * 16) = sk[i]; } \
    *(LAS bf16x8*)(lds + L_V + fa::v_stp<1>(v_r, v_c * 8)) = sv; \
    if (tid < 128) { const float mp = arr[A_MP + (c)], mmL = fmaxf(mp, arr[A_MALL + (c)]), mm = fmaxf(mp, sM); \
        arr[A_U2 + tid] = su * LOG2E; arr[A_MM2 + tid] = mm * LOG2E; arr[A_A + tid] = __expf(mp - mm); arr[A_NEGM2 + tid] = -(sb_ + mm) * LOG2E; arr[A_EW + tid] = __expf(su - mmL); \
        if (tid == 0) arr[A_SC] = __expf(mp - mmL); } } while (0)
    { ML_MAPS(); ML_LOAD(0); }
    for (int c = 0; c < SEQ / 128; ++c) {
        asm volatile("" : "+v"(tid));
        ML_MAPS();
        const size_t row0 = seqb + (dir ? SEQ - 128 * (c + 1) : 128 * c);
        ML_STORE(c);
        __syncthreads();
#if PROBE_A >= 20 || PROBE_B >= 20
        unsigned tS1 = (unsigned)__builtin_amdgcn_s_memrealtime();
#endif
        if (c + 1 < SEQ / 128) ML_LOAD(c + 1);
        const int tb = wid & 3, half = wid >> 2;
        f32x16 intra = {}; float dsum = 0.f;
        {
            bf16x8 qr[8];
#pragma unroll
            for (int ks = 0; ks < 8; ++ks) qr[ks] = *(const LAS bf16x8*)(lds + L_Q + (tb * 32 + r32) * RP + (ks * 16 + hi * 8) * 2);
            const float mm2t = arr[A_MM2 + tb * 32 + r32];
            const int lo = dir ? tb : 0, n = dir ? 4 - tb : tb + 1, h0n = (n + 1) >> 1;
            const int sb_lo = half ? lo + h0n : lo, sb_hi = half ? lo + n : lo + h0n;
            const int vbase = (int)(unsigned)(uintptr_t)(lds + L_V) + v_rd_base(lane);
            for (int sb = sb_lo; sb < sb_hi; ++sb) {
                bf16x8 kf[8]; f32x4 u4[4];
#pragma unroll
                for (int ks = 0; ks < 8; ++ks) kf[ks] = *(const LAS bf16x8*)(lds + L_K + (sb * 32 + r32) * RP + (ks * 16 + hi * 8) * 2);
#pragma unroll
                for (int g = 0; g < 4; ++g) u4[g] = *(const LAS f32x4*)(arr + A_U2 + sb * 32 + 8 * g + 4 * hi);
                const int vb = vbase + sb * 2048;
                const s16x4 l0 = tr_read<0>(vb), h0 = tr_read<512>(vb), l1 = tr_read<1024>(vb), h1 = tr_read<1536>(vb);
                asm volatile("s_waitcnt lgkmcnt(0)" ::: "memory"); __builtin_amdgcn_sched_barrier(0);
                f32x16 p = {};
#pragma unroll
                for (int ks = 0; ks < 8; ++ks) p = __builtin_amdgcn_mfma_f32_32x32x16_bf16(kf[ks], qr[ks], p, 0, 0, 0);
                float w[16];
#pragma unroll
                for (int r = 0; r < 16; ++r) w[r] = __builtin_amdgcn_exp2f(u4[r >> 2][r & 3] - mm2t);
                if (sb == tb) {
#pragma unroll
                    for (int r = 0; r < 16; ++r) { const int sl = crow(r, hi); const bool msk = dir ? (sl < r32) : (sl > r32); w[r] = msk ? 0.f : w[r]; }
                }
#pragma unroll
                for (int r = 0; r < 16; ++r) { p[r] *= w[r]; dsum += p[r]; }
                u32x4 w0 = {cvtpk_s(p[0], p[1]), cvtpk_s(p[2], p[3]), cvtpk_s(p[4], p[5]), cvtpk_s(p[6], p[7])}, w1 = {cvtpk_s(p[8], p[9]), cvtpk_s(p[10], p[11]), cvtpk_s(p[12], p[13]), cvtpk_s(p[14], p[15])};
                intra = __builtin_amdgcn_mfma_f32_32x32x16_bf16(__builtin_bit_cast(bf16x8, w0), ML_PK(l0, h0), intra, 0, 0, 0);
                intra = __builtin_amdgcn_mfma_f32_32x32x16_bf16(__builtin_bit_cast(bf16x8, w1), ML_PK(l1, h1), intra, 0, 0, 0);
            }
            dsum = psum32(dsum);
            if (half) {
                f32x16 inter = {}; bf16x8 cf[8]; f32x4 a4[4];
#pragma unroll
                for (int ks = 0; ks < 8; ++ks) cf[ks] = *(const LAS bf16x8*)(lds + L_C + r32 * RP + (ks * 16 + hi * 8) * 2);
#pragma unroll
                for (int g = 0; g < 4; ++g) a4[g] = *(const LAS f32x4*)(arr + A_A + tb * 32 + 8 * g + 4 * hi);
                asm volatile("s_waitcnt lgkmcnt(0)" ::: "memory"); __builtin_amdgcn_sched_barrier(0);
#pragma unroll
                for (int ks = 0; ks < 8; ++ks) inter = __builtin_amdgcn_mfma_f32_32x32x16_bf16(qr[ks], cf[ks], inter, 0, 0, 0);
                LAS float* part = (LAS float*)(lds + L_PART) + tb * 1024 + lane;
#pragma unroll
                for (int r = 0; r < 16; ++r) part[r * 64] = intra[r] + a4[r >> 2][r & 3] * inter[r];
                if (hi == 0) arr[A_DS1 + tb * 32 + r32] = dsum;
            } else {
                float nq = 0.f; bf16x8 q8[8]; f32x4 n4[16];
#pragma unroll
                for (int cc = 0; cc < 8; ++cc) { q8[cc] = *(const LAS bf16x8*)(lds + L_Q + (tb * 32 + r32) * RP + (hi * 64 + cc * 8) * 2);
                    n4[2 * cc] = *(const LAS f32x4*)(arr + A_N + hi * 64 + cc * 8); n4[2 * cc + 1] = *(const LAS f32x4*)(arr + A_N + hi * 64 + cc * 8 + 4); }
                asm volatile("s_waitcnt lgkmcnt(0)" ::: "memory"); __builtin_amdgcn_sched_barrier(0);
#pragma unroll
                for (int cc = 0; cc < 8; ++cc) {
#pragma unroll
                    for (int j = 0; j < 4; ++j) nq += bf2f((bf16_t)q8[cc][j]) * n4[2 * cc][j] + bf2f((bf16_t)q8[cc][4 + j]) * n4[2 * cc + 1][j]; }
                nq = psum32(nq);
                if (hi == 0) arr[A_NQ + tb * 32 + r32] = nq;
            }
        }
        {
            const int ec = tid & 15, s0 = tid >> 4;
            float ns[8] = {0.f, 0.f, 0.f, 0.f, 0.f, 0.f, 0.f, 0.f}; bf16x8 k8a[4]; float ewa[4];
#pragma unroll
            for (int i = 0; i < 4; ++i) { k8a[i] = *(const LAS bf16x8*)(lds + L_K + (s0 + 32 * i) * RP + ec * 16); ewa[i] = arr[A_EW + s0 + 32 * i]; }
            asm volatile("s_waitcnt lgkmcnt(0)" ::: "memory"); __builtin_amdgcn_sched_barrier(0);
#pragma unroll
            for (int i = 0; i < 4; ++i) { float kv[8];
#pragma unroll
                for (int j = 0; j < 8; ++j) { kv[j] = bf2f((bf16_t)k8a[i][j]) * ewa[i]; ns[j] += kv[j]; }
                u32x4 w_ = {cvtpk_s(kv[0], kv[1]), cvtpk_s(kv[2], kv[3]), cvtpk_s(kv[4], kv[5]), cvtpk_s(kv[6], kv[7])};
                *(LAS u32x4*)(lds + L_KW + fa::v_stp<4>(s0 + 32 * i, ec * 8)) = w_; }
#pragma unroll
            for (int j = 0; j < 8; ++j) { ns[j] += __shfl_xor(ns[j], 16); ns[j] += __shfl_xor(ns[j], 32); }
            if (lane < 16) {
#pragma unroll
                for (int j = 0; j < 8; ++j) arr[A_NLP + wid * 128 + ec * 8 + j] = ns[j]; }
        }
        __syncthreads();
#if PROBE_A >= 20 || PROBE_B >= 20
        unsigned tS3 = (unsigned)__builtin_amdgcn_s_memrealtime();
#endif
        if (wid < 4) {
            const float den = dsum + arr[A_DS1 + tb * 32 + r32] + arr[A_A + tb * 32 + r32] * arr[A_NQ + tb * 32 + r32];
            const float rden = __builtin_amdgcn_rcpf(fmaxf(fabsf(den), __builtin_amdgcn_exp2f(arr[A_NEGM2 + tb * 32 + r32])));
            if (hi == 0) arr[A_RD + tb * 32 + r32] = rden;
            asm volatile("s_waitcnt lgkmcnt(0)" ::: "memory");
            const LAS float* part = (const LAS float*)(lds + L_PART) + tb * 1024 + lane;
            float* Ho = Hout + (row0 + tb * 32) * ML_W + h * 128 + dq * 32 + r32;
            float pv_[16]; f32x4 rd4[4];
#pragma unroll
            for (int r = 0; r < 16; ++r) pv_[r] = part[r * 64];
#pragma unroll
            for (int g = 0; g < 4; ++g) rd4[g] = *(const LAS f32x4*)(arr + A_RD + tb * 32 + 8 * g + 4 * hi);
            asm volatile("s_waitcnt lgkmcnt(0)" ::: "memory"); __builtin_amdgcn_sched_barrier(0);
#pragma unroll
            for (int r = 0; r < 16; ++r) Ho[(size_t)crow(r, hi) * ML_W] = (intra[r] + pv_[r]) * rd4[r >> 2][r & 3];
        } else {
            const int et = wid - 4; const float fC = arr[A_SC];
#pragma unroll
            for (int r = 0; r < 16; ++r) Cacc[r] *= fC;
            const int vb = (int)(unsigned)(uintptr_t)(lds + L_V) + v_rd_base(lane), kb = (int)(unsigned)(uintptr_t)(lds + L_KW) + v_rd_base(lane) + et * 512;
#define ML_CRD(ks, i) const s16x4 al##i = tr_read<(ks) * 1024>(vb), ah##i = tr_read<(ks) * 1024 + 512>(vb), bl##i = tr_read<(ks) * 4096>(kb), bh##i = tr_read<(ks) * 4096 + 2048>(kb)
#define ML_CMM(i) Cacc = __builtin_amdgcn_mfma_f32_32x32x16_bf16(ML_PK(al##i, ah##i), ML_PK(bl##i, bh##i), Cacc, 0, 0, 0)
            { ML_CRD(0, 0); ML_CRD(1, 1); ML_CRD(2, 2); ML_CRD(3, 3);
              asm volatile("s_waitcnt lgkmcnt(0)" ::: "memory"); __builtin_amdgcn_sched_barrier(0);
              ML_CMM(0); ML_CMM(1); ML_CMM(2); ML_CMM(3); }
            { ML_CRD(4, 0); ML_CRD(5, 1); ML_CRD(6, 2); ML_CRD(7, 3);
              asm volatile("s_waitcnt lgkmcnt(0)" ::: "memory"); __builtin_amdgcn_sched_barrier(0);
              ML_CMM(0); ML_CMM(1); ML_CMM(2); ML_CMM(3); }
#undef ML_CRD
#undef ML_CMM
#pragma unroll
            for (int r = 0; r < 16; ++r) *(LAS bf16_t*)(lds + L_C + crow(r, hi) * RP + (et * 32 + r32) * 2) = (bf16_t)f2bf(Cacc[r]);
            const int ht = tid - 256;
            if (ht < 128) { float a_ = 0.f;
#pragma unroll
                for (int w8 = 0; w8 < 8; ++w8) a_ += arr[A_NLP + w8 * 128 + ht];
                arr[A_N + ht] = fC * arr[A_N + ht] + a_; }
        }
        __syncthreads();
#if PROBE_A >= 20 || PROBE_B >= 20
        if (blockIdx.x == 0 && tid0 == 0) { volatile LAS unsigned* tsl = (volatile LAS unsigned*)(lds + 147200); const unsigned tS4 = (unsigned)__builtin_amdgcn_s_memrealtime(); tsl[13] += tS3 - tS1; tsl[14] += tS4 - tS3; }
#endif
    }
#undef ML_LOAD
#undef ML_STORE
#undef ML_MAPS
}
#undef ML_PK
}

__device__ __forceinline__ void mlstm_fast(const Params& p, LAS unsigned char* lds) {
    const int G = gridDim.x, bx = blockIdx.x, vcu = (G % 8 == 0) ? (bx % 8) * (G / 8) + bx / 8 : bx;
    for (int u = vcu; u < BATCH * ML_H * 2 * 4; u += G) {
        const int dq = u & 3, dir = (u >> 2) & 1, h = (u >> 3) & 3, b = u >> 5;
        ml::unit(b, h, dir, dq, (const bf16_t*)(p.ws + WS_XB), (const bf16_t*)(p.ws + WS_Z), (const float*)(p.ws + WS_G), (const float*)(p.ws + WS_SMALL) + SM_GBIAS,
                 dir ? p.out + (size_t)T * ML_W : p.out, (float*)(p.ws + WS_GT) + (size_t)u * ml::GT_UNIT, lds);
    }
}
__device__ __forceinline__ void mla_attn_fast(const Params& p, LAS unsigned char* lds) {
    const int G = gridDim.x, bx = blockIdx.x, vcu = (G % 8 == 0) ? (bx % 8) * (G / 8) + bx / 8 : bx;
    for (int u = vcu; u < BATCH * MLA_H * 16; u += G) {
        const int qb = u & 15, bh = u >> 4;
        fa::mla_unit(bh >> 3, bh & 7, qb, (const bf16_t*)(p.ws + WS_QALL), (const bf16_t*)(p.ws + WS_KV), (const bf16_t*)(p.ws + WS_KR),
                     (const float*)(p.ws + WS_COS), (const float*)(p.ws + WS_SIN), (bf16_t*)(p.ws + WS_Y), lds);
    }
}
__device__ __forceinline__ void x_attn_fast(const Params& p, LAS unsigned char* lds) {
    const int G = gridDim.x, bx = blockIdx.x, vcu = (G % 8 == 0) ? (bx % 8) * (G / 8) + bx / 8 : bx;
    for (int u = vcu; u < BATCH * XH * 2 * 16; u += G) {
        const int qb = u & 15, vh = (u >> 4) & 1, bh = u >> 5;
        fa::xattn_unit(bh >> 2, bh & 3, vh, qb, (const bf16_t*)(p.ws + WS_HQ), (const bf16_t*)(p.ws + WS_KVM), (bf16_t*)(p.ws + WS_OX), lds);
    }
}
__device__ __forceinline__ void phase_final(const Params& p) {
    const float* ssq = (const float*)(p.ws + WS_SSQ) + 4 * (size_t)T; const bf16_t* XB = (const bf16_t*)(p.ws + WS_XB);
    const float* fin = (const float*)(p.ws + WS_SMALL) + SM_FIN;
    const int wid = threadIdx.x >> 6, lane = threadIdx.x & 63;
    for (int row = blockIdx.x * NWAVES + wid; row < T; row += gridDim.x * NWAVES) {
        const float r = rsqrtf(ssq[row] * (1.0f / DM) + EPS);
#pragma unroll
        for (int j = 0; j < 2; ++j) { const int c = j * 512 + lane * 8;
            const u32x4 rb = *(const u32x4*)(XB + (size_t)row * DM + c);
            const f32x4 g0 = *(const f32x4*)(fin + c), g1 = *(const f32x4*)(fin + c + 4);
            f32x4 v0 = (f32x4){__uint_as_float(rb.x << 16), __uint_as_float(rb.x & 0xffff0000u), __uint_as_float(rb.y << 16), __uint_as_float(rb.y & 0xffff0000u)};
            f32x4 v1 = (f32x4){__uint_as_float(rb.z << 16), __uint_as_float(rb.z & 0xffff0000u), __uint_as_float(rb.w << 16), __uint_as_float(rb.w & 0xffff0000u)};
            *(f32x4*)(p.out + (size_t)row * DM + c) = v0 * r * g0; *(f32x4*)(p.out + (size_t)row * DM + c + 4) = v1 * r * g1; }
    }
}

#define XB_TMO      128
#define XB_XCNT(j)  (256  + 64 * (j))
#define XB_XSUB(j)  (1280 + 64 * (j))
#define XB_XGEN(j)  (2304 + 64 * (j))
#define XB_TOP      3328
#define XB_TOPGEN   3392
#define XCD_BAR_WORDS 3456
#define XB_SPIN_CAP (1u << 20)
__device__ __forceinline__ unsigned xb_ld(unsigned* p)              { return __hip_atomic_load(p, __ATOMIC_RELAXED, __HIP_MEMORY_SCOPE_AGENT); }
__device__ __forceinline__ unsigned xb_add(unsigned* p, unsigned v) { return __hip_atomic_fetch_add(p, v, __ATOMIC_RELAXED, __HIP_MEMORY_SCOPE_AGENT); }
__device__ __forceinline__ unsigned xb_xcc_id() { return (unsigned)__builtin_amdgcn_s_getreg((3 << 11) | 20) & 0xFu; }
#define XB_SPIN(cond, bar) do { unsigned _sp = 0; while (cond) { __builtin_amdgcn_s_sleep(1); \
    if ((++_sp & 255u) == 0u) { if (xb_ld(&(bar)[XB_TMO])) break; if (_sp > XB_SPIN_CAP) { atomicAdd(&(bar)[XB_TMO], 1u); break; } } } } while (0)
struct XcdBarrier { unsigned* bar; unsigned x; volatile LAS unsigned* st; };
__device__ __forceinline__ XcdBarrier xcd_barrier_post(unsigned* bar, volatile LAS unsigned* st) {
    XcdBarrier b; b.bar = bar; b.x = xb_xcc_id(); b.st = st;
    if (threadIdx.x == 0) (void)xb_add(&bar[XB_XCNT(b.x)], 1u);
    return b;
}
__device__ __forceinline__ void xcd_barrier_complete(unsigned* bar, unsigned x, unsigned& nloc, unsigned& nx) {
    const unsigned G = gridDim.x * gridDim.y * gridDim.z;
    unsigned sum, cnt, mine, sp = 0u;
    for (;;) {
        sum = 0u; cnt = 0u; mine = 0u;
#pragma unroll
        for (unsigned j = 0; j < 16; ++j) { const unsigned c = xb_ld(&bar[XB_XCNT(j)]); sum += c; cnt += (c > 0u) ? 1u : 0u; mine = (j == x) ? c : mine; }
        if (sum == G) break;
        __builtin_amdgcn_s_sleep(1);
        if ((++sp & 255u) == 0u) { if (xb_ld(&bar[XB_TMO])) break; if (sp > XB_SPIN_CAP) { atomicAdd(&bar[XB_TMO], 1u); break; } }
    }
    nloc = mine > 0u ? mine : 1u; nx = cnt > 0u ? cnt : 1u;
}
__device__ __forceinline__ void xcd_barrier(const XcdBarrier& b) {
    asm volatile("s_waitcnt vmcnt(0)" ::: "memory");
    __syncthreads();
    if (threadIdx.x == 0) {
        unsigned* bar = b.bar;
        __builtin_amdgcn_s_waitcnt(0);
        unsigned nloc = b.st[0], nx = b.st[1];
        if (nloc == 0u) { xcd_barrier_complete(bar, b.x, nloc, nx); b.st[0] = nloc; b.st[1] = nx; }
        const unsigned old = xb_add(&bar[XB_XSUB(b.x)], 1u);
        const unsigned gen = old / nloc;
        if (old + 1u == (gen + 1u) * nloc) {
            __builtin_amdgcn_fence(__ATOMIC_RELEASE, "agent");
            asm volatile("s_waitcnt vmcnt(0)" ::: "memory");
            const unsigned og = xb_add(&bar[XB_TOP], 1u);
            const unsigned tg = og / nx;
            if (og + 1u == (tg + 1u) * nx) xb_add(&bar[XB_TOPGEN], 1u);
            else XB_SPIN(xb_ld(&bar[XB_TOPGEN]) == tg, bar);
            __builtin_amdgcn_fence(__ATOMIC_ACQUIRE, "agent");
            xb_add(&bar[XB_XGEN(b.x)], 1u);
            asm volatile("s_waitcnt vmcnt(0)" ::: "memory");
        } else {
            XB_SPIN(xb_ld(&bar[XB_XGEN(b.x)]) == gen, bar);
            __builtin_amdgcn_fence(__ATOMIC_ACQUIRE, "agent");
            asm volatile("s_waitcnt vmcnt(0)" ::: "memory");
        }
    }
    __syncthreads();
}

constexpr int LDS_BYTES = 147456;
constexpr int NPHASE = 12;

#ifndef MK_N_LAUNCHES
#define MK_N_LAUNCHES 1
#endif

__global__ void __launch_bounds__(NTHR, 2) mega(Params p) {
    extern __shared__ __attribute__((aligned(16))) unsigned char lds_raw[];
    LAS unsigned char* lds = (LAS unsigned char*)lds_raw;
    unsigned char* ws = p.ws;
    float* ssq = (float*)(ws + WS_SSQ);
    const int lo = p.ph_lo, hi = p.ph_hi;
    volatile LAS unsigned* misc = (volatile LAS unsigned*)(lds + LDS_BYTES - 64);
    if (threadIdx.x < 16) misc[threadIdx.x] = 0u;
    __syncthreads();
    XcdBarrier bar; bar.bar = (unsigned*)(ws + WS_CTL) + 4096; bar.x = 0; bar.st = nullptr;
    if (hi - lo > 1) bar = xcd_barrier_post((unsigned*)(ws + WS_CTL) + 4096, misc);
#define IN(k) (lo <= (k) && (k) < hi)
#if PROBE_A >= 0 || PROBE_B >= 0
    volatile LAS unsigned* tsl = (volatile LAS unsigned*)(lds + LDS_BYTES - 256);
    if (blockIdx.x == 0 && threadIdx.x == 0) { tsl[0] = (unsigned)__builtin_amdgcn_s_memrealtime(); tsl[13] = 0u; tsl[14] = 0u; tsl[15] = 0u; }
#define SEAM(k) do { if (IN(k) && IN((k) + 1)) xcd_barrier(bar); if (blockIdx.x == 0 && threadIdx.x == 0) tsl[(k) + 1] = (unsigned)__builtin_amdgcn_s_memrealtime(); } while (0)
#else
#define SEAM(k) do { if (IN(k) && IN((k) + 1)) xcd_barrier(bar); } while (0)
#endif
    if (IN(0)) phase0(p, lds);
    SEAM(0);
    if (IN(1)) {
        Gemm g{(const bf16_t*)(ws + WS_XB), DM, (const bf16_t*)(ws + WS_WIN), DM, T, LDZ, DM};
        EpiZ E{(bf16_t*)(ws + WS_Z), ssq, ssq + T, (bf16_t*)(ws + WS_KR), (float*)(ws + WS_G), (const float*)(ws + WS_COS), (const float*)(ws + WS_SIN)};
        run_gemm(lds, g, E, (int)blockIdx.x);
    }
    SEAM(1);
    if (IN(2)) {
        { Gemm g{(const bf16_t*)(ws + WS_Z) + ZC_CQ, LDZ, (const bf16_t*)(ws + WS_WUQ), QLORA, T, MLA_H * DQK, QLORA};
          EpiScaleBf16 E{(bf16_t*)(ws + WS_QALL), MLA_H * DQK, ssq, 1.0f / QLORA, 1.0f}; run_gemm(lds, g, E, (int)blockIdx.x); }
        { Gemm g{(const bf16_t*)(ws + WS_Z) + ZC_CKV, LDZ, (const bf16_t*)(ws + WS_WUKV), 256, T, 1024, 256};
          EpiScaleBf16 E{(bf16_t*)(ws + WS_KV), 1024, ssq + T, 1.0f / KVLORA, 1.0f}; run_gemm(lds, g, E, (int)blockIdx.x); }
        { Gemm g{(const bf16_t*)(ws + WS_MEMN), DM, (const bf16_t*)(ws + WS_WXKV), DM, TM, 2 * DM, DM};
          EpiScaleBf16 E{(bf16_t*)(ws + WS_KVM), 2 * DM, nullptr, 0.f, 1.0f}; run_gemm(lds, g, E, (int)blockIdx.x); }
        phase_conv(p);
    }
    SEAM(2);
    if (IN(3)) { mlstm_fast(p, lds);
#if PROBE_A == 13
        xcd_barrier(bar); if (blockIdx.x == 0 && threadIdx.x == 0) tsl[14] = (unsigned)__builtin_amdgcn_s_memrealtime();
#endif
        mla_attn_fast(p, lds); }
    SEAM(3);
    if (IN(4)) phase_mlfin(p);
    SEAM(4);
    if (IN(5)) {
        Gemm g{(const bf16_t*)(ws + WS_Y), DM, (const bf16_t*)(ws + WS_WOUT), DM, T, DM, DM};
        EpiResid E{p.x, nullptr, (bf16_t*)(ws + WS_XB), ssq + 2 * T}; run_gemm(lds, g, E, (int)blockIdx.x);
    }
    SEAM(5);
    if (IN(6)) {
        Gemm g{(const bf16_t*)(ws + WS_XB), DM, (const bf16_t*)(ws + WS_WXQ), DM, T, DM, DM};
        EpiScaleBf16 E{(bf16_t*)(ws + WS_HQ), DM, ssq + 2 * T, 1.0f / DM, 1.0f}; run_gemm(lds, g, E, (int)blockIdx.x);
    }
    SEAM(6);
    if (IN(7)) x_attn_fast(p, lds);
    SEAM(7);
    if (IN(8)) {
        Gemm g{(const bf16_t*)(ws + WS_OX), DM, (const bf16_t*)(ws + WS_WXO), DM, T, DM, DM};
        EpiResid E{nullptr, (const bf16_t*)(ws + WS_XB), (bf16_t*)(ws + WS_XB), ssq + 3 * T}; run_gemm(lds, g, E, (int)blockIdx.x);
    }
    SEAM(8);
    if (IN(9)) {
        Gemm g{(const bf16_t*)(ws + WS_XB), DM, (const bf16_t*)(ws + WS_WGU), DM, T, 2 * DFF, DM};
        EpiSwiglu E{(bf16_t*)(ws + WS_H), ssq + 3 * T}; run_gemm(lds, g, E, (int)blockIdx.x);
    }
    SEAM(9);
    if (IN(10)) {
        Gemm g{(const bf16_t*)(ws + WS_H), DFF, (const bf16_t*)(ws + WS_WD), DFF, T, DM, DFF};
        EpiResid E{nullptr, (const bf16_t*)(ws + WS_XB), (bf16_t*)(ws + WS_XB), ssq + 4 * T}; run_gemm(lds, g, E, (int)blockIdx.x);
    }
    SEAM(10);
    if (IN(11)) phase_final(p);
#if PROBE_A >= 0 || PROBE_B >= 0
    {   float* pr = (float*)(ws + WS_CTL + 65536);
        if (blockIdx.x == 0 && threadIdx.x == 0) {
            tsl[12] = 0u; asm volatile("s_waitcnt vmcnt(0)" ::: "memory"); tsl[12] = (unsigned)__builtin_amdgcn_s_memrealtime();
            float da = 0.f, db = 0.f;
            if (PROBE_A >= 0) { const float us = (float)(PROBE_A == 13 ? tsl[14] - tsl[3] : PROBE_A >= 20 ? tsl[PROBE_A - 20 + 13] : tsl[PROBE_A + 1] - tsl[PROBE_A]) * 0.01f; da = sqrtf(PROBE_A_SCALE * us); }
            if (PROBE_B >= 0) { const float us = (float)(PROBE_B >= 20 ? tsl[PROBE_B - 20 + 13] : tsl[PROBE_B + 1] - tsl[PROBE_B]) * 0.01f; db = 0.04f + PROBE_B_SCALE * us; }
            __hip_atomic_store(pr, da, __ATOMIC_RELAXED, __HIP_MEMORY_SCOPE_AGENT); __hip_atomic_store(pr + 1, db, __ATOMIC_RELAXED, __HIP_MEMORY_SCOPE_AGENT);
        }
        xcd_barrier(bar);
        const float da = __hip_atomic_load(pr, __ATOMIC_RELAXED, __HIP_MEMORY_SCOPE_AGENT), db = __hip_atomic_load(pr + 1, __ATOMIC_RELAXED, __HIP_MEMORY_SCOPE_AGENT);
        for (size_t i = (size_t)blockIdx.x * NTHR + threadIdx.x; i < (size_t)T * DM; i += (size_t)gridDim.x * NTHR) p.out[i] += da + (i == 0 ? db : 0.f);
    }
#endif
#undef IN
#undef SEAM
}

extern "C" void kernel_launch(void* const* d_in, const int* in_sizes, int n_in, void* d_out, int out_size, void* d_ws, size_t ws_size, hipStream_t stream) {
    static int grid = 0;
    if (grid == 0) {
        if (n_in != 22 || in_sizes[0] != T * DM || out_size != T * DM) { fprintf(stderr, "kernel_launch: unexpected shapes (n_in %d, in0 %d, out %d)\n", n_in, n_in > 0 ? in_sizes[0] : -1, out_size); grid = -1; return; }
        if (ws_size < WS_END) { fprintf(stderr, "kernel_launch: workspace too small: %zu\n", ws_size); grid = -1; return; }
        int dev = 0, cus = 0, per_cu = 0;
        (void)hipGetDevice(&dev); (void)hipDeviceGetAttribute(&cus, hipDeviceAttributeMultiprocessorCount, dev);
        if (hipFuncSetAttribute((const void*)mega, hipFuncAttributeMaxDynamicSharedMemorySize, LDS_BYTES) != hipSuccess) { fprintf(stderr, "kernel_launch: hipFuncSetAttribute failed\n"); grid = -1; return; }
        if (hipOccupancyMaxActiveBlocksPerMultiprocessor(&per_cu, (const void*)mega, NTHR, LDS_BYTES) != hipSuccess || per_cu < 1) { fprintf(stderr, "kernel_launch: occupancy query says %d\n", per_cu); per_cu = 1; }
        (void)hipGetLastError();
        grid = cus * (per_cu < 1 ? per_cu : 1);
        fprintf(stderr, "kernel_launch: grid %d (cus %d, per_cu %d), ws %zu MiB\n", grid, cus, per_cu, ws_size >> 20);
    }
    if (grid < 0) return;
    Params p{};
    p.x = (const float*)d_in[0]; p.mem = (const float*)d_in[1]; p.pos = (const int*)d_in[2];
    p.attn_norm = (const float*)d_in[3]; p.w_in = (const float*)d_in[4]; p.q_norm = (const float*)d_in[5]; p.w_uq = (const float*)d_in[6];
    p.kv_norm = (const float*)d_in[7]; p.w_ukv = (const float*)d_in[8]; p.conv = (const float*)d_in[9]; p.gbias = (const float*)d_in[10];
    p.ml_norm = (const float*)d_in[11]; p.w_out = (const float*)d_in[12]; p.xattn_norm = (const float*)d_in[13]; p.mem_norm = (const float*)d_in[14];
    p.w_xq = (const float*)d_in[15]; p.w_xkv = (const float*)d_in[16]; p.w_xo = (const float*)d_in[17]; p.ffn_norm = (const float*)d_in[18];
    p.w_gu = (const float*)d_in[19]; p.w_down = (const float*)d_in[20]; p.final_norm = (const float*)d_in[21];
    p.out = (float*)d_out; p.ws = (unsigned char*)d_ws;
    if (hipMemsetAsync((char*)d_ws + WS_CTL, 0, 65536, stream) != hipSuccess) { fprintf(stderr, "kernel_launch: memset failed\n"); return; }
#if MK_N_LAUNCHES == 1
    p.ph_lo = 0; p.ph_hi = NPHASE;
    { void* args[] = {&p};
      const hipError_t e = hipLaunchCooperativeKernel((const void*)mega, dim3(grid), dim3(NTHR), args, LDS_BYTES, stream);
      if (e != hipSuccess) fprintf(stderr, "kernel_launch: cooperative launch failed: %s (grid %d)\n", hipGetErrorString(e), grid); }
#else
    for (int ph = 0; ph < NPHASE; ++ph) {
        p.ph_lo = ph; p.ph_hi = ph + 1;
        hipLaunchKernelGGL(mega, dim3(grid), dim3(NTHR), LDS_BYTES, stream, p);
    }
#endif
    const hipError_t le = hipPeekAtLastError();
    if (le != hipSuccess) fprintf(stderr, "kernel_launch: launch failed: %s\n", hipGetErrorName(le));
}
```

```cpp
#include <hip/hip_runtime.h>
#include <cstdio>
#include <cstdint>

#ifndef PROBE_A
#define PROBE_A (-1)
#define PROBE_A_SCALE 1.0e-7f
#define PROBE_B (-1)
#define PROBE_B_SCALE 1.0e-4f
#endif
constexpr int BATCH = 8, SEQ = 4096, DM = 1024, T = BATCH * SEQ;
constexpr int NMEM = 256, TM = BATCH * NMEM;
constexpr float EPS = 1e-6f;
constexpr int MLA_H = 8, QLORA = 256, KVLORA = 128, NOPE = 64, ROPE = 32, VD = 64, DQK = NOPE + ROPE;
constexpr int ML_H = 4, ML_D = 128, ML_W = 512;
constexpr int XH = 4, XD = 256;
constexpr int DFF = 2816;
constexpr int INW = 2480;
constexpr int LDZ = 2560, ZC_CQ = 0, ZC_CKV = 256, ZC_KR = 384, ZC_G = 416, ZC_QK = 512, ZC_V = 1536, ZC_O = 2048;
constexpr int NWAVES = 8, NTHR = 512;

constexpr size_t MiB = 1u << 20;
constexpr size_t WS_CTL = 0;
constexpr size_t WS_WIN = 1 * MiB;
constexpr size_t WS_WUQ = 6 * MiB;
constexpr size_t WS_WUKV = 7 * MiB;
constexpr size_t WS_WOUT = 8 * MiB;
constexpr size_t WS_WXQ = 10 * MiB;
constexpr size_t WS_WXKV = 12 * MiB;
constexpr size_t WS_WXO = 16 * MiB;
constexpr size_t WS_WGU = 18 * MiB;
constexpr size_t WS_WD = 30 * MiB;
constexpr size_t WS_COS = 36 * MiB;
constexpr size_t WS_SIN = 38 * MiB;
constexpr size_t WS_G = 40 * MiB;
constexpr size_t WS_KR = 42 * MiB;
constexpr size_t WS_SSQ = 44 * MiB;
constexpr size_t WS_SMALL = 45 * MiB;
constexpr int SM_CONV = 0, SM_GBIAS = 3072, SM_MLN = 3136, SM_FIN = 3648, SM_END = 4672;
constexpr size_t WS_MEMN = 46 * MiB;
constexpr size_t WS_KVM = 50 * MiB;
constexpr size_t WS_XB = 64 * MiB;
constexpr size_t WS_Z = 128 * MiB;
constexpr size_t WS_H = 128 * MiB;
constexpr size_t WS_QALL = 288 * MiB;
constexpr size_t WS_KV = 336 * MiB;
constexpr size_t WS_Y = 400 * MiB;
constexpr size_t WS_HQ = 304 * MiB;
constexpr size_t WS_OX = 368 * MiB;
constexpr size_t WS_GT = 464 * MiB;
constexpr size_t WS_END = 476 * MiB;

typedef unsigned short bf16_t;
typedef short bf16x8 __attribute__((ext_vector_type(8)));
typedef float f32x4 __attribute__((ext_vector_type(4)));
typedef unsigned u32x4 __attribute__((ext_vector_type(4)));
typedef unsigned u32x2 __attribute__((ext_vector_type(2)));
#define LAS __attribute__((address_space(3)))

__device__ __forceinline__ float bf2f(bf16_t h) { return __uint_as_float(((unsigned)h) << 16); }
__device__ __forceinline__ unsigned f2bf(float f) { unsigned u = __float_as_uint(f); return (u + 0x7fffu + ((u >> 16) & 1u)) >> 16; }
typedef float f32x2_c __attribute__((ext_vector_type(2))); typedef __bf16 bf16x2_c __attribute__((ext_vector_type(2)));
__device__ __forceinline__ unsigned pk2(float lo, float hi) { f32x2_c v = {lo, hi}; bf16x2_c b = __builtin_convertvector(v, bf16x2_c); return __builtin_bit_cast(unsigned, b); }
__device__ __forceinline__ float wave_sum(float v) {
#pragma unroll
    for (int o = 1; o < 64; o <<= 1) v += __shfl_xor(v, o);
    return v;
}
__device__ __forceinline__ float wave_max(float v) {
#pragma unroll
    for (int o = 1; o < 64; o <<= 1) v = fmaxf(v, __shfl_xor(v, o));
    return v;
}

struct Params {
    const float* x; const float* mem; const int* pos;
    const float *attn_norm, *w_in, *q_norm, *w_uq, *kv_norm, *w_ukv, *conv, *gbias, *ml_norm, *w_out, *xattn_norm, *mem_norm, *w_xq, *w_xkv, *w_xo, *ffn_norm, *w_gu, *w_down, *final_norm;
    float* out; unsigned char* ws;
    int ph_lo, ph_hi;
};

struct Unit { int pm, pn; };
struct Gemm { const bf16_t* A; int lda; const bf16_t* Bt; int ldb; int M, N, K; };

template <class Epi>
__device__ __forceinline__ void gemm_naive(const Gemm g, const Epi& E) {
    const int tid = threadIdx.x, wid = tid >> 6, lane = tid & 63, wr = wid >> 2, wc = wid & 3, fr = lane & 15, fq = lane >> 4;
    const int nM = g.M / 256, nN = g.N / 256;
    for (int unit = blockIdx.x; unit < nM * nN; unit += gridDim.x) {
        Unit u; u.pm = unit / nN; u.pn = unit % nN;
        f32x4 acc[2][2][4][2];
#pragma unroll
        for (int a = 0; a < 2; ++a)
#pragma unroll
            for (int b = 0; b < 2; ++b)
#pragma unroll
                for (int m = 0; m < 4; ++m)
#pragma unroll
                    for (int n = 0; n < 2; ++n) acc[a][b][m][n] = (f32x4){0.f, 0.f, 0.f, 0.f};
        const bf16_t* Ab = g.A + (size_t)(u.pm * 256 + wr * 64 + fr) * g.lda + 8 * fq;
        const bf16_t* Bb = g.Bt + (size_t)(u.pn * 256 + wc * 32 + 8 * (fr >> 2) + (fr & 3)) * g.ldb + 8 * fq;
        for (int kk = 0; kk < g.K; kk += 32) {
            bf16x8 a[2][4], b[2][2];
#pragma unroll
            for (int ai = 0; ai < 2; ++ai)
#pragma unroll
                for (int m = 0; m < 4; ++m) a[ai][m] = *(const bf16x8*)(Ab + (size_t)(ai * 128 + m * 16) * g.lda + kk);
#pragma unroll
            for (int bj = 0; bj < 2; ++bj)
#pragma unroll
                for (int n = 0; n < 2; ++n) b[bj][n] = *(const bf16x8*)(Bb + (size_t)(bj * 128 + 4 * n) * g.ldb + kk);
#pragma unroll
            for (int ai = 0; ai < 2; ++ai)
#pragma unroll
                for (int bj = 0; bj < 2; ++bj)
#pragma unroll
                    for (int m = 0; m < 4; ++m)
#pragma unroll
                        for (int n = 0; n < 2; ++n) acc[ai][bj][m][n] = __builtin_amdgcn_mfma_f32_16x16x32_bf16(b[bj][n], a[ai][m], acc[ai][bj][m][n], 0, 0, 0);
        }
        E(acc, u, wr, wc, fr, fq);
    }
}


#define PG8_LAS __attribute__((address_space(3)))
constexpr int BM = 256, BK = 64, HALF = 128, HTB = HALF * BK * 2  , STAGE_BYTES = 8 * HTB, NXCD = 8, WGM = 8;

__host__ __device__ __forceinline__ int lds_byte(int r, int c) { const int st = (r >> 4) * 2 + (c >> 5), rr = r & 15, cc = c & 31, ob = rr * 64 + cc * 2; return st * 1024 + (ob ^ (((ob >> 9) & 1) << 5)); }
__host__ __device__ __forceinline__ void stage_rc(int b, int& R, int& C) { const int st = b / 1024, sb = b % 1024, swz = sb ^ (((sb >> 9) & 1) << 5); R = (st >> 1) * 16 + swz / 64; C = (st & 1) * 32 + (swz % 64) / 2; }
__host__ __device__ __forceinline__ int perm32(int rho) { const int n = rho >> 4, i = rho & 15; return 8 * (i >> 2) + 4 * n + (i & 3); }


struct StaticOrder {
    int nM, nN, nwg, G, c;
    __host__ __device__ void init(int M, int N, int G_, int c_) { nM = M / BM; nN = N / BM; nwg = nM * nN; G = G_; c = c_; }
    __host__ __device__ bool next(int i, Unit& u) const {
        const long L = (long)i * G + c; if (L >= nwg) return false;
        int wgid = (int)L; { const int q = nwg / NXCD, r = nwg % NXCD, xcd = wgid % NXCD, off = wgid / NXCD; wgid = (xcd < r ? xcd * (q + 1) : r * (q + 1) + (xcd - r) * q) + off; }
        const int nig = WGM * nN, gid = wgid / nig, fm = gid * WGM, gsz = (nM - fm) < WGM ? (nM - fm) : WGM;
        u.pm = fm + ((wgid % nig) % gsz); u.pn = (wgid % nig) / gsz; return true;
    }
    __device__ __forceinline__ void a_ready(const Unit&) const {}
    __device__ __forceinline__ void done(const Unit&) const {}
};

template <class Epi, class Sched, bool ALIGN_EPI = false, bool SP2 = false>
__device__ __forceinline__ void gemm_phase(PG8_LAS unsigned char* lds, const Gemm g, const Sched& S, const Epi& E) {
    const int tid = threadIdx.x, wid = __builtin_amdgcn_readfirstlane(tid >> 6), lane = tid & 63, wr = wid >> 2, wc = wid & 3, fr = lane & 15, fq = lane >> 4;
    const int K = g.K, nt = K / BK, lda = g.lda, ldb = g.ldb;
    unsigned voffA[2], voffB[2];
#pragma unroll
    for (int i = 0; i < 2; ++i) { int R, C; stage_rc(tid * 16 + i * 8192, R, C); const int Rb = Epi::PERM ? ((R & ~31) + perm32(R & 31)) : R;
        voffA[i] = (unsigned)(R * lda + C) * 2u; voffB[i] = (unsigned)(Rb * ldb + C) * 2u; }
    const size_t kstep = (size_t)(BK * 2);
    const size_t hstepA = (size_t)HALF * lda * 2, hstepB = (size_t)HALF * ldb * 2;
    const size_t tstepA = 2 * hstepA, tstepB = 2 * hstepB;
    const unsigned ldsw = (unsigned)wid * 1024u;
    const int aoff = lds_byte(wr * 64 + fr, fq * 8), boff = lds_byte(wc * 32 + fr, fq * 8);
#define PG8_SA(b, h) (((b) * 2 + (h)) * HTB)
#define PG8_SB(b, h) ((4 + (b) * 2 + (h)) * HTB)
#define PG8_STAGE(bufoff, gbase, voff) do { _Pragma("unroll") for (int _i = 0; _i < 2; ++_i) \
        __builtin_amdgcn_global_load_lds((const unsigned*)((const char*)(gbase) + (voff)[_i]), (PG8_LAS unsigned*)(lds + (bufoff) + ldsw + _i * 8192), 16, 0, 0); } while (0)
#define PG8_LDA(dst, b, h) do { _Pragma("unroll") for (int m = 0; m < 4; ++m) _Pragma("unroll") for (int k = 0; k < 2; ++k) dst[m][k] = *(const PG8_LAS bf16x8*)(lds + PG8_SA(b, h) + aoff + m * 2048 + k * 1024); } while (0)
#define PG8_LDB(dst, b, h) do { _Pragma("unroll") for (int n = 0; n < 2; ++n) _Pragma("unroll") for (int k = 0; k < 2; ++k) dst[n][k] = *(const PG8_LAS bf16x8*)(lds + PG8_SB(b, h) + boff + n * 2048 + k * 1024); } while (0)
#define PG8_MMA(ai, bj, At, Bt) do { __builtin_amdgcn_s_setprio(1); _Pragma("unroll") for (int m = 0; m < 4; ++m) _Pragma("unroll") for (int n = 0; n < 2; ++n) _Pragma("unroll") for (int k = 0; k < 2; ++k) \
        acc[ai][bj][m][n] = __builtin_amdgcn_mfma_f32_16x16x32_bf16(Bt[n][k], At[m][k], acc[ai][bj][m][n], 0, 0, 0); __builtin_amdgcn_s_setprio(0); } while (0)
#define PG8_WAIT_V(n) asm volatile("s_waitcnt vmcnt(" #n ")" ::: "memory")
#define PG8_WAIT_L(n) asm volatile("s_waitcnt lgkmcnt(" #n ")" ::: "memory")
#define PG8_BAR __builtin_amdgcn_s_barrier()
#define PG8_SCHED __builtin_amdgcn_sched_barrier(0)
    Unit cur, nxt; int ui = 0;
    if (!S.next(0, cur)) return;
    f32x4 acc[2][2][4][2];
#pragma unroll
    for (int a = 0; a < 2; ++a)
#pragma unroll
        for (int b = 0; b < 2; ++b)
#pragma unroll
            for (int m = 0; m < 4; ++m)
#pragma unroll
                for (int n = 0; n < 2; ++n) acc[a][b][m][n] = (f32x4){0.f, 0.f, 0.f, 0.f};
    bf16x8 At[4][2], B0[2][2], B1[2][2];
    const char* cA = (const char*)g.A + (size_t)cur.pm * tstepA; const char* cB = (const char*)g.Bt + (size_t)cur.pn * tstepB;
    S.a_ready(cur);
    if constexpr (SP2) {
        PG8_STAGE(PG8_SB(0, 0), cB, voffB); PG8_STAGE(PG8_SB(0, 1), cB + hstepB, voffB); PG8_STAGE(PG8_SA(0, 0), cA, voffA); PG8_STAGE(PG8_SA(0, 1), cA + hstepA, voffA);
        if (wr == 1) PG8_BAR;
        PG8_WAIT_V(2); PG8_BAR;
        PG8_STAGE(PG8_SB(1, 0), cB + kstep, voffB); PG8_STAGE(PG8_SA(1, 0), cA + kstep, voffA); PG8_STAGE(PG8_SB(1, 1), cB + hstepB + kstep, voffB);
        PG8_WAIT_V(6); PG8_BAR;
    } else {
        PG8_STAGE(PG8_SB(0, 0), cB, voffB); PG8_STAGE(PG8_SA(0, 0), cA, voffA); PG8_STAGE(PG8_SB(0, 1), cB + hstepB, voffB); PG8_STAGE(PG8_SA(0, 1), cA + hstepA, voffA);
        if (wr == 1) PG8_BAR;
        PG8_WAIT_V(4); PG8_BAR;
        PG8_STAGE(PG8_SB(1, 0), cB + kstep, voffB); PG8_STAGE(PG8_SA(1, 0), cA + kstep, voffA); PG8_STAGE(PG8_SB(1, 1), cB + hstepB + kstep, voffB);
        PG8_WAIT_V(6); PG8_BAR;
    }
    for (;;) {
        const bool has_next = S.next(ui + 1, nxt);
        const char* nA = has_next ? (const char*)g.A + (size_t)nxt.pm * tstepA : cA; const char* nB = has_next ? (const char*)g.Bt + (size_t)nxt.pn * tstepB : cB;
        for (int t = 0; t < nt; t += 2) {
            const bool last = (t == nt - 2);
            const char* a1 = cA + (size_t)(t + 1) * kstep;
            const char* a2 = last ? nA : cA + (size_t)(t + 2) * kstep; const char* b2 = last ? nB : cB + (size_t)(t + 2) * kstep;
            const char* a3 = a2 + kstep; const char* b3 = b2 + kstep;
            if (last && has_next) S.a_ready(nxt);
            if constexpr (SP2) {
            PG8_LDB(B0, 0, 0); PG8_LDB(B1, 0, 1); PG8_SCHED; PG8_LDA(At, 0, 0); PG8_STAGE(PG8_SA(1, 1), a1 + hstepA, voffA);
            PG8_WAIT_V(8); PG8_WAIT_L(0); PG8_BAR; PG8_MMA(0, 0, At, B0); PG8_MMA(0, 1, At, B1); PG8_BAR; PG8_SCHED;
            PG8_LDA(At, 0, 1); PG8_STAGE(PG8_SB(0, 0), b2, voffB); PG8_STAGE(PG8_SB(0, 1), b2 + hstepB, voffB); PG8_STAGE(PG8_SA(0, 0), a2, voffA);
            PG8_WAIT_V(8); PG8_WAIT_L(0); PG8_BAR; PG8_MMA(1, 0, At, B0); PG8_MMA(1, 1, At, B1); PG8_BAR; PG8_SCHED;
            PG8_LDB(B0, 1, 0); PG8_LDB(B1, 1, 1); PG8_SCHED; PG8_LDA(At, 1, 0); PG8_STAGE(PG8_SA(0, 1), a2 + hstepA, voffA);
            PG8_WAIT_V(8); PG8_WAIT_L(0); PG8_BAR; PG8_MMA(0, 0, At, B0); PG8_MMA(0, 1, At, B1); PG8_BAR; PG8_SCHED;
            PG8_LDA(At, 1, 1); PG8_STAGE(PG8_SB(1, 0), b3, voffB); PG8_STAGE(PG8_SB(1, 1), b3 + hstepB, voffB); PG8_STAGE(PG8_SA(1, 0), a3, voffA);
            PG8_WAIT_V(8); PG8_WAIT_L(0); PG8_BAR; PG8_MMA(1, 0, At, B0); PG8_MMA(1, 1, At, B1); PG8_BAR; PG8_SCHED;
            } else {
            PG8_LDB(B0, 0, 0); PG8_SCHED; PG8_LDA(At, 0, 0); PG8_STAGE(PG8_SA(1, 1), a1 + hstepA, voffA);
            PG8_WAIT_L(8); PG8_BAR; PG8_WAIT_L(0); PG8_MMA(0, 0, At, B0); PG8_BAR; PG8_SCHED;
            PG8_LDB(B1, 0, 1); PG8_STAGE(PG8_SB(0, 0), b2, voffB);
            PG8_BAR; PG8_WAIT_L(0); PG8_MMA(0, 1, At, B1); PG8_BAR;
            PG8_LDA(At, 0, 1); PG8_STAGE(PG8_SA(0, 0), a2, voffA);
            PG8_BAR; PG8_WAIT_L(0); PG8_MMA(1, 0, At, B0); PG8_BAR; PG8_SCHED;
            PG8_STAGE(PG8_SB(0, 1), b2 + hstepB, voffB);
            PG8_WAIT_V(6); PG8_BAR; PG8_MMA(1, 1, At, B1); PG8_BAR;
            PG8_LDB(B0, 1, 0); PG8_SCHED; PG8_LDA(At, 1, 0); PG8_STAGE(PG8_SA(0, 1), a2 + hstepA, voffA);
            PG8_WAIT_L(8); PG8_BAR; PG8_WAIT_L(0); PG8_MMA(0, 0, At, B0); PG8_BAR; PG8_SCHED;
            PG8_LDB(B1, 1, 1); PG8_STAGE(PG8_SB(1, 0), b3, voffB);
            PG8_BAR; PG8_WAIT_L(0); PG8_MMA(0, 1, At, B1); PG8_BAR;
            PG8_LDA(At, 1, 1); PG8_STAGE(PG8_SA(1, 0), a3, voffA);
            PG8_BAR; PG8_WAIT_L(0); PG8_MMA(1, 0, At, B0); PG8_BAR; PG8_SCHED;
            PG8_STAGE(PG8_SB(1, 1), b3 + hstepB, voffB);
            PG8_WAIT_V(6); PG8_BAR; PG8_MMA(1, 1, At, B1); PG8_BAR;
            }
        }
        if constexpr (ALIGN_EPI) { if (wr == 0) PG8_BAR; }
        if constexpr (!Epi::AFTER_DRAIN) { E(acc, cur, wr, wc, fr, fq); S.done(cur); }
        if (!has_next) break;
#pragma unroll
        for (int a = 0; a < 2; ++a)
#pragma unroll
            for (int b = 0; b < 2; ++b)
#pragma unroll
                for (int m = 0; m < 4; ++m)
#pragma unroll
                    for (int n = 0; n < 2; ++n) acc[a][b][m][n] = (f32x4){0.f, 0.f, 0.f, 0.f};
        cur = nxt; cA = nA; cB = nB; ++ui;
        if constexpr (ALIGN_EPI) { if (wr == 1) PG8_BAR; }
    }
    PG8_WAIT_V(0);
    if constexpr (!ALIGN_EPI) { if (wr == 0) PG8_BAR; }
    PG8_BAR;
    if constexpr (Epi::AFTER_DRAIN) { E.fused(acc, cur, wr, wc, fr, fq, lds, wid, lane); S.done(cur); }
#undef PG8_SA
#undef PG8_SB
#undef PG8_STAGE
#undef PG8_LDA
#undef PG8_LDB
#undef PG8_MMA
#undef PG8_WAIT_V
#undef PG8_WAIT_L
#undef PG8_BAR
#undef PG8_SCHED
}

__device__ __forceinline__ u32x4 pack8(const f32x4 v0, const f32x4 v1) { u32x4 w; w.x = pk2(v0[0], v0[1]); w.y = pk2(v0[2], v0[3]); w.z = pk2(v1[0], v1[1]); w.w = pk2(v1[2], v1[3]); return w; }
__device__ __forceinline__ float sq8(const f32x4 a, const f32x4 b) { return (a[0] * a[0] + a[1] * a[1]) + (a[2] * a[2] + a[3] * a[3]) + (b[0] * b[0] + b[1] * b[1]) + (b[2] * b[2] + b[3] * b[3]); }

struct EpiZ {
    static constexpr bool PERM = true, AFTER_DRAIN = false;
    bf16_t* Z; float* ssq_q; float* ssq_kv; bf16_t* KR; float* G; const float* cosT; const float* sinT;
    __device__ __forceinline__ void operator()(const f32x4 (&acc)[2][2][4][2], const Unit& u, int wr, int wc, int fr, int fq) const {
#pragma unroll
        for (int ai = 0; ai < 2; ++ai) {
            f32x4 cs[4][4];
            if (u.pn == 1 && wc == 0) {
#pragma unroll
                for (int m = 0; m < 4; ++m) { const size_t ro = (size_t)(u.pm * 256 + ai * 128 + wr * 64 + m * 16 + fr) * 16 + 8 * (fq & 1);
                    cs[m][0] = *(const f32x4*)(cosT + ro); cs[m][1] = *(const f32x4*)(cosT + ro + 4); cs[m][2] = *(const f32x4*)(sinT + ro); cs[m][3] = *(const f32x4*)(sinT + ro + 4); } }
#pragma unroll
            for (int m = 0; m < 4; ++m) {
                const int row = u.pm * 256 + ai * 128 + wr * 64 + m * 16 + fr;
                bf16_t* zp = Z + (size_t)row * LDZ + u.pn * 256 + wc * 32 + 8 * fq;
#pragma unroll
                for (int bj = 0; bj < 2; ++bj) *(u32x4*)(zp + bj * 128) = pack8(acc[ai][bj][m][0], acc[ai][bj][m][1]);
                if (u.pn == 0) {
                    float s = sq8(acc[ai][0][m][0], acc[ai][0][m][1]) + sq8(acc[ai][1][m][0], acc[ai][1][m][1]);
                    s += __shfl_xor(s, 16); s += __shfl_xor(s, 32);
                    if (fq == 0) atomicAdd(ssq_q + row, s);
                } else if (u.pn == 1) {
                    float s = sq8(acc[ai][0][m][0], acc[ai][0][m][1]);
                    s += __shfl_xor(s, 16); s += __shfl_xor(s, 32);
                    if (fq == 0) atomicAdd(ssq_kv + row, s);
                    if (wc == 0) {
                        const f32x4 o0 = acc[ai][1][m][0], o1 = acc[ai][1][m][1];
                        f32x4 p0, p1;
#pragma unroll
                        for (int j = 0; j < 4; ++j) { p0[j] = __shfl_xor(o0[j], 32); p1[j] = __shfl_xor(o1[j], 32); }
                        const f32x4 c0 = cs[m][0], c1 = cs[m][1], s0 = cs[m][2], s1 = cs[m][3];
                        f32x4 r0, r1;
                        if (fq < 2) { r0 = o0 * c0 - p0 * s0; r1 = o1 * c1 - p1 * s1; }
                        else        { r0 = o0 * c0 + p0 * s0; r1 = o1 * c1 + p1 * s1; }
                        *(u32x4*)(KR + (size_t)row * 32 + 8 * fq) = pack8(r0, r1);
                    } else if (wc == 1 && fq < 2) {
                        *(f32x4*)(G + (size_t)row * 16 + 8 * fq) = acc[ai][1][m][0];
                        *(f32x4*)(G + (size_t)row * 16 + 8 * fq + 4) = acc[ai][1][m][1];
                    }
                }
            }
        }
    }
};
struct EpiScaleBf16 {
    static constexpr bool PERM = true, AFTER_DRAIN = false;
    bf16_t* O; int ldo; const float* ssq; float inv_n; float c;
    __device__ __forceinline__ void operator()(const f32x4 (&acc)[2][2][4][2], const Unit& u, int wr, int wc, int fr, int fq) const {
        float sc[2][4];
#pragma unroll
        for (int ai = 0; ai < 2; ++ai)
#pragma unroll
            for (int m = 0; m < 4; ++m) sc[ai][m] = ssq ? ssq[u.pm * 256 + ai * 128 + wr * 64 + m * 16 + fr] : 0.f;
#pragma unroll
        for (int ai = 0; ai < 2; ++ai)
#pragma unroll
            for (int m = 0; m < 4; ++m) {
                const int row = u.pm * 256 + ai * 128 + wr * 64 + m * 16 + fr;
                const float sv = ssq ? c * rsqrtf(sc[ai][m] * inv_n + EPS) : c;
                bf16_t* op = O + (size_t)row * ldo + u.pn * 256 + wc * 32 + 8 * fq;
#pragma unroll
                for (int bj = 0; bj < 2; ++bj) *(u32x4*)(op + bj * 128) = pack8(acc[ai][bj][m][0] * sv, acc[ai][bj][m][1] * sv);
            }
    }
};
struct EpiResid {
    static constexpr bool PERM = true, AFTER_DRAIN = false;
    const float* resf; const bf16_t* resb; bf16_t* XB; float* ssq;
    __device__ __forceinline__ void operator()(const f32x4 (&acc)[2][2][4][2], const Unit& u, int wr, int wc, int fr, int fq) const {
#pragma unroll
        for (int ai = 0; ai < 2; ++ai) {
            f32x4 r0[4][2], r1[4][2];
            if (resf) {
#pragma unroll
                for (int m = 0; m < 4; ++m)
#pragma unroll
                    for (int bj = 0; bj < 2; ++bj) { const size_t off = (size_t)(u.pm * 256 + ai * 128 + wr * 64 + m * 16 + fr) * DM + u.pn * 256 + wc * 32 + 8 * fq + bj * 128;
                        r0[m][bj] = *(const f32x4*)(resf + off); r1[m][bj] = *(const f32x4*)(resf + off + 4); }
            } else {
                u32x4 rb[4][2];
#pragma unroll
                for (int m = 0; m < 4; ++m)
#pragma unroll
                    for (int bj = 0; bj < 2; ++bj) rb[m][bj] = *(const u32x4*)(resb + (size_t)(u.pm * 256 + ai * 128 + wr * 64 + m * 16 + fr) * DM + u.pn * 256 + wc * 32 + 8 * fq + bj * 128);
#pragma unroll
                for (int m = 0; m < 4; ++m)
#pragma unroll
                    for (int bj = 0; bj < 2; ++bj) { const u32x4 q = rb[m][bj];
                        r0[m][bj] = (f32x4){__uint_as_float(q.x << 16), __uint_as_float(q.x & 0xffff0000u), __uint_as_float(q.y << 16), __uint_as_float(q.y & 0xffff0000u)};
                        r1[m][bj] = (f32x4){__uint_as_float(q.z << 16), __uint_as_float(q.z & 0xffff0000u), __uint_as_float(q.w << 16), __uint_as_float(q.w & 0xffff0000u)}; }
            }
#pragma unroll
            for (int m = 0; m < 4; ++m) {
                const int row = u.pm * 256 + ai * 128 + wr * 64 + m * 16 + fr;
                const size_t off = (size_t)row * DM + u.pn * 256 + wc * 32 + 8 * fq;
                float sq = 0.f;
#pragma unroll
                for (int bj = 0; bj < 2; ++bj) {
                    const f32x4 v0 = r0[m][bj] + acc[ai][bj][m][0], v1 = r1[m][bj] + acc[ai][bj][m][1];
                    *(u32x4*)(XB + off + bj * 128) = pack8(v0, v1);
                    sq += sq8(v0, v1);
                }
                sq += __shfl_xor(sq, 16); sq += __shfl_xor(sq, 32);
                if (fq == 0) atomicAdd(ssq + row, sq);
            }
        }
    }
};
struct EpiSwiglu {
    static constexpr bool PERM = true, AFTER_DRAIN = false;
    bf16_t* H; const float* ssq;
    __device__ __forceinline__ void operator()(const f32x4 (&acc)[2][2][4][2], const Unit& u, int wr, int wc, int fr, int fq) const {
        float scv[2][4];
#pragma unroll
        for (int ai = 0; ai < 2; ++ai)
#pragma unroll
            for (int m = 0; m < 4; ++m) scv[ai][m] = ssq[u.pm * 256 + ai * 128 + wr * 64 + m * 16 + fr];
#pragma unroll
        for (int ai = 0; ai < 2; ++ai)
#pragma unroll
            for (int m = 0; m < 4; ++m) {
                const int row = u.pm * 256 + ai * 128 + wr * 64 + m * 16 + fr;
                const float sc = rsqrtf(scv[ai][m] * (1.0f / DM) + EPS);
                f32x4 h[2];
#pragma unroll
                for (int n = 0; n < 2; ++n)
#pragma unroll
                    for (int j = 0; j < 4; ++j) { const float gg = acc[ai][0][m][n][j] * sc, uu = acc[ai][1][m][n][j] * sc;
                        h[n][j] = gg * uu * __builtin_amdgcn_rcpf(1.0f + __builtin_amdgcn_exp2f(-1.4426950408889634f * gg)); }
                *(u32x4*)(H + (size_t)row * DFF + u.pn * 128 + wc * 32 + 8 * fq) = pack8(h[0], h[1]);
            }
    }
};

#ifndef FAST_GEMM
#define FAST_GEMM 1
#endif
template <class Epi>
__device__ __forceinline__ void run_gemm(LAS unsigned char* lds, const Gemm g, const Epi& E, int c) {
#if FAST_GEMM
    StaticOrder S; S.init(g.M, g.N, (int)gridDim.x, c);
    gemm_phase<Epi, StaticOrder, true, true>(lds, g, S, E);
#else
    gemm_naive(g, E);
#endif
}

struct MapIdent { __device__ __forceinline__ int operator()(int n) const { return n; } };
struct MapWin { __device__ __forceinline__ int operator()(int n) const {
    if (n < 416) return n; if (n < 1440) return ZC_QK + (n - 416); if (n < 1952) return ZC_V + (n - 1440); if (n < 2464) return ZC_O + (n - 1952); return ZC_G + (n - 2464); } };
struct MapGU { __device__ __forceinline__ int operator()(int n) const { const int up = n >= DFF, j = up ? n - DFF : n; return (j >> 7) * 256 + up * 128 + (j & 127); } };

template <class Map>
__device__ __forceinline__ void transpose_w(const float* W, int K, int N, const float* gain, bf16_t* WT, int ldt, Map map, LAS float* scr, int gw, int ngw, int lane) {
    const int nblk = (N + 31) / 32, nitems = (K / 64) * nblk;
    for (int it = gw; it < nitems; it += ngw) {
        const int kb = it / nblk, nb = it % nblk, k0 = 64 * kb, n0 = 32 * nb;
        { const int nn = n0 + (lane & 31); const bool ok = nn < N; const float* wp = W + (size_t)(k0 + (lane >> 5)) * N + (ok ? nn : 0);
          float v[32];
#pragma unroll
          for (int i = 0; i < 32; ++i) v[i] = wp[(size_t)(2 * i) * N];
          if (gain) {
#pragma unroll
              for (int i = 0; i < 32; ++i) v[i] *= gain[k0 + 2 * i + (lane >> 5)]; }
#pragma unroll
          for (int i = 0; i < 32; ++i) scr[(2 * i + (lane >> 5)) * 33 + (lane & 31)] = ok ? v[i] : 0.f; }
        asm volatile("s_waitcnt lgkmcnt(0)" ::: "memory");
        const int c = lane & 7;
#pragma unroll
        for (int j = 0; j < 4; ++j) { const int n = (lane >> 3) + 8 * j, nn = n0 + n;
            if (nn < N) { const LAS float* s = scr + (8 * c) * 33 + n;
                u32x4 o; o.x = pk2(s[0 * 33], s[1 * 33]); o.y = pk2(s[2 * 33], s[3 * 33]); o.z = pk2(s[4 * 33], s[5 * 33]); o.w = pk2(s[6 * 33], s[7 * 33]);
                *(u32x4*)(WT + (size_t)map(nn) * ldt + k0 + 8 * c) = o; } }
        asm volatile("s_waitcnt lgkmcnt(0)" ::: "memory");
    }
}
__device__ __forceinline__ void rms_row_bf16(const float* xrow, const float* gain, bf16_t* orow, int lane) {
    const f32x4* xr = (const f32x4*)xrow + lane; const f32x4* gr = (const f32x4*)gain + lane;
    f32x4 v[4]; float s = 0.f;
#pragma unroll
    for (int j = 0; j < 4; ++j) { v[j] = xr[64 * j]; s += (v[j][0] * v[j][0] + v[j][1] * v[j][1]) + (v[j][2] * v[j][2] + v[j][3] * v[j][3]); }
    const float r = rsqrtf(wave_sum(s) * (1.0f / DM) + EPS);
    u32x2* o8 = (u32x2*)orow + lane;
#pragma unroll
    for (int j = 0; j < 4; ++j) { const f32x4 gg = gr[64 * j]; u32x2 w; w.x = pk2(v[j][0] * r * gg[0], v[j][1] * r * gg[1]); w.y = pk2(v[j][2] * r * gg[2], v[j][3] * r * gg[3]); o8[64 * j] = w; }
}

__device__ __forceinline__ void phase0(const Params& p, LAS unsigned char* lds) {
    const int tid = threadIdx.x, wid = tid >> 6, lane = tid & 63;
    const int gw = blockIdx.x * NWAVES + wid, ngw = gridDim.x * NWAVES;
    const int gt = blockIdx.x * NTHR + tid, ngt = gridDim.x * NTHR;
    LAS float* scr = (LAS float*)(lds + wid * 16384);
    unsigned char* ws = p.ws;
    transpose_w(p.w_in, DM, INW, nullptr, (bf16_t*)(ws + WS_WIN), DM, MapWin(), scr, gw, ngw, lane);
    transpose_w(p.w_uq, QLORA, MLA_H * DQK, p.q_norm, (bf16_t*)(ws + WS_WUQ), QLORA, MapIdent(), scr, gw, ngw, lane);
    transpose_w(p.w_ukv, KVLORA, MLA_H * (NOPE + VD), p.kv_norm, (bf16_t*)(ws + WS_WUKV), 256, MapIdent(), scr, gw, ngw, lane);
    transpose_w(p.w_out, DM, DM, nullptr, (bf16_t*)(ws + WS_WOUT), DM, MapIdent(), scr, gw, ngw, lane);
    transpose_w(p.w_xq, DM, DM, p.xattn_norm, (bf16_t*)(ws + WS_WXQ), DM, MapIdent(), scr, gw, ngw, lane);
    transpose_w(p.w_xkv, DM, 2 * DM, nullptr, (bf16_t*)(ws + WS_WXKV), DM, MapIdent(), scr, gw, ngw, lane);
    transpose_w(p.w_xo, DM, DM, nullptr, (bf16_t*)(ws + WS_WXO), DM, MapIdent(), scr, gw, ngw, lane);
    transpose_w(p.w_gu, DM, 2 * DFF, p.ffn_norm, (bf16_t*)(ws + WS_WGU), DM, MapGU(), scr, gw, ngw, lane);
    transpose_w(p.w_down, DFF, DM, nullptr, (bf16_t*)(ws + WS_WD), DFF, MapIdent(), scr, gw, ngw, lane);
    { bf16_t* wz = (bf16_t*)(ws + WS_WIN) + (size_t)432 * DM; for (int i = gt; i < 80 * DM / 8; i += ngt) ((u32x4*)wz)[i] = (u32x4){0u, 0u, 0u, 0u};
      bf16_t* wk = (bf16_t*)(ws + WS_WUKV); for (int i = gt; i < 1024 * 16; i += ngt) { const int r = i >> 4, c = i & 15; *(u32x4*)(wk + (size_t)r * 256 + 128 + 8 * c) = (u32x4){0u, 0u, 0u, 0u}; } }
    { float* sm = (float*)(ws + WS_SMALL);
      for (int i = gt; i < SM_END; i += ngt) { float v = 0.f;
          if (i < SM_GBIAS) v = p.conv[i]; else if (i < SM_GBIAS + 16) v = p.gbias[i - SM_GBIAS]; else if (i >= SM_MLN && i < SM_MLN + 512) v = p.ml_norm[i - SM_MLN]; else if (i >= SM_FIN) v = p.final_norm[i - SM_FIN];
          sm[i] = v; } }
    { float* ssq = (float*)(ws + WS_SSQ); for (int i = gt; i < 5 * T; i += ngt) ssq[i] = 0.f; }
    { float* ct = (float*)(ws + WS_COS); float* st = (float*)(ws + WS_SIN);
      for (int i = gt; i < T * 16; i += ngt) { const int row = i >> 4, j = i & 15;
          float inv = 1.0f;
          switch (j) { case 1: inv = 0.5623413251903491f; break; case 2: inv = 0.31622776601683794f; break; case 3: inv = 0.1778279410038923f; break; case 4: inv = 0.1f; break;
                       case 5: inv = 0.05623413251903491f; break; case 6: inv = 0.03162277660168379f; break; case 7: inv = 0.01778279410038923f; break; case 8: inv = 0.01f; break;
                       case 9: inv = 0.005623413251903491f; break; case 10: inv = 0.003162277660168379f; break; case 11: inv = 0.001778279410038923f; break; case 12: inv = 0.001f; break;
                       case 13: inv = 0.0005623413251903491f; break; case 14: inv = 0.00031622776601683794f; break; case 15: inv = 0.0001778279410038923f; break; default: break; }
          const float ang = (float)p.pos[row] * inv; float sn, cs; sincosf(ang, &sn, &cs); ct[i] = cs; st[i] = sn; } }
    for (int r4 = gw * 4; r4 < T; r4 += ngw * 4) {
        f32x4 v[4][4]; float sq[4];
#pragma unroll
        for (int q = 0; q < 4; ++q) { const f32x4* xr = (const f32x4*)(p.x + (size_t)(r4 + q) * DM) + lane;
#pragma unroll
            for (int j = 0; j < 4; ++j) v[q][j] = xr[64 * j]; }
#pragma unroll
        for (int q = 0; q < 4; ++q) { float s_ = 0.f;
#pragma unroll
            for (int j = 0; j < 4; ++j) s_ += (v[q][j][0] * v[q][j][0] + v[q][j][1] * v[q][j][1]) + (v[q][j][2] * v[q][j][2] + v[q][j][3] * v[q][j][3]);
            sq[q] = s_; }
#pragma unroll
        for (int o = 1; o < 64; o <<= 1) {
#pragma unroll
            for (int q = 0; q < 4; ++q) sq[q] += __shfl_xor(sq[q], o); }
        const f32x4* gr = (const f32x4*)p.attn_norm + lane;
#pragma unroll
        for (int q = 0; q < 4; ++q) { const float r_ = rsqrtf(sq[q] * (1.0f / DM) + EPS); u32x2* o8 = (u32x2*)((bf16_t*)(ws + WS_XB) + (size_t)(r4 + q) * DM) + lane;
#pragma unroll
            for (int j = 0; j < 4; ++j) { const f32x4 gg = gr[64 * j]; u32x2 w; w.x = pk2(v[q][j][0] * r_ * gg[0], v[q][j][1] * r_ * gg[1]); w.y = pk2(v[q][j][2] * r_ * gg[2], v[q][j][3] * r_ * gg[3]); o8[64 * j] = w; } }
    }
    for (int r = gw; r < TM; r += ngw) rms_row_bf16(p.mem + (size_t)r * DM, p.mem_norm, (bf16_t*)(ws + WS_MEMN) + (size_t)r * DM, lane);
}

__device__ __forceinline__ void phase_conv(const Params& p) {
    const bf16_t* Z = (const bf16_t*)(p.ws + WS_Z); bf16_t* Q = (bf16_t*)(p.ws + WS_XB); const float* conv = (const float*)(p.ws + WS_SMALL) + SM_CONV;
    const int gt = blockIdx.x * NTHR + threadIdx.x, ngt = gridDim.x * NTHR;
    for (int i = gt; i < T * 128; i += ngt) {
        const int row = i >> 7, c0 = (i & 127) * 8, t = row & (SEQ - 1);
        const bf16x8 zc = *(const bf16x8*)(Z + (size_t)row * LDZ + ZC_QK + c0);
        bf16x8 zp = (bf16x8){0, 0, 0, 0, 0, 0, 0, 0}, zn = zp;
        if (t > 0) zp = *(const bf16x8*)(Z + (size_t)(row - 1) * LDZ + ZC_QK + c0);
        if (t < SEQ - 1) zn = *(const bf16x8*)(Z + (size_t)(row + 1) * LDZ + ZC_QK + c0);
        const float sc = c0 >= 512 ? 0.08838834764831845f : 1.0f;
        float o[8];
#pragma unroll
        for (int j = 0; j < 8; ++j) { const float a = conv[c0 + j] * bf2f((bf16_t)zp[j]) + conv[1024 + c0 + j] * bf2f((bf16_t)zc[j]) + conv[2048 + c0 + j] * bf2f((bf16_t)zn[j]);
            o[j] = a / (1.0f + __expf(-a)) * sc; }
        u32x4 w; w.x = pk2(o[0], o[1]); w.y = pk2(o[2], o[3]); w.z = pk2(o[4], o[5]); w.w = pk2(o[6], o[7]);
        *(u32x4*)(Q + (size_t)row * 1024 + c0) = w;
    }
}

__device__ __forceinline__ void mlstm_naive(const Params& p) {
    const bf16_t* Z = (const bf16_t*)(p.ws + WS_Z); const bf16_t* QKC = (const bf16_t*)(p.ws + WS_XB); const float* G = (const float*)(p.ws + WS_G); const float* gbias = (const float*)(p.ws + WS_SMALL) + SM_GBIAS;
    bf16_t* HF = (bf16_t*)p.out; bf16_t* HB = HF + (size_t)T * ML_W;
    const int tid = threadIdx.x, d = tid >> 2, eq = tid & 3;
    for (int unit = blockIdx.x; unit < BATCH * ML_H * 2; unit += gridDim.x) {
        const int dir = unit & 1, h = (unit >> 1) & 3, b = unit >> 3;
        float C[32], n[32]; float m = 0.f;
#pragma unroll
        for (int j = 0; j < 32; ++j) { C[j] = 0.f; n[j] = 0.f; }
        const float bi = gbias[dir * 8 + h], bff = gbias[dir * 8 + 4 + h];
        bf16_t* Hout = dir ? HB : HF;
        for (int s = 0; s < SEQ; ++s) {
            const int t = dir ? SEQ - 1 - s : s; const size_t row = (size_t)b * SEQ + t;
            const float ip = G[row * 16 + dir * 8 + h] + bi, fp = G[row * 16 + dir * 8 + 4 + h] + bff;
            const float logf = fminf(fp, 0.f) - log1pf(__expf(-fabsf(fp)));
            const float mn = fmaxf(logf + m, ip), fe = __expf(logf + m - mn), ie = __expf(ip - mn);
            m = mn;
            const float vv = bf2f(Z[row * LDZ + ZC_V + h * 128 + d]) * ie;
            float pn = 0.f, pd = 0.f;
#pragma unroll
            for (int c = 0; c < 4; ++c) {
                const bf16x8 q8 = *(const bf16x8*)(QKC + row * 1024 + h * 128 + eq * 32 + c * 8);
                const bf16x8 k8 = *(const bf16x8*)(QKC + row * 1024 + 512 + h * 128 + eq * 32 + c * 8);
#pragma unroll
                for (int j = 0; j < 8; ++j) { const float qq = bf2f((bf16_t)q8[j]), kk = bf2f((bf16_t)k8[j]);
                    C[c * 8 + j] = fe * C[c * 8 + j] + vv * kk; n[c * 8 + j] = fe * n[c * 8 + j] + ie * kk;
                    pn += C[c * 8 + j] * qq; pd += n[c * 8 + j] * qq; }
            }
            pn += __shfl_xor(pn, 1); pn += __shfl_xor(pn, 2); pd += __shfl_xor(pd, 1); pd += __shfl_xor(pd, 2);
            if (eq == 0) Hout[row * ML_W + h * 128 + d] = (bf16_t)f2bf(pn / fmaxf(fabsf(pd), __expf(-mn)));
        }
    }
}
__device__ __forceinline__ void phase_mlfin(const Params& p) {
    const bf16_t* Z = (const bf16_t*)(p.ws + WS_Z); bf16_t* Y = (bf16_t*)(p.ws + WS_Y);
    const bf16_t* HF = (const bf16_t*)p.out; const bf16_t* HB = HF + (size_t)T * ML_W;
    const float* mln = (const float*)(p.ws + WS_SMALL) + SM_MLN;
    const int wid = threadIdx.x >> 6, lane = threadIdx.x & 63;
    const f32x4 g0 = *(const f32x4*)(mln + lane * 8), g1 = *(const f32x4*)(mln + lane * 8 + 4);
    for (int row4 = (blockIdx.x * NWAVES + wid) * 4; row4 < T; row4 += gridDim.x * NWAVES * 4) {
        u32x4 hf[4], hb[4]; bf16x8 zo[4];
#pragma unroll
        for (int q = 0; q < 4; ++q) { const size_t o = (size_t)(row4 + q) * ML_W + lane * 8;
            hf[q] = *(const u32x4*)(HF + o); hb[q] = *(const u32x4*)(HB + o); zo[q] = *(const bf16x8*)(Z + (size_t)(row4 + q) * LDZ + ZC_O + lane * 8); }
#pragma unroll
        for (int q = 0; q < 4; ++q) {
            float a[8];
            a[0] = __uint_as_float(hf[q].x << 16) + __uint_as_float(hb[q].x << 16); a[1] = __uint_as_float(hf[q].x & 0xffff0000u) + __uint_as_float(hb[q].x & 0xffff0000u);
            a[2] = __uint_as_float(hf[q].y << 16) + __uint_as_float(hb[q].y << 16); a[3] = __uint_as_float(hf[q].y & 0xffff0000u) + __uint_as_float(hb[q].y & 0xffff0000u);
            a[4] = __uint_as_float(hf[q].z << 16) + __uint_as_float(hb[q].z << 16); a[5] = __uint_as_float(hf[q].z & 0xffff0000u) + __uint_as_float(hb[q].z & 0xffff0000u);
            a[6] = __uint_as_float(hf[q].w << 16) + __uint_as_float(hb[q].w << 16); a[7] = __uint_as_float(hf[q].w & 0xffff0000u) + __uint_as_float(hb[q].w & 0xffff0000u);
            float s_ = 0.f;
#pragma unroll
            for (int j = 0; j < 8; ++j) s_ += a[j] * a[j];
            s_ += __shfl_xor(s_, 1); s_ += __shfl_xor(s_, 2); s_ += __shfl_xor(s_, 4); s_ += __shfl_xor(s_, 8);
            const float r = rsqrtf(s_ * (1.0f / ML_D) + EPS);
            float ov[8];
#pragma unroll
            for (int j = 0; j < 8; ++j) { const float hv = a[j] * r * (j < 4 ? g0[j] : g1[j - 4]); const float z = bf2f((bf16_t)zo[q][j]); ov[j] = hv * __builtin_amdgcn_rcpf(1.0f + __builtin_amdgcn_exp2f(-1.4426950408889634f * z)); }
            u32x4 w; w.x = pk2(ov[0], ov[1]); w.y = pk2(ov[2], ov[3]); w.z = pk2(ov[4], ov[5]); w.w = pk2(ov[6], ov[7]);
            *(u32x4*)(Y + (size_t)(row4 + q) * DM + 512 + lane * 8) = w;
        }
    }
}

__device__ __forceinline__ void mla_attn_naive(const Params& p, LAS unsigned char* lds) {
    const bf16_t* QALL = (const bf16_t*)(p.ws + WS_QALL); const bf16_t* KV = (const bf16_t*)(p.ws + WS_KV); const bf16_t* KR = (const bf16_t*)(p.ws + WS_KR);
    const float* cosT = (const float*)(p.ws + WS_COS); const float* sinT = (const float*)(p.ws + WS_SIN); bf16_t* Y = (bf16_t*)(p.ws + WS_Y);
    const int wid = threadIdx.x >> 6, lane = threadIdx.x & 63;
    LAS float* sc = (LAS float*)(lds + wid * 16384);
    LAS float* qs = (LAS float*)(lds + 131072 + wid * 512);
    const float scale = 0.10206207261596575f;
    for (int item = blockIdx.x * NWAVES + wid; item < T * MLA_H; item += gridDim.x * NWAVES) {
        const int h = item & 7, row = item >> 3, b = row / SEQ;
        for (int dd = lane; dd < DQK; dd += 64) {
            float v = bf2f(QALL[(size_t)row * 768 + h * DQK + dd]);
            if (dd >= NOPE) { const int j = (dd - NOPE) & 15; const float c = cosT[(size_t)row * 16 + j], s = sinT[(size_t)row * 16 + j];
                const float other = bf2f(QALL[(size_t)row * 768 + h * DQK + (dd < NOPE + 16 ? dd + 16 : dd - 16)]);
                v = dd < NOPE + 16 ? v * c - other * s : v * c + other * s; }
            qs[dd] = v * scale;
        }
        asm volatile("s_waitcnt lgkmcnt(0)" ::: "memory");
        float mx = -1e30f;
        for (int k0 = 0; k0 < SEQ; k0 += 64) {
            const size_t kr = (size_t)b * SEQ + k0 + lane; float s = 0.f;
#pragma unroll
            for (int c = 0; c < 8; ++c) { const bf16x8 k8 = *(const bf16x8*)(KV + kr * 1024 + h * 128 + c * 8);
#pragma unroll
                for (int j = 0; j < 8; ++j) s += qs[c * 8 + j] * bf2f((bf16_t)k8[j]); }
#pragma unroll
            for (int c = 0; c < 4; ++c) { const bf16x8 k8 = *(const bf16x8*)(KR + kr * 32 + c * 8);
#pragma unroll
                for (int j = 0; j < 8; ++j) s += qs[NOPE + c * 8 + j] * bf2f((bf16_t)k8[j]); }
            sc[k0 + lane] = s; mx = fmaxf(mx, s);
        }
        mx = wave_max(mx);
        float l = 0.f;
        for (int k0 = 0; k0 < SEQ; k0 += 64) { const float e = __expf(sc[k0 + lane] - mx); sc[k0 + lane] = e; l += e; }
        l = wave_sum(l);
        asm volatile("s_waitcnt lgkmcnt(0)" ::: "memory");
        float o = 0.f;
        for (int k = 0; k < SEQ; ++k) o += sc[k] * bf2f(KV[((size_t)b * SEQ + k) * 1024 + h * 128 + 64 + lane]);
        Y[(size_t)row * DM + h * VD + lane] = (bf16_t)f2bf(o / l);
        asm volatile("s_waitcnt lgkmcnt(0)" ::: "memory");
    }
}
__device__ __forceinline__ void x_attn_naive(const Params& p, LAS unsigned char* lds) {
    const bf16_t* HQ = (const bf16_t*)(p.ws + WS_HQ); const bf16_t* KVM = (const bf16_t*)(p.ws + WS_KVM); bf16_t* OX = (bf16_t*)(p.ws + WS_OX);
    const int wid = threadIdx.x >> 6, lane = threadIdx.x & 63;
    LAS float* sc = (LAS float*)(lds + wid * 16384);
    LAS float* qs = (LAS float*)(lds + 131072 + wid * 1024);
    for (int item = blockIdx.x * NWAVES + wid; item < T * XH; item += gridDim.x * NWAVES) {
        const int h = item & 3, row = item >> 2, b = row / SEQ;
        for (int dd = lane; dd < XD; dd += 64) qs[dd] = bf2f(HQ[(size_t)row * DM + h * XD + dd]) * 0.0625f;
        asm volatile("s_waitcnt lgkmcnt(0)" ::: "memory");
        float mx = -1e30f;
        for (int k0 = 0; k0 < NMEM; k0 += 64) {
            const size_t kr = (size_t)b * NMEM + k0 + lane; float s = 0.f;
            for (int c = 0; c < 32; ++c) { const bf16x8 k8 = *(const bf16x8*)(KVM + kr * 2048 + h * XD + c * 8);
#pragma unroll
                for (int j = 0; j < 8; ++j) s += qs[c * 8 + j] * bf2f((bf16_t)k8[j]); }
            sc[k0 + lane] = s; mx = fmaxf(mx, s);
        }
        mx = wave_max(mx);
        float l = 0.f;
        for (int k0 = 0; k0 < NMEM; k0 += 64) { const float e = __expf(sc[k0 + lane] - mx); sc[k0 + lane] = e; l += e; }
        l = wave_sum(l);
        asm volatile("s_waitcnt lgkmcnt(0)" ::: "memory");
        float o[4] = {0.f, 0.f, 0.f, 0.f};
        for (int k = 0; k < NMEM; ++k) { const u32x2 v4 = *(const u32x2*)(KVM + ((size_t)b * NMEM + k) * 2048 + 1024 + h * XD + 4 * lane); const float pk = sc[k];
            o[0] += pk * __uint_as_float(v4.x << 16); o[1] += pk * __uint_as_float(v4.x & 0xffff0000u); o[2] += pk * __uint_as_float(v4.y << 16); o[3] += pk * __uint_as_float(v4.y & 0xffff0000u); }
        const float rl = 1.0f / l; u32x2 w; w.x = pk2(o[0] * rl, o[1] * rl); w.y = pk2(o[2] * rl, o[3] * rl);
        *(u32x2*)(OX + (size_t)row * DM + h * XD + 4 * lane) = w;
        asm volatile("s_waitcnt lgkmcnt(0)" ::: "memory");
    }
}

namespace fa {
using f32x16 = __attribute__((ext_vector_type(16))) float;
using s16x4  = __attribute__((ext_vector_type(4))) short;
typedef float f32x2_t __attribute__((ext_vector_type(2))); typedef __bf16 bf16x2_t __attribute__((ext_vector_type(2)));
#define FA_SBAR() __builtin_amdgcn_sched_barrier(0)
constexpr float THRL = 11.0f;
__device__ __forceinline__ int crow(int r, int hi) { return (r & 3) + 8 * (r >> 2) + 4 * hi; }
__device__ __forceinline__ unsigned cvtpk(float lo, float hi) { unsigned r; asm volatile("v_cvt_pk_bf16_f32 %0, %1, %2" : "=v"(r) : "v"(lo), "v"(hi)); return r; }
__device__ __forceinline__ unsigned cvtpk_s(float lo, float hi) { f32x2_t v = {lo, hi}; bf16x2_t b = __builtin_convertvector(v, bf16x2_t); return __builtin_bit_cast(unsigned, b); }
#define FA_MX3(a, b, c) __builtin_fmaxf(__builtin_fmaxf((a), (b)), (c))
__device__ __forceinline__ float rowmax32(const f32x16& p0, const f32x16& p1) {
    float a = FA_MX3(p0[0], p0[1], p1[0]), b = FA_MX3(p0[2], p0[3], p1[1]); a = FA_MX3(a, p1[2], p1[3]);
#pragma unroll
    for (int r = 4; r < 16; r += 4) { a = FA_MX3(a, p0[r], p0[r + 1]); b = FA_MX3(b, p0[r + 2], p0[r + 3]); a = FA_MX3(a, p1[r], p1[r + 1]); b = FA_MX3(b, p1[r + 2], p1[r + 3]); }
    float rm = __builtin_fmaxf(a, b);
    auto rr = __builtin_amdgcn_permlane32_swap(__float_as_uint(rm), __float_as_uint(rm), false, false);
    return __builtin_fmaxf(__uint_as_float(rr[0]), __uint_as_float(rr[1]));
}
template <bool FIRST>
__device__ __forceinline__ void smA(f32x16& p0, f32x16& p1, float& mref, f32x16& negm, LAS float* fl, int r32, int hi, bool& resc, float& fself) {
    const float rm = rowmax32(p0, p1);
    resc = false; fself = 1.f;
    if (FIRST || __builtin_expect(__any(rm > THRL), 0)) {
        const float dl = FIRST ? rm : __builtin_fmaxf(rm, 0.f);
        mref += dl;
#pragma unroll
        for (int r = 0; r < 16; ++r) { p0[r] -= dl; p1[r] -= dl; }
#pragma unroll
        for (int r = 0; r < 16; ++r) negm[r] = -mref;
        if (!FIRST) { fself = __builtin_amdgcn_exp2f(-dl); if (hi == 0) fl[r32] = fself; resc = true; }
    }
#pragma unroll
    for (int r = 0; r < 16; ++r) p0[r] = __builtin_amdgcn_exp2f(p0[r]);
}
__device__ __forceinline__ void smB(const f32x16& p0, f32x16& p1, bf16x8& pa0, bf16x8& pa1, bf16x8& pa2, bf16x8& pa3) {
#pragma unroll
    for (int r = 0; r < 16; ++r) p1[r] = __builtin_amdgcn_exp2f(p1[r]);
#define FA_PKD(P, B, OUT) do { u32x4 w_ = {cvtpk_s(P[B], P[B + 1]), cvtpk_s(P[B + 2], P[B + 3]), cvtpk_s(P[B + 4], P[B + 5]), cvtpk_s(P[B + 6], P[B + 7])}; OUT = __builtin_bit_cast(bf16x8, w_); } while (0)
    FA_PKD(p0, 0, pa0); FA_PKD(p0, 8, pa1); FA_PKD(p1, 0, pa2); FA_PKD(p1, 8, pa3);
#undef FA_PKD
}
template <int NDQ, int KP>
__device__ __forceinline__ void qkt(f32x16& p0, f32x16& p1, const LAS unsigned char* Ks, const bf16x8* qr, const f32x16& negm, int r32, int hi) {
#pragma unroll
    for (int d0 = 0; d0 < NDQ; ++d0) { const int cb = (d0 * 16 + hi * 8) * 2;
        const bf16x8 b0 = *(const LAS bf16x8*)(Ks + r32 * KP + cb);
        const bf16x8 b1 = *(const LAS bf16x8*)(Ks + (32 + r32) * KP + cb);
        if (d0 == 0) { p0 = __builtin_amdgcn_mfma_f32_32x32x16_bf16(b0, qr[0], negm, 0, 0, 0); p1 = __builtin_amdgcn_mfma_f32_32x32x16_bf16(b1, qr[0], negm, 0, 0, 0); }
        else { p0 = __builtin_amdgcn_mfma_f32_32x32x16_bf16(b0, qr[d0], p0, 0, 0, 0); p1 = __builtin_amdgcn_mfma_f32_32x32x16_bf16(b1, qr[d0], p1, 0, 0, 0); } }
}
template <int NDV> __device__ __forceinline__ int v_st(int k, int c) { const int kk = (k & ~0xC) | ((k & 4) << 1) | ((k & 8) >> 1); return ((kk >> 3) * NDV + (c >> 5)) * 512 + ((kk & 7) * 32 + (c & 31)) * 2; }
template <int NDV> __device__ __forceinline__ int v_stp(int k, int c) { return ((k >> 3) * NDV + (c >> 5)) * 512 + ((k & 7) * 32 + (c & 31)) * 2; }
__device__ __forceinline__ int v_rd_base(int lane) { return ((lane & 3) << 3) | (((lane >> 2) & 3) << 6) | (((lane >> 4) & 1) << 5) | (((lane >> 5) & 1) << 8); }
template <int OFF> __device__ __forceinline__ s16x4 tr_read(int vb) { s16x4 r; asm volatile("ds_read_b64_tr_b16 %0, %1 offset:%2" : "=&v"(r) : "v"(vb), "i"(OFF) : "memory"); return r; }
template <int NDV, int D0> __device__ __forceinline__ void pv_one(f32x16& od, int vb, bf16x8 pa0, bf16x8 pa1, bf16x8 pa2, bf16x8 pa3) {
    constexpr int KS = 2 * NDV * 512, HF = NDV * 512, B0 = D0 * 512;
    const s16x4 l0 = tr_read<B0>(vb), h0 = tr_read<B0 + HF>(vb), l1 = tr_read<B0 + KS>(vb), h1 = tr_read<B0 + KS + HF>(vb);
    const s16x4 l2 = tr_read<B0 + 2 * KS>(vb), h2 = tr_read<B0 + 2 * KS + HF>(vb), l3 = tr_read<B0 + 3 * KS>(vb), h3 = tr_read<B0 + 3 * KS + HF>(vb);
    asm volatile("s_waitcnt lgkmcnt(0)" ::: "memory"); FA_SBAR();
#define FA_PK(L, H) (bf16x8){L[0], L[1], L[2], L[3], H[0], H[1], H[2], H[3]}
    od = __builtin_amdgcn_mfma_f32_32x32x16_bf16(pa0, FA_PK(l0, h0), od, 0, 0, 0);
    od = __builtin_amdgcn_mfma_f32_32x32x16_bf16(pa1, FA_PK(l1, h1), od, 0, 0, 0);
    od = __builtin_amdgcn_mfma_f32_32x32x16_bf16(pa2, FA_PK(l2, h2), od, 0, 0, 0);
    od = __builtin_amdgcn_mfma_f32_32x32x16_bf16(pa3, FA_PK(l3, h3), od, 0, 0, 0);
#undef FA_PK
}
__device__ __forceinline__ void pl_ones(f32x16& lacc, bf16x8 pa0, bf16x8 pa1, bf16x8 pa2, bf16x8 pa3) {
    const bf16x8 one = (bf16x8){0x3F80, 0x3F80, 0x3F80, 0x3F80, 0x3F80, 0x3F80, 0x3F80, 0x3F80};
    lacc = __builtin_amdgcn_mfma_f32_32x32x16_bf16(pa0, one, lacc, 0, 0, 0); lacc = __builtin_amdgcn_mfma_f32_32x32x16_bf16(pa1, one, lacc, 0, 0, 0);
    lacc = __builtin_amdgcn_mfma_f32_32x32x16_bf16(pa2, one, lacc, 0, 0, 0); lacc = __builtin_amdgcn_mfma_f32_32x32x16_bf16(pa3, one, lacc, 0, 0, 0);
}
__device__ __forceinline__ bf16x8 cvt8(const float* v) { u32x4 w = {cvtpk(v[0], v[1]), cvtpk(v[2], v[3]), cvtpk(v[4], v[5]), cvtpk(v[6], v[7])}; return *reinterpret_cast<bf16x8*>(&w); }

constexpr int MLA_KP = 208, MLA_SHM_K = 64 * MLA_KP, MLA_SHM_V = 64 * 64 * 2, MLA_WS = 3 * MLA_SHM_V + 3 * MLA_SHM_K;
__device__ __forceinline__ void mla_unit(int b, int h, int qb, const bf16_t* __restrict__ QALL, const bf16_t* __restrict__ KV, const bf16_t* __restrict__ KR,
                                         const float* __restrict__ cosT, const float* __restrict__ sinT, bf16_t* __restrict__ Y, LAS unsigned char* lds) {
    const int tid = threadIdx.x, wid = tid >> 6, lane = tid & 63, r32 = lane & 31, hi = lane >> 5;
    LAS unsigned char* V_lds = lds; LAS unsigned char* K_lds = lds + 3 * MLA_SHM_V;
    LAS float* fl = (LAS float*)(lds + MLA_WS) + wid * 32;
    float mref = 0.f; f32x16 o[2] = {}; f32x16 lacc = {}; f32x16 negm = {}; bf16x8 qr[6];
    const size_t rowb = (size_t)b * SEQ;
    {
        const size_t qrow = rowb + qb * 256 + wid * 32 + r32;
        const bf16_t* Qw = QALL + qrow * 768 + h * 96 + hi * 8;
        const float C = 0.10206207261596575f * 1.4426950408889634f;
        float x1[8], x2[8];
#pragma unroll
        for (int d0 = 0; d0 < 6; ++d0) { const bf16x8 raw = *(const bf16x8*)(Qw + d0 * 16); float v[8];
#pragma unroll
            for (int j = 0; j < 8; ++j) v[j] = bf2f((bf16_t)raw[j]);
            if (d0 < 4) {
#pragma unroll
                for (int j = 0; j < 8; ++j) v[j] *= C;
                qr[d0] = cvt8(v); }
            else if (d0 == 4) {
#pragma unroll
                for (int j = 0; j < 8; ++j) x1[j] = v[j]; }
            else {
#pragma unroll
                for (int j = 0; j < 8; ++j) x2[j] = v[j]; } }
        float o1[8], o2[8];
#pragma unroll
        for (int j = 0; j < 8; ++j) { const float c = cosT[qrow * 16 + hi * 8 + j], s = sinT[qrow * 16 + hi * 8 + j]; o1[j] = (x1[j] * c - x2[j] * s) * C; o2[j] = (x2[j] * c + x1[j] * s) * C; }
        qr[4] = cvt8(o1); qr[5] = cvt8(o2);
    }
    const int sr = tid >> 3, scn = tid & 7, rr = (tid & 255) >> 2, rc = tid & 3;
    const bf16_t* gkn = KV + (rowb + sr) * 1024 + h * 128 + scn * 8;
    const bf16_t* gv = gkn + 64;
    const bf16_t* gkr = KR + (rowb + rr) * 32 + rc * 8;
    const int okn = sr * MLA_KP + scn * 16, okr = rr * MLA_KP + 128 + rc * 16, ov = v_stp<2>(sr, scn * 8);
    const int vb0 = (int)(unsigned)(uintptr_t)V_lds + v_rd_base(lane);
    bf16x8 s_kn, s_kr, s_v;
#define FA_SLOAD(k0) do { s_v = *(const bf16x8*)(gv + (size_t)(k0) * 1024); s_kn = *(const bf16x8*)(gkn + (size_t)(k0) * 1024); s_kr = *(const bf16x8*)(gkr + (size_t)(k0) * 32); } while (0)
#define FA_SWRITE(sl) do { *(LAS bf16x8*)(V_lds + (sl) * MLA_SHM_V + ov) = s_v; *(LAS bf16x8*)(K_lds + (sl) * MLA_SHM_K + okn) = s_kn; *(LAS bf16x8*)(K_lds + (sl) * MLA_SHM_K + okr) = s_kr; } while (0)
#define FA_RESC(f) do { if (f) { asm volatile("s_waitcnt lgkmcnt(0)" ::: "memory"); \
    _Pragma("unroll") for (int r = 0; r < 16; ++r) { const float f_ = fl[crow(r, hi)]; o[0][r] *= f_; o[1][r] *= f_; lacc[r] *= f_; } } } while (0)
#define FA_PV(vbx) do { pv_one<2, 0>(o[0], (vbx), pa0, pa1, pa2, pa3); pv_one<2, 1>(o[1], (vbx), pa0, pa1, pa2, pa3); pl_ones(lacc, pa0, pa1, pa2, pa3); } while (0)
#define FA_ROT() do { const int t_ = sp; sp = sc; sc = sn; sn = t_; } while (0)
    f32x16 pA0, pA1, pB0, pB1; bool rsA, rsB; float fdum; bf16x8 pa0, pa1, pa2, pa3; constexpr int NT = SEQ / 64;
    int sp = 2, sc = 0, sn = 1;
    FA_SLOAD(0); FA_SWRITE(0); FA_SLOAD(64); __syncthreads();
    FA_SWRITE(1); FA_SLOAD(128);
    qkt<6, MLA_KP>(pA0, pA1, K_lds, qr, negm, r32, hi); smA<true>(pA0, pA1, mref, negm, fl, r32, hi, rsA, fdum);
    __syncthreads(); FA_ROT();
    for (int j = 1; j + 1 < NT; j += 2) {
        FA_SWRITE(sn); FA_SLOAD((j + 2) * 64);
        FA_SBAR(); qkt<6, MLA_KP>(pB0, pB1, K_lds + sc * MLA_SHM_K, qr, negm, r32, hi);
        smB(pA0, pA1, pa0, pa1, pa2, pa3); FA_SBAR();
        FA_PV(vb0 + sp * MLA_SHM_V); smA<false>(pB0, pB1, mref, negm, fl, r32, hi, rsB, fdum);
        FA_RESC(rsB);
        __syncthreads(); FA_ROT();
        FA_SWRITE(sn); if (j + 3 < NT) FA_SLOAD((j + 3) * 64);
        FA_SBAR(); qkt<6, MLA_KP>(pA0, pA1, K_lds + sc * MLA_SHM_K, qr, negm, r32, hi);
        smB(pB0, pB1, pa0, pa1, pa2, pa3); FA_SBAR();
        FA_PV(vb0 + sp * MLA_SHM_V); smA<false>(pA0, pA1, mref, negm, fl, r32, hi, rsA, fdum);
        FA_RESC(rsA);
        __syncthreads(); FA_ROT();
    }
    FA_SBAR(); qkt<6, MLA_KP>(pB0, pB1, K_lds + sc * MLA_SHM_K, qr, negm, r32, hi);
    smB(pA0, pA1, pa0, pa1, pa2, pa3); FA_SBAR();
    FA_PV(vb0 + sp * MLA_SHM_V); smA<false>(pB0, pB1, mref, negm, fl, r32, hi, rsB, fdum);
    FA_RESC(rsB);
    smB(pB0, pB1, pa0, pa1, pa2, pa3); FA_SBAR();
    FA_PV(vb0 + sc * MLA_SHM_V);
    bf16_t* Yw = Y + (rowb + qb * 256 + wid * 32) * DM + h * 64 + r32;
#pragma unroll
    for (int r = 0; r < 16; ++r) { const int orow = crow(r, hi); const float rl = __builtin_amdgcn_rcpf(lacc[r]);
        Yw[(size_t)orow * DM] = (bf16_t)f2bf(o[0][r] * rl); Yw[(size_t)orow * DM + 32] = (bf16_t)f2bf(o[1][r] * rl); }
    __syncthreads();
#undef FA_SLOAD
#undef FA_SWRITE
#undef FA_RESC
#undef FA_PV
#undef FA_ROT
}

__device__ __forceinline__ void partialSM_o(f32x16& p0, f32x16& p1, float& m_reg, float& mn, float& alpha) {
    float pmax = p0[0];
#pragma unroll
    for (int r = 1; r < 16; ++r) pmax = fmaxf(pmax, p0[r]);
#pragma unroll
    for (int r = 0; r < 16; ++r) pmax = fmaxf(pmax, p1[r]);
    { auto rr = __builtin_amdgcn_permlane32_swap(__float_as_uint(pmax), __float_as_uint(pmax), false, false);
      pmax = fmaxf(__uint_as_float(rr[0]), __uint_as_float(rr[1])); }
    if (__builtin_expect(__all(pmax - m_reg <= THRL), 1)) { mn = m_reg; alpha = 1.f; }
    else { mn = fmaxf(m_reg, pmax); alpha = __builtin_amdgcn_exp2f(m_reg - mn); m_reg = mn; }
#pragma unroll
    for (int r = 0; r < 16; ++r) { p0[r] -= mn; p1[r] -= mn; }
#pragma unroll
    for (int r = 0; r < 16; ++r) p0[r] = __builtin_amdgcn_exp2f(p0[r]);
}
__device__ __forceinline__ void finishSM_o(f32x16& p0, f32x16& p1, float alpha, float& l_reg, bf16x8& pa0, bf16x8& pa1, bf16x8& pa2, bf16x8& pa3) {
#pragma unroll
    for (int r = 0; r < 16; ++r) p1[r] = __builtin_amdgcn_exp2f(p1[r]);
    float ps = 0;
#pragma unroll
    for (int r = 0; r < 16; ++r) ps += p0[r];
#pragma unroll
    for (int r = 0; r < 16; ++r) ps += p1[r];
    { auto rr = __builtin_amdgcn_permlane32_swap(__float_as_uint(ps), __float_as_uint(ps), false, false);
      ps = __uint_as_float(rr[0]) + __uint_as_float(rr[1]); }
    l_reg = l_reg * alpha + ps;
#define FA_PK4(P, BASE, OUT) do { unsigned a0 = cvtpk(P[BASE + 0], P[BASE + 1]), a1 = cvtpk(P[BASE + 2], P[BASE + 3]);   \
    unsigned b0 = cvtpk(P[BASE + 4], P[BASE + 5]), b1 = cvtpk(P[BASE + 6], P[BASE + 7]);                              \
    auto r0 = __builtin_amdgcn_permlane32_swap(a0, b0, false, false); auto r1 = __builtin_amdgcn_permlane32_swap(a1, b1, false, false); \
    u32x4 w = {r0[0], r1[0], r0[1], r1[1]}; OUT = *reinterpret_cast<bf16x8*>(&w); } while (0)
    FA_PK4(p0, 0, pa0); FA_PK4(p0, 8, pa1); FA_PK4(p1, 0, pa2); FA_PK4(p1, 8, pa3);
#undef FA_PK4
}
template <int NDQ, int KP>
__device__ __forceinline__ void qkt_o(f32x16& p0, f32x16& p1, const LAS unsigned char* Ks, const bf16x8* qr, int r32, int hi) {
    p0 = f32x16{}; p1 = f32x16{};
#pragma unroll
    for (int d0 = 0; d0 < NDQ; ++d0) { const int cb = (d0 * 16 + hi * 8) * 2;
        const bf16x8 b0 = *(const LAS bf16x8*)(Ks + r32 * KP + cb);
        const bf16x8 b1 = *(const LAS bf16x8*)(Ks + (32 + r32) * KP + cb);
        p0 = __builtin_amdgcn_mfma_f32_32x32x16_bf16(b0, qr[d0], p0, 0, 0, 0);
        p1 = __builtin_amdgcn_mfma_f32_32x32x16_bf16(b1, qr[d0], p1, 0, 0, 0);
        if ((d0 & 3) == 3) __builtin_amdgcn_sched_barrier(0); }
}
constexpr int XA_KP = 528, XA_SHM_K = 64 * XA_KP, XA_SHM_V = 64 * 128 * 2;
__device__ __forceinline__ void xattn_unit(int b, int h, int qb, const bf16_t* __restrict__ HQ, const bf16_t* __restrict__ KVM, bf16_t* __restrict__ OX, LAS unsigned char* lds) {
    const int tid = threadIdx.x, wid = tid >> 6, lane = tid & 63, r32 = lane & 31, hi = lane >> 5;
    LAS unsigned char* K_lds = lds; LAS unsigned char* V_lds = lds + XA_SHM_K;
    LAS float* fl = (LAS float*)(lds + XA_SHM_K + XA_SHM_V) + wid * 32;
    const size_t qrow0 = (size_t)b * SEQ + qb * 256 + wid * 32;
    const int ksr = tid >> 5, ksc = tid & 31;
    const bf16_t* gk = KVM + ((size_t)b * NMEM + ksr) * 2048 + h * 256 + ksc * 8;
    u32x4 pw[4][4];
    float mt[4], l_reg = 0.f, lt[4];
    {
        bf16x8 qr[16];
        { const bf16_t* Qw = HQ + (qrow0 + r32) * DM + h * 256 + hi * 8; const float C = 0.0625f * 1.4426950408889634f;
#pragma unroll
          for (int d0 = 0; d0 < 16; ++d0) { const bf16x8 raw = *(const bf16x8*)(Qw + d0 * 16); float v[8];
#pragma unroll
              for (int j = 0; j < 8; ++j) v[j] = bf2f((bf16_t)raw[j]) * C;
              qr[d0] = cvt8(v); } }
        bf16x8 sk[4];
#define XA_KLOAD(k0) do { _Pragma("unroll") for (int i = 0; i < 4; ++i) sk[i] = *(const bf16x8*)(gk + (size_t)((k0) + 16 * i) * 2048); } while (0)
#define XA_KWRITE() do { _Pragma("unroll") for (int i = 0; i < 4; ++i) *(LAS bf16x8*)(K_lds + (ksr + 16 * i) * XA_KP + ksc * 16) = sk[i]; } while (0)
        float m_run = -3.0e38f;
        XA_KLOAD(0);
#pragma unroll
        for (int t = 0; t < 4; ++t) {
            __syncthreads(); XA_KWRITE(); __syncthreads();
            if (t < 3) XA_KLOAD((t + 1) * 64);
            f32x16 p0, p1;
            qkt_o<16, XA_KP>(p0, p1, K_lds, qr, r32, hi);
            m_run = __builtin_fmaxf(m_run, rowmax32(p0, p1)); mt[t] = m_run;
            float ps = 0.f;
#pragma unroll
            for (int r = 0; r < 16; ++r) { p0[r] = __builtin_amdgcn_exp2f(p0[r] - m_run); p1[r] = __builtin_amdgcn_exp2f(p1[r] - m_run); ps += p0[r] + p1[r]; }
            { auto rr = __builtin_amdgcn_permlane32_swap(__float_as_uint(ps), __float_as_uint(ps), false, false); lt[t] = __uint_as_float(rr[0]) + __uint_as_float(rr[1]); }
            pw[t][0] = (u32x4){cvtpk_s(p0[0], p0[1]), cvtpk_s(p0[2], p0[3]), cvtpk_s(p0[4], p0[5]), cvtpk_s(p0[6], p0[7])};
            pw[t][1] = (u32x4){cvtpk_s(p0[8], p0[9]), cvtpk_s(p0[10], p0[11]), cvtpk_s(p0[12], p0[13]), cvtpk_s(p0[14], p0[15])};
            pw[t][2] = (u32x4){cvtpk_s(p1[0], p1[1]), cvtpk_s(p1[2], p1[3]), cvtpk_s(p1[4], p1[5]), cvtpk_s(p1[6], p1[7])};
            pw[t][3] = (u32x4){cvtpk_s(p1[8], p1[9]), cvtpk_s(p1[10], p1[11]), cvtpk_s(p1[12], p1[13]), cvtpk_s(p1[14], p1[15])};
        }
#undef XA_KLOAD
#undef XA_KWRITE
    }
#pragma unroll
    for (int t = 0; t < 4; ++t) {
        const float c = __builtin_amdgcn_exp2f(mt[t] - mt[3]);
        l_reg += c * lt[t];
        if (t < 3) {
#pragma unroll
            for (int k = 0; k < 4; ++k)
#pragma unroll
                for (int q = 0; q < 4; ++q) { const unsigned w = pw[t][k][q]; pw[t][k][q] = cvtpk_s(__uint_as_float(w << 16) * c, __uint_as_float(w & 0xffff0000u) * c); }
        }
    }
    if (hi == 0) fl[r32] = l_reg;
    int tid2 = tid; asm volatile("" : "+v"(tid2));
    const int vsr = tid2 >> 4, vsc = tid2 & 15, lane2 = tid2 & 63;
    const bf16_t* gv = KVM + ((size_t)b * NMEM + vsr) * 2048 + 1024 + h * 256 + vsc * 8;
    const int vb0 = (int)(unsigned)(uintptr_t)V_lds + v_rd_base(lane2);
    bf16x8 sv[2];
#define XA_VLOAD(t, vh) do { _Pragma("unroll") for (int i = 0; i < 2; ++i) sv[i] = *(const bf16x8*)(gv + (size_t)((t) * 64 + 32 * i) * 2048 + (vh) * 128); } while (0)
#define XA_VWRITE() do { _Pragma("unroll") for (int i = 0; i < 2; ++i) *(LAS bf16x8*)(V_lds + v_stp<4>(vsr + 32 * i, vsc * 8)) = sv[i]; } while (0)
    XA_VLOAD(0, 0);
#pragma unroll
    for (int vh = 0; vh < 2; ++vh) {
        f32x16 o[4] = {};
#pragma unroll
        for (int t = 0; t < 4; ++t) {
            __syncthreads(); XA_VWRITE(); __syncthreads();
            if (t < 3) XA_VLOAD(t + 1, vh); else if (vh == 0) XA_VLOAD(0, 1);
            const bf16x8 pa0 = __builtin_bit_cast(bf16x8, pw[t][0]), pa1 = __builtin_bit_cast(bf16x8, pw[t][1]), pa2 = __builtin_bit_cast(bf16x8, pw[t][2]), pa3 = __builtin_bit_cast(bf16x8, pw[t][3]);
            pv_one<4, 0>(o[0], vb0, pa0, pa1, pa2, pa3); pv_one<4, 1>(o[1], vb0, pa0, pa1, pa2, pa3); pv_one<4, 2>(o[2], vb0, pa0, pa1, pa2, pa3); pv_one<4, 3>(o[3], vb0, pa0, pa1, pa2, pa3);
        }
        asm volatile("s_waitcnt lgkmcnt(0)" ::: "memory");
        const int r32b = lane2 & 31, hib = lane2 >> 5;
        bf16_t* Ow = OX + ((size_t)b * SEQ + qb * 256 + (tid2 >> 6) * 32) * DM + h * 256 + vh * 128 + r32b;
#pragma unroll
        for (int r = 0; r < 16; ++r) { const int orow = crow(r, hib); const float rl = __builtin_amdgcn_rcpf(fl[orow]);
#pragma unroll
            for (int d0 = 0; d0 < 4; ++d0) Ow[(size_t)orow * DM + d0 * 32] = (bf16_t)f2bf(o[d0][r] * rl); }
    }
#undef XA_VLOAD
#undef XA_VWRITE
    __syncthreads();
}
}

namespace ml {
using fa::f32x16; using fa::s16x4; using fa::crow; using fa::cvtpk_s; using fa::tr_read; using fa::v_rd_base;
constexpr int RP = 272;
constexpr int L_Q = 0, L_K = 128 * RP, L_KW = 2 * 128 * RP, L_V = L_KW + 32768, L_C = L_V + 8192, L_ARR = L_C + 32 * RP, L_PART = L_ARR + 10240, L_END = L_PART + 16384;
static_assert(L_END <= 147200, "mLSTM LDS map");
constexpr int A_U2 = 0, A_MM2 = 128, A_A = 256, A_NEGM2 = 384, A_EW = 512, A_N = 640, A_RD = 768, A_DS1 = 896, A_NQ = 1024, A_NLP = 1152  , A_BL = 2176  , A_MALL = 2208  , A_MP = 2240  , A_SC = 2280;
constexpr float LOG2E = 1.4426950408889634f;
constexpr size_t GT_UNIT = 32 * 3 * 128;
#define ML_PK(L, H) (bf16x8){L[0], L[1], L[2], L[3], H[0], H[1], H[2], H[3]}
__device__ __forceinline__ float psum32(float v) { auto rr = __builtin_amdgcn_permlane32_swap(__float_as_uint(v), __float_as_uint(v), false, false); return __uint_as_float(rr[0]) + __uint_as_float(rr[1]); }

__device__ __forceinline__ void unit(int b, int h, int dir, int dq, const bf16_t* __restrict__ QKC, const bf16_t* __restrict__ Z, const float* __restrict__ G, const float* __restrict__ gbias,
                                     bf16_t* __restrict__ Hout, float* __restrict__ GT, LAS unsigned char* lds) {
    const int tid0 = threadIdx.x, wid = __builtin_amdgcn_readfirstlane(tid0 >> 6);
    int tid = tid0;
    LAS float* arr = (LAS float*)(lds + L_ARR);
    const float bias_i = gbias[dir * 8 + h], bias_f = gbias[dir * 8 + 4 + h];
    const size_t seqb = (size_t)b * SEQ;
    for (int i = tid; i < 32 * RP / 4; i += NTHR) ((LAS unsigned*)(lds + L_C))[i] = 0u;
    if (tid < 128) arr[A_N + tid] = 0.f;
    {   const int lane = tid & 63;
        for (int cc = wid; cc < SEQ / 128; cc += NWAVES) {
            const size_t row0 = seqb + (dir ? SEQ - 128 * (cc + 1) : 128 * cc);
            const int i0 = dir ? 127 - 2 * lane : 2 * lane, i1 = dir ? 126 - 2 * lane : 2 * lane + 1;
            const float f0 = G[(row0 + i0) * 16 + dir * 8 + 4 + h] + bias_f, f1 = G[(row0 + i1) * 16 + dir * 8 + 4 + h] + bias_f;
            const float g0 = G[(row0 + i0) * 16 + dir * 8 + h] + bias_i, g1 = G[(row0 + i1) * 16 + dir * 8 + h] + bias_i;
            const float lf0 = fminf(f0, 0.f) - log1pf(__expf(-fabsf(f0))), lf1 = fminf(f1, 0.f) - log1pf(__expf(-fabsf(f1)));
            float P = lf0 + lf1;
#pragma unroll
            for (int o = 1; o < 64; o <<= 1) { const float t_ = __shfl_up(P, o); if (lane >= o) P += t_; }
            const float b1 = P, b0 = P - lf1;
            const float u0 = g0 - b0, u1 = g1 - b1;
            float Pm = fmaxf(u0, u1);
#pragma unroll
            for (int o = 1; o < 64; o <<= 1) { const float t_ = __shfl_up(Pm, o); if (lane >= o) Pm = fmaxf(Pm, t_); }
            float E = __shfl_up(Pm, 1); if (lane == 0) E = -3.0e38f;
            const float M0 = fmaxf(E, u0), M1 = Pm;
            float* gt = GT + (size_t)cc * 384;
            gt[i0] = u0; gt[i1] = u1; gt[128 + i0] = M0; gt[128 + i1] = M1; gt[256 + i0] = b0; gt[256 + i1] = b1;
            if (lane == 63) { arr[A_BL + cc] = P; arr[A_MALL + cc] = Pm; }
        }
    }
    asm volatile("s_waitcnt vmcnt(0)" ::: "memory");
    __syncthreads();
    if (tid == 0) { float m = 0.f; arr[A_MP] = 0.f;
        for (int cc = 0; cc < SEQ / 128; ++cc) { m = arr[A_BL + cc] + fmaxf(m, arr[A_MALL + cc]); arr[A_MP + cc + 1] = m; } }
    __syncthreads();
    f32x16 Cacc = {};
#define ML_MAPS() const int lane = tid & 63, r32 = lane & 31, hi = lane >> 5, qr_r = tid >> 4, qr_c = tid & 15, v_r = tid >> 2, v_c = tid & 3; (void)lane; (void)r32; (void)hi
    bf16x8 sq[4], sk[4], sv; float su = 0.f, sM = 0.f, sb_ = 0.f;
#define ML_LOAD(c) do { const size_t row0_ = seqb + (dir ? SEQ - 128 * ((c) + 1) : 128 * (c)); \
    _Pragma("unroll") for (int i = 0; i < 4; ++i) { const bf16_t* pq = QKC + (row0_ + qr_r + 32 * i) * 1024 + h * 128 + qr_c * 8; sq[i] = *(const bf16x8*)pq; sk[i] = *(const bf16x8*)(pq + 512); } \
    sv = *(const bf16x8*)(Z + (row0_ + v_r) * LDZ + ZC_V + h * 128 + dq * 32 + v_c * 8); \
    if (tid < 128) { const float* gt = GT + (size_t)(c) * 384 + tid; su = gt[0]; sM = gt[128]; sb_ = gt[256]; } } while (0)
#define ML_STORE(c) do { _Pragma("unroll") for (int i = 0; i < 4; ++i) { *(LAS bf16x8*)(lds + L_Q + (qr_r + 32 * i) * RP + qr_c * 16) = sq[i]; *(LAS bf16x8*)(lds + L_K + (qr_r + 32 * i) * RP + qr_c * 16) = sk[i]; } \
    *(LAS bf16x8*)(lds + L_V + fa::v_stp<1>(v_r, v_c * 8)) = sv; \
    if (tid < 128) { const float mp = arr[A_MP + (c)], mmL = fmaxf(mp, arr[A_MALL + (c)]), mm = fmaxf(mp, sM); \
        arr[A_U2 + tid] = su * LOG2E; arr[A_MM2 + tid] = mm * LOG2E; arr[A_A + tid] = __expf(mp - mm); arr[A_NEGM2 + tid] = -(sb_ + mm) * LOG2E; arr[A_EW + tid] = __expf(su - mmL); \
        if (tid == 0) arr[A_SC] = __expf(mp - mmL); } } while (0)
    { ML_MAPS(); ML_LOAD(0); }
    for (int c = 0; c < SEQ / 128; ++c) {
        asm volatile("" : "+v"(tid));
        ML_MAPS();
        const size_t row0 = seqb + (dir ? SEQ - 128 * (c + 1) : 128 * c);
        ML_STORE(c);
        __syncthreads();
#if PROBE_A >= 20 || PROBE_B >= 20
        unsigned tS1 = (unsigned)__builtin_amdgcn_s_memrealtime();
#endif
        if (c + 1 < SEQ / 128) ML_LOAD(c + 1);
        const int tb = wid & 3, half = wid >> 2;
        f32x16 intra = {}; float dsum = 0.f;
        {
            bf16x8 qr[8];
#pragma unroll
            for (int ks = 0; ks < 8; ++ks) qr[ks] = *(const LAS bf16x8*)(lds + L_Q + (tb * 32 + r32) * RP + (ks * 16 + hi * 8) * 2);
            const float mm2t = arr[A_MM2 + tb * 32 + r32];
            const int lo = dir ? tb : 0, n = dir ? 4 - tb : tb + 1, h0n = (n + 1) >> 1;
            const int sb_lo = half ? lo + h0n : lo, sb_hi = half ? lo + n : lo + h0n;
            const int vbase = (int)(unsigned)(uintptr_t)(lds + L_V) + v_rd_base(lane);
            for (int sb = sb_lo; sb < sb_hi; ++sb) {
                bf16x8 kf[8]; f32x4 u4[4];
#pragma unroll
                for (int ks = 0; ks < 8; ++ks) kf[ks] = *(const LAS bf16x8*)(lds + L_K + (sb * 32 + r32) * RP + (ks * 16 + hi * 8) * 2);
#pragma unroll
                for (int g = 0; g < 4; ++g) u4[g] = *(const LAS f32x4*)(arr + A_U2 + sb * 32 + 8 * g + 4 * hi);
                const int vb = vbase + sb * 2048;
                const s16x4 l0 = tr_read<0>(vb), h0 = tr_read<512>(vb), l1 = tr_read<1024>(vb), h1 = tr_read<1536>(vb);
                asm volatile("s_waitcnt lgkmcnt(0)" ::: "memory"); __builtin_amdgcn_sched_barrier(0);
                f32x16 p = {};
#pragma unroll
                for (int ks = 0; ks < 8; ++ks) p = __builtin_amdgcn_mfma_f32_32x32x16_bf16(kf[ks], qr[ks], p, 0, 0, 0);
                float w[16];
#pragma unroll
                for (int r = 0; r < 16; ++r) w[r] = __builtin_amdgcn_exp2f(u4[r >> 2][r & 3] - mm2t);
                if (sb == tb) {
#pragma unroll
                    for (int r = 0; r < 16; ++r) { const int sl = crow(r, hi); const bool msk = dir ? (sl < r32) : (sl > r32); w[r] = msk ? 0.f : w[r]; }
                }
#pragma unroll
                for (int r = 0; r < 16; ++r) { p[r] *= w[r]; dsum += p[r]; }
                u32x4 w0 = {cvtpk_s(p[0], p[1]), cvtpk_s(p[2], p[3]), cvtpk_s(p[4], p[5]), cvtpk_s(p[6], p[7])}, w1 = {cvtpk_s(p[8], p[9]), cvtpk_s(p[10], p[11]), cvtpk_s(p[12], p[13]), cvtpk_s(p[14], p[15])};
                intra = __builtin_amdgcn_mfma_f32_32x32x16_bf16(__builtin_bit_cast(bf16x8, w0), ML_PK(l0, h0), intra, 0, 0, 0);
                intra = __builtin_amdgcn_mfma_f32_32x32x16_bf16(__builtin_bit_cast(bf16x8, w1), ML_PK(l1, h1), intra, 0, 0, 0);
            }
            dsum = psum32(dsum);
            if (half) {
                f32x16 inter = {}; bf16x8 cf[8]; f32x4 a4[4];
#pragma unroll
                for (int ks = 0; ks < 8; ++ks) cf[ks] = *(const LAS bf16x8*)(lds + L_C + r32 * RP + (ks * 16 + hi * 8) * 2);
#pragma unroll
                for (int g = 0; g < 4; ++g) a4[g] = *(const LAS f32x4*)(arr + A_A + tb * 32 + 8 * g + 4 * hi);
                asm volatile("s_waitcnt lgkmcnt(0)" ::: "memory"); __builtin_amdgcn_sched_barrier(0);
#pragma unroll
                for (int ks = 0; ks < 8; ++ks) inter = __builtin_amdgcn_mfma_f32_32x32x16_bf16(qr[ks], cf[ks], inter, 0, 0, 0);
                LAS float* part = (LAS float*)(lds + L_PART) + tb * 1024 + lane;
#pragma unroll
                for (int r = 0; r < 16; ++r) part[r * 64] = intra[r] + a4[r >> 2][r & 3] * inter[r];
                if (hi == 0) arr[A_DS1 + tb * 32 + r32] = dsum;
            } else {
                float nq = 0.f; bf16x8 q8[8]; f32x4 n4[16];
#pragma unroll
                for (int cc = 0; cc < 8; ++cc) { q8[cc] = *(const LAS bf16x8*)(lds + L_Q + (tb * 32 + r32) * RP + (hi * 64 + cc * 8) * 2);
                    n4[2 * cc] = *(const LAS f32x4*)(arr + A_N + hi * 64 + cc * 8); n4[2 * cc + 1] = *(const LAS f32x4*)(arr + A_N + hi * 64 + cc * 8 + 4); }
                asm volatile("s_waitcnt lgkmcnt(0)" ::: "memory"); __builtin_amdgcn_sched_barrier(0);
#pragma unroll
                for (int cc = 0; cc < 8; ++cc) {
#pragma unroll
                    for (int j = 0; j < 4; ++j) nq += bf2f((bf16_t)q8[cc][j]) * n4[2 * cc][j] + bf2f((bf16_t)q8[cc][4 + j]) * n4[2 * cc + 1][j]; }
                nq = psum32(nq);
                if (hi == 0) arr[A_NQ + tb * 32 + r32] = nq;
            }
        }
        {
            const int ec = tid & 15, s0 = tid >> 4;
            float ns[8] = {0.f, 0.f, 0.f, 0.f, 0.f, 0.f, 0.f, 0.f}; bf16x8 k8a[4]; float ewa[4];
#pragma unroll
            for (int i = 0; i < 4; ++i) { k8a[i] = *(const LAS bf16x8*)(lds + L_K + (s0 + 32 * i) * RP + ec * 16); ewa[i] = arr[A_EW + s0 + 32 * i]; }
            asm volatile("s_waitcnt lgkmcnt(0)" ::: "memory"); __builtin_amdgcn_sched_barrier(0);
#pragma unroll
            for (int i = 0; i < 4; ++i) { float kv[8];
#pragma unroll
                for (int j = 0; j < 8; ++j) { kv[j] = bf2f((bf16_t)k8a[i][j]) * ewa[i]; ns[j] += kv[j]; }
                u32x4 w_ = {cvtpk_s(kv[0], kv[1]), cvtpk_s(kv[2], kv[3]), cvtpk_s(kv[4], kv[5]), cvtpk_s(kv[6], kv[7])};
                *(LAS u32x4*)(lds + L_KW + fa::v_stp<4>(s0 + 32 * i, ec * 8)) = w_; }
#pragma unroll
            for (int j = 0; j < 8; ++j) { ns[j] += __shfl_xor(ns[j], 16); ns[j] += __shfl_xor(ns[j], 32); }
            if (lane < 16) {
#pragma unroll
                for (int j = 0; j < 8; ++j) arr[A_NLP + wid * 128 + ec * 8 + j] = ns[j]; }
        }
        __syncthreads();
#if PROBE_A >= 20 || PROBE_B >= 20
        unsigned tS3 = (unsigned)__builtin_amdgcn_s_memrealtime();
#endif
        if (wid < 4) {
            const float den = dsum + arr[A_DS1 + tb * 32 + r32] + arr[A_A + tb * 32 + r32] * arr[A_NQ + tb * 32 + r32];
            const float rden = __builtin_amdgcn_rcpf(fmaxf(fabsf(den), __builtin_amdgcn_exp2f(arr[A_NEGM2 + tb * 32 + r32])));
            if (hi == 0) arr[A_RD + tb * 32 + r32] = rden;
            asm volatile("s_waitcnt lgkmcnt(0)" ::: "memory");
            const LAS float* part = (const LAS float*)(lds + L_PART) + tb * 1024 + lane;
            bf16_t* Ho = Hout + (row0 + tb * 32) * ML_W + h * 128 + dq * 32 + r32;
            float pv_[16]; f32x4 rd4[4];
#pragma unroll
            for (int r = 0; r < 16; ++r) pv_[r] = part[r * 64];
#pragma unroll
            for (int g = 0; g < 4; ++g) rd4[g] = *(const LAS f32x4*)(arr + A_RD + tb * 32 + 8 * g + 4 * hi);
            asm volatile("s_waitcnt lgkmcnt(0)" ::: "memory"); __builtin_amdgcn_sched_barrier(0);
#pragma unroll
            for (int r = 0; r < 16; ++r) Ho[(size_t)crow(r, hi) * ML_W] = (bf16_t)f2bf((intra[r] + pv_[r]) * rd4[r >> 2][r & 3]);
        } else {
            const int et = wid - 4; const float fC = arr[A_SC];
#pragma unroll
            for (int r = 0; r < 16; ++r) Cacc[r] *= fC;
            const int vb = (int)(unsigned)(uintptr_t)(lds + L_V) + v_rd_base(lane), kb = (int)(unsigned)(uintptr_t)(lds + L_KW) + v_rd_base(lane) + et * 512;
#define ML_CRD(ks, i) const s16x4 al##i = tr_read<(ks) * 1024>(vb), ah##i = tr_read<(ks) * 1024 + 512>(vb), bl##i = tr_read<(ks) * 4096>(kb), bh##i = tr_read<(ks) * 4096 + 2048>(kb)
#define ML_CMM(i) Cacc = __builtin_amdgcn_mfma_f32_32x32x16_bf16(ML_PK(al##i, ah##i), ML_PK(bl##i, bh##i), Cacc, 0, 0, 0)
            { ML_CRD(0, 0); ML_CRD(1, 1); ML_CRD(2, 2); ML_CRD(3, 3);
              asm volatile("s_waitcnt lgkmcnt(0)" ::: "memory"); __builtin_amdgcn_sched_barrier(0);
              ML_CMM(0); ML_CMM(1); ML_CMM(2); ML_CMM(3); }
            { ML_CRD(4, 0); ML_CRD(5, 1); ML_CRD(6, 2); ML_CRD(7, 3);
              asm volatile("s_waitcnt lgkmcnt(0)" ::: "memory"); __builtin_amdgcn_sched_barrier(0);
              ML_CMM(0); ML_CMM(1); ML_CMM(2); ML_CMM(3); }
#undef ML_CRD
#undef ML_CMM
#pragma unroll
            for (int r = 0; r < 16; ++r) *(LAS bf16_t*)(lds + L_C + crow(r, hi) * RP + (et * 32 + r32) * 2) = (bf16_t)f2bf(Cacc[r]);
            const int ht = tid - 256;
            if (ht < 128) { float a_ = 0.f;
#pragma unroll
                for (int w8 = 0; w8 < 8; ++w8) a_ += arr[A_NLP + w8 * 128 + ht];
                arr[A_N + ht] = fC * arr[A_N + ht] + a_; }
        }
        __syncthreads();
#if PROBE_A >= 20 || PROBE_B >= 20
        if (blockIdx.x == 0 && tid0 == 0) { volatile LAS unsigned* tsl = (volatile LAS unsigned*)(lds + 147200); const unsigned tS4 = (unsigned)__builtin_amdgcn_s_memrealtime(); tsl[13] += tS3 - tS1; tsl[14] += tS4 - tS3; }
#endif
    }
#undef ML_LOAD
#undef ML_STORE
#undef ML_MAPS
}
#undef ML_PK
}

__device__ __forceinline__ void mlstm_fast(const Params& p, LAS unsigned char* lds) {
    const int G = gridDim.x, bx = blockIdx.x, vcu = (G % 8 == 0) ? (bx % 8) * (G / 8) + bx / 8 : bx;
    for (int u = vcu; u < BATCH * ML_H * 2 * 4; u += G) {
        const int dq = u & 3, dir = (u >> 2) & 1, h = (u >> 3) & 3, b = u >> 5;
        ml::unit(b, h, dir, dq, (const bf16_t*)(p.ws + WS_XB), (const bf16_t*)(p.ws + WS_Z), (const float*)(p.ws + WS_G), (const float*)(p.ws + WS_SMALL) + SM_GBIAS,
                 dir ? (bf16_t*)p.out + (size_t)T * ML_W : (bf16_t*)p.out, (float*)(p.ws + WS_GT) + (size_t)u * ml::GT_UNIT, lds);
    }
}
__device__ __forceinline__ void mla_attn_fast(const Params& p, LAS unsigned char* lds) {
    const int G = gridDim.x, bx = blockIdx.x, vcu = (G % 8 == 0) ? (bx % 8) * (G / 8) + bx / 8 : bx;
    for (int u = vcu; u < BATCH * MLA_H * 16; u += G) {
        const int qb = u & 15, bh = u >> 4;
        fa::mla_unit(bh >> 3, bh & 7, qb, (const bf16_t*)(p.ws + WS_QALL), (const bf16_t*)(p.ws + WS_KV), (const bf16_t*)(p.ws + WS_KR),
                     (const float*)(p.ws + WS_COS), (const float*)(p.ws + WS_SIN), (bf16_t*)(p.ws + WS_Y), lds);
    }
}
__device__ __forceinline__ void x_attn_fast(const Params& p, LAS unsigned char* lds) {
    const int G = gridDim.x, bx = blockIdx.x, vcu = (G % 8 == 0) ? (bx % 8) * (G / 8) + bx / 8 : bx;
    for (int u = vcu; u < BATCH * XH * 16; u += G) {
        const int qb = u & 15, bh = u >> 4;
        fa::xattn_unit(bh >> 2, bh & 3, qb, (const bf16_t*)(p.ws + WS_HQ), (const bf16_t*)(p.ws + WS_KVM), (bf16_t*)(p.ws + WS_OX), lds);
    }
}
__device__ __forceinline__ void phase_final(const Params& p) {
    const float* ssq = (const float*)(p.ws + WS_SSQ) + 4 * (size_t)T; const bf16_t* XB = (const bf16_t*)(p.ws + WS_XB);
    const float* fin = (const float*)(p.ws + WS_SMALL) + SM_FIN;
    const int wid = threadIdx.x >> 6, lane = threadIdx.x & 63;
    f32x4 g[2][2];
#pragma unroll
    for (int j = 0; j < 2; ++j) { g[j][0] = *(const f32x4*)(fin + j * 512 + lane * 8); g[j][1] = *(const f32x4*)(fin + j * 512 + lane * 8 + 4); }
    for (int row4 = (blockIdx.x * NWAVES + wid) * 4; row4 < T; row4 += gridDim.x * NWAVES * 4) {
        u32x4 rb[4][2]; float rs[4];
#pragma unroll
        for (int q = 0; q < 4; ++q) { rs[q] = ssq[row4 + q];
#pragma unroll
            for (int j = 0; j < 2; ++j) rb[q][j] = *(const u32x4*)(XB + (size_t)(row4 + q) * DM + j * 512 + lane * 8); }
#pragma unroll
        for (int q = 0; q < 4; ++q) { const float r = rsqrtf(rs[q] * (1.0f / DM) + EPS);
#pragma unroll
            for (int j = 0; j < 2; ++j) { const u32x4 w = rb[q][j];
                const f32x4 v0 = (f32x4){__uint_as_float(w.x << 16), __uint_as_float(w.x & 0xffff0000u), __uint_as_float(w.y << 16), __uint_as_float(w.y & 0xffff0000u)};
                const f32x4 v1 = (f32x4){__uint_as_float(w.z << 16), __uint_as_float(w.z & 0xffff0000u), __uint_as_float(w.w << 16), __uint_as_float(w.w & 0xffff0000u)};
                float* o = p.out + (size_t)(row4 + q) * DM + j * 512 + lane * 8;
                *(f32x4*)o = v0 * r * g[j][0]; *(f32x4*)(o + 4) = v1 * r * g[j][1]; } }
    }
}

#define XB_TMO      128
#define XB_XCNT(j)  (256  + 64 * (j))
#define XB_XSUB(j)  (1280 + 64 * (j))
#define XB_XGEN(j)  (2304 + 64 * (j))
#define XB_TOP      3328
#define XB_TOPGEN   3392
#define XCD_BAR_WORDS 3456
#define XB_SPIN_CAP (1u << 20)
__device__ __forceinline__ unsigned xb_ld(unsigned* p)              { return __hip_atomic_load(p, __ATOMIC_RELAXED, __HIP_MEMORY_SCOPE_AGENT); }
__device__ __forceinline__ unsigned xb_add(unsigned* p, unsigned v) { return __hip_atomic_fetch_add(p, v, __ATOMIC_RELAXED, __HIP_MEMORY_SCOPE_AGENT); }
__device__ __forceinline__ unsigned xb_xcc_id() { return (unsigned)__builtin_amdgcn_s_getreg((3 << 11) | 20) & 0xFu; }
#define XB_SPIN(cond, bar) do { unsigned _sp = 0; while (cond) { __builtin_amdgcn_s_sleep(1); \
    if ((++_sp & 255u) == 0u) { if (xb_ld(&(bar)[XB_TMO])) break; if (_sp > XB_SPIN_CAP) { atomicAdd(&(bar)[XB_TMO], 1u); break; } } } } while (0)
struct XcdBarrier { unsigned* bar; unsigned x; volatile LAS unsigned* st; };
__device__ __forceinline__ XcdBarrier xcd_barrier_post(unsigned* bar, volatile LAS unsigned* st) {
    XcdBarrier b; b.bar = bar; b.x = xb_xcc_id(); b.st = st;
    if (threadIdx.x == 0) (void)xb_add(&bar[XB_XCNT(b.x)], 1u);
    return b;
}
__device__ __forceinline__ void xcd_barrier_complete(unsigned* bar, unsigned x, unsigned& nloc, unsigned& nx) {
    const unsigned G = gridDim.x * gridDim.y * gridDim.z;
    unsigned sum, cnt, mine, sp = 0u;
    for (;;) {
        sum = 0u; cnt = 0u; mine = 0u;
#pragma unroll
        for (unsigned j = 0; j < 16; ++j) { const unsigned c = xb_ld(&bar[XB_XCNT(j)]); sum += c; cnt += (c > 0u) ? 1u : 0u; mine = (j == x) ? c : mine; }
        if (sum == G) break;
        __builtin_amdgcn_s_sleep(1);
        if ((++sp & 255u) == 0u) { if (xb_ld(&bar[XB_TMO])) break; if (sp > XB_SPIN_CAP) { atomicAdd(&bar[XB_TMO], 1u); break; } }
    }
    nloc = mine > 0u ? mine : 1u; nx = cnt > 0u ? cnt : 1u;
}
__device__ __forceinline__ void xcd_barrier(const XcdBarrier& b) {
    asm volatile("s_waitcnt vmcnt(0)" ::: "memory");
    __syncthreads();
    if (threadIdx.x == 0) {
        unsigned* bar = b.bar;
        __builtin_amdgcn_s_waitcnt(0);
        unsigned nloc = b.st[0], nx = b.st[1];
        if (nloc == 0u) { xcd_barrier_complete(bar, b.x, nloc, nx); b.st[0] = nloc; b.st[1] = nx; }
        const unsigned old = xb_add(&bar[XB_XSUB(b.x)], 1u);
        const unsigned gen = old / nloc;
        if (old + 1u == (gen + 1u) * nloc) {
            __builtin_amdgcn_fence(__ATOMIC_RELEASE, "agent");
            asm volatile("s_waitcnt vmcnt(0)" ::: "memory");
            const unsigned og = xb_add(&bar[XB_TOP], 1u);
            const unsigned tg = og / nx;
            if (og + 1u == (tg + 1u) * nx) xb_add(&bar[XB_TOPGEN], 1u);
            else XB_SPIN(xb_ld(&bar[XB_TOPGEN]) == tg, bar);
            __builtin_amdgcn_fence(__ATOMIC_ACQUIRE, "agent");
            xb_add(&bar[XB_XGEN(b.x)], 1u);
            asm volatile("s_waitcnt vmcnt(0)" ::: "memory");
        } else {
            XB_SPIN(xb_ld(&bar[XB_XGEN(b.x)]) == gen, bar);
            __builtin_amdgcn_fence(__ATOMIC_ACQUIRE, "agent");
            asm volatile("s_waitcnt vmcnt(0)" ::: "memory");
        }
    }
    __syncthreads();
}

constexpr int LDS_BYTES = 147456;
constexpr int NPHASE = 12;

#ifndef MK_N_LAUNCHES
#define MK_N_LAUNCHES 1
#endif

__global__ void __launch_bounds__(NTHR, 2) mega(Params p) {
    extern __shared__ __attribute__((aligned(16))) unsigned char lds_raw[];
    LAS unsigned char* lds = (LAS unsigned char*)lds_raw;
    unsigned char* ws = p.ws;
    float* ssq = (float*)(ws + WS_SSQ);
    const int lo = p.ph_lo, hi = p.ph_hi;
    volatile LAS unsigned* misc = (volatile LAS unsigned*)(lds + LDS_BYTES - 64);
    if (threadIdx.x < 16) misc[threadIdx.x] = 0u;
    __syncthreads();
    XcdBarrier bar; bar.bar = (unsigned*)(ws + WS_CTL) + 4096; bar.x = 0; bar.st = nullptr;
    if (hi - lo > 1) bar = xcd_barrier_post((unsigned*)(ws + WS_CTL) + 4096, misc);
#define IN(k) (lo <= (k) && (k) < hi)
#if PROBE_A >= 0 || PROBE_B >= 0
    volatile LAS unsigned* tsl = (volatile LAS unsigned*)(lds + LDS_BYTES - 256);
    if (blockIdx.x == 0 && threadIdx.x == 0) { tsl[0] = (unsigned)__builtin_amdgcn_s_memrealtime(); tsl[13] = 0u; tsl[14] = 0u; tsl[15] = 0u; }
#define SEAM(k) do { if (IN(k) && IN((k) + 1)) xcd_barrier(bar); if (blockIdx.x == 0 && threadIdx.x == 0) tsl[(k) + 1] = (unsigned)__builtin_amdgcn_s_memrealtime(); } while (0)
#else
#define SEAM(k) do { if (IN(k) && IN((k) + 1)) xcd_barrier(bar); } while (0)
#endif
    if (IN(0)) phase0(p, lds);
    SEAM(0);
    if (IN(1)) {
        Gemm g{(const bf16_t*)(ws + WS_XB), DM, (const bf16_t*)(ws + WS_WIN), DM, T, LDZ, DM};
        EpiZ E{(bf16_t*)(ws + WS_Z), ssq, ssq + T, (bf16_t*)(ws + WS_KR), (float*)(ws + WS_G), (const float*)(ws + WS_COS), (const float*)(ws + WS_SIN)};
        run_gemm(lds, g, E, (int)blockIdx.x);
    }
    SEAM(1);
    if (IN(2)) {
        { Gemm g{(const bf16_t*)(ws + WS_Z) + ZC_CQ, LDZ, (const bf16_t*)(ws + WS_WUQ), QLORA, T, MLA_H * DQK, QLORA};
          EpiScaleBf16 E{(bf16_t*)(ws + WS_QALL), MLA_H * DQK, ssq, 1.0f / QLORA, 1.0f}; run_gemm(lds, g, E, (int)blockIdx.x); }
        { Gemm g{(const bf16_t*)(ws + WS_Z) + ZC_CKV, LDZ, (const bf16_t*)(ws + WS_WUKV), 256, T, 1024, 256};
          EpiScaleBf16 E{(bf16_t*)(ws + WS_KV), 1024, ssq + T, 1.0f / KVLORA, 1.0f}; run_gemm(lds, g, E, (int)blockIdx.x); }
        { Gemm g{(const bf16_t*)(ws + WS_MEMN), DM, (const bf16_t*)(ws + WS_WXKV), DM, TM, 2 * DM, DM};
          EpiScaleBf16 E{(bf16_t*)(ws + WS_KVM), 2 * DM, nullptr, 0.f, 1.0f}; run_gemm(lds, g, E, (int)blockIdx.x); }
        phase_conv(p);
    }
    SEAM(2);
    if (IN(3)) { mlstm_fast(p, lds);
#if PROBE_A == 13
        xcd_barrier(bar); if (blockIdx.x == 0 && threadIdx.x == 0) tsl[14] = (unsigned)__builtin_amdgcn_s_memrealtime();
#endif
        mla_attn_fast(p, lds); }
    SEAM(3);
    if (IN(4)) phase_mlfin(p);
    SEAM(4);
    if (IN(5)) {
        Gemm g{(const bf16_t*)(ws + WS_Y), DM, (const bf16_t*)(ws + WS_WOUT), DM, T, DM, DM};
        EpiResid E{p.x, nullptr, (bf16_t*)(ws + WS_XB), ssq + 2 * T}; run_gemm(lds, g, E, (int)blockIdx.x);
    }
    SEAM(5);
    if (IN(6)) {
        Gemm g{(const bf16_t*)(ws + WS_XB), DM, (const bf16_t*)(ws + WS_WXQ), DM, T, DM, DM};
        EpiScaleBf16 E{(bf16_t*)(ws + WS_HQ), DM, ssq + 2 * T, 1.0f / DM, 1.0f}; run_gemm(lds, g, E, (int)blockIdx.x);
    }
    SEAM(6);
    if (IN(7)) x_attn_fast(p, lds);
    SEAM(7);
    if (IN(8)) {
        Gemm g{(const bf16_t*)(ws + WS_OX), DM, (const bf16_t*)(ws + WS_WXO), DM, T, DM, DM};
        EpiResid E{nullptr, (const bf16_t*)(ws + WS_XB), (bf16_t*)(ws + WS_XB), ssq + 3 * T}; run_gemm(lds, g, E, (int)blockIdx.x);
    }
    SEAM(8);
    if (IN(9)) {
        Gemm g{(const bf16_t*)(ws + WS_XB), DM, (const bf16_t*)(ws + WS_WGU), DM, T, 2 * DFF, DM};
        EpiSwiglu E{(bf16_t*)(ws + WS_H), ssq + 3 * T}; run_gemm(lds, g, E, (int)blockIdx.x);
    }
    SEAM(9);
    if (IN(10)) {
        Gemm g{(const bf16_t*)(ws + WS_H), DFF, (const bf16_t*)(ws + WS_WD), DFF, T, DM, DFF};
        EpiResid E{nullptr, (const bf16_t*)(ws + WS_XB), (bf16_t*)(ws + WS_XB), ssq + 4 * T}; run_gemm(lds, g, E, (int)blockIdx.x);
    }
    SEAM(10);
    if (IN(11)) phase_final(p);
#if PROBE_A >= 0 || PROBE_B >= 0
    {   float* pr = (float*)(ws + WS_CTL + 65536);
        if (blockIdx.x == 0 && threadIdx.x == 0) {
            tsl[12] = 0u; asm volatile("s_waitcnt vmcnt(0)" ::: "memory"); tsl[12] = (unsigned)__builtin_amdgcn_s_memrealtime();
            float da = 0.f, db = 0.f;
            if (PROBE_A >= 0) { const float us = (float)(PROBE_A == 13 ? tsl[14] - tsl[3] : PROBE_A >= 20 ? tsl[PROBE_A - 20 + 13] : tsl[PROBE_A + 1] - tsl[PROBE_A]) * 0.01f; da = sqrtf(PROBE_A_SCALE * us); }
            if (PROBE_B >= 0) { const float us = (float)(PROBE_B >= 20 ? tsl[PROBE_B - 20 + 13] : tsl[PROBE_B + 1] - tsl[PROBE_B]) * 0.01f; db = 0.04f + PROBE_B_SCALE * us; }
            __hip_atomic_store(pr, da, __ATOMIC_RELAXED, __HIP_MEMORY_SCOPE_AGENT); __hip_atomic_store(pr + 1, db, __ATOMIC_RELAXED, __HIP_MEMORY_SCOPE_AGENT);
        }
        xcd_barrier(bar);
        const float da = __hip_atomic_load(pr, __ATOMIC_RELAXED, __HIP_MEMORY_SCOPE_AGENT), db = __hip_atomic_load(pr + 1, __ATOMIC_RELAXED, __HIP_MEMORY_SCOPE_AGENT);
        for (size_t i = (size_t)blockIdx.x * NTHR + threadIdx.x; i < (size_t)T * DM; i += (size_t)gridDim.x * NTHR) p.out[i] += da + (i == 0 ? db : 0.f);
    }
#endif
#undef IN
#undef SEAM
}

extern "C" void kernel_launch(void* const* d_in, const int* in_sizes, int n_in, void* d_out, int out_size, void* d_ws, size_t ws_size, hipStream_t stream) {
    static int grid = 0;
    if (grid == 0) {
        if (n_in != 22 || in_sizes[0] != T * DM || out_size != T * DM) { fprintf(stderr, "kernel_launch: unexpected shapes (n_in %d, in0 %d, out %d)\n", n_in, n_in > 0 ? in_sizes[0] : -1, out_size); grid = -1; return; }
        if (ws_size < WS_END) { fprintf(stderr, "kernel_launch: workspace too small: %zu\n", ws_size); grid = -1; return; }
        int dev = 0, cus = 0, per_cu = 0;
        (void)hipGetDevice(&dev); (void)hipDeviceGetAttribute(&cus, hipDeviceAttributeMultiprocessorCount, dev);
        if (hipFuncSetAttribute((const void*)mega, hipFuncAttributeMaxDynamicSharedMemorySize, LDS_BYTES) != hipSuccess) { fprintf(stderr, "kernel_launch: hipFuncSetAttribute failed\n"); grid = -1; return; }
        if (hipOccupancyMaxActiveBlocksPerMultiprocessor(&per_cu, (const void*)mega, NTHR, LDS_BYTES) != hipSuccess || per_cu < 1) { fprintf(stderr, "kernel_launch: occupancy query says %d\n", per_cu); per_cu = 1; }
        (void)hipGetLastError();
        grid = cus * (per_cu < 1 ? per_cu : 1);
        fprintf(stderr, "kernel_launch: grid %d (cus %d, per_cu %d), ws %zu MiB\n", grid, cus, per_cu, ws_size >> 20);
    }
    if (grid < 0) return;
    Params p{};
    p.x = (const float*)d_in[0]; p.mem = (const float*)d_in[1]; p.pos = (const int*)d_in[2];
    p.attn_norm = (const float*)d_in[3]; p.w_in = (const float*)d_in[4]; p.q_norm = (const float*)d_in[5]; p.w_uq = (const float*)d_in[6];
    p.kv_norm = (const float*)d_in[7]; p.w_ukv = (const float*)d_in[8]; p.conv = (const float*)d_in[9]; p.gbias = (const float*)d_in[10];
    p.ml_norm = (const float*)d_in[11]; p.w_out = (const float*)d_in[12]; p.xattn_norm = (const float*)d_in[13]; p.mem_norm = (const float*)d_in[14];
    p.w_xq = (const float*)d_in[15]; p.w_xkv = (const float*)d_in[16]; p.w_xo = (const float*)d_in[17]; p.ffn_norm = (const float*)d_in[18];
    p.w_gu = (const float*)d_in[19]; p.w_down = (const float*)d_in[20]; p.final_norm = (const float*)d_in[21];
    p.out = (float*)d_out; p.ws = (unsigned char*)d_ws;
    if (hipMemsetAsync((char*)d_ws + WS_CTL, 0, 65536, stream) != hipSuccess) { fprintf(stderr, "kernel_launch: memset failed\n"); return; }
#if MK_N_LAUNCHES == 1
    p.ph_lo = 0; p.ph_hi = NPHASE;
    { void* args[] = {&p};
      const hipError_t e = hipLaunchCooperativeKernel((const void*)mega, dim3(grid), dim3(NTHR), args, LDS_BYTES, stream);
      if (e != hipSuccess) fprintf(stderr, "kernel_launch: cooperative launch failed: %s (grid %d)\n", hipGetErrorString(e), grid); }
#else
    for (int ph = 0; ph < NPHASE; ++ph) {
        p.ph_lo = ph; p.ph_hi = ph + 1;
        hipLaunchKernelGGL(mega, dim3(grid), dim3(NTHR), LDS_BYTES, stream, p);
    }
#endif
    const hipError_t le = hipPeekAtLastError();
    if (le != hipSuccess) fprintf(stderr, "kernel_launch: launch failed: %s\n", hipGetErrorName(le));
}
```

```cpp
#include <hip/hip_runtime.h>
#include <cstdio>
#include <cstdint>

#ifndef PROBE_A
#define PROBE_A (-1)
#define PROBE_A_SCALE 1.0e-7f
#define PROBE_B (-1)
#define PROBE_B_SCALE 1.0e-4f
#endif
constexpr int BATCH = 8, SEQ = 4096, DM = 1024, T = BATCH * SEQ;
constexpr int NMEM = 256, TM = BATCH * NMEM;
constexpr float EPS = 1e-6f;
constexpr int MLA_H = 8, QLORA = 256, KVLORA = 128, NOPE = 64, ROPE = 32, VD = 64, DQK = NOPE + ROPE;
constexpr int ML_H = 4, ML_D = 128, ML_W = 512;
constexpr int XH = 4, XD = 256;
constexpr int DFF = 2816;
constexpr int INW = 2480;
constexpr int LDZ = 2560, ZC_CQ = 0, ZC_CKV = 256, ZC_KR = 384, ZC_G = 416, ZC_QK = 512, ZC_V = 1536, ZC_O = 2048;
constexpr int NWAVES = 8, NTHR = 512;

constexpr size_t MiB = 1u << 20;
constexpr size_t WS_CTL = 0;
constexpr size_t WS_WIN = 1 * MiB;
constexpr size_t WS_WUQ = 6 * MiB;
constexpr size_t WS_WUKV = 7 * MiB;
constexpr size_t WS_WOUT = 8 * MiB;
constexpr size_t WS_WXQ = 10 * MiB;
constexpr size_t WS_WXKV = 12 * MiB;
constexpr size_t WS_WXO = 16 * MiB;
constexpr size_t WS_WGU = 18 * MiB;
constexpr size_t WS_WD = 30 * MiB;
constexpr size_t WS_COS = 36 * MiB;
constexpr size_t WS_SIN = 38 * MiB;
constexpr size_t WS_G = 40 * MiB;
constexpr size_t WS_KR = 42 * MiB;
constexpr size_t WS_SSQ = 44 * MiB;
constexpr size_t WS_SMALL = 45 * MiB;
constexpr int SM_CONV = 0, SM_GBIAS = 3072, SM_MLN = 3136, SM_FIN = 3648, SM_END = 4672;
constexpr size_t WS_MEMN = 46 * MiB;
constexpr size_t WS_KVM = 50 * MiB;
constexpr size_t WS_XB = 64 * MiB;
constexpr size_t WS_Z = 128 * MiB;
constexpr size_t WS_H = 128 * MiB;
constexpr size_t WS_QALL = 288 * MiB;
constexpr size_t WS_KV = 336 * MiB;
constexpr size_t WS_Y = 400 * MiB;
constexpr size_t WS_HQ = 304 * MiB;
constexpr size_t WS_OX = 368 * MiB;
constexpr size_t WS_GT = 464 * MiB;
constexpr size_t WS_END = 476 * MiB;

typedef unsigned short bf16_t;
typedef short bf16x8 __attribute__((ext_vector_type(8)));
typedef float f32x4 __attribute__((ext_vector_type(4)));
typedef unsigned u32x4 __attribute__((ext_vector_type(4)));
typedef unsigned u32x2 __attribute__((ext_vector_type(2)));
#define LAS __attribute__((address_space(3)))

__device__ __forceinline__ float bf2f(bf16_t h) { return __uint_as_float(((unsigned)h) << 16); }
__device__ __forceinline__ unsigned f2bf(float f) { unsigned u = __float_as_uint(f); return (u + 0x7fffu + ((u >> 16) & 1u)) >> 16; }
typedef float f32x2_c __attribute__((ext_vector_type(2))); typedef __bf16 bf16x2_c __attribute__((ext_vector_type(2)));
__device__ __forceinline__ unsigned pk2(float lo, float hi) { f32x2_c v = {lo, hi}; bf16x2_c b = __builtin_convertvector(v, bf16x2_c); return __builtin_bit_cast(unsigned, b); }
__device__ __forceinline__ float wave_sum(float v) {
#pragma unroll
    for (int o = 1; o < 64; o <<= 1) v += __shfl_xor(v, o);
    return v;
}
__device__ __forceinline__ float wave_max(float v) {
#pragma unroll
    for (int o = 1; o < 64; o <<= 1) v = fmaxf(v, __shfl_xor(v, o));
    return v;
}

struct Params {
    const float* x; const float* mem; const int* pos;
    const float *attn_norm, *w_in, *q_norm, *w_uq, *kv_norm, *w_ukv, *conv, *gbias, *ml_norm, *w_out, *xattn_norm, *mem_norm, *w_xq, *w_xkv, *w_xo, *ffn_norm, *w_gu, *w_down, *final_norm;
    float* out; unsigned char* ws;
    int ph_lo, ph_hi;
};

struct Unit { int pm, pn; };
struct Gemm { const bf16_t* A; int lda; const bf16_t* Bt; int ldb; int M, N, K; };

template <class Epi>
__device__ __forceinline__ void gemm_naive(const Gemm g, const Epi& E) {
    const int tid = threadIdx.x, wid = tid >> 6, lane = tid & 63, wr = wid >> 2, wc = wid & 3, fr = lane & 15, fq = lane >> 4;
    const int nM = g.M / 256, nN = g.N / 256;
    for (int unit = blockIdx.x; unit < nM * nN; unit += gridDim.x) {
        Unit u; u.pm = unit / nN; u.pn = unit % nN;
        f32x4 acc[2][2][4][2];
#pragma unroll
        for (int a = 0; a < 2; ++a)
#pragma unroll
            for (int b = 0; b < 2; ++b)
#pragma unroll
                for (int m = 0; m < 4; ++m)
#pragma unroll
                    for (int n = 0; n < 2; ++n) acc[a][b][m][n] = (f32x4){0.f, 0.f, 0.f, 0.f};
        const bf16_t* Ab = g.A + (size_t)(u.pm * 256 + wr * 64 + fr) * g.lda + 8 * fq;
        const bf16_t* Bb = g.Bt + (size_t)(u.pn * 256 + wc * 32 + 8 * (fr >> 2) + (fr & 3)) * g.ldb + 8 * fq;
        for (int kk = 0; kk < g.K; kk += 32) {
            bf16x8 a[2][4], b[2][2];
#pragma unroll
            for (int ai = 0; ai < 2; ++ai)
#pragma unroll
                for (int m = 0; m < 4; ++m) a[ai][m] = *(const bf16x8*)(Ab + (size_t)(ai * 128 + m * 16) * g.lda + kk);
#pragma unroll
            for (int bj = 0; bj < 2; ++bj)
#pragma unroll
                for (int n = 0; n < 2; ++n) b[bj][n] = *(const bf16x8*)(Bb + (size_t)(bj * 128 + 4 * n) * g.ldb + kk);
#pragma unroll
            for (int ai = 0; ai < 2; ++ai)
#pragma unroll
                for (int bj = 0; bj < 2; ++bj)
#pragma unroll
                    for (int m = 0; m < 4; ++m)
#pragma unroll
                        for (int n = 0; n < 2; ++n) acc[ai][bj][m][n] = __builtin_amdgcn_mfma_f32_16x16x32_bf16(b[bj][n], a[ai][m], acc[ai][bj][m][n], 0, 0, 0);
        }
        E(acc, u, wr, wc, fr, fq);
    }
}


#define PG8_LAS __attribute__((address_space(3)))
constexpr int BM = 256, BK = 64, HALF = 128, HTB = HALF * BK * 2  , STAGE_BYTES = 8 * HTB, NXCD = 8, WGM = 8;

__host__ __device__ __forceinline__ int lds_byte(int r, int c) { const int st = (r >> 4) * 2 + (c >> 5), rr = r & 15, cc = c & 31, ob = rr * 64 + cc * 2; return st * 1024 + (ob ^ (((ob >> 9) & 1) << 5)); }
__host__ __device__ __forceinline__ void stage_rc(int b, int& R, int& C) { const int st = b / 1024, sb = b % 1024, swz = sb ^ (((sb >> 9) & 1) << 5); R = (st >> 1) * 16 + swz / 64; C = (st & 1) * 32 + (swz % 64) / 2; }
__host__ __device__ __forceinline__ int perm32(int rho) { const int n = rho >> 4, i = rho & 15; return 8 * (i >> 2) + 4 * n + (i & 3); }


struct StaticOrder {
    int nM, nN, nwg, G, c;
    __host__ __device__ __forceinline__ void init(int M, int N, int G_, int c_) { nM = M / BM; nN = N / BM; nwg = nM * nN; G = G_; c = c_; }
    __host__ __device__ __forceinline__ bool next(int i, Unit& u) const {
        const long L = (long)i * G + c; if (L >= nwg) return false;
        int wgid = (int)L; { const int q = nwg / NXCD, r = nwg % NXCD, xcd = wgid % NXCD, off = wgid / NXCD; wgid = (xcd < r ? xcd * (q + 1) : r * (q + 1) + (xcd - r) * q) + off; }
        const int nig = WGM * nN, gid = wgid / nig, fm = gid * WGM, gsz = (nM - fm) < WGM ? (nM - fm) : WGM;
        u.pm = fm + ((wgid % nig) % gsz); u.pn = (wgid % nig) / gsz; return true;
    }
    __device__ __forceinline__ void a_ready(const Unit&) const {}
    __device__ __forceinline__ void done(const Unit&) const {}
};

template <class Epi, class Sched, bool ALIGN_EPI = false, bool SP2 = false>
__device__ __forceinline__ void gemm_phase(PG8_LAS unsigned char* lds, const Gemm g, const Sched& S, const Epi& E) {
    const int tid = threadIdx.x, wid = __builtin_amdgcn_readfirstlane(tid >> 6), lane = tid & 63, wr = wid >> 2, wc = wid & 3, fr = lane & 15, fq = lane >> 4;
    const int K = g.K, nt = K / BK, lda = g.lda, ldb = g.ldb;
    unsigned voffA[2], voffB[2];
#pragma unroll
    for (int i = 0; i < 2; ++i) { int R, C; stage_rc(tid * 16 + i * 8192, R, C); const int Rb = Epi::PERM ? ((R & ~31) + perm32(R & 31)) : R;
        voffA[i] = (unsigned)(R * lda + C) * 2u; voffB[i] = (unsigned)(Rb * ldb + C) * 2u; }
    const size_t kstep = (size_t)(BK * 2);
    const size_t hstepA = (size_t)HALF * lda * 2, hstepB = (size_t)HALF * ldb * 2;
    const size_t tstepA = 2 * hstepA, tstepB = 2 * hstepB;
    const unsigned ldsw = (unsigned)wid * 1024u;
    const int aoff = lds_byte(wr * 64 + fr, fq * 8), boff = lds_byte(wc * 32 + fr, fq * 8);
#define PG8_SA(b, h) (((b) * 2 + (h)) * HTB)
#define PG8_SB(b, h) ((4 + (b) * 2 + (h)) * HTB)
#define PG8_STAGE(bufoff, gbase, voff) do { _Pragma("unroll") for (int _i = 0; _i < 2; ++_i) \
        __builtin_amdgcn_global_load_lds((const unsigned*)((const char*)(gbase) + (voff)[_i]), (PG8_LAS unsigned*)(lds + (bufoff) + ldsw + _i * 8192), 16, 0, 0); } while (0)
#define PG8_LDA(dst, b, h) do { _Pragma("unroll") for (int m = 0; m < 4; ++m) _Pragma("unroll") for (int k = 0; k < 2; ++k) dst[m][k] = *(const PG8_LAS bf16x8*)(lds + PG8_SA(b, h) + aoff + m * 2048 + k * 1024); } while (0)
#define PG8_LDB(dst, b, h) do { _Pragma("unroll") for (int n = 0; n < 2; ++n) _Pragma("unroll") for (int k = 0; k < 2; ++k) dst[n][k] = *(const PG8_LAS bf16x8*)(lds + PG8_SB(b, h) + boff + n * 2048 + k * 1024); } while (0)
#define PG8_MMA(ai, bj, At, Bt) do { __builtin_amdgcn_s_setprio(1); _Pragma("unroll") for (int m = 0; m < 4; ++m) _Pragma("unroll") for (int n = 0; n < 2; ++n) _Pragma("unroll") for (int k = 0; k < 2; ++k) \
        acc[ai][bj][m][n] = __builtin_amdgcn_mfma_f32_16x16x32_bf16(Bt[n][k], At[m][k], acc[ai][bj][m][n], 0, 0, 0); __builtin_amdgcn_s_setprio(0); } while (0)
#define PG8_WAIT_V(n) asm volatile("s_waitcnt vmcnt(" #n ")" ::: "memory")
#define PG8_WAIT_L(n) asm volatile("s_waitcnt lgkmcnt(" #n ")" ::: "memory")
#define PG8_BAR __builtin_amdgcn_s_barrier()
#define PG8_SCHED __builtin_amdgcn_sched_barrier(0)
    Unit cur, nxt; int ui = 0;
    if (!S.next(0, cur)) return;
    f32x4 acc[2][2][4][2];
#pragma unroll
    for (int a = 0; a < 2; ++a)
#pragma unroll
        for (int b = 0; b < 2; ++b)
#pragma unroll
            for (int m = 0; m < 4; ++m)
#pragma unroll
                for (int n = 0; n < 2; ++n) acc[a][b][m][n] = (f32x4){0.f, 0.f, 0.f, 0.f};
    bf16x8 At[4][2], B0[2][2], B1[2][2];
    const char* cA = (const char*)g.A + (size_t)cur.pm * tstepA; const char* cB = (const char*)g.Bt + (size_t)cur.pn * tstepB;
    S.a_ready(cur);
    if constexpr (SP2) {
        PG8_STAGE(PG8_SB(0, 0), cB, voffB); PG8_STAGE(PG8_SB(0, 1), cB + hstepB, voffB); PG8_STAGE(PG8_SA(0, 0), cA, voffA); PG8_STAGE(PG8_SA(0, 1), cA + hstepA, voffA);
        if (wr == 1) PG8_BAR;
        PG8_WAIT_V(2); PG8_BAR;
        PG8_STAGE(PG8_SB(1, 0), cB + kstep, voffB); PG8_STAGE(PG8_SA(1, 0), cA + kstep, voffA); PG8_STAGE(PG8_SB(1, 1), cB + hstepB + kstep, voffB);
        PG8_WAIT_V(6); PG8_BAR;
    } else {
        PG8_STAGE(PG8_SB(0, 0), cB, voffB); PG8_STAGE(PG8_SA(0, 0), cA, voffA); PG8_STAGE(PG8_SB(0, 1), cB + hstepB, voffB); PG8_STAGE(PG8_SA(0, 1), cA + hstepA, voffA);
        if (wr == 1) PG8_BAR;
        PG8_WAIT_V(4); PG8_BAR;
        PG8_STAGE(PG8_SB(1, 0), cB + kstep, voffB); PG8_STAGE(PG8_SA(1, 0), cA + kstep, voffA); PG8_STAGE(PG8_SB(1, 1), cB + hstepB + kstep, voffB);
        PG8_WAIT_V(6); PG8_BAR;
    }
    for (;;) {
        const bool has_next = S.next(ui + 1, nxt);
        const char* nA = has_next ? (const char*)g.A + (size_t)nxt.pm * tstepA : cA; const char* nB = has_next ? (const char*)g.Bt + (size_t)nxt.pn * tstepB : cB;
        for (int t = 0; t < nt; t += 2) {
            const bool last = (t == nt - 2);
            const char* a1 = cA + (size_t)(t + 1) * kstep;
            const char* a2 = last ? nA : cA + (size_t)(t + 2) * kstep; const char* b2 = last ? nB : cB + (size_t)(t + 2) * kstep;
            const char* a3 = a2 + kstep; const char* b3 = b2 + kstep;
            if (last && has_next) S.a_ready(nxt);
            if constexpr (SP2) {
            PG8_LDB(B0, 0, 0); PG8_LDB(B1, 0, 1); PG8_SCHED; PG8_LDA(At, 0, 0); PG8_STAGE(PG8_SA(1, 1), a1 + hstepA, voffA);
            PG8_WAIT_V(8); PG8_WAIT_L(0); PG8_BAR; PG8_MMA(0, 0, At, B0); PG8_MMA(0, 1, At, B1); PG8_BAR; PG8_SCHED;
            PG8_LDA(At, 0, 1); PG8_STAGE(PG8_SB(0, 0), b2, voffB); PG8_STAGE(PG8_SB(0, 1), b2 + hstepB, voffB); PG8_STAGE(PG8_SA(0, 0), a2, voffA);
            PG8_WAIT_V(8); PG8_WAIT_L(0); PG8_BAR; PG8_MMA(1, 0, At, B0); PG8_MMA(1, 1, At, B1); PG8_BAR; PG8_SCHED;
            PG8_LDB(B0, 1, 0); PG8_LDB(B1, 1, 1); PG8_SCHED; PG8_LDA(At, 1, 0); PG8_STAGE(PG8_SA(0, 1), a2 + hstepA, voffA);
            PG8_WAIT_V(8); PG8_WAIT_L(0); PG8_BAR; PG8_MMA(0, 0, At, B0); PG8_MMA(0, 1, At, B1); PG8_BAR; PG8_SCHED;
            PG8_LDA(At, 1, 1); PG8_STAGE(PG8_SB(1, 0), b3, voffB); PG8_STAGE(PG8_SB(1, 1), b3 + hstepB, voffB); PG8_STAGE(PG8_SA(1, 0), a3, voffA);
            PG8_WAIT_V(8); PG8_WAIT_L(0); PG8_BAR; PG8_MMA(1, 0, At, B0); PG8_MMA(1, 1, At, B1); PG8_BAR; PG8_SCHED;
            } else {
            PG8_LDB(B0, 0, 0); PG8_SCHED; PG8_LDA(At, 0, 0); PG8_STAGE(PG8_SA(1, 1), a1 + hstepA, voffA);
            PG8_WAIT_L(8); PG8_BAR; PG8_WAIT_L(0); PG8_MMA(0, 0, At, B0); PG8_BAR; PG8_SCHED;
            PG8_LDB(B1, 0, 1); PG8_STAGE(PG8_SB(0, 0), b2, voffB);
            PG8_BAR; PG8_WAIT_L(0); PG8_MMA(0, 1, At, B1); PG8_BAR;
            PG8_LDA(At, 0, 1); PG8_STAGE(PG8_SA(0, 0), a2, voffA);
            PG8_BAR; PG8_WAIT_L(0); PG8_MMA(1, 0, At, B0); PG8_BAR; PG8_SCHED;
            PG8_STAGE(PG8_SB(0, 1), b2 + hstepB, voffB);
            PG8_WAIT_V(6); PG8_BAR; PG8_MMA(1, 1, At, B1); PG8_BAR;
            PG8_LDB(B0, 1, 0); PG8_SCHED; PG8_LDA(At, 1, 0); PG8_STAGE(PG8_SA(0, 1), a2 + hstepA, voffA);
            PG8_WAIT_L(8); PG8_BAR; PG8_WAIT_L(0); PG8_MMA(0, 0, At, B0); PG8_BAR; PG8_SCHED;
            PG8_LDB(B1, 1, 1); PG8_STAGE(PG8_SB(1, 0), b3, voffB);
            PG8_BAR; PG8_WAIT_L(0); PG8_MMA(0, 1, At, B1); PG8_BAR;
            PG8_LDA(At, 1, 1); PG8_STAGE(PG8_SA(1, 0), a3, voffA);
            PG8_BAR; PG8_WAIT_L(0); PG8_MMA(1, 0, At, B0); PG8_BAR; PG8_SCHED;
            PG8_STAGE(PG8_SB(1, 1), b3 + hstepB, voffB);
            PG8_WAIT_V(6); PG8_BAR; PG8_MMA(1, 1, At, B1); PG8_BAR;
            }
        }
        if constexpr (ALIGN_EPI) { if (wr == 0) PG8_BAR; }
        if constexpr (!Epi::AFTER_DRAIN) { E(acc, cur, wr, wc, fr, fq); S.done(cur); }
        if (!has_next) break;
#pragma unroll
        for (int a = 0; a < 2; ++a)
#pragma unroll
            for (int b = 0; b < 2; ++b)
#pragma unroll
                for (int m = 0; m < 4; ++m)
#pragma unroll
                    for (int n = 0; n < 2; ++n) acc[a][b][m][n] = (f32x4){0.f, 0.f, 0.f, 0.f};
        cur = nxt; cA = nA; cB = nB; ++ui;
        if constexpr (ALIGN_EPI) { if (wr == 1) PG8_BAR; }
    }
    PG8_WAIT_V(0);
    if constexpr (!ALIGN_EPI) { if (wr == 0) PG8_BAR; }
    PG8_BAR;
    if constexpr (Epi::AFTER_DRAIN) { E.fused(acc, cur, wr, wc, fr, fq, lds, wid, lane); S.done(cur); }
#undef PG8_SA
#undef PG8_SB
#undef PG8_STAGE
#undef PG8_LDA
#undef PG8_LDB
#undef PG8_MMA
#undef PG8_WAIT_V
#undef PG8_WAIT_L
#undef PG8_BAR
#undef PG8_SCHED
}

__device__ __forceinline__ u32x4 pack8(const f32x4 v0, const f32x4 v1) { u32x4 w; w.x = pk2(v0[0], v0[1]); w.y = pk2(v0[2], v0[3]); w.z = pk2(v1[0], v1[1]); w.w = pk2(v1[2], v1[3]); return w; }
__device__ __forceinline__ float sq8(const f32x4 a, const f32x4 b) { return (a[0] * a[0] + a[1] * a[1]) + (a[2] * a[2] + a[3] * a[3]) + (b[0] * b[0] + b[1] * b[1]) + (b[2] * b[2] + b[3] * b[3]); }

struct EpiZ {
    static constexpr bool PERM = true, AFTER_DRAIN = false;
    bf16_t* Z; float* ssq_q; float* ssq_kv; bf16_t* KR; float* G; const float* cosT; const float* sinT;
    __device__ __forceinline__ void operator()(const f32x4 (&acc)[2][2][4][2], const Unit& u, int wr, int wc, int fr, int fq) const {
#pragma unroll
        for (int ai = 0; ai < 2; ++ai) {
            f32x4 cs[4][4];
            if (u.pn == 1 && wc == 0) {
#pragma unroll
                for (int m = 0; m < 4; ++m) { const size_t ro = (size_t)(u.pm * 256 + ai * 128 + wr * 64 + m * 16 + fr) * 16 + 8 * (fq & 1);
                    cs[m][0] = *(const f32x4*)(cosT + ro); cs[m][1] = *(const f32x4*)(cosT + ro + 4); cs[m][2] = *(const f32x4*)(sinT + ro); cs[m][3] = *(const f32x4*)(sinT + ro + 4); } }
#pragma unroll
            for (int m = 0; m < 4; ++m) {
                const int row = u.pm * 256 + ai * 128 + wr * 64 + m * 16 + fr;
                bf16_t* zp = Z + (size_t)row * LDZ + u.pn * 256 + wc * 32 + 8 * fq;
#pragma unroll
                for (int bj = 0; bj < 2; ++bj) *(u32x4*)(zp + bj * 128) = pack8(acc[ai][bj][m][0], acc[ai][bj][m][1]);
                if (u.pn == 0) {
                    float s = sq8(acc[ai][0][m][0], acc[ai][0][m][1]) + sq8(acc[ai][1][m][0], acc[ai][1][m][1]);
                    s += __shfl_xor(s, 16); s += __shfl_xor(s, 32);
                    if (fq == 0) atomicAdd(ssq_q + row, s);
                } else if (u.pn == 1) {
                    float s = sq8(acc[ai][0][m][0], acc[ai][0][m][1]);
                    s += __shfl_xor(s, 16); s += __shfl_xor(s, 32);
                    if (fq == 0) atomicAdd(ssq_kv + row, s);
                    if (wc == 0) {
                        const f32x4 o0 = acc[ai][1][m][0], o1 = acc[ai][1][m][1];
                        f32x4 p0, p1;
#pragma unroll
                        for (int j = 0; j < 4; ++j) { p0[j] = __shfl_xor(o0[j], 32); p1[j] = __shfl_xor(o1[j], 32); }
                        const f32x4 c0 = cs[m][0], c1 = cs[m][1], s0 = cs[m][2], s1 = cs[m][3];
                        f32x4 r0, r1;
                        if (fq < 2) { r0 = o0 * c0 - p0 * s0; r1 = o1 * c1 - p1 * s1; }
                        else        { r0 = o0 * c0 + p0 * s0; r1 = o1 * c1 + p1 * s1; }
                        *(u32x4*)(KR + (size_t)row * 32 + 8 * fq) = pack8(r0, r1);
                    } else if (wc == 1 && fq < 2) {
                        *(f32x4*)(G + (size_t)row * 16 + 8 * fq) = acc[ai][1][m][0];
                        *(f32x4*)(G + (size_t)row * 16 + 8 * fq + 4) = acc[ai][1][m][1];
                    }
                }
            }
        }
    }
};
struct EpiScaleBf16 {
    static constexpr bool PERM = true, AFTER_DRAIN = false;
    bf16_t* O; int ldo; const float* ssq; float inv_n; float c;
    __device__ __forceinline__ void operator()(const f32x4 (&acc)[2][2][4][2], const Unit& u, int wr, int wc, int fr, int fq) const {
        float sc[2][4];
#pragma unroll
        for (int ai = 0; ai < 2; ++ai)
#pragma unroll
            for (int m = 0; m < 4; ++m) sc[ai][m] = ssq ? ssq[u.pm * 256 + ai * 128 + wr * 64 + m * 16 + fr] : 0.f;
#pragma unroll
        for (int ai = 0; ai < 2; ++ai)
#pragma unroll
            for (int m = 0; m < 4; ++m) {
                const int row = u.pm * 256 + ai * 128 + wr * 64 + m * 16 + fr;
                const float sv = ssq ? c * rsqrtf(sc[ai][m] * inv_n + EPS) : c;
                bf16_t* op = O + (size_t)row * ldo + u.pn * 256 + wc * 32 + 8 * fq;
#pragma unroll
                for (int bj = 0; bj < 2; ++bj) *(u32x4*)(op + bj * 128) = pack8(acc[ai][bj][m][0] * sv, acc[ai][bj][m][1] * sv);
            }
    }
};
struct EpiResid {
    static constexpr bool PERM = true, AFTER_DRAIN = false;
    const float* resf; const bf16_t* resb; bf16_t* XB; float* ssq;
    __device__ __forceinline__ void operator()(const f32x4 (&acc)[2][2][4][2], const Unit& u, int wr, int wc, int fr, int fq) const {
#pragma unroll
        for (int ai = 0; ai < 2; ++ai) {
            f32x4 r0[4][2], r1[4][2];
            if (resf) {
#pragma unroll
                for (int m = 0; m < 4; ++m)
#pragma unroll
                    for (int bj = 0; bj < 2; ++bj) { const size_t off = (size_t)(u.pm * 256 + ai * 128 + wr * 64 + m * 16 + fr) * DM + u.pn * 256 + wc * 32 + 8 * fq + bj * 128;
                        r0[m][bj] = *(const f32x4*)(resf + off); r1[m][bj] = *(const f32x4*)(resf + off + 4); }
            } else {
                u32x4 rb[4][2];
#pragma unroll
                for (int m = 0; m < 4; ++m)
#pragma unroll
                    for (int bj = 0; bj < 2; ++bj) rb[m][bj] = *(const u32x4*)(resb + (size_t)(u.pm * 256 + ai * 128 + wr * 64 + m * 16 + fr) * DM + u.pn * 256 + wc * 32 + 8 * fq + bj * 128);
#pragma unroll
                for (int m = 0; m < 4; ++m)
#pragma unroll
                    for (int bj = 0; bj < 2; ++bj) { const u32x4 q = rb[m][bj];
                        r0[m][bj] = (f32x4){__uint_as_float(q.x << 16), __uint_as_float(q.x & 0xffff0000u), __uint_as_float(q.y << 16), __uint_as_float(q.y & 0xffff0000u)};
                        r1[m][bj] = (f32x4){__uint_as_float(q.z << 16), __uint_as_float(q.z & 0xffff0000u), __uint_as_float(q.w << 16), __uint_as_float(q.w & 0xffff0000u)}; }
            }
#pragma unroll
            for (int m = 0; m < 4; ++m) {
                const int row = u.pm * 256 + ai * 128 + wr * 64 + m * 16 + fr;
                const size_t off = (size_t)row * DM + u.pn * 256 + wc * 32 + 8 * fq;
                float sq = 0.f;
#pragma unroll
                for (int bj = 0; bj < 2; ++bj) {
                    const f32x4 v0 = r0[m][bj] + acc[ai][bj][m][0], v1 = r1[m][bj] + acc[ai][bj][m][1];
                    *(u32x4*)(XB + off + bj * 128) = pack8(v0, v1);
                    sq += sq8(v0, v1);
                }
                sq += __shfl_xor(sq, 16); sq += __shfl_xor(sq, 32);
                if (fq == 0) atomicAdd(ssq + row, sq);
            }
        }
    }
};
struct EpiSwiglu {
    static constexpr bool PERM = true, AFTER_DRAIN = false;
    bf16_t* H; const float* ssq;
    __device__ __forceinline__ void operator()(const f32x4 (&acc)[2][2][4][2], const Unit& u, int wr, int wc, int fr, int fq) const {
        float scv[2][4];
#pragma unroll
        for (int ai = 0; ai < 2; ++ai)
#pragma unroll
            for (int m = 0; m < 4; ++m) scv[ai][m] = ssq[u.pm * 256 + ai * 128 + wr * 64 + m * 16 + fr];
#pragma unroll
        for (int ai = 0; ai < 2; ++ai)
#pragma unroll
            for (int m = 0; m < 4; ++m) {
                const int row = u.pm * 256 + ai * 128 + wr * 64 + m * 16 + fr;
                const float sc = rsqrtf(scv[ai][m] * (1.0f / DM) + EPS);
                f32x4 h[2];
#pragma unroll
                for (int n = 0; n < 2; ++n)
#pragma unroll
                    for (int j = 0; j < 4; ++j) { const float gg = acc[ai][0][m][n][j] * sc, uu = acc[ai][1][m][n][j] * sc;
                        h[n][j] = gg * uu * __builtin_amdgcn_rcpf(1.0f + __builtin_amdgcn_exp2f(-1.4426950408889634f * gg)); }
                *(u32x4*)(H + (size_t)row * DFF + u.pn * 128 + wc * 32 + 8 * fq) = pack8(h[0], h[1]);
            }
    }
};

struct SingleOrder {
    StaticOrder base; int i;
    __device__ __forceinline__ bool next(int j, Unit& u) const { return j == 0 ? base.next(i, u) : false; }
    __device__ __forceinline__ void a_ready(const Unit&) const {}
    __device__ __forceinline__ void done(const Unit&) const {}
};
#ifndef FAST_GEMM
#define FAST_GEMM 1
#endif
template <class Epi>
__device__ __forceinline__ void run_gemm(LAS unsigned char* lds, const Gemm g, const Epi& E, int c) {
#if FAST_GEMM
    StaticOrder S; S.init(g.M, g.N, (int)gridDim.x, c);
    gemm_phase<Epi, StaticOrder, true, true>(lds, g, S, E);
#else
    gemm_naive(g, E);
#endif
}

struct MapIdent { __device__ __forceinline__ int operator()(int n) const { return n; } };
struct MapWin { __device__ __forceinline__ int operator()(int n) const {
    if (n < 416) return n; if (n < 1440) return ZC_QK + (n - 416); if (n < 1952) return ZC_V + (n - 1440); if (n < 2464) return ZC_O + (n - 1952); return ZC_G + (n - 2464); } };
struct MapGU { __device__ __forceinline__ int operator()(int n) const { const int up = n >= DFF, j = up ? n - DFF : n; return (j >> 7) * 256 + up * 128 + (j & 127); } };

template <class Map>
__device__ __forceinline__ void transpose_w(const float* W, int K, int N, const float* gain, bf16_t* WT, int ldt, Map map, LAS float* scr, int gw, int ngw, int lane) {
    const int nblk = (N + 31) / 32, nitems = (K / 64) * nblk;
    for (int it = gw; it < nitems; it += ngw) {
        const int kb = it / nblk, nb = it % nblk, k0 = 64 * kb, n0 = 32 * nb;
        { const int nn = n0 + (lane & 31); const bool ok = nn < N; const float* wp = W + (size_t)(k0 + (lane >> 5)) * N + (ok ? nn : 0);
          float v[32];
#pragma unroll
          for (int i = 0; i < 32; ++i) v[i] = wp[(size_t)(2 * i) * N];
          if (gain) {
#pragma unroll
              for (int i = 0; i < 32; ++i) v[i] *= gain[k0 + 2 * i + (lane >> 5)]; }
#pragma unroll
          for (int i = 0; i < 32; ++i) scr[(2 * i + (lane >> 5)) * 33 + (lane & 31)] = ok ? v[i] : 0.f; }
        asm volatile("s_waitcnt lgkmcnt(0)" ::: "memory");
        const int c = lane & 7;
#pragma unroll
        for (int j = 0; j < 4; ++j) { const int n = (lane >> 3) + 8 * j, nn = n0 + n;
            if (nn < N) { const LAS float* s = scr + (8 * c) * 33 + n;
                u32x4 o; o.x = pk2(s[0 * 33], s[1 * 33]); o.y = pk2(s[2 * 33], s[3 * 33]); o.z = pk2(s[4 * 33], s[5 * 33]); o.w = pk2(s[6 * 33], s[7 * 33]);
                *(u32x4*)(WT + (size_t)map(nn) * ldt + k0 + 8 * c) = o; } }
        asm volatile("s_waitcnt lgkmcnt(0)" ::: "memory");
    }
}
__device__ __forceinline__ void rms_row_bf16(const float* xrow, const float* gain, bf16_t* orow, int lane) {
    const f32x4* xr = (const f32x4*)xrow + lane; const f32x4* gr = (const f32x4*)gain + lane;
    f32x4 v[4]; float s = 0.f;
#pragma unroll
    for (int j = 0; j < 4; ++j) { v[j] = xr[64 * j]; s += (v[j][0] * v[j][0] + v[j][1] * v[j][1]) + (v[j][2] * v[j][2] + v[j][3] * v[j][3]); }
    const float r = rsqrtf(wave_sum(s) * (1.0f / DM) + EPS);
    u32x2* o8 = (u32x2*)orow + lane;
#pragma unroll
    for (int j = 0; j < 4; ++j) { const f32x4 gg = gr[64 * j]; u32x2 w; w.x = pk2(v[j][0] * r * gg[0], v[j][1] * r * gg[1]); w.y = pk2(v[j][2] * r * gg[2], v[j][3] * r * gg[3]); o8[64 * j] = w; }
}

__device__ __forceinline__ void phase0(const Params& p, LAS unsigned char* lds) {
    const int tid = threadIdx.x, wid = tid >> 6, lane = tid & 63;
    const int gw = blockIdx.x * NWAVES + wid, ngw = gridDim.x * NWAVES;
    const int gt = blockIdx.x * NTHR + tid, ngt = gridDim.x * NTHR;
    LAS float* scr = (LAS float*)(lds + wid * 16384);
    unsigned char* ws = p.ws;
    transpose_w(p.w_in, DM, INW, nullptr, (bf16_t*)(ws + WS_WIN), DM, MapWin(), scr, gw, ngw, lane);
    transpose_w(p.w_uq, QLORA, MLA_H * DQK, p.q_norm, (bf16_t*)(ws + WS_WUQ), QLORA, MapIdent(), scr, gw, ngw, lane);
    transpose_w(p.w_ukv, KVLORA, MLA_H * (NOPE + VD), p.kv_norm, (bf16_t*)(ws + WS_WUKV), 256, MapIdent(), scr, gw, ngw, lane);
    transpose_w(p.w_out, DM, DM, nullptr, (bf16_t*)(ws + WS_WOUT), DM, MapIdent(), scr, gw, ngw, lane);
    transpose_w(p.w_xq, DM, DM, p.xattn_norm, (bf16_t*)(ws + WS_WXQ), DM, MapIdent(), scr, gw, ngw, lane);
    transpose_w(p.w_xkv, DM, 2 * DM, nullptr, (bf16_t*)(ws + WS_WXKV), DM, MapIdent(), scr, gw, ngw, lane);
    transpose_w(p.w_xo, DM, DM, nullptr, (bf16_t*)(ws + WS_WXO), DM, MapIdent(), scr, gw, ngw, lane);
    transpose_w(p.w_gu, DM, 2 * DFF, p.ffn_norm, (bf16_t*)(ws + WS_WGU), DM, MapGU(), scr, gw, ngw, lane);
    transpose_w(p.w_down, DFF, DM, nullptr, (bf16_t*)(ws + WS_WD), DFF, MapIdent(), scr, gw, ngw, lane);
    { bf16_t* wz = (bf16_t*)(ws + WS_WIN) + (size_t)432 * DM; for (int i = gt; i < 80 * DM / 8; i += ngt) ((u32x4*)wz)[i] = (u32x4){0u, 0u, 0u, 0u};
      bf16_t* wk = (bf16_t*)(ws + WS_WUKV); for (int i = gt; i < 1024 * 16; i += ngt) { const int r = i >> 4, c = i & 15; *(u32x4*)(wk + (size_t)r * 256 + 128 + 8 * c) = (u32x4){0u, 0u, 0u, 0u}; } }
    { float* sm = (float*)(ws + WS_SMALL);
      for (int i = gt; i < SM_END; i += ngt) { float v = 0.f;
          if (i < SM_GBIAS) v = p.conv[i]; else if (i < SM_GBIAS + 16) v = p.gbias[i - SM_GBIAS]; else if (i >= SM_MLN && i < SM_MLN + 512) v = p.ml_norm[i - SM_MLN]; else if (i >= SM_FIN) v = p.final_norm[i - SM_FIN];
          sm[i] = v; } }
    { float* ssq = (float*)(ws + WS_SSQ); for (int i = gt; i < 5 * T; i += ngt) ssq[i] = 0.f; }
    { float* ct = (float*)(ws + WS_COS); float* st = (float*)(ws + WS_SIN);
      for (int i = gt; i < T * 16; i += ngt) { const int row = i >> 4, j = i & 15;
          float inv = 1.0f;
          switch (j) { case 1: inv = 0.5623413251903491f; break; case 2: inv = 0.31622776601683794f; break; case 3: inv = 0.1778279410038923f; break; case 4: inv = 0.1f; break;
                       case 5: inv = 0.05623413251903491f; break; case 6: inv = 0.03162277660168379f; break; case 7: inv = 0.01778279410038923f; break; case 8: inv = 0.01f; break;
                       case 9: inv = 0.005623413251903491f; break; case 10: inv = 0.003162277660168379f; break; case 11: inv = 0.001778279410038923f; break; case 12: inv = 0.001f; break;
                       case 13: inv = 0.0005623413251903491f; break; case 14: inv = 0.00031622776601683794f; break; case 15: inv = 0.0001778279410038923f; break; default: break; }
          const float ang = (float)p.pos[row] * inv; float sn, cs; sincosf(ang, &sn, &cs); ct[i] = cs; st[i] = sn; } }
    for (int r4 = gw * 4; r4 < T; r4 += ngw * 4) {
        f32x4 v[4][4]; float sq[4];
#pragma unroll
        for (int q = 0; q < 4; ++q) { const f32x4* xr = (const f32x4*)(p.x + (size_t)(r4 + q) * DM) + lane;
#pragma unroll
            for (int j = 0; j < 4; ++j) v[q][j] = xr[64 * j]; }
#pragma unroll
        for (int q = 0; q < 4; ++q) { float s_ = 0.f;
#pragma unroll
            for (int j = 0; j < 4; ++j) s_ += (v[q][j][0] * v[q][j][0] + v[q][j][1] * v[q][j][1]) + (v[q][j][2] * v[q][j][2] + v[q][j][3] * v[q][j][3]);
            sq[q] = s_; }
#pragma unroll
        for (int o = 1; o < 64; o <<= 1) {
#pragma unroll
            for (int q = 0; q < 4; ++q) sq[q] += __shfl_xor(sq[q], o); }
        const f32x4* gr = (const f32x4*)p.attn_norm + lane;
#pragma unroll
        for (int q = 0; q < 4; ++q) { const float r_ = rsqrtf(sq[q] * (1.0f / DM) + EPS); u32x2* o8 = (u32x2*)((bf16_t*)(ws + WS_XB) + (size_t)(r4 + q) * DM) + lane;
#pragma unroll
            for (int j = 0; j < 4; ++j) { const f32x4 gg = gr[64 * j]; u32x2 w; w.x = pk2(v[q][j][0] * r_ * gg[0], v[q][j][1] * r_ * gg[1]); w.y = pk2(v[q][j][2] * r_ * gg[2], v[q][j][3] * r_ * gg[3]); o8[64 * j] = w; } }
    }
    for (int r = gw; r < TM; r += ngw) rms_row_bf16(p.mem + (size_t)r * DM, p.mem_norm, (bf16_t*)(ws + WS_MEMN) + (size_t)r * DM, lane);
}

__device__ __forceinline__ void phase_conv(const Params& p) {
    const bf16_t* Z = (const bf16_t*)(p.ws + WS_Z); bf16_t* Q = (bf16_t*)(p.ws + WS_XB); const float* conv = (const float*)(p.ws + WS_SMALL) + SM_CONV;
    const int c0 = (threadIdx.x & 127) * 8, rsub = threadIdx.x >> 7;
    f32x4 w[3][2];
#pragma unroll
    for (int k = 0; k < 3; ++k) { w[k][0] = *(const f32x4*)(conv + k * 1024 + c0); w[k][1] = *(const f32x4*)(conv + k * 1024 + c0 + 4); }
    const float sc = c0 >= 512 ? 0.08838834764831845f : 1.0f;
    for (int row = blockIdx.x * 4 + rsub; row < T; row += gridDim.x * 4) {
        const int t = row & (SEQ - 1);
        const bf16x8 zc = *(const bf16x8*)(Z + (size_t)row * LDZ + ZC_QK + c0);
        bf16x8 zp = (bf16x8){0, 0, 0, 0, 0, 0, 0, 0}, zn = zp;
        if (t > 0) zp = *(const bf16x8*)(Z + (size_t)(row - 1) * LDZ + ZC_QK + c0);
        if (t < SEQ - 1) zn = *(const bf16x8*)(Z + (size_t)(row + 1) * LDZ + ZC_QK + c0);
        float o[8];
#pragma unroll
        for (int j = 0; j < 8; ++j) { const float a = w[0][j >> 2][j & 3] * bf2f((bf16_t)zp[j]) + w[1][j >> 2][j & 3] * bf2f((bf16_t)zc[j]) + w[2][j >> 2][j & 3] * bf2f((bf16_t)zn[j]);
            o[j] = a * sc * __builtin_amdgcn_rcpf(1.0f + __builtin_amdgcn_exp2f(-1.4426950408889634f * a)); }
        u32x4 wv; wv.x = pk2(o[0], o[1]); wv.y = pk2(o[2], o[3]); wv.z = pk2(o[4], o[5]); wv.w = pk2(o[6], o[7]);
        *(u32x4*)(Q + (size_t)row * 1024 + c0) = wv;
    }
}

__device__ __forceinline__ void mlstm_naive(const Params& p) {
    const bf16_t* Z = (const bf16_t*)(p.ws + WS_Z); const bf16_t* QKC = (const bf16_t*)(p.ws + WS_XB); const float* G = (const float*)(p.ws + WS_G); const float* gbias = (const float*)(p.ws + WS_SMALL) + SM_GBIAS;
    bf16_t* HF = (bf16_t*)p.out; bf16_t* HB = HF + (size_t)T * ML_W;
    const int tid = threadIdx.x, d = tid >> 2, eq = tid & 3;
    for (int unit = blockIdx.x; unit < BATCH * ML_H * 2; unit += gridDim.x) {
        const int dir = unit & 1, h = (unit >> 1) & 3, b = unit >> 3;
        float C[32], n[32]; float m = 0.f;
#pragma unroll
        for (int j = 0; j < 32; ++j) { C[j] = 0.f; n[j] = 0.f; }
        const float bi = gbias[dir * 8 + h], bff = gbias[dir * 8 + 4 + h];
        bf16_t* Hout = dir ? HB : HF;
        for (int s = 0; s < SEQ; ++s) {
            const int t = dir ? SEQ - 1 - s : s; const size_t row = (size_t)b * SEQ + t;
            const float ip = G[row * 16 + dir * 8 + h] + bi, fp = G[row * 16 + dir * 8 + 4 + h] + bff;
            const float logf = fminf(fp, 0.f) - log1pf(__expf(-fabsf(fp)));
            const float mn = fmaxf(logf + m, ip), fe = __expf(logf + m - mn), ie = __expf(ip - mn);
            m = mn;
            const float vv = bf2f(Z[row * LDZ + ZC_V + h * 128 + d]) * ie;
            float pn = 0.f, pd = 0.f;
#pragma unroll
            for (int c = 0; c < 4; ++c) {
                const bf16x8 q8 = *(const bf16x8*)(QKC + row * 1024 + h * 128 + eq * 32 + c * 8);
                const bf16x8 k8 = *(const bf16x8*)(QKC + row * 1024 + 512 + h * 128 + eq * 32 + c * 8);
#pragma unroll
                for (int j = 0; j < 8; ++j) { const float qq = bf2f((bf16_t)q8[j]), kk = bf2f((bf16_t)k8[j]);
                    C[c * 8 + j] = fe * C[c * 8 + j] + vv * kk; n[c * 8 + j] = fe * n[c * 8 + j] + ie * kk;
                    pn += C[c * 8 + j] * qq; pd += n[c * 8 + j] * qq; }
            }
            pn += __shfl_xor(pn, 1); pn += __shfl_xor(pn, 2); pd += __shfl_xor(pd, 1); pd += __shfl_xor(pd, 2);
            if (eq == 0) Hout[row * ML_W + h * 128 + d] = (bf16_t)f2bf(pn / fmaxf(fabsf(pd), __expf(-mn)));
        }
    }
}
__device__ __forceinline__ void phase_mlfin(const Params& p, int bidx, int nblk) {
    const bf16_t* Z = (const bf16_t*)(p.ws + WS_Z); bf16_t* Y = (bf16_t*)(p.ws + WS_Y);
    const bf16_t* HF = (const bf16_t*)p.out; const bf16_t* HB = HF + (size_t)T * ML_W;
    const float* mln = (const float*)(p.ws + WS_SMALL) + SM_MLN;
    const int wid = threadIdx.x >> 6, lane = threadIdx.x & 63;
    const f32x4 g0 = *(const f32x4*)(mln + lane * 8), g1 = *(const f32x4*)(mln + lane * 8 + 4);
    for (int row4 = (bidx * NWAVES + wid) * 4; row4 < T; row4 += nblk * NWAVES * 4) {
        u32x4 hf[4], hb[4]; bf16x8 zo[4];
#pragma unroll
        for (int q = 0; q < 4; ++q) { const size_t o = (size_t)(row4 + q) * ML_W + lane * 8;
            hf[q] = *(const u32x4*)(HF + o); hb[q] = *(const u32x4*)(HB + o); zo[q] = *(const bf16x8*)(Z + (size_t)(row4 + q) * LDZ + ZC_O + lane * 8); }
#pragma unroll
        for (int q = 0; q < 4; ++q) {
            float a[8];
            a[0] = __uint_as_float(hf[q].x << 16) + __uint_as_float(hb[q].x << 16); a[1] = __uint_as_float(hf[q].x & 0xffff0000u) + __uint_as_float(hb[q].x & 0xffff0000u);
            a[2] = __uint_as_float(hf[q].y << 16) + __uint_as_float(hb[q].y << 16); a[3] = __uint_as_float(hf[q].y & 0xffff0000u) + __uint_as_float(hb[q].y & 0xffff0000u);
            a[4] = __uint_as_float(hf[q].z << 16) + __uint_as_float(hb[q].z << 16); a[5] = __uint_as_float(hf[q].z & 0xffff0000u) + __uint_as_float(hb[q].z & 0xffff0000u);
            a[6] = __uint_as_float(hf[q].w << 16) + __uint_as_float(hb[q].w << 16); a[7] = __uint_as_float(hf[q].w & 0xffff0000u) + __uint_as_float(hb[q].w & 0xffff0000u);
            float s_ = 0.f;
#pragma unroll
            for (int j = 0; j < 8; ++j) s_ += a[j] * a[j];
            s_ += __shfl_xor(s_, 1); s_ += __shfl_xor(s_, 2); s_ += __shfl_xor(s_, 4); s_ += __shfl_xor(s_, 8);
            const float r = rsqrtf(s_ * (1.0f / ML_D) + EPS);
            float ov[8];
#pragma unroll
            for (int j = 0; j < 8; ++j) { const float hv = a[j] * r * (j < 4 ? g0[j] : g1[j - 4]); const float z = bf2f((bf16_t)zo[q][j]); ov[j] = hv * __builtin_amdgcn_rcpf(1.0f + __builtin_amdgcn_exp2f(-1.4426950408889634f * z)); }
            u32x4 w; w.x = pk2(ov[0], ov[1]); w.y = pk2(ov[2], ov[3]); w.z = pk2(ov[4], ov[5]); w.w = pk2(ov[6], ov[7]);
            *(u32x4*)(Y + (size_t)(row4 + q) * DM + 512 + lane * 8) = w;
        }
    }
}

__device__ __forceinline__ void mla_attn_naive(const Params& p, LAS unsigned char* lds) {
    const bf16_t* QALL = (const bf16_t*)(p.ws + WS_QALL); const bf16_t* KV = (const bf16_t*)(p.ws + WS_KV); const bf16_t* KR = (const bf16_t*)(p.ws + WS_KR);
    const float* cosT = (const float*)(p.ws + WS_COS); const float* sinT = (const float*)(p.ws + WS_SIN); bf16_t* Y = (bf16_t*)(p.ws + WS_Y);
    const int wid = threadIdx.x >> 6, lane = threadIdx.x & 63;
    LAS float* sc = (LAS float*)(lds + wid * 16384);
    LAS float* qs = (LAS float*)(lds + 131072 + wid * 512);
    const float scale = 0.10206207261596575f;
    for (int item = blockIdx.x * NWAVES + wid; item < T * MLA_H; item += gridDim.x * NWAVES) {
        const int h = item & 7, row = item >> 3, b = row / SEQ;
        for (int dd = lane; dd < DQK; dd += 64) {
            float v = bf2f(QALL[(size_t)row * 768 + h * DQK + dd]);
            if (dd >= NOPE) { const int j = (dd - NOPE) & 15; const float c = cosT[(size_t)row * 16 + j], s = sinT[(size_t)row * 16 + j];
                const float other = bf2f(QALL[(size_t)row * 768 + h * DQK + (dd < NOPE + 16 ? dd + 16 : dd - 16)]);
                v = dd < NOPE + 16 ? v * c - other * s : v * c + other * s; }
            qs[dd] = v * scale;
        }
        asm volatile("s_waitcnt lgkmcnt(0)" ::: "memory");
        float mx = -1e30f;
        for (int k0 = 0; k0 < SEQ; k0 += 64) {
            const size_t kr = (size_t)b * SEQ + k0 + lane; float s = 0.f;
#pragma unroll
            for (int c = 0; c < 8; ++c) { const bf16x8 k8 = *(const bf16x8*)(KV + kr * 1024 + h * 128 + c * 8);
#pragma unroll
                for (int j = 0; j < 8; ++j) s += qs[c * 8 + j] * bf2f((bf16_t)k8[j]); }
#pragma unroll
            for (int c = 0; c < 4; ++c) { const bf16x8 k8 = *(const bf16x8*)(KR + kr * 32 + c * 8);
#pragma unroll
                for (int j = 0; j < 8; ++j) s += qs[NOPE + c * 8 + j] * bf2f((bf16_t)k8[j]); }
            sc[k0 + lane] = s; mx = fmaxf(mx, s);
        }
        mx = wave_max(mx);
        float l = 0.f;
        for (int k0 = 0; k0 < SEQ; k0 += 64) { const float e = __expf(sc[k0 + lane] - mx); sc[k0 + lane] = e; l += e; }
        l = wave_sum(l);
        asm volatile("s_waitcnt lgkmcnt(0)" ::: "memory");
        float o = 0.f;
        for (int k = 0; k < SEQ; ++k) o += sc[k] * bf2f(KV[((size_t)b * SEQ + k) * 1024 + h * 128 + 64 + lane]);
        Y[(size_t)row * DM + h * VD + lane] = (bf16_t)f2bf(o / l);
        asm volatile("s_waitcnt lgkmcnt(0)" ::: "memory");
    }
}
__device__ __forceinline__ void x_attn_naive(const Params& p, LAS unsigned char* lds) {
    const bf16_t* HQ = (const bf16_t*)(p.ws + WS_HQ); const bf16_t* KVM = (const bf16_t*)(p.ws + WS_KVM); bf16_t* OX = (bf16_t*)(p.ws + WS_OX);
    const int wid = threadIdx.x >> 6, lane = threadIdx.x & 63;
    LAS float* sc = (LAS float*)(lds + wid * 16384);
    LAS float* qs = (LAS float*)(lds + 131072 + wid * 1024);
    for (int item = blockIdx.x * NWAVES + wid; item < T * XH; item += gridDim.x * NWAVES) {
        const int h = item & 3, row = item >> 2, b = row / SEQ;
        for (int dd = lane; dd < XD; dd += 64) qs[dd] = bf2f(HQ[(size_t)row * DM + h * XD + dd]) * 0.0625f;
        asm volatile("s_waitcnt lgkmcnt(0)" ::: "memory");
        float mx = -1e30f;
        for (int k0 = 0; k0 < NMEM; k0 += 64) {
            const size_t kr = (size_t)b * NMEM + k0 + lane; float s = 0.f;
            for (int c = 0; c < 32; ++c) { const bf16x8 k8 = *(const bf16x8*)(KVM + kr * 2048 + h * XD + c * 8);
#pragma unroll
                for (int j = 0; j < 8; ++j) s += qs[c * 8 + j] * bf2f((bf16_t)k8[j]); }
            sc[k0 + lane] = s; mx = fmaxf(mx, s);
        }
        mx = wave_max(mx);
        float l = 0.f;
        for (int k0 = 0; k0 < NMEM; k0 += 64) { const float e = __expf(sc[k0 + lane] - mx); sc[k0 + lane] = e; l += e; }
        l = wave_sum(l);
        asm volatile("s_waitcnt lgkmcnt(0)" ::: "memory");
        float o[4] = {0.f, 0.f, 0.f, 0.f};
        for (int k = 0; k < NMEM; ++k) { const u32x2 v4 = *(const u32x2*)(KVM + ((size_t)b * NMEM + k) * 2048 + 1024 + h * XD + 4 * lane); const float pk = sc[k];
            o[0] += pk * __uint_as_float(v4.x << 16); o[1] += pk * __uint_as_float(v4.x & 0xffff0000u); o[2] += pk * __uint_as_float(v4.y << 16); o[3] += pk * __uint_as_float(v4.y & 0xffff0000u); }
        const float rl = 1.0f / l; u32x2 w; w.x = pk2(o[0] * rl, o[1] * rl); w.y = pk2(o[2] * rl, o[3] * rl);
        *(u32x2*)(OX + (size_t)row * DM + h * XD + 4 * lane) = w;
        asm volatile("s_waitcnt lgkmcnt(0)" ::: "memory");
    }
}

namespace fa {
using f32x16 = __attribute__((ext_vector_type(16))) float;
using s16x4  = __attribute__((ext_vector_type(4))) short;
typedef float f32x2_t __attribute__((ext_vector_type(2))); typedef __bf16 bf16x2_t __attribute__((ext_vector_type(2)));
#define FA_SBAR() __builtin_amdgcn_sched_barrier(0)
constexpr float THRL = 11.0f;
__device__ __forceinline__ int crow(int r, int hi) { return (r & 3) + 8 * (r >> 2) + 4 * hi; }
__device__ __forceinline__ unsigned cvtpk(float lo, float hi) { unsigned r; asm volatile("v_cvt_pk_bf16_f32 %0, %1, %2" : "=v"(r) : "v"(lo), "v"(hi)); return r; }
__device__ __forceinline__ unsigned cvtpk_s(float lo, float hi) { f32x2_t v = {lo, hi}; bf16x2_t b = __builtin_convertvector(v, bf16x2_t); return __builtin_bit_cast(unsigned, b); }
#define FA_MX3(a, b, c) __builtin_fmaxf(__builtin_fmaxf((a), (b)), (c))
__device__ __forceinline__ float rowmax32(const f32x16& p0, const f32x16& p1) {
    float a = FA_MX3(p0[0], p0[1], p1[0]), b = FA_MX3(p0[2], p0[3], p1[1]); a = FA_MX3(a, p1[2], p1[3]);
#pragma unroll
    for (int r = 4; r < 16; r += 4) { a = FA_MX3(a, p0[r], p0[r + 1]); b = FA_MX3(b, p0[r + 2], p0[r + 3]); a = FA_MX3(a, p1[r], p1[r + 1]); b = FA_MX3(b, p1[r + 2], p1[r + 3]); }
    float rm = __builtin_fmaxf(a, b);
    auto rr = __builtin_amdgcn_permlane32_swap(__float_as_uint(rm), __float_as_uint(rm), false, false);
    return __builtin_fmaxf(__uint_as_float(rr[0]), __uint_as_float(rr[1]));
}
template <bool FIRST>
__device__ __forceinline__ void smA(f32x16& p0, f32x16& p1, float& mref, f32x16& negm, LAS float* fl, int r32, int hi, bool& resc, float& fself) {
    const float rm = rowmax32(p0, p1);
    resc = false; fself = 1.f;
    if (FIRST || __builtin_expect(__any(rm > THRL), 0)) {
        const float dl = FIRST ? rm : __builtin_fmaxf(rm, 0.f);
        mref += dl;
#pragma unroll
        for (int r = 0; r < 16; ++r) { p0[r] -= dl; p1[r] -= dl; }
#pragma unroll
        for (int r = 0; r < 16; ++r) negm[r] = -mref;
        if (!FIRST) { fself = __builtin_amdgcn_exp2f(-dl); if (hi == 0) fl[r32] = fself; resc = true; }
    }
#pragma unroll
    for (int r = 0; r < 16; ++r) p0[r] = __builtin_amdgcn_exp2f(p0[r]);
}
__device__ __forceinline__ void smB(const f32x16& p0, f32x16& p1, bf16x8& pa0, bf16x8& pa1, bf16x8& pa2, bf16x8& pa3) {
#pragma unroll
    for (int r = 0; r < 16; ++r) p1[r] = __builtin_amdgcn_exp2f(p1[r]);
#define FA_PKD(P, B, OUT) do { u32x4 w_ = {cvtpk_s(P[B], P[B + 1]), cvtpk_s(P[B + 2], P[B + 3]), cvtpk_s(P[B + 4], P[B + 5]), cvtpk_s(P[B + 6], P[B + 7])}; OUT = __builtin_bit_cast(bf16x8, w_); } while (0)
    FA_PKD(p0, 0, pa0); FA_PKD(p0, 8, pa1); FA_PKD(p1, 0, pa2); FA_PKD(p1, 8, pa3);
#undef FA_PKD
}
template <int NDQ, int KP>
__device__ __forceinline__ void qkt(f32x16& p0, f32x16& p1, const LAS unsigned char* Ks, const bf16x8* qr, const f32x16& negm, int r32, int hi) {
#pragma unroll
    for (int d0 = 0; d0 < NDQ; ++d0) { const int cb = (d0 * 16 + hi * 8) * 2;
        const bf16x8 b0 = *(const LAS bf16x8*)(Ks + r32 * KP + cb);
        const bf16x8 b1 = *(const LAS bf16x8*)(Ks + (32 + r32) * KP + cb);
        if (d0 == 0) { p0 = __builtin_amdgcn_mfma_f32_32x32x16_bf16(b0, qr[0], negm, 0, 0, 0); p1 = __builtin_amdgcn_mfma_f32_32x32x16_bf16(b1, qr[0], negm, 0, 0, 0); }
        else { p0 = __builtin_amdgcn_mfma_f32_32x32x16_bf16(b0, qr[d0], p0, 0, 0, 0); p1 = __builtin_amdgcn_mfma_f32_32x32x16_bf16(b1, qr[d0], p1, 0, 0, 0); } }
}
template <int NDV> __device__ __forceinline__ int v_st(int k, int c) { const int kk = (k & ~0xC) | ((k & 4) << 1) | ((k & 8) >> 1); return ((kk >> 3) * NDV + (c >> 5)) * 512 + ((kk & 7) * 32 + (c & 31)) * 2; }
template <int NDV> __device__ __forceinline__ int v_stp(int k, int c) { return ((k >> 3) * NDV + (c >> 5)) * 512 + ((k & 7) * 32 + (c & 31)) * 2; }
__device__ __forceinline__ int v_rd_base(int lane) { return ((lane & 3) << 3) | (((lane >> 2) & 3) << 6) | (((lane >> 4) & 1) << 5) | (((lane >> 5) & 1) << 8); }
template <int OFF> __device__ __forceinline__ s16x4 tr_read(int vb) { s16x4 r; asm volatile("ds_read_b64_tr_b16 %0, %1 offset:%2" : "=&v"(r) : "v"(vb), "i"(OFF) : "memory"); return r; }
template <int NDV, int D0> __device__ __forceinline__ void pv_one(f32x16& od, int vb, bf16x8 pa0, bf16x8 pa1, bf16x8 pa2, bf16x8 pa3) {
    constexpr int KS = 2 * NDV * 512, HF = NDV * 512, B0 = D0 * 512;
    const s16x4 l0 = tr_read<B0>(vb), h0 = tr_read<B0 + HF>(vb), l1 = tr_read<B0 + KS>(vb), h1 = tr_read<B0 + KS + HF>(vb);
    const s16x4 l2 = tr_read<B0 + 2 * KS>(vb), h2 = tr_read<B0 + 2 * KS + HF>(vb), l3 = tr_read<B0 + 3 * KS>(vb), h3 = tr_read<B0 + 3 * KS + HF>(vb);
    asm volatile("s_waitcnt lgkmcnt(0)" ::: "memory"); FA_SBAR();
#define FA_PK(L, H) (bf16x8){L[0], L[1], L[2], L[3], H[0], H[1], H[2], H[3]}
    od = __builtin_amdgcn_mfma_f32_32x32x16_bf16(pa0, FA_PK(l0, h0), od, 0, 0, 0);
    od = __builtin_amdgcn_mfma_f32_32x32x16_bf16(pa1, FA_PK(l1, h1), od, 0, 0, 0);
    od = __builtin_amdgcn_mfma_f32_32x32x16_bf16(pa2, FA_PK(l2, h2), od, 0, 0, 0);
    od = __builtin_amdgcn_mfma_f32_32x32x16_bf16(pa3, FA_PK(l3, h3), od, 0, 0, 0);
#undef FA_PK
}
__device__ __forceinline__ void pl_ones(f32x16& lacc, bf16x8 pa0, bf16x8 pa1, bf16x8 pa2, bf16x8 pa3) {
    const bf16x8 one = (bf16x8){0x3F80, 0x3F80, 0x3F80, 0x3F80, 0x3F80, 0x3F80, 0x3F80, 0x3F80};
    lacc = __builtin_amdgcn_mfma_f32_32x32x16_bf16(pa0, one, lacc, 0, 0, 0); lacc = __builtin_amdgcn_mfma_f32_32x32x16_bf16(pa1, one, lacc, 0, 0, 0);
    lacc = __builtin_amdgcn_mfma_f32_32x32x16_bf16(pa2, one, lacc, 0, 0, 0); lacc = __builtin_amdgcn_mfma_f32_32x32x16_bf16(pa3, one, lacc, 0, 0, 0);
}
__device__ __forceinline__ bf16x8 cvt8(const float* v) { u32x4 w = {cvtpk(v[0], v[1]), cvtpk(v[2], v[3]), cvtpk(v[4], v[5]), cvtpk(v[6], v[7])}; return *reinterpret_cast<bf16x8*>(&w); }

constexpr int MLA_KP = 208, MLA_SHM_K = 64 * MLA_KP, MLA_SHM_V = 64 * 64 * 2, MLA_WS = 3 * MLA_SHM_V + 3 * MLA_SHM_K;
__device__ __forceinline__ void mla_unit(int b, int h, int qb, const bf16_t* __restrict__ QALL, const bf16_t* __restrict__ KV, const bf16_t* __restrict__ KR,
                                         const float* __restrict__ cosT, const float* __restrict__ sinT, bf16_t* __restrict__ Y, LAS unsigned char* lds) {
    const int tid = threadIdx.x, wid = tid >> 6, lane = tid & 63, r32 = lane & 31, hi = lane >> 5;
    LAS unsigned char* V_lds = lds; LAS unsigned char* K_lds = lds + 3 * MLA_SHM_V;
    LAS float* fl = (LAS float*)(lds + MLA_WS) + wid * 32;
    float mref = 0.f; f32x16 o[2] = {}; f32x16 lacc = {}; f32x16 negm = {}; bf16x8 qr[6];
    const size_t rowb = (size_t)b * SEQ;
    {
        const size_t qrow = rowb + qb * 256 + wid * 32 + r32;
        const bf16_t* Qw = QALL + qrow * 768 + h * 96 + hi * 8;
        const float C = 0.10206207261596575f * 1.4426950408889634f;
        float x1[8], x2[8];
#pragma unroll
        for (int d0 = 0; d0 < 6; ++d0) { const bf16x8 raw = *(const bf16x8*)(Qw + d0 * 16); float v[8];
#pragma unroll
            for (int j = 0; j < 8; ++j) v[j] = bf2f((bf16_t)raw[j]);
            if (d0 < 4) {
#pragma unroll
                for (int j = 0; j < 8; ++j) v[j] *= C;
                qr[d0] = cvt8(v); }
            else if (d0 == 4) {
#pragma unroll
                for (int j = 0; j < 8; ++j) x1[j] = v[j]; }
            else {
#pragma unroll
                for (int j = 0; j < 8; ++j) x2[j] = v[j]; } }
        float o1[8], o2[8];
#pragma unroll
        for (int j = 0; j < 8; ++j) { const float c = cosT[qrow * 16 + hi * 8 + j], s = sinT[qrow * 16 + hi * 8 + j]; o1[j] = (x1[j] * c - x2[j] * s) * C; o2[j] = (x2[j] * c + x1[j] * s) * C; }
        qr[4] = cvt8(o1); qr[5] = cvt8(o2);
    }
    const int sr = tid >> 3, scn = tid & 7, rr = (tid & 255) >> 2, rc = tid & 3;
    const bf16_t* gkn = KV + (rowb + sr) * 1024 + h * 128 + scn * 8;
    const bf16_t* gv = gkn + 64;
    const bf16_t* gkr = KR + (rowb + rr) * 32 + rc * 8;
    const int okn = sr * MLA_KP + scn * 16, okr = rr * MLA_KP + 128 + rc * 16, ov = v_stp<2>(sr, scn * 8);
    const int vb0 = (int)(unsigned)(uintptr_t)V_lds + v_rd_base(lane);
    bf16x8 s_kn, s_kr, s_v;
#define FA_SLOAD(k0) do { s_v = *(const bf16x8*)(gv + (size_t)(k0) * 1024); s_kn = *(const bf16x8*)(gkn + (size_t)(k0) * 1024); s_kr = *(const bf16x8*)(gkr + (size_t)(k0) * 32); } while (0)
#define FA_SWRITE(sl) do { *(LAS bf16x8*)(V_lds + (sl) * MLA_SHM_V + ov) = s_v; *(LAS bf16x8*)(K_lds + (sl) * MLA_SHM_K + okn) = s_kn; *(LAS bf16x8*)(K_lds + (sl) * MLA_SHM_K + okr) = s_kr; } while (0)
#define FA_RESC(f) do { if (f) { asm volatile("s_waitcnt lgkmcnt(0)" ::: "memory"); \
    _Pragma("unroll") for (int r = 0; r < 16; ++r) { const float f_ = fl[crow(r, hi)]; o[0][r] *= f_; o[1][r] *= f_; lacc[r] *= f_; } } } while (0)
#define FA_PV(vbx) do { pv_one<2, 0>(o[0], (vbx), pa0, pa1, pa2, pa3); pv_one<2, 1>(o[1], (vbx), pa0, pa1, pa2, pa3); pl_ones(lacc, pa0, pa1, pa2, pa3); } while (0)
#define FA_ROT() do { const int t_ = sp; sp = sc; sc = sn; sn = t_; } while (0)
    f32x16 pA0, pA1, pB0, pB1; bool rsA, rsB; float fdum; bf16x8 pa0, pa1, pa2, pa3; constexpr int NT = SEQ / 64;
    int sp = 2, sc = 0, sn = 1;
    FA_SLOAD(0); FA_SWRITE(0); FA_SLOAD(64); __syncthreads();
    FA_SWRITE(1); FA_SLOAD(128);
    qkt<6, MLA_KP>(pA0, pA1, K_lds, qr, negm, r32, hi); smA<true>(pA0, pA1, mref, negm, fl, r32, hi, rsA, fdum);
    __syncthreads(); FA_ROT();
    for (int j = 1; j + 1 < NT; j += 2) {
        FA_SWRITE(sn); FA_SLOAD((j + 2) * 64);
        FA_SBAR(); qkt<6, MLA_KP>(pB0, pB1, K_lds + sc * MLA_SHM_K, qr, negm, r32, hi);
        smB(pA0, pA1, pa0, pa1, pa2, pa3); FA_SBAR();
        FA_PV(vb0 + sp * MLA_SHM_V); smA<false>(pB0, pB1, mref, negm, fl, r32, hi, rsB, fdum);
        FA_RESC(rsB);
        __syncthreads(); FA_ROT();
        FA_SWRITE(sn); if (j + 3 < NT) FA_SLOAD((j + 3) * 64);
        FA_SBAR(); qkt<6, MLA_KP>(pA0, pA1, K_lds + sc * MLA_SHM_K, qr, negm, r32, hi);
        smB(pB0, pB1, pa0, pa1, pa2, pa3); FA_SBAR();
        FA_PV(vb0 + sp * MLA_SHM_V); smA<false>(pA0, pA1, mref, negm, fl, r32, hi, rsA, fdum);
        FA_RESC(rsA);
        __syncthreads(); FA_ROT();
    }
    FA_SBAR(); qkt<6, MLA_KP>(pB0, pB1, K_lds + sc * MLA_SHM_K, qr, negm, r32, hi);
    smB(pA0, pA1, pa0, pa1, pa2, pa3); FA_SBAR();
    FA_PV(vb0 + sp * MLA_SHM_V); smA<false>(pB0, pB1, mref, negm, fl, r32, hi, rsB, fdum);
    FA_RESC(rsB);
    smB(pB0, pB1, pa0, pa1, pa2, pa3); FA_SBAR();
    FA_PV(vb0 + sc * MLA_SHM_V);
    bf16_t* Yw = Y + (rowb + qb * 256 + wid * 32) * DM + h * 64 + r32;
#pragma unroll
    for (int r = 0; r < 16; ++r) { const int orow = crow(r, hi); const float rl = __builtin_amdgcn_rcpf(lacc[r]);
        Yw[(size_t)orow * DM] = (bf16_t)f2bf(o[0][r] * rl); Yw[(size_t)orow * DM + 32] = (bf16_t)f2bf(o[1][r] * rl); }
    __syncthreads();
#undef FA_SLOAD
#undef FA_SWRITE
#undef FA_RESC
#undef FA_PV
#undef FA_ROT
}

__device__ __forceinline__ void partialSM_o(f32x16& p0, f32x16& p1, float& m_reg, float& mn, float& alpha) {
    float pmax = p0[0];
#pragma unroll
    for (int r = 1; r < 16; ++r) pmax = fmaxf(pmax, p0[r]);
#pragma unroll
    for (int r = 0; r < 16; ++r) pmax = fmaxf(pmax, p1[r]);
    { auto rr = __builtin_amdgcn_permlane32_swap(__float_as_uint(pmax), __float_as_uint(pmax), false, false);
      pmax = fmaxf(__uint_as_float(rr[0]), __uint_as_float(rr[1])); }
    if (__builtin_expect(__all(pmax - m_reg <= THRL), 1)) { mn = m_reg; alpha = 1.f; }
    else { mn = fmaxf(m_reg, pmax); alpha = __builtin_amdgcn_exp2f(m_reg - mn); m_reg = mn; }
#pragma unroll
    for (int r = 0; r < 16; ++r) { p0[r] -= mn; p1[r] -= mn; }
#pragma unroll
    for (int r = 0; r < 16; ++r) p0[r] = __builtin_amdgcn_exp2f(p0[r]);
}
__device__ __forceinline__ void finishSM_o(f32x16& p0, f32x16& p1, float alpha, float& l_reg, bf16x8& pa0, bf16x8& pa1, bf16x8& pa2, bf16x8& pa3) {
#pragma unroll
    for (int r = 0; r < 16; ++r) p1[r] = __builtin_amdgcn_exp2f(p1[r]);
    float ps = 0;
#pragma unroll
    for (int r = 0; r < 16; ++r) ps += p0[r];
#pragma unroll
    for (int r = 0; r < 16; ++r) ps += p1[r];
    { auto rr = __builtin_amdgcn_permlane32_swap(__float_as_uint(ps), __float_as_uint(ps), false, false);
      ps = __uint_as_float(rr[0]) + __uint_as_float(rr[1]); }
    l_reg = l_reg * alpha + ps;
#define FA_PK4(P, BASE, OUT) do { unsigned a0 = cvtpk(P[BASE + 0], P[BASE + 1]), a1 = cvtpk(P[BASE + 2], P[BASE + 3]);   \
    unsigned b0 = cvtpk(P[BASE + 4], P[BASE + 5]), b1 = cvtpk(P[BASE + 6], P[BASE + 7]);                              \
    auto r0 = __builtin_amdgcn_permlane32_swap(a0, b0, false, false); auto r1 = __builtin_amdgcn_permlane32_swap(a1, b1, false, false); \
    u32x4 w = {r0[0], r1[0], r0[1], r1[1]}; OUT = *reinterpret_cast<bf16x8*>(&w); } while (0)
    FA_PK4(p0, 0, pa0); FA_PK4(p0, 8, pa1); FA_PK4(p1, 0, pa2); FA_PK4(p1, 8, pa3);
#undef FA_PK4
}
template <int NDQ, int KP>
__device__ __forceinline__ void qkt_o(f32x16& p0, f32x16& p1, const LAS unsigned char* Ks, const bf16x8* qr, int r32, int hi) {
    p0 = f32x16{}; p1 = f32x16{};
#pragma unroll
    for (int d0 = 0; d0 < NDQ; ++d0) { const int cb = (d0 * 16 + hi * 8) * 2;
        const bf16x8 b0 = *(const LAS bf16x8*)(Ks + r32 * KP + cb);
        const bf16x8 b1 = *(const LAS bf16x8*)(Ks + (32 + r32) * KP + cb);
        p0 = __builtin_amdgcn_mfma_f32_32x32x16_bf16(b0, qr[d0], p0, 0, 0, 0);
        p1 = __builtin_amdgcn_mfma_f32_32x32x16_bf16(b1, qr[d0], p1, 0, 0, 0);
        if ((d0 & 3) == 3) __builtin_amdgcn_sched_barrier(0); }
}
constexpr int XA_KP = 528, XA_SHM_K = 64 * XA_KP, XA_SHM_V = 64 * 128 * 2;
__device__ __forceinline__ void xattn_unit(int b, int h, int qb, const bf16_t* __restrict__ HQ, const bf16_t* __restrict__ KVM, bf16_t* __restrict__ OX, LAS unsigned char* lds) {
    const int tid = threadIdx.x, wid = tid >> 6, lane = tid & 63, r32 = lane & 31, hi = lane >> 5;
    LAS unsigned char* K_lds = lds; LAS unsigned char* V_lds = lds + XA_SHM_K;
    LAS float* fl = (LAS float*)(lds + XA_SHM_K + XA_SHM_V) + wid * 32;
    const size_t qrow0 = (size_t)b * SEQ + qb * 256 + wid * 32;
    const int ksr = tid >> 5, ksc = tid & 31;
    const bf16_t* gk = KVM + ((size_t)b * NMEM + ksr) * 2048 + h * 256 + ksc * 8;
    u32x4 pw[4][4];
    float mt[4], l_reg = 0.f, lt[4];
    {
        bf16x8 qr[16];
        { const bf16_t* Qw = HQ + (qrow0 + r32) * DM + h * 256 + hi * 8; const float C = 0.0625f * 1.4426950408889634f;
#pragma unroll
          for (int d0 = 0; d0 < 16; ++d0) { const bf16x8 raw = *(const bf16x8*)(Qw + d0 * 16); float v[8];
#pragma unroll
              for (int j = 0; j < 8; ++j) v[j] = bf2f((bf16_t)raw[j]) * C;
              qr[d0] = cvt8(v); } }
        bf16x8 sk[4];
#define XA_KLOAD(k0) do { _Pragma("unroll") for (int i = 0; i < 4; ++i) sk[i] = *(const bf16x8*)(gk + (size_t)((k0) + 16 * i) * 2048); } while (0)
#define XA_KWRITE() do { _Pragma("unroll") for (int i = 0; i < 4; ++i) *(LAS bf16x8*)(K_lds + (ksr + 16 * i) * XA_KP + ksc * 16) = sk[i]; } while (0)
        float m_run = -3.0e38f;
        XA_KLOAD(0);
#pragma unroll
        for (int t = 0; t < 4; ++t) {
            __syncthreads(); XA_KWRITE(); __syncthreads();
            if (t < 3) XA_KLOAD((t + 1) * 64);
            f32x16 p0, p1;
            qkt_o<16, XA_KP>(p0, p1, K_lds, qr, r32, hi);
            m_run = __builtin_fmaxf(m_run, rowmax32(p0, p1)); mt[t] = m_run;
            float ps = 0.f;
#pragma unroll
            for (int r = 0; r < 16; ++r) { p0[r] = __builtin_amdgcn_exp2f(p0[r] - m_run); p1[r] = __builtin_amdgcn_exp2f(p1[r] - m_run); ps += p0[r] + p1[r]; }
            { auto rr = __builtin_amdgcn_permlane32_swap(__float_as_uint(ps), __float_as_uint(ps), false, false); lt[t] = __uint_as_float(rr[0]) + __uint_as_float(rr[1]); }
            pw[t][0] = (u32x4){cvtpk_s(p0[0], p0[1]), cvtpk_s(p0[2], p0[3]), cvtpk_s(p0[4], p0[5]), cvtpk_s(p0[6], p0[7])};
            pw[t][1] = (u32x4){cvtpk_s(p0[8], p0[9]), cvtpk_s(p0[10], p0[11]), cvtpk_s(p0[12], p0[13]), cvtpk_s(p0[14], p0[15])};
            pw[t][2] = (u32x4){cvtpk_s(p1[0], p1[1]), cvtpk_s(p1[2], p1[3]), cvtpk_s(p1[4], p1[5]), cvtpk_s(p1[6], p1[7])};
            pw[t][3] = (u32x4){cvtpk_s(p1[8], p1[9]), cvtpk_s(p1[10], p1[11]), cvtpk_s(p1[12], p1[13]), cvtpk_s(p1[14], p1[15])};
        }
#undef XA_KLOAD
#undef XA_KWRITE
    }
#pragma unroll
    for (int t = 0; t < 4; ++t) {
        const float c = __builtin_amdgcn_exp2f(mt[t] - mt[3]);
        l_reg += c * lt[t];
        if (t < 3) {
#pragma unroll
            for (int k = 0; k < 4; ++k)
#pragma unroll
                for (int q = 0; q < 4; ++q) { const unsigned w = pw[t][k][q]; pw[t][k][q] = cvtpk_s(__uint_as_float(w << 16) * c, __uint_as_float(w & 0xffff0000u) * c); }
        }
    }
    if (hi == 0) fl[r32] = l_reg;
    int tid2 = tid; asm volatile("" : "+v"(tid2));
    const int vsr = tid2 >> 4, vsc = tid2 & 15, lane2 = tid2 & 63;
    const bf16_t* gv = KVM + ((size_t)b * NMEM + vsr) * 2048 + 1024 + h * 256 + vsc * 8;
    const int vb0 = (int)(unsigned)(uintptr_t)V_lds + v_rd_base(lane2);
    bf16x8 sv[2];
#define XA_VLOAD(t, vh) do { _Pragma("unroll") for (int i = 0; i < 2; ++i) sv[i] = *(const bf16x8*)(gv + (size_t)((t) * 64 + 32 * i) * 2048 + (vh) * 128); } while (0)
#define XA_VWRITE() do { _Pragma("unroll") for (int i = 0; i < 2; ++i) *(LAS bf16x8*)(V_lds + v_stp<4>(vsr + 32 * i, vsc * 8)) = sv[i]; } while (0)
    XA_VLOAD(0, 0);
#pragma unroll
    for (int vh = 0; vh < 2; ++vh) {
        f32x16 o[4] = {};
#pragma unroll
        for (int t = 0; t < 4; ++t) {
            __syncthreads(); XA_VWRITE(); __syncthreads();
            if (t < 3) XA_VLOAD(t + 1, vh); else if (vh == 0) XA_VLOAD(0, 1);
            const bf16x8 pa0 = __builtin_bit_cast(bf16x8, pw[t][0]), pa1 = __builtin_bit_cast(bf16x8, pw[t][1]), pa2 = __builtin_bit_cast(bf16x8, pw[t][2]), pa3 = __builtin_bit_cast(bf16x8, pw[t][3]);
            pv_one<4, 0>(o[0], vb0, pa0, pa1, pa2, pa3); pv_one<4, 1>(o[1], vb0, pa0, pa1, pa2, pa3); pv_one<4, 2>(o[2], vb0, pa0, pa1, pa2, pa3); pv_one<4, 3>(o[3], vb0, pa0, pa1, pa2, pa3);
        }
        asm volatile("s_waitcnt lgkmcnt(0)" ::: "memory");
        const int r32b = lane2 & 31, hib = lane2 >> 5;
        bf16_t* Ow = OX + ((size_t)b * SEQ + qb * 256 + (tid2 >> 6) * 32) * DM + h * 256 + vh * 128 + r32b;
#pragma unroll
        for (int r = 0; r < 16; ++r) { const int orow = crow(r, hib); const float rl = __builtin_amdgcn_rcpf(fl[orow]);
#pragma unroll
            for (int d0 = 0; d0 < 4; ++d0) Ow[(size_t)orow * DM + d0 * 32] = (bf16_t)f2bf(o[d0][r] * rl); }
    }
#undef XA_VLOAD
#undef XA_VWRITE
    __syncthreads();
}
}

namespace ml {
using fa::f32x16; using fa::s16x4; using fa::crow; using fa::cvtpk_s; using fa::tr_read; using fa::v_rd_base;
constexpr int RP = 272;
constexpr int L_Q = 0, L_K = 128 * RP, L_KW = 2 * 128 * RP, L_V = L_KW + 32768, L_C = L_V + 16384, L_ARR = L_C + 64 * RP, L_END = L_ARR + 8704;
static_assert(L_END <= 147200, "mLSTM LDS map");
constexpr int A_U2 = 0, A_MM2 = 128, A_A = 256, A_NEGM2 = 384, A_EW = 512, A_N = 640, A_RD = 768  , A_NLP = 1024  , A_BL = 2048  , A_MALL = 2080  , A_MP = 2112  , A_SC = 2152;
constexpr float LOG2E = 1.4426950408889634f;
constexpr size_t GT_UNIT = 32 * 3 * 128;
constexpr int NUNIT = BATCH * ML_H * 2 * 2;
#define ML_PK(L, H) (bf16x8){L[0], L[1], L[2], L[3], H[0], H[1], H[2], H[3]}
__device__ __forceinline__ float psum32(float v) { auto rr = __builtin_amdgcn_permlane32_swap(__float_as_uint(v), __float_as_uint(v), false, false); return __uint_as_float(rr[0]) + __uint_as_float(rr[1]); }

__device__ __forceinline__ void unit(int b, int h, int dir, int dh, const bf16_t* __restrict__ QKC, const bf16_t* __restrict__ Z, const float* __restrict__ G, const float* __restrict__ gbias,
                                     bf16_t* __restrict__ Hout, float* __restrict__ GT, LAS unsigned char* lds) {
    const int tid0 = threadIdx.x, wid = __builtin_amdgcn_readfirstlane(tid0 >> 6);
    int tid = tid0;
    LAS float* arr = (LAS float*)(lds + L_ARR);
    const float bias_i = gbias[dir * 8 + h], bias_f = gbias[dir * 8 + 4 + h];
    const size_t seqb = (size_t)b * SEQ;
    for (int i = tid; i < 64 * RP / 4; i += NTHR) ((LAS unsigned*)(lds + L_C))[i] = 0u;
    if (tid < 128) arr[A_N + tid] = 0.f;
    {   const int lane = tid & 63;
        for (int cc = wid; cc < SEQ / 128; cc += NWAVES) {
            const size_t row0 = seqb + (dir ? SEQ - 128 * (cc + 1) : 128 * cc);
            const int i0 = dir ? 127 - 2 * lane : 2 * lane, i1 = dir ? 126 - 2 * lane : 2 * lane + 1;
            const float f0 = G[(row0 + i0) * 16 + dir * 8 + 4 + h] + bias_f, f1 = G[(row0 + i1) * 16 + dir * 8 + 4 + h] + bias_f;
            const float g0 = G[(row0 + i0) * 16 + dir * 8 + h] + bias_i, g1 = G[(row0 + i1) * 16 + dir * 8 + h] + bias_i;
            const float lf0 = fminf(f0, 0.f) - log1pf(__expf(-fabsf(f0))), lf1 = fminf(f1, 0.f) - log1pf(__expf(-fabsf(f1)));
            float P = lf0 + lf1;
#pragma unroll
            for (int o = 1; o < 64; o <<= 1) { const float t_ = __shfl_up(P, o); if (lane >= o) P += t_; }
            const float b1 = P, b0 = P - lf1;
            const float u0 = g0 - b0, u1 = g1 - b1;
            float Pm = fmaxf(u0, u1);
#pragma unroll
            for (int o = 1; o < 64; o <<= 1) { const float t_ = __shfl_up(Pm, o); if (lane >= o) Pm = fmaxf(Pm, t_); }
            float E = __shfl_up(Pm, 1); if (lane == 0) E = -3.0e38f;
            const float M0 = fmaxf(E, u0), M1 = Pm;
            float* gt = GT + (size_t)cc * 384;
            gt[i0] = u0; gt[i1] = u1; gt[128 + i0] = M0; gt[128 + i1] = M1; gt[256 + i0] = b0; gt[256 + i1] = b1;
            if (lane == 63) { arr[A_BL + cc] = P; arr[A_MALL + cc] = Pm; }
        }
    }
    asm volatile("s_waitcnt vmcnt(0)" ::: "memory");
    __syncthreads();
    if (tid == 0) { float m = 0.f; arr[A_MP] = 0.f;
        for (int cc = 0; cc < SEQ / 128; ++cc) { m = arr[A_BL + cc] + fmaxf(m, arr[A_MALL + cc]); arr[A_MP + cc + 1] = m; } }
    __syncthreads();
    f32x16 Cacc = {};
#define ML_MAPS() const int lane = tid & 63, r32 = lane & 31, hi = lane >> 5, qr_r = tid >> 4, qr_c = tid & 15, v_r = tid >> 3, v_c = tid & 7; (void)lane; (void)r32; (void)hi
    bf16x8 sq[4], sk[4], sv[2]; float su = 0.f, sM = 0.f, sb_ = 0.f;
#define ML_LOAD(c) do { const size_t row0_ = seqb + (dir ? SEQ - 128 * ((c) + 1) : 128 * (c)); \
    _Pragma("unroll") for (int i = 0; i < 4; ++i) { const bf16_t* pq = QKC + (row0_ + qr_r + 32 * i) * 1024 + h * 128 + qr_c * 8; sq[i] = *(const bf16x8*)pq; sk[i] = *(const bf16x8*)(pq + 512); } \
    _Pragma("unroll") for (int i = 0; i < 2; ++i) sv[i] = *(const bf16x8*)(Z + (row0_ + v_r + 64 * i) * LDZ + ZC_V + h * 128 + dh * 64 + v_c * 8); \
    if (tid < 128) { const float* gt = GT + (size_t)(c) * 384 + tid; su = gt[0]; sM = gt[128]; sb_ = gt[256]; } } while (0)
#define ML_STORE(c) do { _Pragma("unroll") for (int i = 0; i < 4; ++i) { *(LAS bf16x8*)(lds + L_Q + (qr_r + 32 * i) * RP + qr_c * 16) = sq[i]; *(LAS bf16x8*)(lds + L_K + (qr_r + 32 * i) * RP + qr_c * 16) = sk[i]; } \
    _Pragma("unroll") for (int i = 0; i < 2; ++i) *(LAS bf16x8*)(lds + L_V + fa::v_stp<2>(v_r + 64 * i, v_c * 8)) = sv[i]; \
    if (tid < 128) { const float mp = arr[A_MP + (c)], mmL = fmaxf(mp, arr[A_MALL + (c)]), mm = fmaxf(mp, sM); \
        arr[A_U2 + tid] = su * LOG2E; arr[A_MM2 + tid] = mm * LOG2E; arr[A_A + tid] = __expf(mp - mm); arr[A_NEGM2 + tid] = -(sb_ + mm) * LOG2E; arr[A_EW + tid] = __expf(su - mmL); \
        if (tid == 0) arr[A_SC] = __expf(mp - mmL); } } while (0)
    { ML_MAPS(); ML_LOAD(0); }
    for (int c = 0; c < SEQ / 128; ++c) {
        asm volatile("" : "+v"(tid));
        ML_MAPS();
        const size_t row0 = seqb + (dir ? SEQ - 128 * (c + 1) : 128 * c);
        ML_STORE(c);
        __syncthreads();
#if PROBE_A >= 20 || PROBE_B >= 20
        unsigned tS1 = (unsigned)__builtin_amdgcn_s_memrealtime();
#endif
        if (c + 1 < SEQ / 128) ML_LOAD(c + 1);
        const int tb = wid & 3, dt = wid >> 2;
        {
            f32x16 intra = {}; float dsum = 0.f;
            bf16x8 qr[8];
#pragma unroll
            for (int ks = 0; ks < 8; ++ks) qr[ks] = *(const LAS bf16x8*)(lds + L_Q + (tb * 32 + r32) * RP + (ks * 16 + hi * 8) * 2);
            const float mm2t = arr[A_MM2 + tb * 32 + r32];
            const int sb_lo = dir ? tb : 0, sb_hi = dir ? 4 : tb + 1;
            const int vbase = (int)(unsigned)(uintptr_t)(lds + L_V) + v_rd_base(lane) + dt * 512;
            for (int sb = sb_lo; sb < sb_hi; ++sb) {
                bf16x8 kf[8]; f32x4 u4[4];
#pragma unroll
                for (int ks = 0; ks < 8; ++ks) kf[ks] = *(const LAS bf16x8*)(lds + L_K + (sb * 32 + r32) * RP + (ks * 16 + hi * 8) * 2);
#pragma unroll
                for (int g = 0; g < 4; ++g) u4[g] = *(const LAS f32x4*)(arr + A_U2 + sb * 32 + 8 * g + 4 * hi);
                const int vb = vbase + sb * 4096;
                const s16x4 l0 = tr_read<0>(vb), h0 = tr_read<1024>(vb), l1 = tr_read<2048>(vb), h1 = tr_read<3072>(vb);
                asm volatile("s_waitcnt lgkmcnt(0)" ::: "memory"); __builtin_amdgcn_sched_barrier(0);
                f32x16 p = {};
#pragma unroll
                for (int ks = 0; ks < 8; ++ks) p = __builtin_amdgcn_mfma_f32_32x32x16_bf16(kf[ks], qr[ks], p, 0, 0, 0);
                float w[16];
#pragma unroll
                for (int r = 0; r < 16; ++r) w[r] = __builtin_amdgcn_exp2f(u4[r >> 2][r & 3] - mm2t);
                if (sb == tb) {
#pragma unroll
                    for (int r = 0; r < 16; ++r) { const int sl = crow(r, hi); const bool msk = dir ? (sl < r32) : (sl > r32); w[r] = msk ? 0.f : w[r]; }
                }
#pragma unroll
                for (int r = 0; r < 16; ++r) { p[r] *= w[r]; dsum += p[r]; }
                u32x4 w0 = {cvtpk_s(p[0], p[1]), cvtpk_s(p[2], p[3]), cvtpk_s(p[4], p[5]), cvtpk_s(p[6], p[7])}, w1 = {cvtpk_s(p[8], p[9]), cvtpk_s(p[10], p[11]), cvtpk_s(p[12], p[13]), cvtpk_s(p[14], p[15])};
                intra = __builtin_amdgcn_mfma_f32_32x32x16_bf16(__builtin_bit_cast(bf16x8, w0), ML_PK(l0, h0), intra, 0, 0, 0);
                intra = __builtin_amdgcn_mfma_f32_32x32x16_bf16(__builtin_bit_cast(bf16x8, w1), ML_PK(l1, h1), intra, 0, 0, 0);
            }
            dsum = psum32(dsum);
            float nq = 0.f;
            {   bf16x8 q8[8]; f32x4 n4[16];
#pragma unroll
                for (int cc = 0; cc < 8; ++cc) { q8[cc] = *(const LAS bf16x8*)(lds + L_Q + (tb * 32 + r32) * RP + (hi * 64 + cc * 8) * 2);
                    n4[2 * cc] = *(const LAS f32x4*)(arr + A_N + hi * 64 + cc * 8); n4[2 * cc + 1] = *(const LAS f32x4*)(arr + A_N + hi * 64 + cc * 8 + 4); }
                asm volatile("s_waitcnt lgkmcnt(0)" ::: "memory"); __builtin_amdgcn_sched_barrier(0);
#pragma unroll
                for (int cc = 0; cc < 8; ++cc) {
#pragma unroll
                    for (int j = 0; j < 4; ++j) nq += bf2f((bf16_t)q8[cc][j]) * n4[2 * cc][j] + bf2f((bf16_t)q8[cc][4 + j]) * n4[2 * cc + 1][j]; }
                nq = psum32(nq);
                __builtin_amdgcn_sched_barrier(0);
            }
            f32x16 inter = {}; bf16x8 cf[8]; f32x4 a4[4];
#pragma unroll
            for (int ks = 0; ks < 8; ++ks) cf[ks] = *(const LAS bf16x8*)(lds + L_C + (dt * 32 + r32) * RP + (ks * 16 + hi * 8) * 2);
#pragma unroll
            for (int g = 0; g < 4; ++g) a4[g] = *(const LAS f32x4*)(arr + A_A + tb * 32 + 8 * g + 4 * hi);
            const float at = arr[A_A + tb * 32 + r32], ngm = arr[A_NEGM2 + tb * 32 + r32];
            asm volatile("s_waitcnt lgkmcnt(0)" ::: "memory"); __builtin_amdgcn_sched_barrier(0);
#pragma unroll
            for (int ks = 0; ks < 8; ++ks) inter = __builtin_amdgcn_mfma_f32_32x32x16_bf16(qr[ks], cf[ks], inter, 0, 0, 0);
            const float den = dsum + at * nq;
            const float rden = __builtin_amdgcn_rcpf(fmaxf(fabsf(den), __builtin_amdgcn_exp2f(ngm)));
            if (hi == 0) arr[A_RD + wid * 32 + r32] = rden;
            asm volatile("s_waitcnt lgkmcnt(0)" ::: "memory");
            f32x4 rd4[4];
#pragma unroll
            for (int g = 0; g < 4; ++g) rd4[g] = *(const LAS f32x4*)(arr + A_RD + wid * 32 + 8 * g + 4 * hi);
            bf16_t* Ho = Hout + (row0 + tb * 32) * ML_W + h * 128 + dh * 64 + dt * 32 + r32;
#pragma unroll
            for (int r = 0; r < 16; ++r) Ho[(size_t)crow(r, hi) * ML_W] = (bf16_t)f2bf((intra[r] + a4[r >> 2][r & 3] * inter[r]) * rd4[r >> 2][r & 3]);
        }
        {
            const int ec = tid & 15, s0 = tid >> 4;
            float ns[8] = {0.f, 0.f, 0.f, 0.f, 0.f, 0.f, 0.f, 0.f}; bf16x8 k8a[4]; float ewa[4];
#pragma unroll
            for (int i = 0; i < 4; ++i) { k8a[i] = *(const LAS bf16x8*)(lds + L_K + (s0 + 32 * i) * RP + ec * 16); ewa[i] = arr[A_EW + s0 + 32 * i]; }
            asm volatile("s_waitcnt lgkmcnt(0)" ::: "memory"); __builtin_amdgcn_sched_barrier(0);
#pragma unroll
            for (int i = 0; i < 4; ++i) { float kv[8];
#pragma unroll
                for (int j = 0; j < 8; ++j) { kv[j] = bf2f((bf16_t)k8a[i][j]) * ewa[i]; ns[j] += kv[j]; }
                u32x4 w_ = {cvtpk_s(kv[0], kv[1]), cvtpk_s(kv[2], kv[3]), cvtpk_s(kv[4], kv[5]), cvtpk_s(kv[6], kv[7])};
                *(LAS u32x4*)(lds + L_KW + fa::v_stp<4>(s0 + 32 * i, ec * 8)) = w_; }
#pragma unroll
            for (int j = 0; j < 8; ++j) { ns[j] += __shfl_xor(ns[j], 16); ns[j] += __shfl_xor(ns[j], 32); }
            if (lane < 16) {
#pragma unroll
                for (int j = 0; j < 8; ++j) arr[A_NLP + wid * 128 + ec * 8 + j] = ns[j]; }
        }
        __syncthreads();
#if PROBE_A >= 20 || PROBE_B >= 20
        unsigned tS3 = (unsigned)__builtin_amdgcn_s_memrealtime();
#endif
        {
            const int et = wid & 3, dt2 = wid >> 2; const float fC = arr[A_SC];
#pragma unroll
            for (int r = 0; r < 16; ++r) Cacc[r] *= fC;
            const int vb = (int)(unsigned)(uintptr_t)(lds + L_V) + v_rd_base(lane) + dt2 * 512, kb = (int)(unsigned)(uintptr_t)(lds + L_KW) + v_rd_base(lane) + et * 512;
#define ML_CRD(ks, i) const s16x4 al##i = tr_read<(ks) * 2048>(vb), ah##i = tr_read<(ks) * 2048 + 1024>(vb), bl##i = tr_read<(ks) * 4096>(kb), bh##i = tr_read<(ks) * 4096 + 2048>(kb)
#define ML_CMM(i) Cacc = __builtin_amdgcn_mfma_f32_32x32x16_bf16(ML_PK(al##i, ah##i), ML_PK(bl##i, bh##i), Cacc, 0, 0, 0)
            { ML_CRD(0, 0); ML_CRD(1, 1); ML_CRD(2, 2); ML_CRD(3, 3);
              asm volatile("s_waitcnt lgkmcnt(0)" ::: "memory"); __builtin_amdgcn_sched_barrier(0);
              ML_CMM(0); ML_CMM(1); ML_CMM(2); ML_CMM(3); }
            { ML_CRD(4, 0); ML_CRD(5, 1); ML_CRD(6, 2); ML_CRD(7, 3);
              asm volatile("s_waitcnt lgkmcnt(0)" ::: "memory"); __builtin_amdgcn_sched_barrier(0);
              ML_CMM(0); ML_CMM(1); ML_CMM(2); ML_CMM(3); }
#undef ML_CRD
#undef ML_CMM
#pragma unroll
            for (int r = 0; r < 16; ++r) *(LAS bf16_t*)(lds + L_C + (dt2 * 32 + crow(r, hi)) * RP + (et * 32 + r32) * 2) = (bf16_t)f2bf(Cacc[r]);
            if (tid < 128) { float a_ = 0.f;
#pragma unroll
                for (int w8 = 0; w8 < 8; ++w8) a_ += arr[A_NLP + w8 * 128 + tid];
                arr[A_N + tid] = fC * arr[A_N + tid] + a_; }
        }
        __syncthreads();
#if PROBE_A >= 20 || PROBE_B >= 20
        if (blockIdx.x == 0 && tid0 == 0) { volatile LAS unsigned* tsl = (volatile LAS unsigned*)(lds + 147200); const unsigned tS4 = (unsigned)__builtin_amdgcn_s_memrealtime(); tsl[13] += tS3 - tS1; tsl[14] += tS4 - tS3; }
#endif
    }
#undef ML_LOAD
#undef ML_STORE
#undef ML_MAPS
}
#undef ML_PK
}

__device__ __forceinline__ void mlstm_fast(const Params& p, LAS unsigned char* lds) {
    const int G = gridDim.x, bx = blockIdx.x;
    if (G == 256) {
        if ((bx >> 3) < 16) { const int u = (bx & 7) * 16 + (bx >> 3);
            ml::unit(u >> 4, (u >> 2) & 3, (u >> 1) & 1, u & 1, (const bf16_t*)(p.ws + WS_XB), (const bf16_t*)(p.ws + WS_Z), (const float*)(p.ws + WS_G), (const float*)(p.ws + WS_SMALL) + SM_GBIAS,
                     ((u >> 1) & 1) ? (bf16_t*)p.out + (size_t)T * ML_W : (bf16_t*)p.out, (float*)(p.ws + WS_GT) + (size_t)u * ml::GT_UNIT, lds); }
    } else {
        for (int u = bx; u < ml::NUNIT; u += G)
            ml::unit(u >> 4, (u >> 2) & 3, (u >> 1) & 1, u & 1, (const bf16_t*)(p.ws + WS_XB), (const bf16_t*)(p.ws + WS_Z), (const float*)(p.ws + WS_G), (const float*)(p.ws + WS_SMALL) + SM_GBIAS,
                     ((u >> 1) & 1) ? (bf16_t*)p.out + (size_t)T * ML_W : (bf16_t*)p.out, (float*)(p.ws + WS_GT) + (size_t)u * ml::GT_UNIT, lds);
    }
}
__device__ __forceinline__ void mla_attn_fast(const Params& p, LAS unsigned char* lds) {
    unsigned* ctr = (unsigned*)(p.ws + WS_CTL) + 8192;
    volatile LAS unsigned* slot = (volatile LAS unsigned*)(lds + 147456 - 64) + 8;
    const int myx = blockIdx.x & 7;
    for (int xo = 0; xo < 8; ++xo) {
        const int x = (myx + xo) & 7;
        for (;;) {
            if (threadIdx.x == 0) slot[0] = __hip_atomic_fetch_add(ctr + 64 * x, 1u, __ATOMIC_RELAXED, __HIP_MEMORY_SCOPE_AGENT);
            __syncthreads();
            const unsigned k = slot[0];
            __syncthreads();
            if (k >= 128u) break;
            const int bh = x + 8 * (int)(k >> 4), qb = (int)(k & 15);
            fa::mla_unit(bh >> 3, bh & 7, qb, (const bf16_t*)(p.ws + WS_QALL), (const bf16_t*)(p.ws + WS_KV), (const bf16_t*)(p.ws + WS_KR),
                         (const float*)(p.ws + WS_COS), (const float*)(p.ws + WS_SIN), (bf16_t*)(p.ws + WS_Y), lds);
        }
    }
}
__device__ __forceinline__ void x_attn_fast(const Params& p, LAS unsigned char* lds) {
    const int G = gridDim.x, bx = blockIdx.x, vcu = (G % 8 == 0) ? (bx % 8) * (G / 8) + bx / 8 : bx;
    for (int u = vcu; u < BATCH * XH * 16; u += G) {
        const int qb = u & 15, bh = u >> 4;
        fa::xattn_unit(bh >> 2, bh & 3, qb, (const bf16_t*)(p.ws + WS_HQ), (const bf16_t*)(p.ws + WS_KVM), (bf16_t*)(p.ws + WS_OX), lds);
    }
}
__device__ __forceinline__ void phase_final(const Params& p) {
    const float* ssq = (const float*)(p.ws + WS_SSQ) + 4 * (size_t)T; const bf16_t* XB = (const bf16_t*)(p.ws + WS_XB);
    const float* fin = (const float*)(p.ws + WS_SMALL) + SM_FIN;
    const int wid = threadIdx.x >> 6, lane = threadIdx.x & 63;
    f32x4 g[2][2];
#pragma unroll
    for (int j = 0; j < 2; ++j) { g[j][0] = *(const f32x4*)(fin + j * 512 + lane * 8); g[j][1] = *(const f32x4*)(fin + j * 512 + lane * 8 + 4); }
    for (int row4 = (blockIdx.x * NWAVES + wid) * 4; row4 < T; row4 += gridDim.x * NWAVES * 4) {
        u32x4 rb[4][2]; float rs[4];
#pragma unroll
        for (int q = 0; q < 4; ++q) { rs[q] = ssq[row4 + q];
#pragma unroll
            for (int j = 0; j < 2; ++j) rb[q][j] = *(const u32x4*)(XB + (size_t)(row4 + q) * DM + j * 512 + lane * 8); }
#pragma unroll
        for (int q = 0; q < 4; ++q) { const float r = rsqrtf(rs[q] * (1.0f / DM) + EPS);
#pragma unroll
            for (int j = 0; j < 2; ++j) { const u32x4 w = rb[q][j];
                const f32x4 v0 = (f32x4){__uint_as_float(w.x << 16), __uint_as_float(w.x & 0xffff0000u), __uint_as_float(w.y << 16), __uint_as_float(w.y & 0xffff0000u)};
                const f32x4 v1 = (f32x4){__uint_as_float(w.z << 16), __uint_as_float(w.z & 0xffff0000u), __uint_as_float(w.w << 16), __uint_as_float(w.w & 0xffff0000u)};
                float* o = p.out + (size_t)(row4 + q) * DM + j * 512 + lane * 8;
                *(f32x4*)o = v0 * r * g[j][0]; *(f32x4*)(o + 4) = v1 * r * g[j][1]; } }
    }
}

#define XB_TMO      128
#define XB_XCNT(j)  (256  + 64 * (j))
#define XB_XSUB(j)  (1280 + 64 * (j))
#define XB_XGEN(j)  (2304 + 64 * (j))
#define XB_TOP      3328
#define XB_TOPGEN   3392
#define XCD_BAR_WORDS 3456
#define XB_SPIN_CAP (1u << 20)
__device__ __forceinline__ unsigned xb_ld(unsigned* p)              { return __hip_atomic_load(p, __ATOMIC_RELAXED, __HIP_MEMORY_SCOPE_AGENT); }
__device__ __forceinline__ unsigned xb_add(unsigned* p, unsigned v) { return __hip_atomic_fetch_add(p, v, __ATOMIC_RELAXED, __HIP_MEMORY_SCOPE_AGENT); }
__device__ __forceinline__ unsigned xb_xcc_id() { return (unsigned)__builtin_amdgcn_s_getreg((3 << 11) | 20) & 0xFu; }
#define XB_SPIN(cond, bar) do { unsigned _sp = 0; while (cond) { __builtin_amdgcn_s_sleep(1); \
    if ((++_sp & 255u) == 0u) { if (xb_ld(&(bar)[XB_TMO])) break; if (_sp > XB_SPIN_CAP) { atomicAdd(&(bar)[XB_TMO], 1u); break; } } } } while (0)
struct XcdBarrier { unsigned* bar; unsigned x; volatile LAS unsigned* st; };
__device__ __forceinline__ XcdBarrier xcd_barrier_post(unsigned* bar, volatile LAS unsigned* st) {
    XcdBarrier b; b.bar = bar; b.x = xb_xcc_id(); b.st = st;
    if (threadIdx.x == 0) (void)xb_add(&bar[XB_XCNT(b.x)], 1u);
    return b;
}
__device__ __forceinline__ void xcd_barrier_complete(unsigned* bar, unsigned x, unsigned& nloc, unsigned& nx) {
    const unsigned G = gridDim.x * gridDim.y * gridDim.z;
    unsigned sum, cnt, mine, sp = 0u;
    for (;;) {
        sum = 0u; cnt = 0u; mine = 0u;
#pragma unroll
        for (unsigned j = 0; j < 16; ++j) { const unsigned c = xb_ld(&bar[XB_XCNT(j)]); sum += c; cnt += (c > 0u) ? 1u : 0u; mine = (j == x) ? c : mine; }
        if (sum == G) break;
        __builtin_amdgcn_s_sleep(1);
        if ((++sp & 255u) == 0u) { if (xb_ld(&bar[XB_TMO])) break; if (sp > XB_SPIN_CAP) { atomicAdd(&bar[XB_TMO], 1u); break; } }
    }
    nloc = mine > 0u ? mine : 1u; nx = cnt > 0u ? cnt : 1u;
}
__device__ __forceinline__ void xcd_barrier(const XcdBarrier& b) {
    asm volatile("s_waitcnt vmcnt(0)" ::: "memory");
    __syncthreads();
    if (threadIdx.x == 0) {
        unsigned* bar = b.bar;
        __builtin_amdgcn_s_waitcnt(0);
        unsigned nloc = b.st[0], nx = b.st[1];
        if (nloc == 0u) { xcd_barrier_complete(bar, b.x, nloc, nx); b.st[0] = nloc; b.st[1] = nx; }
        const unsigned old = xb_add(&bar[XB_XSUB(b.x)], 1u);
        const unsigned gen = old / nloc;
        if (old + 1u == (gen + 1u) * nloc) {
            __builtin_amdgcn_fence(__ATOMIC_RELEASE, "agent");
            asm volatile("s_waitcnt vmcnt(0)" ::: "memory");
            const unsigned og = xb_add(&bar[XB_TOP], 1u);
            const unsigned tg = og / nx;
            if (og + 1u == (tg + 1u) * nx) xb_add(&bar[XB_TOPGEN], 1u);
            else XB_SPIN(xb_ld(&bar[XB_TOPGEN]) == tg, bar);
            __builtin_amdgcn_fence(__ATOMIC_ACQUIRE, "agent");
            xb_add(&bar[XB_XGEN(b.x)], 1u);
            asm volatile("s_waitcnt vmcnt(0)" ::: "memory");
        } else {
            XB_SPIN(xb_ld(&bar[XB_XGEN(b.x)]) == gen, bar);
            __builtin_amdgcn_fence(__ATOMIC_ACQUIRE, "agent");
            asm volatile("s_waitcnt vmcnt(0)" ::: "memory");
        }
    }
    __syncthreads();
}

constexpr int LDS_BYTES = 147456;
constexpr int NPHASE = 12;

#ifndef MK_N_LAUNCHES
#define MK_N_LAUNCHES 1
#endif

__global__ void __launch_bounds__(NTHR, 2) mega(Params p) {
    extern __shared__ __attribute__((aligned(16))) unsigned char lds_raw[];
    LAS unsigned char* lds = (LAS unsigned char*)lds_raw;
    unsigned char* ws = p.ws;
    float* ssq = (float*)(ws + WS_SSQ);
    const int lo = p.ph_lo, hi = p.ph_hi;
    volatile LAS unsigned* misc = (volatile LAS unsigned*)(lds + LDS_BYTES - 64);
    if (threadIdx.x < 16) misc[threadIdx.x] = 0u;
    __syncthreads();
    XcdBarrier bar; bar.bar = (unsigned*)(ws + WS_CTL) + 4096; bar.x = 0; bar.st = nullptr;
    if (hi - lo > 1) bar = xcd_barrier_post((unsigned*)(ws + WS_CTL) + 4096, misc);
#define IN(k) (lo <= (k) && (k) < hi)
#if PROBE_A >= 0 || PROBE_B >= 0
    volatile LAS unsigned* tsl = (volatile LAS unsigned*)(lds + LDS_BYTES - 256);
    if (blockIdx.x == 0 && threadIdx.x == 0) { tsl[0] = (unsigned)__builtin_amdgcn_s_memrealtime(); tsl[13] = 0u; tsl[14] = 0u; tsl[15] = 0u; }
#define SEAM(k) do { if (IN(k) && IN((k) + 1)) xcd_barrier(bar); if (blockIdx.x == 0 && threadIdx.x == 0) tsl[(k) + 1] = (unsigned)__builtin_amdgcn_s_memrealtime(); } while (0)
#else
#define SEAM(k) do { if (IN(k) && IN((k) + 1)) xcd_barrier(bar); } while (0)
#endif
    if (IN(0)) phase0(p, lds);
    SEAM(0);
    if (IN(1)) {
        Gemm g{(const bf16_t*)(ws + WS_XB), DM, (const bf16_t*)(ws + WS_WIN), DM, T, LDZ, DM};
        EpiZ E{(bf16_t*)(ws + WS_Z), ssq, ssq + T, (bf16_t*)(ws + WS_KR), (float*)(ws + WS_G), (const float*)(ws + WS_COS), (const float*)(ws + WS_SIN)};
        run_gemm(lds, g, E, (int)blockIdx.x);
    }
    SEAM(1);
    if (IN(2)) {
        { Gemm g{(const bf16_t*)(ws + WS_Z) + ZC_CQ, LDZ, (const bf16_t*)(ws + WS_WUQ), QLORA, T, MLA_H * DQK, QLORA};
          EpiScaleBf16 E{(bf16_t*)(ws + WS_QALL), MLA_H * DQK, ssq, 1.0f / QLORA, 1.0f}; run_gemm(lds, g, E, (int)blockIdx.x); }
        { Gemm g{(const bf16_t*)(ws + WS_Z) + ZC_CKV, LDZ, (const bf16_t*)(ws + WS_WUKV), 256, T, 1024, 256};
          EpiScaleBf16 E{(bf16_t*)(ws + WS_KV), 1024, ssq + T, 1.0f / KVLORA, 1.0f}; run_gemm(lds, g, E, (int)blockIdx.x); }
        phase_conv(p);
    }
    SEAM(2);
    if (IN(3)) { mlstm_fast(p, lds);
#if PROBE_A == 13
        xcd_barrier(bar); if (blockIdx.x == 0 && threadIdx.x == 0) tsl[14] = (unsigned)__builtin_amdgcn_s_memrealtime();
#endif
        mla_attn_fast(p, lds); }
    SEAM(3);
    if (IN(4)) {
        const int nb = (int)gridDim.x;
        if (nb >= 128) {
            if ((int)blockIdx.x < 64) { Gemm g{(const bf16_t*)(ws + WS_MEMN), DM, (const bf16_t*)(ws + WS_WXKV), DM, TM, 2 * DM, DM};
                EpiScaleBf16 E{(bf16_t*)(ws + WS_KVM), 2 * DM, nullptr, 0.f, 1.0f};
                StaticOrder S; S.init(g.M, g.N, 64, (int)blockIdx.x); gemm_phase<EpiScaleBf16, StaticOrder, true, true>(lds, g, S, E); }
            else phase_mlfin(p, (int)blockIdx.x - 64, nb - 64);
        } else {
            { Gemm g{(const bf16_t*)(ws + WS_MEMN), DM, (const bf16_t*)(ws + WS_WXKV), DM, TM, 2 * DM, DM};
              EpiScaleBf16 E{(bf16_t*)(ws + WS_KVM), 2 * DM, nullptr, 0.f, 1.0f}; run_gemm(lds, g, E, (int)blockIdx.x); }
            phase_mlfin(p, (int)blockIdx.x, nb);
        }
    }
    SEAM(4);
    if (IN(5)) {
        Gemm g{(const bf16_t*)(ws + WS_Y), DM, (const bf16_t*)(ws + WS_WOUT), DM, T, DM, DM};
        EpiResid E{p.x, nullptr, (bf16_t*)(ws + WS_XB), ssq + 2 * T}; run_gemm(lds, g, E, (int)blockIdx.x);
    }
    SEAM(5);
    if (IN(6)) {
        Gemm g{(const bf16_t*)(ws + WS_XB), DM, (const bf16_t*)(ws + WS_WXQ), DM, T, DM, DM};
        EpiScaleBf16 E{(bf16_t*)(ws + WS_HQ), DM, ssq + 2 * T, 1.0f / DM, 1.0f};
        StaticOrder S0; S0.init(g.M, g.N, (int)gridDim.x, (int)blockIdx.x);
        for (int ui = 0; ; ++ui) {
            Unit u; if (!S0.next(ui, u)) break;
            const SingleOrder S{S0, ui};
            gemm_phase<EpiScaleBf16, SingleOrder, true, true>(lds, g, S, E);
            asm volatile("s_waitcnt vmcnt(0)" ::: "memory"); __syncthreads();
            fa::xattn_unit(u.pm >> 4, u.pn, u.pm & 15, (const bf16_t*)(ws + WS_HQ), (const bf16_t*)(ws + WS_KVM), (bf16_t*)(ws + WS_OX), lds);
        }
    }
    SEAM(7);
    if (IN(8)) {
        Gemm g{(const bf16_t*)(ws + WS_OX), DM, (const bf16_t*)(ws + WS_WXO), DM, T, DM, DM};
        EpiResid E{nullptr, (const bf16_t*)(ws + WS_XB), (bf16_t*)(ws + WS_XB), ssq + 3 * T}; run_gemm(lds, g, E, (int)blockIdx.x);
    }
    SEAM(8);
    if (IN(9)) {
        Gemm g{(const bf16_t*)(ws + WS_XB), DM, (const bf16_t*)(ws + WS_WGU), DM, T, 2 * DFF, DM};
        EpiSwiglu E{(bf16_t*)(ws + WS_H), ssq + 3 * T}; run_gemm(lds, g, E, (int)blockIdx.x);
    }
    SEAM(9);
    if (IN(10)) {
        Gemm g{(const bf16_t*)(ws + WS_H), DFF, (const bf16_t*)(ws + WS_WD), DFF, T, DM, DFF};
        EpiResid E{nullptr, (const bf16_t*)(ws + WS_XB), (bf16_t*)(ws + WS_XB), ssq + 4 * T}; run_gemm(lds, g, E, (int)blockIdx.x);
    }
    SEAM(10);
    if (IN(11)) phase_final(p);
#if PROBE_A >= 0 || PROBE_B >= 0
    {   float* pr = (float*)(ws + WS_CTL + 65536);
        if (blockIdx.x == 0 && threadIdx.x == 0) {
            tsl[12] = 0u; asm volatile("s_waitcnt vmcnt(0)" ::: "memory"); tsl[12] = (unsigned)__builtin_amdgcn_s_memrealtime();
            float da = 0.f, db = 0.f;
            if (PROBE_A >= 0) { const float us = (float)(PROBE_A == 13 ? tsl[14] - tsl[3] : PROBE_A >= 20 ? tsl[PROBE_A - 20 + 13] : tsl[PROBE_A + 1] - tsl[PROBE_A]) * 0.01f; da = sqrtf(PROBE_A_SCALE * us); }
            if (PROBE_B >= 0) { const float us = (float)(PROBE_B >= 20 ? tsl[PROBE_B - 20 + 13] : tsl[PROBE_B + 1] - tsl[PROBE_B]) * 0.01f; db = 0.04f + PROBE_B_SCALE * us; }
            __hip_atomic_store(pr, da, __ATOMIC_RELAXED, __HIP_MEMORY_SCOPE_AGENT); __hip_atomic_store(pr + 1, db, __ATOMIC_RELAXED, __HIP_MEMORY_SCOPE_AGENT);
        }
        xcd_barrier(bar);
        const float da = __hip_atomic_load(pr, __ATOMIC_RELAXED, __HIP_MEMORY_SCOPE_AGENT), db = __hip_atomic_load(pr + 1, __ATOMIC_RELAXED, __HIP_MEMORY_SCOPE_AGENT);
        for (size_t i = (size_t)blockIdx.x * NTHR + threadIdx.x; i < (size_t)T * DM; i += (size_t)gridDim.x * NTHR) p.out[i] += da + (i == 0 ? db : 0.f);
    }
#endif
#undef IN
#undef SEAM
}

extern "C" void kernel_launch(void* const* d_in, const int* in_sizes, int n_in, void* d_out, int out_size, void* d_ws, size_t ws_size, hipStream_t stream) {
    static int grid = 0;
    if (grid == 0) {
        if (n_in != 22 || in_sizes[0] != T * DM || out_size != T * DM) { fprintf(stderr, "kernel_launch: unexpected shapes (n_in %d, in0 %d, out %d)\n", n_in, n_in > 0 ? in_sizes[0] : -1, out_size); grid = -1; return; }
        if (ws_size < WS_END) { fprintf(stderr, "kernel_launch: workspace too small: %zu\n", ws_size); grid = -1; return; }
        int dev = 0, cus = 0, per_cu = 0;
        (void)hipGetDevice(&dev); (void)hipDeviceGetAttribute(&cus, hipDeviceAttributeMultiprocessorCount, dev);
        if (hipFuncSetAttribute((const void*)mega, hipFuncAttributeMaxDynamicSharedMemorySize, LDS_BYTES) != hipSuccess) { fprintf(stderr, "kernel_launch: hipFuncSetAttribute failed\n"); grid = -1; return; }
        if (hipOccupancyMaxActiveBlocksPerMultiprocessor(&per_cu, (const void*)mega, NTHR, LDS_BYTES) != hipSuccess || per_cu < 1) { fprintf(stderr, "kernel_launch: occupancy query says %d\n", per_cu); per_cu = 1; }
        (void)hipGetLastError();
        grid = cus * (per_cu < 1 ? per_cu : 1);
        fprintf(stderr, "kernel_launch: grid %d (cus %d, per_cu %d), ws %zu MiB\n", grid, cus, per_cu, ws_size >> 20);
    }
    if (grid < 0) return;
    Params p{};
    p.x = (const float*)d_in[0]; p.mem = (const float*)d_in[1]; p.pos = (const int*)d_in[2];
    p.attn_norm = (const float*)d_in[3]; p.w_in = (const float*)d_in[4]; p.q_norm = (const float*)d_in[5]; p.w_uq = (const float*)d_in[6];
    p.kv_norm = (const float*)d_in[7]; p.w_ukv = (const float*)d_in[8]; p.conv = (const float*)d_in[9]; p.gbias = (const float*)d_in[10];
    p.ml_norm = (const float*)d_in[11]; p.w_out = (const float*)d_in[12]; p.xattn_norm = (const float*)d_in[13]; p.mem_norm = (const float*)d_in[14];
    p.w_xq = (const float*)d_in[15]; p.w_xkv = (const float*)d_in[16]; p.w_xo = (const float*)d_in[17]; p.ffn_norm = (const float*)d_in[18];
    p.w_gu = (const float*)d_in[19]; p.w_down = (const float*)d_in[20]; p.final_norm = (const float*)d_in[21];
    p.out = (float*)d_out; p.ws = (unsigned char*)d_ws;
    if (hipMemsetAsync((char*)d_ws + WS_CTL, 0, 65536, stream) != hipSuccess) { fprintf(stderr, "kernel_launch: memset failed\n"); return; }
#if MK_N_LAUNCHES == 1
    p.ph_lo = 0; p.ph_hi = NPHASE;
    { void* args[] = {&p};
      const hipError_t e = hipLaunchCooperativeKernel((const void*)mega, dim3(grid), dim3(NTHR), args, LDS_BYTES, stream);
      if (e != hipSuccess) fprintf(stderr, "kernel_launch: cooperative launch failed: %s (grid %d)\n", hipGetErrorString(e), grid); }
#else
    for (int ph = 0; ph < NPHASE; ++ph) {
        p.ph_lo = ph; p.ph_hi = ph + 1;
        hipLaunchKernelGGL(mega, dim3(grid), dim3(NTHR), LDS_BYTES, stream, p);
    }
#endif
    const hipError_t le = hipPeekAtLastError();
    if (le != hipSuccess) fprintf(stderr, "kernel_launch: launch failed: %s\n", hipGetErrorName(le));
}
```

```cpp
#include <hip/hip_runtime.h>
#include <cstdio>
#include <cstdint>

#ifndef PROBE_A
#define PROBE_A (-1)
#define PROBE_A_SCALE 1.0e-7f
#define PROBE_B (-1)
#define PROBE_B_SCALE 1.0e-4f
#endif
constexpr int BATCH = 8, SEQ = 4096, DM = 1024, T = BATCH * SEQ;
constexpr int NMEM = 256, TM = BATCH * NMEM;
constexpr float EPS = 1e-6f;
constexpr int MLA_H = 8, QLORA = 256, KVLORA = 128, NOPE = 64, ROPE = 32, VD = 64, DQK = NOPE + ROPE;
constexpr int ML_H = 4, ML_D = 128, ML_W = 512;
constexpr int XH = 4, XD = 256;
constexpr int DFF = 2816;
constexpr int INW = 2480;
constexpr int LDZ = 2560, ZC_CQ = 0, ZC_CKV = 256, ZC_KR = 384, ZC_G = 416, ZC_QK = 512, ZC_V = 1536, ZC_O = 2048;
constexpr int NWAVES = 8, NTHR = 512;

constexpr size_t MiB = 1u << 20;
constexpr size_t WS_CTL = 0;
constexpr size_t WS_WIN = 1 * MiB;
constexpr size_t WS_WUQ = 6 * MiB;
constexpr size_t WS_WUKV = 7 * MiB;
constexpr size_t WS_WOUT = 8 * MiB;
constexpr size_t WS_WXQ = 10 * MiB;
constexpr size_t WS_WXKV = 12 * MiB;
constexpr size_t WS_WXO = 16 * MiB;
constexpr size_t WS_WGU = 18 * MiB;
constexpr size_t WS_WD = 30 * MiB;
constexpr size_t WS_COS = 36 * MiB;
constexpr size_t WS_SIN = 38 * MiB;
constexpr size_t WS_G = 40 * MiB;
constexpr size_t WS_KR = 42 * MiB;
constexpr size_t WS_SSQ = 44 * MiB;
constexpr size_t WS_SMALL = 45 * MiB;
constexpr int SM_CONV = 0, SM_GBIAS = 3072, SM_MLN = 3136, SM_FIN = 3648, SM_END = 4672;
constexpr size_t WS_MEMN = 46 * MiB;
constexpr size_t WS_KVM = 50 * MiB;
constexpr size_t WS_XB = 64 * MiB;
constexpr size_t WS_Z = 128 * MiB;
constexpr size_t WS_H = 128 * MiB;
constexpr size_t WS_QALL = 288 * MiB;
constexpr size_t WS_KV = 336 * MiB;
constexpr size_t WS_Y = 400 * MiB;
constexpr size_t WS_HQ = 304 * MiB;
constexpr size_t WS_OX = 368 * MiB;
constexpr size_t WS_GT = 464 * MiB;
constexpr size_t WS_END = 476 * MiB;

typedef unsigned short bf16_t;
typedef short bf16x8 __attribute__((ext_vector_type(8)));
typedef float f32x4 __attribute__((ext_vector_type(4)));
typedef unsigned u32x4 __attribute__((ext_vector_type(4)));
typedef unsigned u32x2 __attribute__((ext_vector_type(2)));
#define LAS __attribute__((address_space(3)))

__device__ __forceinline__ float bf2f(bf16_t h) { return __uint_as_float(((unsigned)h) << 16); }
__device__ __forceinline__ unsigned f2bf(float f) { unsigned u = __float_as_uint(f); return (u + 0x7fffu + ((u >> 16) & 1u)) >> 16; }
typedef float f32x2_c __attribute__((ext_vector_type(2))); typedef __bf16 bf16x2_c __attribute__((ext_vector_type(2)));
__device__ __forceinline__ unsigned pk2(float lo, float hi) { f32x2_c v = {lo, hi}; bf16x2_c b = __builtin_convertvector(v, bf16x2_c); return __builtin_bit_cast(unsigned, b); }
__device__ __forceinline__ float wave_sum(float v) {
#pragma unroll
    for (int o = 1; o < 64; o <<= 1) v += __shfl_xor(v, o);
    return v;
}
__device__ __forceinline__ float wave_max(float v) {
#pragma unroll
    for (int o = 1; o < 64; o <<= 1) v = fmaxf(v, __shfl_xor(v, o));
    return v;
}

struct Params {
    const float* x; const float* mem; const int* pos;
    const float *attn_norm, *w_in, *q_norm, *w_uq, *kv_norm, *w_ukv, *conv, *gbias, *ml_norm, *w_out, *xattn_norm, *mem_norm, *w_xq, *w_xkv, *w_xo, *ffn_norm, *w_gu, *w_down, *final_norm;
    float* out; unsigned char* ws;
    int ph_lo, ph_hi;
};

struct Unit { int pm, pn; };
struct Gemm { const bf16_t* A; int lda; const bf16_t* Bt; int ldb; int M, N, K; };


#define PG8_LAS __attribute__((address_space(3)))
constexpr int BM = 256, BK = 64, HALF = 128, HTB = HALF * BK * 2  , STAGE_BYTES = 8 * HTB, NXCD = 8, WGM = 8;

__host__ __device__ __forceinline__ int lds_byte(int r, int c) { const int st = (r >> 4) * 2 + (c >> 5), rr = r & 15, cc = c & 31, ob = rr * 64 + cc * 2; return st * 1024 + (ob ^ (((ob >> 9) & 1) << 5)); }
__host__ __device__ __forceinline__ void stage_rc(int b, int& R, int& C) { const int st = b / 1024, sb = b % 1024, swz = sb ^ (((sb >> 9) & 1) << 5); R = (st >> 1) * 16 + swz / 64; C = (st & 1) * 32 + (swz % 64) / 2; }
__host__ __device__ __forceinline__ int perm32(int rho) { const int n = rho >> 4, i = rho & 15; return 8 * (i >> 2) + 4 * n + (i & 3); }


struct StaticOrder {
    int nM, nN, nwg, G, c;
    __host__ __device__ __forceinline__ void init(int M, int N, int G_, int c_) { nM = M / BM; nN = N / BM; nwg = nM * nN; G = G_; c = c_; }
    __host__ __device__ __forceinline__ bool next(int i, Unit& u) const {
        const long L = (long)i * G + c; if (L >= nwg) return false;
        int wgid = (int)L; { const int q = nwg / NXCD, r = nwg % NXCD, xcd = wgid % NXCD, off = wgid / NXCD; wgid = (xcd < r ? xcd * (q + 1) : r * (q + 1) + (xcd - r) * q) + off; }
        const int nig = WGM * nN, gid = wgid / nig, fm = gid * WGM, gsz = (nM - fm) < WGM ? (nM - fm) : WGM;
        u.pm = fm + ((wgid % nig) % gsz); u.pn = (wgid % nig) / gsz; return true;
    }
    __device__ __forceinline__ void a_ready(const Unit&) const {}
    __device__ __forceinline__ void done(const Unit&) const {}
};

template <class Epi, class Sched, bool ALIGN_EPI = false, bool SP2 = false>
__device__ __forceinline__ void gemm_phase(PG8_LAS unsigned char* lds, const Gemm g, const Sched& S, const Epi& E) {
    const int tid = threadIdx.x, wid = __builtin_amdgcn_readfirstlane(tid >> 6), lane = tid & 63, wr = wid >> 2, wc = wid & 3, fr = lane & 15, fq = lane >> 4;
    const int K = g.K, nt = K / BK, lda = g.lda, ldb = g.ldb;
    unsigned voffA[2], voffB[2];
#pragma unroll
    for (int i = 0; i < 2; ++i) { int R, C; stage_rc(tid * 16 + i * 8192, R, C); const int Rb = Epi::PERM ? ((R & ~31) + perm32(R & 31)) : R;
        voffA[i] = (unsigned)(R * lda + C) * 2u; voffB[i] = (unsigned)(Rb * ldb + C) * 2u; }
    const size_t kstep = (size_t)(BK * 2);
    const size_t hstepA = (size_t)HALF * lda * 2, hstepB = (size_t)HALF * ldb * 2;
    const size_t tstepA = 2 * hstepA, tstepB = 2 * hstepB;
    const unsigned ldsw = (unsigned)wid * 1024u;
    const int aoff = lds_byte(wr * 64 + fr, fq * 8), boff = lds_byte(wc * 32 + fr, fq * 8);
#define PG8_SA(b, h) (((b) * 2 + (h)) * HTB)
#define PG8_SB(b, h) ((4 + (b) * 2 + (h)) * HTB)
#define PG8_STAGE(bufoff, gbase, voff) do { _Pragma("unroll") for (int _i = 0; _i < 2; ++_i) \
        __builtin_amdgcn_global_load_lds((const unsigned*)((const char*)(gbase) + (voff)[_i]), (PG8_LAS unsigned*)(lds + (bufoff) + ldsw + _i * 8192), 16, 0, 0); } while (0)
#define PG8_LDA(dst, b, h) do { _Pragma("unroll") for (int m = 0; m < 4; ++m) _Pragma("unroll") for (int k = 0; k < 2; ++k) dst[m][k] = *(const PG8_LAS bf16x8*)(lds + PG8_SA(b, h) + aoff + m * 2048 + k * 1024); } while (0)
#define PG8_LDB(dst, b, h) do { _Pragma("unroll") for (int n = 0; n < 2; ++n) _Pragma("unroll") for (int k = 0; k < 2; ++k) dst[n][k] = *(const PG8_LAS bf16x8*)(lds + PG8_SB(b, h) + boff + n * 2048 + k * 1024); } while (0)
#define PG8_MMA(ai, bj, At, Bt) do { __builtin_amdgcn_s_setprio(1); _Pragma("unroll") for (int m = 0; m < 4; ++m) _Pragma("unroll") for (int n = 0; n < 2; ++n) _Pragma("unroll") for (int k = 0; k < 2; ++k) \
        acc[ai][bj][m][n] = __builtin_amdgcn_mfma_f32_16x16x32_bf16(Bt[n][k], At[m][k], acc[ai][bj][m][n], 0, 0, 0); __builtin_amdgcn_s_setprio(0); } while (0)
#define PG8_WAIT_V(n) asm volatile("s_waitcnt vmcnt(" #n ")" ::: "memory")
#define PG8_WAIT_L(n) asm volatile("s_waitcnt lgkmcnt(" #n ")" ::: "memory")
#define PG8_BAR __builtin_amdgcn_s_barrier()
#define PG8_SCHED __builtin_amdgcn_sched_barrier(0)
    Unit cur, nxt; int ui = 0;
    if (!S.next(0, cur)) return;
    f32x4 acc[2][2][4][2];
#pragma unroll
    for (int a = 0; a < 2; ++a)
#pragma unroll
        for (int b = 0; b < 2; ++b)
#pragma unroll
            for (int m = 0; m < 4; ++m)
#pragma unroll
                for (int n = 0; n < 2; ++n) acc[a][b][m][n] = (f32x4){0.f, 0.f, 0.f, 0.f};
    bf16x8 At[4][2], B0[2][2], B1[2][2];
    const char* cA = (const char*)g.A + (size_t)cur.pm * tstepA; const char* cB = (const char*)g.Bt + (size_t)cur.pn * tstepB;
    S.a_ready(cur);
    if constexpr (SP2) {
        PG8_STAGE(PG8_SB(0, 0), cB, voffB); PG8_STAGE(PG8_SB(0, 1), cB + hstepB, voffB); PG8_STAGE(PG8_SA(0, 0), cA, voffA); PG8_STAGE(PG8_SA(0, 1), cA + hstepA, voffA);
        if (wr == 1) PG8_BAR;
        PG8_WAIT_V(2); PG8_BAR;
        PG8_STAGE(PG8_SB(1, 0), cB + kstep, voffB); PG8_STAGE(PG8_SA(1, 0), cA + kstep, voffA); PG8_STAGE(PG8_SB(1, 1), cB + hstepB + kstep, voffB);
        PG8_WAIT_V(6); PG8_BAR;
    } else {
        PG8_STAGE(PG8_SB(0, 0), cB, voffB); PG8_STAGE(PG8_SA(0, 0), cA, voffA); PG8_STAGE(PG8_SB(0, 1), cB + hstepB, voffB); PG8_STAGE(PG8_SA(0, 1), cA + hstepA, voffA);
        if (wr == 1) PG8_BAR;
        PG8_WAIT_V(4); PG8_BAR;
        PG8_STAGE(PG8_SB(1, 0), cB + kstep, voffB); PG8_STAGE(PG8_SA(1, 0), cA + kstep, voffA); PG8_STAGE(PG8_SB(1, 1), cB + hstepB + kstep, voffB);
        PG8_WAIT_V(6); PG8_BAR;
    }
    for (;;) {
        const bool has_next = S.next(ui + 1, nxt);
        const char* nA = has_next ? (const char*)g.A + (size_t)nxt.pm * tstepA : cA; const char* nB = has_next ? (const char*)g.Bt + (size_t)nxt.pn * tstepB : cB;
        for (int t = 0; t < nt; t += 2) {
            const bool last = (t == nt - 2);
            const char* a1 = cA + (size_t)(t + 1) * kstep;
            const char* a2 = last ? nA : cA + (size_t)(t + 2) * kstep; const char* b2 = last ? nB : cB + (size_t)(t + 2) * kstep;
            const char* a3 = a2 + kstep; const char* b3 = b2 + kstep;
            if (last && has_next) S.a_ready(nxt);
            if constexpr (SP2) {
            PG8_LDB(B0, 0, 0); PG8_LDB(B1, 0, 1); PG8_SCHED; PG8_LDA(At, 0, 0); PG8_STAGE(PG8_SA(1, 1), a1 + hstepA, voffA);
            PG8_WAIT_V(8); PG8_WAIT_L(0); PG8_BAR; PG8_MMA(0, 0, At, B0); PG8_MMA(0, 1, At, B1); PG8_BAR; PG8_SCHED;
            PG8_LDA(At, 0, 1); PG8_STAGE(PG8_SB(0, 0), b2, voffB); PG8_STAGE(PG8_SB(0, 1), b2 + hstepB, voffB); PG8_STAGE(PG8_SA(0, 0), a2, voffA);
            PG8_WAIT_V(8); PG8_WAIT_L(0); PG8_BAR; PG8_MMA(1, 0, At, B0); PG8_MMA(1, 1, At, B1); PG8_BAR; PG8_SCHED;
            PG8_LDB(B0, 1, 0); PG8_LDB(B1, 1, 1); PG8_SCHED; PG8_LDA(At, 1, 0); PG8_STAGE(PG8_SA(0, 1), a2 + hstepA, voffA);
            PG8_WAIT_V(8); PG8_WAIT_L(0); PG8_BAR; PG8_MMA(0, 0, At, B0); PG8_MMA(0, 1, At, B1); PG8_BAR; PG8_SCHED;
            PG8_LDA(At, 1, 1); PG8_STAGE(PG8_SB(1, 0), b3, voffB); PG8_STAGE(PG8_SB(1, 1), b3 + hstepB, voffB); PG8_STAGE(PG8_SA(1, 0), a3, voffA);
            PG8_WAIT_V(8); PG8_WAIT_L(0); PG8_BAR; PG8_MMA(1, 0, At, B0); PG8_MMA(1, 1, At, B1); PG8_BAR; PG8_SCHED;
            } else {
            PG8_LDB(B0, 0, 0); PG8_SCHED; PG8_LDA(At, 0, 0); PG8_STAGE(PG8_SA(1, 1), a1 + hstepA, voffA);
            PG8_WAIT_L(8); PG8_BAR; PG8_WAIT_L(0); PG8_MMA(0, 0, At, B0); PG8_BAR; PG8_SCHED;
            PG8_LDB(B1, 0, 1); PG8_STAGE(PG8_SB(0, 0), b2, voffB);
            PG8_BAR; PG8_WAIT_L(0); PG8_MMA(0, 1, At, B1); PG8_BAR;
            PG8_LDA(At, 0, 1); PG8_STAGE(PG8_SA(0, 0), a2, voffA);
            PG8_BAR; PG8_WAIT_L(0); PG8_MMA(1, 0, At, B0); PG8_BAR; PG8_SCHED;
            PG8_STAGE(PG8_SB(0, 1), b2 + hstepB, voffB);
            PG8_WAIT_V(6); PG8_BAR; PG8_MMA(1, 1, At, B1); PG8_BAR;
            PG8_LDB(B0, 1, 0); PG8_SCHED; PG8_LDA(At, 1, 0); PG8_STAGE(PG8_SA(0, 1), a2 + hstepA, voffA);
            PG8_WAIT_L(8); PG8_BAR; PG8_WAIT_L(0); PG8_MMA(0, 0, At, B0); PG8_BAR; PG8_SCHED;
            PG8_LDB(B1, 1, 1); PG8_STAGE(PG8_SB(1, 0), b3, voffB);
            PG8_BAR; PG8_WAIT_L(0); PG8_MMA(0, 1, At, B1); PG8_BAR;
            PG8_LDA(At, 1, 1); PG8_STAGE(PG8_SA(1, 0), a3, voffA);
            PG8_BAR; PG8_WAIT_L(0); PG8_MMA(1, 0, At, B0); PG8_BAR; PG8_SCHED;
            PG8_STAGE(PG8_SB(1, 1), b3 + hstepB, voffB);
            PG8_WAIT_V(6); PG8_BAR; PG8_MMA(1, 1, At, B1); PG8_BAR;
            }
        }
        if constexpr (ALIGN_EPI) { if (wr == 0) PG8_BAR; }
        if constexpr (!Epi::AFTER_DRAIN) { E(acc, cur, wr, wc, fr, fq); S.done(cur); }
        if (!has_next) break;
#pragma unroll
        for (int a = 0; a < 2; ++a)
#pragma unroll
            for (int b = 0; b < 2; ++b)
#pragma unroll
                for (int m = 0; m < 4; ++m)
#pragma unroll
                    for (int n = 0; n < 2; ++n) acc[a][b][m][n] = (f32x4){0.f, 0.f, 0.f, 0.f};
        cur = nxt; cA = nA; cB = nB; ++ui;
        if constexpr (ALIGN_EPI) { if (wr == 1) PG8_BAR; }
    }
    PG8_WAIT_V(0);
    if constexpr (!ALIGN_EPI) { if (wr == 0) PG8_BAR; }
    PG8_BAR;
    if constexpr (Epi::AFTER_DRAIN) { E.fused(acc, cur, wr, wc, fr, fq, lds, wid, lane); S.done(cur); }
#undef PG8_SA
#undef PG8_SB
#undef PG8_STAGE
#undef PG8_LDA
#undef PG8_LDB
#undef PG8_MMA
#undef PG8_WAIT_V
#undef PG8_WAIT_L
#undef PG8_BAR
#undef PG8_SCHED
}

__device__ __forceinline__ u32x4 pack8(const f32x4 v0, const f32x4 v1) { u32x4 w; w.x = pk2(v0[0], v0[1]); w.y = pk2(v0[2], v0[3]); w.z = pk2(v1[0], v1[1]); w.w = pk2(v1[2], v1[3]); return w; }
__device__ __forceinline__ float sq8(const f32x4 a, const f32x4 b) { return (a[0] * a[0] + a[1] * a[1]) + (a[2] * a[2] + a[3] * a[3]) + (b[0] * b[0] + b[1] * b[1]) + (b[2] * b[2] + b[3] * b[3]); }

struct EpiZ {
    static constexpr bool PERM = true, AFTER_DRAIN = false;
    bf16_t* Z; float* ssq_q; float* ssq_kv; bf16_t* KR; float* G; const float* cosT; const float* sinT;
    __device__ __forceinline__ void operator()(const f32x4 (&acc)[2][2][4][2], const Unit& u, int wr, int wc, int fr, int fq) const {
#pragma unroll
        for (int ai = 0; ai < 2; ++ai) {
            f32x4 cs[4][4];
            if (u.pn == 1 && wc == 0) {
#pragma unroll
                for (int m = 0; m < 4; ++m) { const size_t ro = (size_t)(u.pm * 256 + ai * 128 + wr * 64 + m * 16 + fr) * 16 + 8 * (fq & 1);
                    cs[m][0] = *(const f32x4*)(cosT + ro); cs[m][1] = *(const f32x4*)(cosT + ro + 4); cs[m][2] = *(const f32x4*)(sinT + ro); cs[m][3] = *(const f32x4*)(sinT + ro + 4); } }
#pragma unroll
            for (int m = 0; m < 4; ++m) {
                const int row = u.pm * 256 + ai * 128 + wr * 64 + m * 16 + fr;
                bf16_t* zp = Z + (size_t)row * LDZ + u.pn * 256 + wc * 32 + 8 * fq;
#pragma unroll
                for (int bj = 0; bj < 2; ++bj) *(u32x4*)(zp + bj * 128) = pack8(acc[ai][bj][m][0], acc[ai][bj][m][1]);
                if (u.pn == 0) {
                    float s = sq8(acc[ai][0][m][0], acc[ai][0][m][1]) + sq8(acc[ai][1][m][0], acc[ai][1][m][1]);
                    s += __shfl_xor(s, 16); s += __shfl_xor(s, 32);
                    if (fq == 0) atomicAdd(ssq_q + row, s);
                } else if (u.pn == 1) {
                    float s = sq8(acc[ai][0][m][0], acc[ai][0][m][1]);
                    s += __shfl_xor(s, 16); s += __shfl_xor(s, 32);
                    if (fq == 0) atomicAdd(ssq_kv + row, s);
                    if (wc == 0) {
                        const f32x4 o0 = acc[ai][1][m][0], o1 = acc[ai][1][m][1];
                        f32x4 p0, p1;
#pragma unroll
                        for (int j = 0; j < 4; ++j) { p0[j] = __shfl_xor(o0[j], 32); p1[j] = __shfl_xor(o1[j], 32); }
                        const f32x4 c0 = cs[m][0], c1 = cs[m][1], s0 = cs[m][2], s1 = cs[m][3];
                        f32x4 r0, r1;
                        if (fq < 2) { r0 = o0 * c0 - p0 * s0; r1 = o1 * c1 - p1 * s1; }
                        else        { r0 = o0 * c0 + p0 * s0; r1 = o1 * c1 + p1 * s1; }
                        *(u32x4*)(KR + (size_t)row * 32 + 8 * fq) = pack8(r0, r1);
                    } else if (wc == 1 && fq < 2) {
                        *(f32x4*)(G + (size_t)row * 16 + 8 * fq) = acc[ai][1][m][0];
                        *(f32x4*)(G + (size_t)row * 16 + 8 * fq + 4) = acc[ai][1][m][1];
                    }
                }
            }
        }
    }
};
struct EpiScaleBf16 {
    static constexpr bool PERM = true, AFTER_DRAIN = false;
    bf16_t* O; int ldo; const float* ssq; float inv_n; float c;
    __device__ __forceinline__ void operator()(const f32x4 (&acc)[2][2][4][2], const Unit& u, int wr, int wc, int fr, int fq) const {
        float sc[2][4];
#pragma unroll
        for (int ai = 0; ai < 2; ++ai)
#pragma unroll
            for (int m = 0; m < 4; ++m) sc[ai][m] = ssq ? ssq[u.pm * 256 + ai * 128 + wr * 64 + m * 16 + fr] : 0.f;
#pragma unroll
        for (int ai = 0; ai < 2; ++ai)
#pragma unroll
            for (int m = 0; m < 4; ++m) {
                const int row = u.pm * 256 + ai * 128 + wr * 64 + m * 16 + fr;
                const float sv = ssq ? c * rsqrtf(sc[ai][m] * inv_n + EPS) : c;
                bf16_t* op = O + (size_t)row * ldo + u.pn * 256 + wc * 32 + 8 * fq;
#pragma unroll
                for (int bj = 0; bj < 2; ++bj) *(u32x4*)(op + bj * 128) = pack8(acc[ai][bj][m][0] * sv, acc[ai][bj][m][1] * sv);
            }
    }
};
struct EpiResid {
    static constexpr bool PERM = true, AFTER_DRAIN = false;
    const float* resf; const bf16_t* resb; bf16_t* XB; float* ssq;
    __device__ __forceinline__ void operator()(const f32x4 (&acc)[2][2][4][2], const Unit& u, int wr, int wc, int fr, int fq) const {
#pragma unroll
        for (int ai = 0; ai < 2; ++ai) {
            f32x4 r0[4][2], r1[4][2];
            if (resf) {
#pragma unroll
                for (int m = 0; m < 4; ++m)
#pragma unroll
                    for (int bj = 0; bj < 2; ++bj) { const size_t off = (size_t)(u.pm * 256 + ai * 128 + wr * 64 + m * 16 + fr) * DM + u.pn * 256 + wc * 32 + 8 * fq + bj * 128;
                        r0[m][bj] = *(const f32x4*)(resf + off); r1[m][bj] = *(const f32x4*)(resf + off + 4); }
            } else {
                u32x4 rb[4][2];
#pragma unroll
                for (int m = 0; m < 4; ++m)
#pragma unroll
                    for (int bj = 0; bj < 2; ++bj) rb[m][bj] = *(const u32x4*)(resb + (size_t)(u.pm * 256 + ai * 128 + wr * 64 + m * 16 + fr) * DM + u.pn * 256 + wc * 32 + 8 * fq + bj * 128);
#pragma unroll
                for (int m = 0; m < 4; ++m)
#pragma unroll
                    for (int bj = 0; bj < 2; ++bj) { const u32x4 q = rb[m][bj];
                        r0[m][bj] = (f32x4){__uint_as_float(q.x << 16), __uint_as_float(q.x & 0xffff0000u), __uint_as_float(q.y << 16), __uint_as_float(q.y & 0xffff0000u)};
                        r1[m][bj] = (f32x4){__uint_as_float(q.z << 16), __uint_as_float(q.z & 0xffff0000u), __uint_as_float(q.w << 16), __uint_as_float(q.w & 0xffff0000u)}; }
            }
#pragma unroll
            for (int m = 0; m < 4; ++m) {
                const int row = u.pm * 256 + ai * 128 + wr * 64 + m * 16 + fr;
                const size_t off = (size_t)row * DM + u.pn * 256 + wc * 32 + 8 * fq;
                float sq = 0.f;
#pragma unroll
                for (int bj = 0; bj < 2; ++bj) {
                    const f32x4 v0 = r0[m][bj] + acc[ai][bj][m][0], v1 = r1[m][bj] + acc[ai][bj][m][1];
                    *(u32x4*)(XB + off + bj * 128) = pack8(v0, v1);
                    sq += sq8(v0, v1);
                }
                sq += __shfl_xor(sq, 16); sq += __shfl_xor(sq, 32);
                if (fq == 0) atomicAdd(ssq + row, sq);
            }
        }
    }
};
struct EpiSwiglu {
    static constexpr bool PERM = true, AFTER_DRAIN = false;
    bf16_t* H; const float* ssq;
    __device__ __forceinline__ void operator()(const f32x4 (&acc)[2][2][4][2], const Unit& u, int wr, int wc, int fr, int fq) const {
        float scv[2][4];
#pragma unroll
        for (int ai = 0; ai < 2; ++ai)
#pragma unroll
            for (int m = 0; m < 4; ++m) scv[ai][m] = ssq[u.pm * 256 + ai * 128 + wr * 64 + m * 16 + fr];
#pragma unroll
        for (int ai = 0; ai < 2; ++ai)
#pragma unroll
            for (int m = 0; m < 4; ++m) {
                const int row = u.pm * 256 + ai * 128 + wr * 64 + m * 16 + fr;
                const float sc = rsqrtf(scv[ai][m] * (1.0f / DM) + EPS);
                f32x4 h[2];
#pragma unroll
                for (int n = 0; n < 2; ++n)
#pragma unroll
                    for (int j = 0; j < 4; ++j) { const float gg = acc[ai][0][m][n][j] * sc, uu = acc[ai][1][m][n][j] * sc;
                        h[n][j] = gg * uu * __builtin_amdgcn_rcpf(1.0f + __builtin_amdgcn_exp2f(-1.4426950408889634f * gg)); }
                *(u32x4*)(H + (size_t)row * DFF + u.pn * 128 + wc * 32 + 8 * fq) = pack8(h[0], h[1]);
            }
    }
};

struct SingleOrder {
    StaticOrder base; int i;
    __device__ __forceinline__ bool next(int j, Unit& u) const { return j == 0 ? base.next(i, u) : false; }
    __device__ __forceinline__ void a_ready(const Unit&) const {}
    __device__ __forceinline__ void done(const Unit&) const {}
};
template <class Epi>
__device__ __forceinline__ void run_gemm(LAS unsigned char* lds, const Gemm g, const Epi& E, int c) {
    StaticOrder S; S.init(g.M, g.N, (int)gridDim.x, c);
    gemm_phase<Epi, StaticOrder, true, true>(lds, g, S, E);
}

struct MapIdent { __device__ __forceinline__ int operator()(int n) const { return n; } };
struct MapWin { __device__ __forceinline__ int operator()(int n) const {
    if (n < 416) return n; if (n < 1440) return ZC_QK + (n - 416); if (n < 1952) return ZC_V + (n - 1440); if (n < 2464) return ZC_O + (n - 1952); return ZC_G + (n - 2464); } };
struct MapGU { __device__ __forceinline__ int operator()(int n) const { const int up = n >= DFF, j = up ? n - DFF : n; return (j >> 7) * 256 + up * 128 + (j & 127); } };

template <class Map>
__device__ __forceinline__ void transpose_w(const float* W, int K, int N, const float* gain, bf16_t* WT, int ldt, Map map, LAS float* scr, int gw, int ngw, int lane) {
    const int nblk = (N + 31) / 32, nitems = (K / 64) * nblk;
    for (int it = gw; it < nitems; it += ngw) {
        const int kb = it / nblk, nb = it % nblk, k0 = 64 * kb, n0 = 32 * nb;
        { const int nn = n0 + (lane & 31); const bool ok = nn < N; const float* wp = W + (size_t)(k0 + (lane >> 5)) * N + (ok ? nn : 0);
          float v[32];
#pragma unroll
          for (int i = 0; i < 32; ++i) v[i] = wp[(size_t)(2 * i) * N];
          if (gain) {
#pragma unroll
              for (int i = 0; i < 32; ++i) v[i] *= gain[k0 + 2 * i + (lane >> 5)]; }
#pragma unroll
          for (int i = 0; i < 32; ++i) scr[(2 * i + (lane >> 5)) * 33 + (lane & 31)] = ok ? v[i] : 0.f; }
        asm volatile("s_waitcnt lgkmcnt(0)" ::: "memory");
        const int c = lane & 7;
#pragma unroll
        for (int j = 0; j < 4; ++j) { const int n = (lane >> 3) + 8 * j, nn = n0 + n;
            if (nn < N) { const LAS float* s = scr + (8 * c) * 33 + n;
                u32x4 o; o.x = pk2(s[0 * 33], s[1 * 33]); o.y = pk2(s[2 * 33], s[3 * 33]); o.z = pk2(s[4 * 33], s[5 * 33]); o.w = pk2(s[6 * 33], s[7 * 33]);
                *(u32x4*)(WT + (size_t)map(nn) * ldt + k0 + 8 * c) = o; } }
        asm volatile("s_waitcnt lgkmcnt(0)" ::: "memory");
    }
}
__device__ __forceinline__ void rms_row_bf16(const float* xrow, const float* gain, bf16_t* orow, int lane) {
    const f32x4* xr = (const f32x4*)xrow + lane; const f32x4* gr = (const f32x4*)gain + lane;
    f32x4 v[4]; float s = 0.f;
#pragma unroll
    for (int j = 0; j < 4; ++j) { v[j] = xr[64 * j]; s += (v[j][0] * v[j][0] + v[j][1] * v[j][1]) + (v[j][2] * v[j][2] + v[j][3] * v[j][3]); }
    const float r = rsqrtf(wave_sum(s) * (1.0f / DM) + EPS);
    u32x2* o8 = (u32x2*)orow + lane;
#pragma unroll
    for (int j = 0; j < 4; ++j) { const f32x4 gg = gr[64 * j]; u32x2 w; w.x = pk2(v[j][0] * r * gg[0], v[j][1] * r * gg[1]); w.y = pk2(v[j][2] * r * gg[2], v[j][3] * r * gg[3]); o8[64 * j] = w; }
}

__device__ __forceinline__ void phase0(const Params& p, LAS unsigned char* lds) {
    const int tid = threadIdx.x, wid = tid >> 6, lane = tid & 63;
    const int gw = blockIdx.x * NWAVES + wid, ngw = gridDim.x * NWAVES;
    const int gt = blockIdx.x * NTHR + tid, ngt = gridDim.x * NTHR;
    LAS float* scr = (LAS float*)(lds + wid * 16384);
    unsigned char* ws = p.ws;
    transpose_w(p.w_in, DM, INW, nullptr, (bf16_t*)(ws + WS_WIN), DM, MapWin(), scr, gw, ngw, lane);
    transpose_w(p.w_uq, QLORA, MLA_H * DQK, p.q_norm, (bf16_t*)(ws + WS_WUQ), QLORA, MapIdent(), scr, gw, ngw, lane);
    transpose_w(p.w_ukv, KVLORA, MLA_H * (NOPE + VD), p.kv_norm, (bf16_t*)(ws + WS_WUKV), 256, MapIdent(), scr, gw, ngw, lane);
    transpose_w(p.w_out, DM, DM, nullptr, (bf16_t*)(ws + WS_WOUT), DM, MapIdent(), scr, gw, ngw, lane);
    transpose_w(p.w_xq, DM, DM, p.xattn_norm, (bf16_t*)(ws + WS_WXQ), DM, MapIdent(), scr, gw, ngw, lane);
    transpose_w(p.w_xkv, DM, 2 * DM, nullptr, (bf16_t*)(ws + WS_WXKV), DM, MapIdent(), scr, gw, ngw, lane);
    transpose_w(p.w_xo, DM, DM, nullptr, (bf16_t*)(ws + WS_WXO), DM, MapIdent(), scr, gw, ngw, lane);
    transpose_w(p.w_gu, DM, 2 * DFF, p.ffn_norm, (bf16_t*)(ws + WS_WGU), DM, MapGU(), scr, gw, ngw, lane);
    transpose_w(p.w_down, DFF, DM, nullptr, (bf16_t*)(ws + WS_WD), DFF, MapIdent(), scr, gw, ngw, lane);
    { bf16_t* wz = (bf16_t*)(ws + WS_WIN) + (size_t)432 * DM; for (int i = gt; i < 80 * DM / 8; i += ngt) ((u32x4*)wz)[i] = (u32x4){0u, 0u, 0u, 0u};
      bf16_t* wk = (bf16_t*)(ws + WS_WUKV); for (int i = gt; i < 1024 * 16; i += ngt) { const int r = i >> 4, c = i & 15; *(u32x4*)(wk + (size_t)r * 256 + 128 + 8 * c) = (u32x4){0u, 0u, 0u, 0u}; } }
    { float* sm = (float*)(ws + WS_SMALL);
      for (int i = gt; i < SM_END; i += ngt) { float v = 0.f;
          if (i < SM_GBIAS) v = p.conv[i]; else if (i < SM_GBIAS + 16) v = p.gbias[i - SM_GBIAS]; else if (i >= SM_MLN && i < SM_MLN + 512) v = p.ml_norm[i - SM_MLN]; else if (i >= SM_FIN) v = p.final_norm[i - SM_FIN];
          sm[i] = v; } }
    { float* ssq = (float*)(ws + WS_SSQ); for (int i = gt; i < 5 * T; i += ngt) ssq[i] = 0.f; }
    { float* ct = (float*)(ws + WS_COS); float* st = (float*)(ws + WS_SIN);
      for (int i = gt; i < T * 16; i += ngt) { const int row = i >> 4, j = i & 15;
          float inv = 1.0f;
          switch (j) { case 1: inv = 0.5623413251903491f; break; case 2: inv = 0.31622776601683794f; break; case 3: inv = 0.1778279410038923f; break; case 4: inv = 0.1f; break;
                       case 5: inv = 0.05623413251903491f; break; case 6: inv = 0.03162277660168379f; break; case 7: inv = 0.01778279410038923f; break; case 8: inv = 0.01f; break;
                       case 9: inv = 0.005623413251903491f; break; case 10: inv = 0.003162277660168379f; break; case 11: inv = 0.001778279410038923f; break; case 12: inv = 0.001f; break;
                       case 13: inv = 0.0005623413251903491f; break; case 14: inv = 0.00031622776601683794f; break; case 15: inv = 0.0001778279410038923f; break; default: break; }
          const float ang = (float)p.pos[row] * inv; float sn, cs; sincosf(ang, &sn, &cs); ct[i] = cs; st[i] = sn; } }
    for (int r4 = gw * 4; r4 < T; r4 += ngw * 4) {
        f32x4 v[4][4]; float sq[4];
#pragma unroll
        for (int q = 0; q < 4; ++q) { const f32x4* xr = (const f32x4*)(p.x + (size_t)(r4 + q) * DM) + lane;
#pragma unroll
            for (int j = 0; j < 4; ++j) v[q][j] = xr[64 * j]; }
#pragma unroll
        for (int q = 0; q < 4; ++q) { float s_ = 0.f;
#pragma unroll
            for (int j = 0; j < 4; ++j) s_ += (v[q][j][0] * v[q][j][0] + v[q][j][1] * v[q][j][1]) + (v[q][j][2] * v[q][j][2] + v[q][j][3] * v[q][j][3]);
            sq[q] = s_; }
#pragma unroll
        for (int o = 1; o < 64; o <<= 1) {
#pragma unroll
            for (int q = 0; q < 4; ++q) sq[q] += __shfl_xor(sq[q], o); }
        const f32x4* gr = (const f32x4*)p.attn_norm + lane;
#pragma unroll
        for (int q = 0; q < 4; ++q) { const float r_ = rsqrtf(sq[q] * (1.0f / DM) + EPS); u32x2* o8 = (u32x2*)((bf16_t*)(ws + WS_XB) + (size_t)(r4 + q) * DM) + lane;
#pragma unroll
            for (int j = 0; j < 4; ++j) { const f32x4 gg = gr[64 * j]; u32x2 w; w.x = pk2(v[q][j][0] * r_ * gg[0], v[q][j][1] * r_ * gg[1]); w.y = pk2(v[q][j][2] * r_ * gg[2], v[q][j][3] * r_ * gg[3]); o8[64 * j] = w; } }
    }
    for (int r = gw; r < TM; r += ngw) rms_row_bf16(p.mem + (size_t)r * DM, p.mem_norm, (bf16_t*)(ws + WS_MEMN) + (size_t)r * DM, lane);
}

__device__ __forceinline__ void phase_conv(const Params& p) {
    const bf16_t* Z = (const bf16_t*)(p.ws + WS_Z); bf16_t* Q = (bf16_t*)(p.ws + WS_XB); const float* conv = (const float*)(p.ws + WS_SMALL) + SM_CONV;
    const int c0 = (threadIdx.x & 127) * 8, rsub = threadIdx.x >> 7;
    f32x4 w[3][2];
#pragma unroll
    for (int k = 0; k < 3; ++k) { w[k][0] = *(const f32x4*)(conv + k * 1024 + c0); w[k][1] = *(const f32x4*)(conv + k * 1024 + c0 + 4); }
    const float sc = c0 >= 512 ? 0.08838834764831845f : 1.0f;
    for (int row = blockIdx.x * 4 + rsub; row < T; row += gridDim.x * 4) {
        const int t = row & (SEQ - 1);
        const bf16x8 zc = *(const bf16x8*)(Z + (size_t)row * LDZ + ZC_QK + c0);
        bf16x8 zp = (bf16x8){0, 0, 0, 0, 0, 0, 0, 0}, zn = zp;
        if (t > 0) zp = *(const bf16x8*)(Z + (size_t)(row - 1) * LDZ + ZC_QK + c0);
        if (t < SEQ - 1) zn = *(const bf16x8*)(Z + (size_t)(row + 1) * LDZ + ZC_QK + c0);
        float o[8];
#pragma unroll
        for (int j = 0; j < 8; ++j) { const float a = w[0][j >> 2][j & 3] * bf2f((bf16_t)zp[j]) + w[1][j >> 2][j & 3] * bf2f((bf16_t)zc[j]) + w[2][j >> 2][j & 3] * bf2f((bf16_t)zn[j]);
            o[j] = a * sc * __builtin_amdgcn_rcpf(1.0f + __builtin_amdgcn_exp2f(-1.4426950408889634f * a)); }
        u32x4 wv; wv.x = pk2(o[0], o[1]); wv.y = pk2(o[2], o[3]); wv.z = pk2(o[4], o[5]); wv.w = pk2(o[6], o[7]);
        *(u32x4*)(Q + (size_t)row * 1024 + c0) = wv;
    }
}

__device__ __forceinline__ void phase_mlfin(const Params& p, int bidx, int nblk) {
    const bf16_t* Z = (const bf16_t*)(p.ws + WS_Z); bf16_t* Y = (bf16_t*)(p.ws + WS_Y);
    const bf16_t* HF = (const bf16_t*)p.out; const bf16_t* HB = HF + (size_t)T * ML_W;
    const float* mln = (const float*)(p.ws + WS_SMALL) + SM_MLN;
    const int wid = threadIdx.x >> 6, lane = threadIdx.x & 63;
    const f32x4 g0 = *(const f32x4*)(mln + lane * 8), g1 = *(const f32x4*)(mln + lane * 8 + 4);
    for (int row4 = (bidx * NWAVES + wid) * 4; row4 < T; row4 += nblk * NWAVES * 4) {
        u32x4 hf[4], hb[4]; bf16x8 zo[4];
#pragma unroll
        for (int q = 0; q < 4; ++q) { const size_t o = (size_t)(row4 + q) * ML_W + lane * 8;
            hf[q] = *(const u32x4*)(HF + o); hb[q] = *(const u32x4*)(HB + o); zo[q] = *(const bf16x8*)(Z + (size_t)(row4 + q) * LDZ + ZC_O + lane * 8); }
#pragma unroll
        for (int q = 0; q < 4; ++q) {
            float a[8];
            a[0] = __uint_as_float(hf[q].x << 16) + __uint_as_float(hb[q].x << 16); a[1] = __uint_as_float(hf[q].x & 0xffff0000u) + __uint_as_float(hb[q].x & 0xffff0000u);
            a[2] = __uint_as_float(hf[q].y << 16) + __uint_as_float(hb[q].y << 16); a[3] = __uint_as_float(hf[q].y & 0xffff0000u) + __uint_as_float(hb[q].y & 0xffff0000u);
            a[4] = __uint_as_float(hf[q].z << 16) + __uint_as_float(hb[q].z << 16); a[5] = __uint_as_float(hf[q].z & 0xffff0000u) + __uint_as_float(hb[q].z & 0xffff0000u);
            a[6] = __uint_as_float(hf[q].w << 16) + __uint_as_float(hb[q].w << 16); a[7] = __uint_as_float(hf[q].w & 0xffff0000u) + __uint_as_float(hb[q].w & 0xffff0000u);
            float s_ = 0.f;
#pragma unroll
            for (int j = 0; j < 8; ++j) s_ += a[j] * a[j];
            s_ += __shfl_xor(s_, 1); s_ += __shfl_xor(s_, 2); s_ += __shfl_xor(s_, 4); s_ += __shfl_xor(s_, 8);
            const float r = rsqrtf(s_ * (1.0f / ML_D) + EPS);
            float ov[8];
#pragma unroll
            for (int j = 0; j < 8; ++j) { const float hv = a[j] * r * (j < 4 ? g0[j] : g1[j - 4]); const float z = bf2f((bf16_t)zo[q][j]); ov[j] = hv * __builtin_amdgcn_rcpf(1.0f + __builtin_amdgcn_exp2f(-1.4426950408889634f * z)); }
            u32x4 w; w.x = pk2(ov[0], ov[1]); w.y = pk2(ov[2], ov[3]); w.z = pk2(ov[4], ov[5]); w.w = pk2(ov[6], ov[7]);
            *(u32x4*)(Y + (size_t)(row4 + q) * DM + 512 + lane * 8) = w;
        }
    }
}

namespace fa {
using f32x16 = __attribute__((ext_vector_type(16))) float;
using s16x4  = __attribute__((ext_vector_type(4))) short;
typedef float f32x2_t __attribute__((ext_vector_type(2))); typedef __bf16 bf16x2_t __attribute__((ext_vector_type(2)));
#define FA_SBAR() __builtin_amdgcn_sched_barrier(0)
constexpr float THRL = 11.0f;
__device__ __forceinline__ int crow(int r, int hi) { return (r & 3) + 8 * (r >> 2) + 4 * hi; }
__device__ __forceinline__ unsigned cvtpk(float lo, float hi) { unsigned r; asm volatile("v_cvt_pk_bf16_f32 %0, %1, %2" : "=v"(r) : "v"(lo), "v"(hi)); return r; }
__device__ __forceinline__ unsigned cvtpk_s(float lo, float hi) { f32x2_t v = {lo, hi}; bf16x2_t b = __builtin_convertvector(v, bf16x2_t); return __builtin_bit_cast(unsigned, b); }
#define FA_MX3(a, b, c) __builtin_fmaxf(__builtin_fmaxf((a), (b)), (c))
__device__ __forceinline__ float rowmax32(const f32x16& p0, const f32x16& p1) {
    float a = FA_MX3(p0[0], p0[1], p1[0]), b = FA_MX3(p0[2], p0[3], p1[1]); a = FA_MX3(a, p1[2], p1[3]);
#pragma unroll
    for (int r = 4; r < 16; r += 4) { a = FA_MX3(a, p0[r], p0[r + 1]); b = FA_MX3(b, p0[r + 2], p0[r + 3]); a = FA_MX3(a, p1[r], p1[r + 1]); b = FA_MX3(b, p1[r + 2], p1[r + 3]); }
    float rm = __builtin_fmaxf(a, b);
    auto rr = __builtin_amdgcn_permlane32_swap(__float_as_uint(rm), __float_as_uint(rm), false, false);
    return __builtin_fmaxf(__uint_as_float(rr[0]), __uint_as_float(rr[1]));
}
template <bool FIRST>
__device__ __forceinline__ void smA(f32x16& p0, f32x16& p1, float& mref, f32x16& negm, LAS float* fl, int r32, int hi, bool& resc, float& fself) {
    const float rm = rowmax32(p0, p1);
    resc = false; fself = 1.f;
    if (FIRST || __builtin_expect(__any(rm > THRL), 0)) {
        const float dl = FIRST ? rm : __builtin_fmaxf(rm, 0.f);
        mref += dl;
#pragma unroll
        for (int r = 0; r < 16; ++r) { p0[r] -= dl; p1[r] -= dl; }
#pragma unroll
        for (int r = 0; r < 16; ++r) negm[r] = -mref;
        if (!FIRST) { fself = __builtin_amdgcn_exp2f(-dl); if (hi == 0) fl[r32] = fself; resc = true; }
    }
#pragma unroll
    for (int r = 0; r < 16; ++r) p0[r] = __builtin_amdgcn_exp2f(p0[r]);
}
__device__ __forceinline__ void smB(const f32x16& p0, f32x16& p1, bf16x8& pa0, bf16x8& pa1, bf16x8& pa2, bf16x8& pa3) {
#pragma unroll
    for (int r = 0; r < 16; ++r) p1[r] = __builtin_amdgcn_exp2f(p1[r]);
#define FA_PKD(P, B, OUT) do { u32x4 w_ = {cvtpk_s(P[B], P[B + 1]), cvtpk_s(P[B + 2], P[B + 3]), cvtpk_s(P[B + 4], P[B + 5]), cvtpk_s(P[B + 6], P[B + 7])}; OUT = __builtin_bit_cast(bf16x8, w_); } while (0)
    FA_PKD(p0, 0, pa0); FA_PKD(p0, 8, pa1); FA_PKD(p1, 0, pa2); FA_PKD(p1, 8, pa3);
#undef FA_PKD
}
template <int NDQ, int KP>
__device__ __forceinline__ void qkt(f32x16& p0, f32x16& p1, const LAS unsigned char* Ks, const bf16x8* qr, const f32x16& negm, int r32, int hi) {
#pragma unroll
    for (int d0 = 0; d0 < NDQ; ++d0) { const int cb = (d0 * 16 + hi * 8) * 2;
        const bf16x8 b0 = *(const LAS bf16x8*)(Ks + r32 * KP + cb);
        const bf16x8 b1 = *(const LAS bf16x8*)(Ks + (32 + r32) * KP + cb);
        if (d0 == 0) { p0 = __builtin_amdgcn_mfma_f32_32x32x16_bf16(b0, qr[0], negm, 0, 0, 0); p1 = __builtin_amdgcn_mfma_f32_32x32x16_bf16(b1, qr[0], negm, 0, 0, 0); }
        else { p0 = __builtin_amdgcn_mfma_f32_32x32x16_bf16(b0, qr[d0], p0, 0, 0, 0); p1 = __builtin_amdgcn_mfma_f32_32x32x16_bf16(b1, qr[d0], p1, 0, 0, 0); } }
}
template <int NDV> __device__ __forceinline__ int v_st(int k, int c) { const int kk = (k & ~0xC) | ((k & 4) << 1) | ((k & 8) >> 1); return ((kk >> 3) * NDV + (c >> 5)) * 512 + ((kk & 7) * 32 + (c & 31)) * 2; }
template <int NDV> __device__ __forceinline__ int v_stp(int k, int c) { return ((k >> 3) * NDV + (c >> 5)) * 512 + ((k & 7) * 32 + (c & 31)) * 2; }
__device__ __forceinline__ int v_rd_base(int lane) { return ((lane & 3) << 3) | (((lane >> 2) & 3) << 6) | (((lane >> 4) & 1) << 5) | (((lane >> 5) & 1) << 8); }
template <int OFF> __device__ __forceinline__ s16x4 tr_read(int vb) { s16x4 r; asm volatile("ds_read_b64_tr_b16 %0, %1 offset:%2" : "=&v"(r) : "v"(vb), "i"(OFF) : "memory"); return r; }
template <int NDV, int D0> __device__ __forceinline__ void pv_one(f32x16& od, int vb, bf16x8 pa0, bf16x8 pa1, bf16x8 pa2, bf16x8 pa3) {
    constexpr int KS = 2 * NDV * 512, HF = NDV * 512, B0 = D0 * 512;
    const s16x4 l0 = tr_read<B0>(vb), h0 = tr_read<B0 + HF>(vb), l1 = tr_read<B0 + KS>(vb), h1 = tr_read<B0 + KS + HF>(vb);
    const s16x4 l2 = tr_read<B0 + 2 * KS>(vb), h2 = tr_read<B0 + 2 * KS + HF>(vb), l3 = tr_read<B0 + 3 * KS>(vb), h3 = tr_read<B0 + 3 * KS + HF>(vb);
    asm volatile("s_waitcnt lgkmcnt(0)" ::: "memory"); FA_SBAR();
#define FA_PK(L, H) (bf16x8){L[0], L[1], L[2], L[3], H[0], H[1], H[2], H[3]}
    od = __builtin_amdgcn_mfma_f32_32x32x16_bf16(pa0, FA_PK(l0, h0), od, 0, 0, 0);
    od = __builtin_amdgcn_mfma_f32_32x32x16_bf16(pa1, FA_PK(l1, h1), od, 0, 0, 0);
    od = __builtin_amdgcn_mfma_f32_32x32x16_bf16(pa2, FA_PK(l2, h2), od, 0, 0, 0);
    od = __builtin_amdgcn_mfma_f32_32x32x16_bf16(pa3, FA_PK(l3, h3), od, 0, 0, 0);
#undef FA_PK
}
__device__ __forceinline__ void pl_ones(f32x16& lacc, bf16x8 pa0, bf16x8 pa1, bf16x8 pa2, bf16x8 pa3) {
    const bf16x8 one = (bf16x8){0x3F80, 0x3F80, 0x3F80, 0x3F80, 0x3F80, 0x3F80, 0x3F80, 0x3F80};
    lacc = __builtin_amdgcn_mfma_f32_32x32x16_bf16(pa0, one, lacc, 0, 0, 0); lacc = __builtin_amdgcn_mfma_f32_32x32x16_bf16(pa1, one, lacc, 0, 0, 0);
    lacc = __builtin_amdgcn_mfma_f32_32x32x16_bf16(pa2, one, lacc, 0, 0, 0); lacc = __builtin_amdgcn_mfma_f32_32x32x16_bf16(pa3, one, lacc, 0, 0, 0);
}
__device__ __forceinline__ bf16x8 cvt8(const float* v) { u32x4 w = {cvtpk(v[0], v[1]), cvtpk(v[2], v[3]), cvtpk(v[4], v[5]), cvtpk(v[6], v[7])}; return *reinterpret_cast<bf16x8*>(&w); }

constexpr int MLA_KP = 208, MLA_SHM_K = 64 * MLA_KP, MLA_SHM_V = 64 * 64 * 2, MLA_WS = 3 * MLA_SHM_V + 3 * MLA_SHM_K;
__device__ __forceinline__ void mla_unit(int b, int h, int qb, const bf16_t* __restrict__ QALL, const bf16_t* __restrict__ KV, const bf16_t* __restrict__ KR,
                                         const float* __restrict__ cosT, const float* __restrict__ sinT, bf16_t* __restrict__ Y, LAS unsigned char* lds) {
    const int tid = threadIdx.x, wid = tid >> 6, lane = tid & 63, r32 = lane & 31, hi = lane >> 5;
    LAS unsigned char* V_lds = lds; LAS unsigned char* K_lds = lds + 3 * MLA_SHM_V;
    LAS float* fl = (LAS float*)(lds + MLA_WS) + wid * 32;
    float mref = 0.f; f32x16 o[2] = {}; f32x16 lacc = {}; f32x16 negm = {}; bf16x8 qr[6];
    const size_t rowb = (size_t)b * SEQ;
    {
        const size_t qrow = rowb + qb * 256 + wid * 32 + r32;
        const bf16_t* Qw = QALL + qrow * 768 + h * 96 + hi * 8;
        const float C = 0.10206207261596575f * 1.4426950408889634f;
        float x1[8], x2[8];
#pragma unroll
        for (int d0 = 0; d0 < 6; ++d0) { const bf16x8 raw = *(const bf16x8*)(Qw + d0 * 16); float v[8];
#pragma unroll
            for (int j = 0; j < 8; ++j) v[j] = bf2f((bf16_t)raw[j]);
            if (d0 < 4) {
#pragma unroll
                for (int j = 0; j < 8; ++j) v[j] *= C;
                qr[d0] = cvt8(v); }
            else if (d0 == 4) {
#pragma unroll
                for (int j = 0; j < 8; ++j) x1[j] = v[j]; }
            else {
#pragma unroll
                for (int j = 0; j < 8; ++j) x2[j] = v[j]; } }
        float o1[8], o2[8];
#pragma unroll
        for (int j = 0; j < 8; ++j) { const float c = cosT[qrow * 16 + hi * 8 + j], s = sinT[qrow * 16 + hi * 8 + j]; o1[j] = (x1[j] * c - x2[j] * s) * C; o2[j] = (x2[j] * c + x1[j] * s) * C; }
        qr[4] = cvt8(o1); qr[5] = cvt8(o2);
    }
    const int sr = tid >> 3, scn = tid & 7, rr = (tid & 255) >> 2, rc = tid & 3;
    const bf16_t* gkn = KV + (rowb + sr) * 1024 + h * 128 + scn * 8;
    const bf16_t* gv = gkn + 64;
    const bf16_t* gkr = KR + (rowb + rr) * 32 + rc * 8;
    const int okn = sr * MLA_KP + scn * 16, okr = rr * MLA_KP + 128 + rc * 16, ov = v_stp<2>(sr, scn * 8);
    const int vb0 = (int)(unsigned)(uintptr_t)V_lds + v_rd_base(lane);
    bf16x8 s_kn, s_kr, s_v;
#define FA_SLOAD(k0) do { s_v = *(const bf16x8*)(gv + (size_t)(k0) * 1024); s_kn = *(const bf16x8*)(gkn + (size_t)(k0) * 1024); s_kr = *(const bf16x8*)(gkr + (size_t)(k0) * 32); } while (0)
#define FA_SWRITE(sl) do { *(LAS bf16x8*)(V_lds + (sl) * MLA_SHM_V + ov) = s_v; *(LAS bf16x8*)(K_lds + (sl) * MLA_SHM_K + okn) = s_kn; *(LAS bf16x8*)(K_lds + (sl) * MLA_SHM_K + okr) = s_kr; } while (0)
#define FA_RESC(f) do { if (f) { asm volatile("s_waitcnt lgkmcnt(0)" ::: "memory"); \
    _Pragma("unroll") for (int r = 0; r < 16; ++r) { const float f_ = fl[crow(r, hi)]; o[0][r] *= f_; o[1][r] *= f_; lacc[r] *= f_; } } } while (0)
#define FA_PV(vbx) do { pv_one<2, 0>(o[0], (vbx), pa0, pa1, pa2, pa3); pv_one<2, 1>(o[1], (vbx), pa0, pa1, pa2, pa3); pl_ones(lacc, pa0, pa1, pa2, pa3); } while (0)
#define FA_ROT() do { const int t_ = sp; sp = sc; sc = sn; sn = t_; } while (0)
    f32x16 pA0, pA1, pB0, pB1; bool rsA, rsB; float fdum; bf16x8 pa0, pa1, pa2, pa3; constexpr int NT = SEQ / 64;
    int sp = 2, sc = 0, sn = 1;
    FA_SLOAD(0); FA_SWRITE(0); FA_SLOAD(64); __syncthreads();
    FA_SWRITE(1); FA_SLOAD(128);
    qkt<6, MLA_KP>(pA0, pA1, K_lds, qr, negm, r32, hi); smA<true>(pA0, pA1, mref, negm, fl, r32, hi, rsA, fdum);
    __syncthreads(); FA_ROT();
    for (int j = 1; j + 1 < NT; j += 2) {
        FA_SWRITE(sn); FA_SLOAD((j + 2) * 64);
        FA_SBAR(); qkt<6, MLA_KP>(pB0, pB1, K_lds + sc * MLA_SHM_K, qr, negm, r32, hi);
        smB(pA0, pA1, pa0, pa1, pa2, pa3); FA_SBAR();
        FA_PV(vb0 + sp * MLA_SHM_V); smA<false>(pB0, pB1, mref, negm, fl, r32, hi, rsB, fdum);
        FA_RESC(rsB);
        __syncthreads(); FA_ROT();
        FA_SWRITE(sn); if (j + 3 < NT) FA_SLOAD((j + 3) * 64);
        FA_SBAR(); qkt<6, MLA_KP>(pA0, pA1, K_lds + sc * MLA_SHM_K, qr, negm, r32, hi);
        smB(pB0, pB1, pa0, pa1, pa2, pa3); FA_SBAR();
        FA_PV(vb0 + sp * MLA_SHM_V); smA<false>(pA0, pA1, mref, negm, fl, r32, hi, rsA, fdum);
        FA_RESC(rsA);
        __syncthreads(); FA_ROT();
    }
    FA_SBAR(); qkt<6, MLA_KP>(pB0, pB1, K_lds + sc * MLA_SHM_K, qr, negm, r32, hi);
    smB(pA0, pA1, pa0, pa1, pa2, pa3); FA_SBAR();
    FA_PV(vb0 + sp * MLA_SHM_V); smA<false>(pB0, pB1, mref, negm, fl, r32, hi, rsB, fdum);
    FA_RESC(rsB);
    smB(pB0, pB1, pa0, pa1, pa2, pa3); FA_SBAR();
    FA_PV(vb0 + sc * MLA_SHM_V);
    bf16_t* Yw = Y + (rowb + qb * 256 + wid * 32) * DM + h * 64 + r32;
#pragma unroll
    for (int r = 0; r < 16; ++r) { const int orow = crow(r, hi); const float rl = __builtin_amdgcn_rcpf(lacc[r]);
        Yw[(size_t)orow * DM] = (bf16_t)f2bf(o[0][r] * rl); Yw[(size_t)orow * DM + 32] = (bf16_t)f2bf(o[1][r] * rl); }
    __syncthreads();
#undef FA_SLOAD
#undef FA_SWRITE
#undef FA_RESC
#undef FA_PV
#undef FA_ROT
}

template <int NDQ, int KP>
__device__ __forceinline__ void qkt_o(f32x16& p0, f32x16& p1, const LAS unsigned char* Ks, const bf16x8* qr, int r32, int hi) {
    p0 = f32x16{}; p1 = f32x16{};
#pragma unroll
    for (int d0 = 0; d0 < NDQ; ++d0) { const int cb = (d0 * 16 + hi * 8) * 2;
        const bf16x8 b0 = *(const LAS bf16x8*)(Ks + r32 * KP + cb);
        const bf16x8 b1 = *(const LAS bf16x8*)(Ks + (32 + r32) * KP + cb);
        p0 = __builtin_amdgcn_mfma_f32_32x32x16_bf16(b0, qr[d0], p0, 0, 0, 0);
        p1 = __builtin_amdgcn_mfma_f32_32x32x16_bf16(b1, qr[d0], p1, 0, 0, 0);
        if ((d0 & 3) == 3) __builtin_amdgcn_sched_barrier(0); }
}
constexpr int XA_KP = 528, XA_SHM_K = 64 * XA_KP, XA_SHM_V = 64 * 128 * 2;
__device__ __forceinline__ void xattn_unit(int b, int h, int qb, const bf16_t* __restrict__ HQ, const bf16_t* __restrict__ KVM, bf16_t* __restrict__ OX, LAS unsigned char* lds) {
    const int tid = threadIdx.x, wid = tid >> 6, lane = tid & 63, r32 = lane & 31, hi = lane >> 5;
    LAS unsigned char* K_lds = lds; LAS unsigned char* V_lds = lds + XA_SHM_K;
    LAS float* fl = (LAS float*)(lds + XA_SHM_K + XA_SHM_V) + wid * 32;
    const size_t qrow0 = (size_t)b * SEQ + qb * 256 + wid * 32;
    const int ksr = tid >> 5, ksc = tid & 31;
    const bf16_t* gk = KVM + ((size_t)b * NMEM + ksr) * 2048 + h * 256 + ksc * 8;
    u32x4 pw[4][4];
    float mt[4], l_reg = 0.f, lt[4];
    {
        bf16x8 qr[16];
        { const bf16_t* Qw = HQ + (qrow0 + r32) * DM + h * 256 + hi * 8; const float C = 0.0625f * 1.4426950408889634f;
#pragma unroll
          for (int d0 = 0; d0 < 16; ++d0) { const bf16x8 raw = *(const bf16x8*)(Qw + d0 * 16); float v[8];
#pragma unroll
              for (int j = 0; j < 8; ++j) v[j] = bf2f((bf16_t)raw[j]) * C;
              qr[d0] = cvt8(v); } }
        bf16x8 sk[4];
#define XA_KLOAD(k0) do { _Pragma("unroll") for (int i = 0; i < 4; ++i) sk[i] = *(const bf16x8*)(gk + (size_t)((k0) + 16 * i) * 2048); } while (0)
#define XA_KWRITE() do { _Pragma("unroll") for (int i = 0; i < 4; ++i) *(LAS bf16x8*)(K_lds + (ksr + 16 * i) * XA_KP + ksc * 16) = sk[i]; } while (0)
        float m_run = -3.0e38f;
        XA_KLOAD(0);
#pragma unroll
        for (int t = 0; t < 4; ++t) {
            __syncthreads(); XA_KWRITE(); __syncthreads();
            if (t < 3) XA_KLOAD((t + 1) * 64);
            f32x16 p0, p1;
            qkt_o<16, XA_KP>(p0, p1, K_lds, qr, r32, hi);
            m_run = __builtin_fmaxf(m_run, rowmax32(p0, p1)); mt[t] = m_run;
            float ps = 0.f;
#pragma unroll
            for (int r = 0; r < 16; ++r) { p0[r] = __builtin_amdgcn_exp2f(p0[r] - m_run); p1[r] = __builtin_amdgcn_exp2f(p1[r] - m_run); ps += p0[r] + p1[r]; }
            { auto rr = __builtin_amdgcn_permlane32_swap(__float_as_uint(ps), __float_as_uint(ps), false, false); lt[t] = __uint_as_float(rr[0]) + __uint_as_float(rr[1]); }
            pw[t][0] = (u32x4){cvtpk_s(p0[0], p0[1]), cvtpk_s(p0[2], p0[3]), cvtpk_s(p0[4], p0[5]), cvtpk_s(p0[6], p0[7])};
            pw[t][1] = (u32x4){cvtpk_s(p0[8], p0[9]), cvtpk_s(p0[10], p0[11]), cvtpk_s(p0[12], p0[13]), cvtpk_s(p0[14], p0[15])};
            pw[t][2] = (u32x4){cvtpk_s(p1[0], p1[1]), cvtpk_s(p1[2], p1[3]), cvtpk_s(p1[4], p1[5]), cvtpk_s(p1[6], p1[7])};
            pw[t][3] = (u32x4){cvtpk_s(p1[8], p1[9]), cvtpk_s(p1[10], p1[11]), cvtpk_s(p1[12], p1[13]), cvtpk_s(p1[14], p1[15])};
        }
#undef XA_KLOAD
#undef XA_KWRITE
    }
#pragma unroll
    for (int t = 0; t < 4; ++t) {
        const float c = __builtin_amdgcn_exp2f(mt[t] - mt[3]);
        l_reg += c * lt[t];
        if (t < 3) {
#pragma unroll
            for (int k = 0; k < 4; ++k)
#pragma unroll
                for (int q = 0; q < 4; ++q) { const unsigned w = pw[t][k][q]; pw[t][k][q] = cvtpk_s(__uint_as_float(w << 16) * c, __uint_as_float(w & 0xffff0000u) * c); }
        }
    }
    if (hi == 0) fl[r32] = l_reg;
    int tid2 = tid; asm volatile("" : "+v"(tid2));
    const int vsr = tid2 >> 4, vsc = tid2 & 15, lane2 = tid2 & 63;
    const bf16_t* gv = KVM + ((size_t)b * NMEM + vsr) * 2048 + 1024 + h * 256 + vsc * 8;
    const int vb0 = (int)(unsigned)(uintptr_t)V_lds + v_rd_base(lane2);
    bf16x8 sv[2];
#define XA_VLOAD(t, vh) do { _Pragma("unroll") for (int i = 0; i < 2; ++i) sv[i] = *(const bf16x8*)(gv + (size_t)((t) * 64 + 32 * i) * 2048 + (vh) * 128); } while (0)
#define XA_VWRITE() do { _Pragma("unroll") for (int i = 0; i < 2; ++i) *(LAS bf16x8*)(V_lds + v_stp<4>(vsr + 32 * i, vsc * 8)) = sv[i]; } while (0)
    XA_VLOAD(0, 0);
#pragma unroll
    for (int vh = 0; vh < 2; ++vh) {
        f32x16 o[4] = {};
#pragma unroll
        for (int t = 0; t < 4; ++t) {
            __syncthreads(); XA_VWRITE(); __syncthreads();
            if (t < 3) XA_VLOAD(t + 1, vh); else if (vh == 0) XA_VLOAD(0, 1);
            const bf16x8 pa0 = __builtin_bit_cast(bf16x8, pw[t][0]), pa1 = __builtin_bit_cast(bf16x8, pw[t][1]), pa2 = __builtin_bit_cast(bf16x8, pw[t][2]), pa3 = __builtin_bit_cast(bf16x8, pw[t][3]);
            pv_one<4, 0>(o[0], vb0, pa0, pa1, pa2, pa3); pv_one<4, 1>(o[1], vb0, pa0, pa1, pa2, pa3); pv_one<4, 2>(o[2], vb0, pa0, pa1, pa2, pa3); pv_one<4, 3>(o[3], vb0, pa0, pa1, pa2, pa3);
        }
        asm volatile("s_waitcnt lgkmcnt(0)" ::: "memory");
        const int r32b = lane2 & 31, hib = lane2 >> 5;
        bf16_t* Ow = OX + ((size_t)b * SEQ + qb * 256 + (tid2 >> 6) * 32) * DM + h * 256 + vh * 128 + r32b;
#pragma unroll
        for (int r = 0; r < 16; ++r) { const int orow = crow(r, hib); const float rl = __builtin_amdgcn_rcpf(fl[orow]);
#pragma unroll
            for (int d0 = 0; d0 < 4; ++d0) Ow[(size_t)orow * DM + d0 * 32] = (bf16_t)f2bf(o[d0][r] * rl); }
    }
#undef XA_VLOAD
#undef XA_VWRITE
    __syncthreads();
}
}

namespace ml {
using fa::f32x16; using fa::s16x4; using fa::crow; using fa::cvtpk_s; using fa::tr_read; using fa::v_rd_base;
constexpr int RP = 272;
constexpr int L_Q = 0, L_K = 128 * RP, L_KW = 2 * 128 * RP, L_V = L_KW + 32768, L_C = L_V + 16384, L_ARR = L_C + 64 * RP, L_END = L_ARR + 8704;
static_assert(L_END <= 147200, "mLSTM LDS map");
constexpr int A_U2 = 0, A_MM2 = 128, A_A = 256, A_NEGM2 = 384, A_EW = 512, A_N = 640, A_RD = 768  , A_NLP = 1024  , A_BL = 2048  , A_MALL = 2080  , A_MP = 2112  , A_SC = 2152;
constexpr float LOG2E = 1.4426950408889634f;
constexpr size_t GT_UNIT = 32 * 3 * 128;
constexpr int NUNIT = BATCH * ML_H * 2 * 2;
#define ML_PK(L, H) (bf16x8){L[0], L[1], L[2], L[3], H[0], H[1], H[2], H[3]}
__device__ __forceinline__ float psum32(float v) { auto rr = __builtin_amdgcn_permlane32_swap(__float_as_uint(v), __float_as_uint(v), false, false); return __uint_as_float(rr[0]) + __uint_as_float(rr[1]); }

__device__ __forceinline__ void unit(int b, int h, int dir, int dh, const bf16_t* __restrict__ QKC, const bf16_t* __restrict__ Z, const float* __restrict__ G, const float* __restrict__ gbias,
                                     bf16_t* __restrict__ Hout, float* __restrict__ GT, LAS unsigned char* lds) {
    const int tid0 = threadIdx.x, wid = __builtin_amdgcn_readfirstlane(tid0 >> 6);
    int tid = tid0;
    LAS float* arr = (LAS float*)(lds + L_ARR);
    const float bias_i = gbias[dir * 8 + h], bias_f = gbias[dir * 8 + 4 + h];
    const size_t seqb = (size_t)b * SEQ;
    for (int i = tid; i < 64 * RP / 4; i += NTHR) ((LAS unsigned*)(lds + L_C))[i] = 0u;
    if (tid < 128) arr[A_N + tid] = 0.f;
    {   const int lane = tid & 63;
        for (int cc = wid; cc < SEQ / 128; cc += NWAVES) {
            const size_t row0 = seqb + (dir ? SEQ - 128 * (cc + 1) : 128 * cc);
            const int i0 = dir ? 127 - 2 * lane : 2 * lane, i1 = dir ? 126 - 2 * lane : 2 * lane + 1;
            const float f0 = G[(row0 + i0) * 16 + dir * 8 + 4 + h] + bias_f, f1 = G[(row0 + i1) * 16 + dir * 8 + 4 + h] + bias_f;
            const float g0 = G[(row0 + i0) * 16 + dir * 8 + h] + bias_i, g1 = G[(row0 + i1) * 16 + dir * 8 + h] + bias_i;
            const float lf0 = fminf(f0, 0.f) - log1pf(__expf(-fabsf(f0))), lf1 = fminf(f1, 0.f) - log1pf(__expf(-fabsf(f1)));
            float P = lf0 + lf1;
#pragma unroll
            for (int o = 1; o < 64; o <<= 1) { const float t_ = __shfl_up(P, o); if (lane >= o) P += t_; }
            const float b1 = P, b0 = P - lf1;
            const float u0 = g0 - b0, u1 = g1 - b1;
            float Pm = fmaxf(u0, u1);
#pragma unroll
            for (int o = 1; o < 64; o <<= 1) { const float t_ = __shfl_up(Pm, o); if (lane >= o) Pm = fmaxf(Pm, t_); }
            float E = __shfl_up(Pm, 1); if (lane == 0) E = -3.0e38f;
            const float M0 = fmaxf(E, u0), M1 = Pm;
            float* gt = GT + (size_t)cc * 384;
            gt[i0] = u0; gt[i1] = u1; gt[128 + i0] = M0; gt[128 + i1] = M1; gt[256 + i0] = b0; gt[256 + i1] = b1;
            if (lane == 63) { arr[A_BL + cc] = P; arr[A_MALL + cc] = Pm; }
        }
    }
    asm volatile("s_waitcnt vmcnt(0)" ::: "memory");
    __syncthreads();
    if (tid == 0) { float m = 0.f; arr[A_MP] = 0.f;
        for (int cc = 0; cc < SEQ / 128; ++cc) { m = arr[A_BL + cc] + fmaxf(m, arr[A_MALL + cc]); arr[A_MP + cc + 1] = m; } }
    __syncthreads();
    f32x16 Cacc = {};
#define ML_MAPS() const int lane = tid & 63, r32 = lane & 31, hi = lane >> 5, qr_r = tid >> 4, qr_c = tid & 15, v_r = tid >> 3, v_c = tid & 7; (void)lane; (void)r32; (void)hi
    bf16x8 sq[4], sk[4], sv[2]; float su = 0.f, sM = 0.f, sb_ = 0.f;
#define ML_LOAD(c) do { const size_t row0_ = seqb + (dir ? SEQ - 128 * ((c) + 1) : 128 * (c)); \
    _Pragma("unroll") for (int i = 0; i < 4; ++i) { const bf16_t* pq = QKC + (row0_ + qr_r + 32 * i) * 1024 + h * 128 + qr_c * 8; sq[i] = *(const bf16x8*)pq; sk[i] = *(const bf16x8*)(pq + 512); } \
    _Pragma("unroll") for (int i = 0; i < 2; ++i) sv[i] = *(const bf16x8*)(Z + (row0_ + v_r + 64 * i) * LDZ + ZC_V + h * 128 + dh * 64 + v_c * 8); \
    if (tid < 128) { const float* gt = GT + (size_t)(c) * 384 + tid; su = gt[0]; sM = gt[128]; sb_ = gt[256]; } } while (0)
#define ML_STORE(c) do { _Pragma("unroll") for (int i = 0; i < 4; ++i) { *(LAS bf16x8*)(lds + L_Q + (qr_r + 32 * i) * RP + qr_c * 16) = sq[i]; *(LAS bf16x8*)(lds + L_K + (qr_r + 32 * i) * RP + qr_c * 16) = sk[i]; } \
    _Pragma("unroll") for (int i = 0; i < 2; ++i) *(LAS bf16x8*)(lds + L_V + fa::v_stp<2>(v_r + 64 * i, v_c * 8)) = sv[i]; \
    if (tid < 128) { const float mp = arr[A_MP + (c)], mmL = fmaxf(mp, arr[A_MALL + (c)]), mm = fmaxf(mp, sM); \
        arr[A_U2 + tid] = su * LOG2E; arr[A_MM2 + tid] = mm * LOG2E; arr[A_A + tid] = __expf(mp - mm); arr[A_NEGM2 + tid] = -(sb_ + mm) * LOG2E; arr[A_EW + tid] = __expf(su - mmL); \
        if (tid == 0) arr[A_SC] = __expf(mp - mmL); } } while (0)
    { ML_MAPS(); ML_LOAD(0); }
    for (int c = 0; c < SEQ / 128; ++c) {
        asm volatile("" : "+v"(tid));
        ML_MAPS();
        const size_t row0 = seqb + (dir ? SEQ - 128 * (c + 1) : 128 * c);
        ML_STORE(c);
        __syncthreads();
#if PROBE_A >= 20 || PROBE_B >= 20
        unsigned tS1 = (unsigned)__builtin_amdgcn_s_memrealtime();
#endif
        if (c + 1 < SEQ / 128) ML_LOAD(c + 1);
        const int tb = wid & 3, dt = wid >> 2;
        {
            bf16x8 qr[8];
#pragma unroll
            for (int ks = 0; ks < 8; ++ks) qr[ks] = *(const LAS bf16x8*)(lds + L_Q + (tb * 32 + r32) * RP + (ks * 16 + hi * 8) * 2);
            float nq = 0.f;
            {   bf16x8 q8[8]; f32x4 n4[16];
#pragma unroll
                for (int cc = 0; cc < 8; ++cc) { q8[cc] = *(const LAS bf16x8*)(lds + L_Q + (tb * 32 + r32) * RP + (hi * 64 + cc * 8) * 2);
                    n4[2 * cc] = *(const LAS f32x4*)(arr + A_N + hi * 64 + cc * 8); n4[2 * cc + 1] = *(const LAS f32x4*)(arr + A_N + hi * 64 + cc * 8 + 4); }
                asm volatile("s_waitcnt lgkmcnt(0)" ::: "memory"); __builtin_amdgcn_sched_barrier(0);
#pragma unroll
                for (int cc = 0; cc < 8; ++cc) {
#pragma unroll
                    for (int j = 0; j < 4; ++j) nq += bf2f((bf16_t)q8[cc][j]) * n4[2 * cc][j] + bf2f((bf16_t)q8[cc][4 + j]) * n4[2 * cc + 1][j]; }
                nq = psum32(nq);
            }
            __syncthreads();
            const float mm2t = arr[A_MM2 + tb * 32 + r32];
            const int sb_lo = dir ? tb : 0, sb_hi = dir ? 4 : tb + 1, nsb = sb_hi - sb_lo, h0n = (nsb + 1) >> 1;
            const int my_lo = dt ? sb_lo + h0n : sb_lo, my_hi = dt ? sb_hi : sb_lo + h0n;
            LAS unsigned char* px = lds + L_Q;
            float dsum = 0.f;
            for (int sb = my_lo; sb < my_hi; ++sb) {
                bf16x8 kf[8]; f32x4 u4[4];
#pragma unroll
                for (int ks = 0; ks < 8; ++ks) kf[ks] = *(const LAS bf16x8*)(lds + L_K + (sb * 32 + r32) * RP + (ks * 16 + hi * 8) * 2);
#pragma unroll
                for (int g = 0; g < 4; ++g) u4[g] = *(const LAS f32x4*)(arr + A_U2 + sb * 32 + 8 * g + 4 * hi);
                asm volatile("s_waitcnt lgkmcnt(0)" ::: "memory"); __builtin_amdgcn_sched_barrier(0);
                f32x16 p = {};
#pragma unroll
                for (int ks = 0; ks < 8; ++ks) p = __builtin_amdgcn_mfma_f32_32x32x16_bf16(kf[ks], qr[ks], p, 0, 0, 0);
                float w[16];
#pragma unroll
                for (int r = 0; r < 16; ++r) w[r] = __builtin_amdgcn_exp2f(u4[r >> 2][r & 3] - mm2t);
                if (sb == tb) {
#pragma unroll
                    for (int r = 0; r < 16; ++r) { const int sl = crow(r, hi); const bool msk = dir ? (sl < r32) : (sl > r32); w[r] = msk ? 0.f : w[r]; }
                }
#pragma unroll
                for (int r = 0; r < 16; ++r) { p[r] *= w[r]; dsum += p[r]; }
                const u32x4 w0 = {cvtpk_s(p[0], p[1]), cvtpk_s(p[2], p[3]), cvtpk_s(p[4], p[5]), cvtpk_s(p[6], p[7])}, w1 = {cvtpk_s(p[8], p[9]), cvtpk_s(p[10], p[11]), cvtpk_s(p[12], p[13]), cvtpk_s(p[14], p[15])};
                *(LAS u32x4*)(px + (tb * 4 + sb) * 2048 + lane * 16) = w0; *(LAS u32x4*)(px + (tb * 4 + sb) * 2048 + 1024 + lane * 16) = w1;
            }
            dsum = psum32(dsum);
            if (hi == 0) *(LAS float*)(px + 32768 + ((tb * 2 + dt) * 32 + r32) * 4) = dsum;
            __syncthreads();
            f32x16 intra = {};
            const int vbase = (int)(unsigned)(uintptr_t)(lds + L_V) + v_rd_base(lane) + dt * 512;
            for (int sb = sb_lo; sb < sb_hi; ++sb) {
                const u32x4 w0 = *(const LAS u32x4*)(px + (tb * 4 + sb) * 2048 + lane * 16), w1 = *(const LAS u32x4*)(px + (tb * 4 + sb) * 2048 + 1024 + lane * 16);
                const int vb = vbase + sb * 4096;
                const s16x4 l0 = tr_read<0>(vb), h0 = tr_read<1024>(vb), l1 = tr_read<2048>(vb), h1 = tr_read<3072>(vb);
                asm volatile("s_waitcnt lgkmcnt(0)" ::: "memory"); __builtin_amdgcn_sched_barrier(0);
                intra = __builtin_amdgcn_mfma_f32_32x32x16_bf16(__builtin_bit_cast(bf16x8, w0), ML_PK(l0, h0), intra, 0, 0, 0);
                intra = __builtin_amdgcn_mfma_f32_32x32x16_bf16(__builtin_bit_cast(bf16x8, w1), ML_PK(l1, h1), intra, 0, 0, 0);
            }
            f32x16 inter = {}; bf16x8 cf[8]; f32x4 a4[4];
#pragma unroll
            for (int ks = 0; ks < 8; ++ks) cf[ks] = *(const LAS bf16x8*)(lds + L_C + (dt * 32 + r32) * RP + (ks * 16 + hi * 8) * 2);
#pragma unroll
            for (int g = 0; g < 4; ++g) a4[g] = *(const LAS f32x4*)(arr + A_A + tb * 32 + 8 * g + 4 * hi);
            const float at = arr[A_A + tb * 32 + r32], ngm = arr[A_NEGM2 + tb * 32 + r32];
            const float ds0 = *(const LAS float*)(px + 32768 + ((tb * 2) * 32 + r32) * 4), ds1 = *(const LAS float*)(px + 32768 + ((tb * 2 + 1) * 32 + r32) * 4);
            asm volatile("s_waitcnt lgkmcnt(0)" ::: "memory"); __builtin_amdgcn_sched_barrier(0);
#pragma unroll
            for (int ks = 0; ks < 8; ++ks) inter = __builtin_amdgcn_mfma_f32_32x32x16_bf16(qr[ks], cf[ks], inter, 0, 0, 0);
            const float den = (ds0 + ds1) + at * nq;
            const float rden = __builtin_amdgcn_rcpf(fmaxf(fabsf(den), __builtin_amdgcn_exp2f(ngm)));
            if (hi == 0) arr[A_RD + wid * 32 + r32] = rden;
            asm volatile("s_waitcnt lgkmcnt(0)" ::: "memory");
            f32x4 rd4[4];
#pragma unroll
            for (int g = 0; g < 4; ++g) rd4[g] = *(const LAS f32x4*)(arr + A_RD + wid * 32 + 8 * g + 4 * hi);
            bf16_t* Ho = Hout + (row0 + tb * 32) * ML_W + h * 128 + dh * 64 + dt * 32 + r32;
#pragma unroll
            for (int r = 0; r < 16; ++r) Ho[(size_t)crow(r, hi) * ML_W] = (bf16_t)f2bf((intra[r] + a4[r >> 2][r & 3] * inter[r]) * rd4[r >> 2][r & 3]);
        }
        {
            const int ec = tid & 15, s0 = tid >> 4;
            float ns[8] = {0.f, 0.f, 0.f, 0.f, 0.f, 0.f, 0.f, 0.f}; bf16x8 k8a[4]; float ewa[4];
#pragma unroll
            for (int i = 0; i < 4; ++i) { k8a[i] = *(const LAS bf16x8*)(lds + L_K + (s0 + 32 * i) * RP + ec * 16); ewa[i] = arr[A_EW + s0 + 32 * i]; }
            asm volatile("s_waitcnt lgkmcnt(0)" ::: "memory"); __builtin_amdgcn_sched_barrier(0);
#pragma unroll
            for (int i = 0; i < 4; ++i) { float kv[8];
#pragma unroll
                for (int j = 0; j < 8; ++j) { kv[j] = bf2f((bf16_t)k8a[i][j]) * ewa[i]; ns[j] += kv[j]; }
                u32x4 w_ = {cvtpk_s(kv[0], kv[1]), cvtpk_s(kv[2], kv[3]), cvtpk_s(kv[4], kv[5]), cvtpk_s(kv[6], kv[7])};
                *(LAS u32x4*)(lds + L_KW + fa::v_stp<4>(s0 + 32 * i, ec * 8)) = w_; }
#pragma unroll
            for (int j = 0; j < 8; ++j) { ns[j] += __shfl_xor(ns[j], 16); ns[j] += __shfl_xor(ns[j], 32); }
            if (lane < 16) {
#pragma unroll
                for (int j = 0; j < 8; ++j) arr[A_NLP + wid * 128 + ec * 8 + j] = ns[j]; }
        }
        __syncthreads();
#if PROBE_A >= 20 || PROBE_B >= 20
        unsigned tS3 = (unsigned)__builtin_amdgcn_s_memrealtime();
#endif
        {
            const int et = wid & 3, dt2 = wid >> 2; const float fC = arr[A_SC];
#pragma unroll
            for (int r = 0; r < 16; ++r) Cacc[r] *= fC;
            const int vb = (int)(unsigned)(uintptr_t)(lds + L_V) + v_rd_base(lane) + dt2 * 512, kb = (int)(unsigned)(uintptr_t)(lds + L_KW) + v_rd_base(lane) + et * 512;
#define ML_CRD(ks, i) const s16x4 al##i = tr_read<(ks) * 2048>(vb), ah##i = tr_read<(ks) * 2048 + 1024>(vb), bl##i = tr_read<(ks) * 4096>(kb), bh##i = tr_read<(ks) * 4096 + 2048>(kb)
#define ML_CMM(i) Cacc = __builtin_amdgcn_mfma_f32_32x32x16_bf16(ML_PK(al##i, ah##i), ML_PK(bl##i, bh##i), Cacc, 0, 0, 0)
            { ML_CRD(0, 0); ML_CRD(1, 1); ML_CRD(2, 2); ML_CRD(3, 3);
              asm volatile("s_waitcnt lgkmcnt(0)" ::: "memory"); __builtin_amdgcn_sched_barrier(0);
              ML_CMM(0); ML_CMM(1); ML_CMM(2); ML_CMM(3); }
            { ML_CRD(4, 0); ML_CRD(5, 1); ML_CRD(6, 2); ML_CRD(7, 3);
              asm volatile("s_waitcnt lgkmcnt(0)" ::: "memory"); __builtin_amdgcn_sched_barrier(0);
              ML_CMM(0); ML_CMM(1); ML_CMM(2); ML_CMM(3); }
#undef ML_CRD
#undef ML_CMM
#pragma unroll
            for (int r = 0; r < 16; ++r) *(LAS bf16_t*)(lds + L_C + (dt2 * 32 + crow(r, hi)) * RP + (et * 32 + r32) * 2) = (bf16_t)f2bf(Cacc[r]);
            if (tid < 128) { float a_ = 0.f;
#pragma unroll
                for (int w8 = 0; w8 < 8; ++w8) a_ += arr[A_NLP + w8 * 128 + tid];
                arr[A_N + tid] = fC * arr[A_N + tid] + a_; }
        }
        __syncthreads();
#if PROBE_A >= 20 || PROBE_B >= 20
        if (blockIdx.x == 0 && tid0 == 0) { volatile LAS unsigned* tsl = (volatile LAS unsigned*)(lds + 147200); const unsigned tS4 = (unsigned)__builtin_amdgcn_s_memrealtime(); tsl[13] += tS3 - tS1; tsl[14] += tS4 - tS3; }
#endif
    }
#undef ML_LOAD
#undef ML_STORE
#undef ML_MAPS
}
#undef ML_PK
}

__device__ __forceinline__ void mlstm_fast(const Params& p, LAS unsigned char* lds) {
    const int G = gridDim.x, bx = blockIdx.x;
    if (G == 256) {
        if ((bx >> 3) < 16) { const int u = (bx & 7) * 16 + (bx >> 3);
            ml::unit(u >> 4, (u >> 2) & 3, (u >> 1) & 1, u & 1, (const bf16_t*)(p.ws + WS_XB), (const bf16_t*)(p.ws + WS_Z), (const float*)(p.ws + WS_G), (const float*)(p.ws + WS_SMALL) + SM_GBIAS,
                     ((u >> 1) & 1) ? (bf16_t*)p.out + (size_t)T * ML_W : (bf16_t*)p.out, (float*)(p.ws + WS_GT) + (size_t)u * ml::GT_UNIT, lds); }
    } else {
        for (int u = bx; u < ml::NUNIT; u += G)
            ml::unit(u >> 4, (u >> 2) & 3, (u >> 1) & 1, u & 1, (const bf16_t*)(p.ws + WS_XB), (const bf16_t*)(p.ws + WS_Z), (const float*)(p.ws + WS_G), (const float*)(p.ws + WS_SMALL) + SM_GBIAS,
                     ((u >> 1) & 1) ? (bf16_t*)p.out + (size_t)T * ML_W : (bf16_t*)p.out, (float*)(p.ws + WS_GT) + (size_t)u * ml::GT_UNIT, lds);
    }
}
__device__ __forceinline__ void mla_attn_fast(const Params& p, LAS unsigned char* lds) {
    unsigned* ctr = (unsigned*)(p.ws + WS_CTL) + 8192;
    volatile LAS unsigned* slot = (volatile LAS unsigned*)(lds + 147456 - 64) + 8;
    const int myx = blockIdx.x & 7;
    for (int xo = 0; xo < 8; ++xo) {
        const int x = (myx + xo) & 7;
        for (;;) {
            if (threadIdx.x == 0) slot[0] = __hip_atomic_fetch_add(ctr + 64 * x, 1u, __ATOMIC_RELAXED, __HIP_MEMORY_SCOPE_AGENT);
            __syncthreads();
            const unsigned k = slot[0];
            __syncthreads();
            if (k >= 128u) break;
            const int bh = x + 8 * (int)(k >> 4), qb = (int)(k & 15);
            fa::mla_unit(bh >> 3, bh & 7, qb, (const bf16_t*)(p.ws + WS_QALL), (const bf16_t*)(p.ws + WS_KV), (const bf16_t*)(p.ws + WS_KR),
                         (const float*)(p.ws + WS_COS), (const float*)(p.ws + WS_SIN), (bf16_t*)(p.ws + WS_Y), lds);
        }
    }
}
__device__ __forceinline__ void phase_final(const Params& p) {
    const float* ssq = (const float*)(p.ws + WS_SSQ) + 4 * (size_t)T; const bf16_t* XB = (const bf16_t*)(p.ws + WS_XB);
    const float* fin = (const float*)(p.ws + WS_SMALL) + SM_FIN;
    const int wid = threadIdx.x >> 6, lane = threadIdx.x & 63;
    f32x4 g[2][2];
#pragma unroll
    for (int j = 0; j < 2; ++j) { g[j][0] = *(const f32x4*)(fin + j * 512 + lane * 8); g[j][1] = *(const f32x4*)(fin + j * 512 + lane * 8 + 4); }
    for (int row4 = (blockIdx.x * NWAVES + wid) * 4; row4 < T; row4 += gridDim.x * NWAVES * 4) {
        u32x4 rb[4][2]; float rs[4];
#pragma unroll
        for (int q = 0; q < 4; ++q) { rs[q] = ssq[row4 + q];
#pragma unroll
            for (int j = 0; j < 2; ++j) rb[q][j] = *(const u32x4*)(XB + (size_t)(row4 + q) * DM + j * 512 + lane * 8); }
#pragma unroll
        for (int q = 0; q < 4; ++q) { const float r = rsqrtf(rs[q] * (1.0f / DM) + EPS);
#pragma unroll
            for (int j = 0; j < 2; ++j) { const u32x4 w = rb[q][j];
                const f32x4 v0 = (f32x4){__uint_as_float(w.x << 16), __uint_as_float(w.x & 0xffff0000u), __uint_as_float(w.y << 16), __uint_as_float(w.y & 0xffff0000u)};
                const f32x4 v1 = (f32x4){__uint_as_float(w.z << 16), __uint_as_float(w.z & 0xffff0000u), __uint_as_float(w.w << 16), __uint_as_float(w.w & 0xffff0000u)};
                float* o = p.out + (size_t)(row4 + q) * DM + j * 512 + lane * 8;
                *(f32x4*)o = v0 * r * g[j][0]; *(f32x4*)(o + 4) = v1 * r * g[j][1]; } }
    }
}

#define XB_TMO      128
#define XB_XCNT(j)  (256  + 64 * (j))
#define XB_XSUB(j)  (1280 + 64 * (j))
#define XB_XGEN(j)  (2304 + 64 * (j))
#define XB_TOP      3328
#define XB_TOPGEN   3392
#define XCD_BAR_WORDS 3456
#define XB_SPIN_CAP (1u << 20)
__device__ __forceinline__ unsigned xb_ld(unsigned* p)              { return __hip_atomic_load(p, __ATOMIC_RELAXED, __HIP_MEMORY_SCOPE_AGENT); }
__device__ __forceinline__ unsigned xb_add(unsigned* p, unsigned v) { return __hip_atomic_fetch_add(p, v, __ATOMIC_RELAXED, __HIP_MEMORY_SCOPE_AGENT); }
__device__ __forceinline__ unsigned xb_xcc_id() { return (unsigned)__builtin_amdgcn_s_getreg((3 << 11) | 20) & 0xFu; }
#define XB_SPIN(cond, bar) do { unsigned _sp = 0; while (cond) { __builtin_amdgcn_s_sleep(1); \
    if ((++_sp & 255u) == 0u) { if (xb_ld(&(bar)[XB_TMO])) break; if (_sp > XB_SPIN_CAP) { atomicAdd(&(bar)[XB_TMO], 1u); break; } } } } while (0)
struct XcdBarrier { unsigned* bar; unsigned x; volatile LAS unsigned* st; };
__device__ __forceinline__ XcdBarrier xcd_barrier_post(unsigned* bar, volatile LAS unsigned* st) {
    XcdBarrier b; b.bar = bar; b.x = xb_xcc_id(); b.st = st;
    if (threadIdx.x == 0) (void)xb_add(&bar[XB_XCNT(b.x)], 1u);
    return b;
}
__device__ __forceinline__ void xcd_barrier_complete(unsigned* bar, unsigned x, unsigned& nloc, unsigned& nx) {
    const unsigned G = gridDim.x * gridDim.y * gridDim.z;
    unsigned sum, cnt, mine, sp = 0u;
    for (;;) {
        sum = 0u; cnt = 0u; mine = 0u;
#pragma unroll
        for (unsigned j = 0; j < 16; ++j) { const unsigned c = xb_ld(&bar[XB_XCNT(j)]); sum += c; cnt += (c > 0u) ? 1u : 0u; mine = (j == x) ? c : mine; }
        if (sum == G) break;
        __builtin_amdgcn_s_sleep(1);
        if ((++sp & 255u) == 0u) { if (xb_ld(&bar[XB_TMO])) break; if (sp > XB_SPIN_CAP) { atomicAdd(&bar[XB_TMO], 1u); break; } }
    }
    nloc = mine > 0u ? mine : 1u; nx = cnt > 0u ? cnt : 1u;
}
__device__ __forceinline__ void xcd_barrier(const XcdBarrier& b) {
    asm volatile("s_waitcnt vmcnt(0)" ::: "memory");
    __syncthreads();
    if (threadIdx.x == 0) {
        unsigned* bar = b.bar;
        __builtin_amdgcn_s_waitcnt(0);
        unsigned nloc = b.st[0], nx = b.st[1];
        if (nloc == 0u) { xcd_barrier_complete(bar, b.x, nloc, nx); b.st[0] = nloc; b.st[1] = nx; }
        const unsigned old = xb_add(&bar[XB_XSUB(b.x)], 1u);
        const unsigned gen = old / nloc;
        if (old + 1u == (gen + 1u) * nloc) {
            __builtin_amdgcn_fence(__ATOMIC_RELEASE, "agent");
            asm volatile("s_waitcnt vmcnt(0)" ::: "memory");
            const unsigned og = xb_add(&bar[XB_TOP], 1u);
            const unsigned tg = og / nx;
            if (og + 1u == (tg + 1u) * nx) xb_add(&bar[XB_TOPGEN], 1u);
            else XB_SPIN(xb_ld(&bar[XB_TOPGEN]) == tg, bar);
            __builtin_amdgcn_fence(__ATOMIC_ACQUIRE, "agent");
            xb_add(&bar[XB_XGEN(b.x)], 1u);
            asm volatile("s_waitcnt vmcnt(0)" ::: "memory");
        } else {
            XB_SPIN(xb_ld(&bar[XB_XGEN(b.x)]) == gen, bar);
            __builtin_amdgcn_fence(__ATOMIC_ACQUIRE, "agent");
            asm volatile("s_waitcnt vmcnt(0)" ::: "memory");
        }
    }
    __syncthreads();
}

constexpr int LDS_BYTES = 147456;
constexpr int NPHASE = 12;

#ifndef MK_N_LAUNCHES
#define MK_N_LAUNCHES 1
#endif

__global__ void __launch_bounds__(NTHR, 2) mega(Params p) {
    extern __shared__ __attribute__((aligned(16))) unsigned char lds_raw[];
    LAS unsigned char* lds = (LAS unsigned char*)lds_raw;
    unsigned char* ws = p.ws;
    float* ssq = (float*)(ws + WS_SSQ);
    const int lo = p.ph_lo, hi = p.ph_hi;
    volatile LAS unsigned* misc = (volatile LAS unsigned*)(lds + LDS_BYTES - 64);
    if (threadIdx.x < 16) misc[threadIdx.x] = 0u;
    __syncthreads();
    XcdBarrier bar; bar.bar = (unsigned*)(ws + WS_CTL) + 4096; bar.x = 0; bar.st = nullptr;
    if (hi - lo > 1) bar = xcd_barrier_post((unsigned*)(ws + WS_CTL) + 4096, misc);
#define IN(k) (lo <= (k) && (k) < hi)
#if PROBE_A >= 0 || PROBE_B >= 0
    volatile LAS unsigned* tsl = (volatile LAS unsigned*)(lds + LDS_BYTES - 256);
    if (blockIdx.x == 0 && threadIdx.x == 0) { tsl[0] = (unsigned)__builtin_amdgcn_s_memrealtime(); tsl[13] = 0u; tsl[14] = 0u; tsl[15] = 0u; }
#define SEAM(k) do { if (IN(k) && IN((k) + 1)) xcd_barrier(bar); if (blockIdx.x == 0 && threadIdx.x == 0) tsl[(k) + 1] = (unsigned)__builtin_amdgcn_s_memrealtime(); } while (0)
#else
#define SEAM(k) do { if (IN(k) && IN((k) + 1)) xcd_barrier(bar); } while (0)
#endif
    if (IN(0)) phase0(p, lds);
    SEAM(0);
    if (IN(1)) {
        Gemm g{(const bf16_t*)(ws + WS_XB), DM, (const bf16_t*)(ws + WS_WIN), DM, T, LDZ, DM};
        EpiZ E{(bf16_t*)(ws + WS_Z), ssq, ssq + T, (bf16_t*)(ws + WS_KR), (float*)(ws + WS_G), (const float*)(ws + WS_COS), (const float*)(ws + WS_SIN)};
        run_gemm(lds, g, E, (int)blockIdx.x);
    }
    SEAM(1);
    if (IN(2)) {
        { Gemm g{(const bf16_t*)(ws + WS_Z) + ZC_CQ, LDZ, (const bf16_t*)(ws + WS_WUQ), QLORA, T, MLA_H * DQK, QLORA};
          EpiScaleBf16 E{(bf16_t*)(ws + WS_QALL), MLA_H * DQK, ssq, 1.0f / QLORA, 1.0f}; run_gemm(lds, g, E, (int)blockIdx.x); }
        { Gemm g{(const bf16_t*)(ws + WS_Z) + ZC_CKV, LDZ, (const bf16_t*)(ws + WS_WUKV), 256, T, 1024, 256};
          EpiScaleBf16 E{(bf16_t*)(ws + WS_KV), 1024, ssq + T, 1.0f / KVLORA, 1.0f}; run_gemm(lds, g, E, (int)blockIdx.x); }
        phase_conv(p);
    }
    SEAM(2);
    if (IN(3)) { mlstm_fast(p, lds);
#if PROBE_A == 13
        xcd_barrier(bar); if (blockIdx.x == 0 && threadIdx.x == 0) tsl[14] = (unsigned)__builtin_amdgcn_s_memrealtime();
#endif
        mla_attn_fast(p, lds); }
    SEAM(3);
    if (IN(4)) {
        const int nb = (int)gridDim.x;
        if (nb >= 128) {
            if ((int)blockIdx.x < 64) { Gemm g{(const bf16_t*)(ws + WS_MEMN), DM, (const bf16_t*)(ws + WS_WXKV), DM, TM, 2 * DM, DM};
                EpiScaleBf16 E{(bf16_t*)(ws + WS_KVM), 2 * DM, nullptr, 0.f, 1.0f};
                StaticOrder S; S.init(g.M, g.N, 64, (int)blockIdx.x); gemm_phase<EpiScaleBf16, StaticOrder, true, true>(lds, g, S, E); }
            else phase_mlfin(p, (int)blockIdx.x - 64, nb - 64);
        } else {
            { Gemm g{(const bf16_t*)(ws + WS_MEMN), DM, (const bf16_t*)(ws + WS_WXKV), DM, TM, 2 * DM, DM};
              EpiScaleBf16 E{(bf16_t*)(ws + WS_KVM), 2 * DM, nullptr, 0.f, 1.0f}; run_gemm(lds, g, E, (int)blockIdx.x); }
            phase_mlfin(p, (int)blockIdx.x, nb);
        }
    }
    SEAM(4);
    if (IN(5)) {
        Gemm g{(const bf16_t*)(ws + WS_Y), DM, (const bf16_t*)(ws + WS_WOUT), DM, T, DM, DM};
        EpiResid E{p.x, nullptr, (bf16_t*)(ws + WS_XB), ssq + 2 * T}; run_gemm(lds, g, E, (int)blockIdx.x);
    }
    SEAM(5);
    if (IN(6)) {
        Gemm g{(const bf16_t*)(ws + WS_XB), DM, (const bf16_t*)(ws + WS_WXQ), DM, T, DM, DM};
        EpiScaleBf16 E{(bf16_t*)(ws + WS_HQ), DM, ssq + 2 * T, 1.0f / DM, 1.0f};
        StaticOrder S0; S0.init(g.M, g.N, (int)gridDim.x, (int)blockIdx.x);
        for (int ui = 0; ; ++ui) {
            Unit u; if (!S0.next(ui, u)) break;
            const SingleOrder S{S0, ui};
            gemm_phase<EpiScaleBf16, SingleOrder, true, true>(lds, g, S, E);
            asm volatile("s_waitcnt vmcnt(0)" ::: "memory"); __syncthreads();
            fa::xattn_unit(u.pm >> 4, u.pn, u.pm & 15, (const bf16_t*)(ws + WS_HQ), (const bf16_t*)(ws + WS_KVM), (bf16_t*)(ws + WS_OX), lds);
        }
    }
    SEAM(7);
    if (IN(8)) {
        Gemm g{(const bf16_t*)(ws + WS_OX), DM, (const bf16_t*)(ws + WS_WXO), DM, T, DM, DM};
        EpiResid E{nullptr, (const bf16_t*)(ws + WS_XB), (bf16_t*)(ws + WS_XB), ssq + 3 * T}; run_gemm(lds, g, E, (int)blockIdx.x);
    }
    SEAM(8);
    if (IN(9)) {
        Gemm g{(const bf16_t*)(ws + WS_XB), DM, (const bf16_t*)(ws + WS_WGU), DM, T, 2 * DFF, DM};
        EpiSwiglu E{(bf16_t*)(ws + WS_H), ssq + 3 * T}; run_gemm(lds, g, E, (int)blockIdx.x);
    }
    SEAM(9);
    if (IN(10)) {
        Gemm g{(const bf16_t*)(ws + WS_H), DFF, (const bf16_t*)(ws + WS_WD), DFF, T, DM, DFF};
        EpiResid E{nullptr, (const bf16_t*)(ws + WS_XB), (bf16_t*)(ws + WS_XB), ssq + 4 * T}; run_gemm(lds, g, E, (int)blockIdx.x);
    }
    SEAM(10);
    if (IN(11)) phase_final(p);
#if PROBE_A >= 0 || PROBE_B >= 0
    {   float* pr = (float*)(ws + WS_CTL + 65536);
        if (blockIdx.x == 0 && threadIdx.x == 0) {
            tsl[12] = 0u; asm volatile("s_waitcnt vmcnt(0)" ::: "memory"); tsl[12] = (unsigned)__builtin_amdgcn_s_memrealtime();
            float da = 0.f, db = 0.f;
            if (PROBE_A >= 0) { const float us = (float)(PROBE_A == 13 ? tsl[14] - tsl[3] : PROBE_A >= 20 ? tsl[PROBE_A - 20 + 13] : tsl[PROBE_A + 1] - tsl[PROBE_A]) * 0.01f; da = sqrtf(PROBE_A_SCALE * us); }
            if (PROBE_B >= 0) { const float us = (float)(PROBE_B >= 20 ? tsl[PROBE_B - 20 + 13] : tsl[PROBE_B + 1] - tsl[PROBE_B]) * 0.01f; db = 0.04f + PROBE_B_SCALE * us; }
            __hip_atomic_store(pr, da, __ATOMIC_RELAXED, __HIP_MEMORY_SCOPE_AGENT); __hip_atomic_store(pr + 1, db, __ATOMIC_RELAXED, __HIP_MEMORY_SCOPE_AGENT);
        }
        xcd_barrier(bar);
        const float da = __hip_atomic_load(pr, __ATOMIC_RELAXED, __HIP_MEMORY_SCOPE_AGENT), db = __hip_atomic_load(pr + 1, __ATOMIC_RELAXED, __HIP_MEMORY_SCOPE_AGENT);
        for (size_t i = (size_t)blockIdx.x * NTHR + threadIdx.x; i < (size_t)T * DM; i += (size_t)gridDim.x * NTHR) p.out[i] += da + (i == 0 ? db : 0.f);
    }
#endif
#undef IN
#undef SEAM
}

extern "C" void kernel_launch(void* const* d_in, const int* in_sizes, int n_in, void* d_out, int out_size, void* d_ws, size_t ws_size, hipStream_t stream) {
    static int grid = 0;
    if (grid == 0) {
        if (n_in != 22 || in_sizes[0] != T * DM || out_size != T * DM) { fprintf(stderr, "kernel_launch: unexpected shapes (n_in %d, in0 %d, out %d)\n", n_in, n_in > 0 ? in_sizes[0] : -1, out_size); grid = -1; return; }
        if (ws_size < WS_END) { fprintf(stderr, "kernel_launch: workspace too small: %zu\n", ws_size); grid = -1; return; }
        int dev = 0, cus = 0, per_cu = 0;
        (void)hipGetDevice(&dev); (void)hipDeviceGetAttribute(&cus, hipDeviceAttributeMultiprocessorCount, dev);
        if (hipFuncSetAttribute((const void*)mega, hipFuncAttributeMaxDynamicSharedMemorySize, LDS_BYTES) != hipSuccess) { fprintf(stderr, "kernel_launch: hipFuncSetAttribute failed\n"); grid = -1; return; }
        if (hipOccupancyMaxActiveBlocksPerMultiprocessor(&per_cu, (const void*)mega, NTHR, LDS_BYTES) != hipSuccess || per_cu < 1) { fprintf(stderr, "kernel_launch: occupancy query says %d\n", per_cu); per_cu = 1; }
        (void)hipGetLastError();
        grid = cus * (per_cu < 1 ? per_cu : 1);
        fprintf(stderr, "kernel_launch: grid %d (cus %d, per_cu %d), ws %zu MiB\n", grid, cus, per_cu, ws_size >> 20);
    }
    if (grid < 0) return;
    Params p{};
    p.x = (const float*)d_in[0]; p.mem = (const float*)d_in[1]; p.pos = (const int*)d_in[2];
    p.attn_norm = (const float*)d_in[3]; p.w_in = (const float*)d_in[4]; p.q_norm = (const float*)d_in[5]; p.w_uq = (const float*)d_in[6];
    p.kv_norm = (const float*)d_in[7]; p.w_ukv = (const float*)d_in[8]; p.conv = (const float*)d_in[9]; p.gbias = (const float*)d_in[10];
    p.ml_norm = (const float*)d_in[11]; p.w_out = (const float*)d_in[12]; p.xattn_norm = (const float*)d_in[13]; p.mem_norm = (const float*)d_in[14];
    p.w_xq = (const float*)d_in[15]; p.w_xkv = (const float*)d_in[16]; p.w_xo = (const float*)d_in[17]; p.ffn_norm = (const float*)d_in[18];
    p.w_gu = (const float*)d_in[19]; p.w_down = (const float*)d_in[20]; p.final_norm = (const float*)d_in[21];
    p.out = (float*)d_out; p.ws = (unsigned char*)d_ws;
    if (hipMemsetAsync((char*)d_ws + WS_CTL, 0, 65536, stream) != hipSuccess) { fprintf(stderr, "kernel_launch: memset failed\n"); return; }
#if MK_N_LAUNCHES == 1
    p.ph_lo = 0; p.ph_hi = NPHASE;
    { void* args[] = {&p};
      const hipError_t e = hipLaunchCooperativeKernel((const void*)mega, dim3(grid), dim3(NTHR), args, LDS_BYTES, stream);
      if (e != hipSuccess) fprintf(stderr, "kernel_launch: cooperative launch failed: %s (grid %d)\n", hipGetErrorString(e), grid); }
#else
    for (int ph = 0; ph < NPHASE; ++ph) {
        p.ph_lo = ph; p.ph_hi = ph + 1;
        hipLaunchKernelGGL(mega, dim3(grid), dim3(NTHR), LDS_BYTES, stream, p);
    }
#endif
    const hipError_t le = hipPeekAtLastError();
    if (le != hipSuccess) fprintf(stderr, "kernel_launch: launch failed: %s\n", hipGetErrorName(le));
}
```
